# Optimizing an MI355X kernel written in HIP

```python
import jax, jax.numpy as jnp
from jax import lax
import numpy as np

D_MODEL = 2048
BATCH = 8
SEQ = 2048
DEPTH = 1

CTX_LEN = 256
GRID_W = 64
D_MIX = D_MODEL
NA_HEADS = 8
HEAD_DIM = 128
D_ATTN = NA_HEADS * HEAD_DIM
D_CONV = D_MIX - D_ATTN
CONV_GROUPS = 8
CONV_W = 3
WIN_H = 8
WIN_W = 16
PEER_HEADS = 8
PEER_TOPK = 16
N_KEYS = 128
N_EXPERTS = N_KEYS * N_KEYS
PEER_QDIM = 256
PEER_BLOCK = 128
N_MOD = 6
EPS = 1e-6
NEG_INF = -1e30

kernel_name = "hymba_natten_shortconv_peer_dit"


def rms_norm(x, g):
    xf = x.astype(jnp.float32)
    y = xf * lax.rsqrt(jnp.mean(xf * xf, axis=-1, keepdims=True) + EPS)
    return (y * g.astype(jnp.float32)).astype(x.dtype)


def modulate(h, shift, scale):
    return h * (1 + scale) + shift


def split_proj(p):
    return jnp.split(p, [D_ATTN, 2 * D_ATTN, 3 * D_ATTN, 3 * D_ATTN + D_CONV, 3 * D_ATTN + 2 * D_CONV], axis=-1)


def to_heads(t):
    b, n, _ = t.shape
    return t.reshape(b, n, NA_HEADS, HEAD_DIM).transpose(0, 2, 1, 3)


def from_heads(t):
    b, h, n, d = t.shape
    return t.transpose(0, 2, 1, 3).reshape(b, n, h * d)


def group_rms(y, g):
    gs, dg = g.shape
    return rms_norm(y.reshape(*y.shape[:-1], gs, dg), g).reshape(y.shape)


def short_conv(u, b_gate, c_gate, w_conv):
    z = c_gate * u
    y = lax.conv_general_dilated(z, w_conv[:, None, :], window_strides=(1,),
                                 padding=((CONV_W // 2, CONV_W // 2),),
                                 dimension_numbers=('NWC', 'WIO', 'NWC'),
                                 feature_group_count=D_CONV)
    return b_gate * y


def neighbourhood_attention(q, k, v, k_ctx, v_ctx, rpb):
    b, h, n, dh = q.shape
    rows = n // GRID_W
    kh = min(WIN_H, rows)
    scale = dh ** -0.5
    qg = q.reshape(b, h, rows, GRID_W, dh)
    kg = k.reshape(b, h, rows, GRID_W, dh)
    vg = v.reshape(b, h, rows, GRID_W, dh)
    col = jnp.arange(GRID_W)
    col_start = jnp.clip(col - WIN_W // 2, 0, GRID_W - WIN_W)
    col_in = (col[None, :] >= col_start[:, None]) & (col[None, :] < col_start[:, None] + WIN_W)
    dc = jnp.clip(col[None, :] - col[:, None], -(WIN_W - 1), WIN_W - 1) + (WIN_W - 1)
    rpb32 = rpb.astype(jnp.float32)

    def row_block(r):
        rs = jnp.clip(r - kh // 2, 0, rows - kh)
        q_blk = lax.dynamic_index_in_dim(qg, r, axis=2, keepdims=False)
        k_blk = lax.dynamic_slice_in_dim(kg, rs, kh, axis=2)
        v_blk = lax.dynamic_slice_in_dim(vg, rs, kh, axis=2)
        s_win = jnp.einsum('bhqd,bhikd->bhqik', q_blk, k_blk).astype(jnp.float32) * scale
        dr = rs + jnp.arange(kh) - r + (WIN_H - 1)
        bias = rpb32[:, dr[None, :, None], dc[:, None, :]]
        s_win = jnp.where(col_in[:, None, :], s_win + bias, NEG_INF)
        s_ctx = jnp.einsum('bhqd,bhld->bhql', q_blk, k_ctx).astype(jnp.float32) * scale
        p = jax.nn.softmax(jnp.concatenate([s_win.reshape(b, h, GRID_W, kh * GRID_W), s_ctx], axis=-1), axis=-1)
        p = p.astype(v.dtype)
        o = jnp.einsum('bhqn,bhnd->bhqd', p[..., :kh * GRID_W], v_blk.reshape(b, h, kh * GRID_W, dh))
        return o + jnp.einsum('bhql,bhld->bhqd', p[..., kh * GRID_W:], v_ctx)

    out = lax.map(row_block, jnp.arange(rows))
    return out.transpose(1, 0, 3, 2, 4).reshape(b, n, h * dh)


def context_attention(q, k, v):
    s = jnp.einsum('bhqd,bhkd->bhqk', q, k).astype(jnp.float32) * (q.shape[-1] ** -0.5)
    p = jax.nn.softmax(s, axis=-1).astype(v.dtype)
    return from_heads(jnp.einsum('bhqk,bhkd->bhqd', p, v))


def peer(h, w_pq, sub_keys, u_tab, v_tab):
    b, n, d = h.shape
    tok = h.reshape(-1, PEER_BLOCK, d)

    def block(hb):
        nb = hb.shape[0]
        q = (hb @ w_pq).reshape(nb, PEER_HEADS, 2, PEER_QDIM // 2)
        s = jnp.einsum('nhpd,hpkd->nhpk', q, sub_keys).astype(jnp.float32)
        s_top, i_top = lax.top_k(s, PEER_TOPK)
        cand = s_top[:, :, 0, :, None] + s_top[:, :, 1, None, :]
        cand_idx = i_top[:, :, 0, :, None] * N_KEYS + i_top[:, :, 1, None, :]
        best_s, best_pos = lax.top_k(cand.reshape(nb, PEER_HEADS, PEER_TOPK * PEER_TOPK), PEER_TOPK)
        expert = jnp.take_along_axis(cand_idx.reshape(nb, PEER_HEADS, PEER_TOPK * PEER_TOPK), best_pos, axis=-1)
        gate = jax.nn.softmax(best_s, axis=-1).astype(hb.dtype).reshape(nb, PEER_HEADS * PEER_TOPK)
        expert = expert.reshape(nb, PEER_HEADS * PEER_TOPK)
        u = u_tab[expert]
        v = v_tab[expert]
        act = jax.nn.gelu(jnp.einsum('nd,ned->ne', hb, u), approximate=False) * gate
        return jnp.einsum('ne,ned->nd', act, v)

    return lax.map(block, tok).reshape(b, n, d)


def setup_inputs(seed: int = 0) -> dict:
    key = jax.random.key(seed)
    ks = jax.random.split(key, 20)
    f32 = jnp.float32
    nrm = lambda k, shape, s: jax.random.normal(k, shape, f32) * s
    gain = lambda k, shape: 1.0 + 0.05 * jax.random.normal(k, shape, f32)
    L = DEPTH
    return {
        "x": nrm(ks[0], (BATCH, SEQ, D_MODEL), 1.0),
        "c": nrm(ks[1], (BATCH, D_MODEL), 1.0),
        "ctx": nrm(ks[2], (BATCH, CTX_LEN, D_MODEL), 1.0),
        "c_ctx": nrm(ks[3], (D_MODEL,), 1.0),
        "w_ada": nrm(ks[4], (L, D_MODEL, N_MOD * D_MODEL), D_MODEL ** -0.5),
        "b_ada": nrm(ks[5], (L, N_MOD * D_MODEL), 0.02),
        "g_norm1": gain(ks[6], (L, D_MODEL)),
        "w_in": nrm(ks[7], (L, D_MODEL, 3 * D_ATTN + 3 * D_CONV), D_MODEL ** -0.5),
        "q_norm": gain(ks[8], (L, HEAD_DIM)),
        "k_norm": gain(ks[9], (L, HEAD_DIM)),
        "rpb": nrm(ks[10], (L, NA_HEADS, 2 * WIN_H - 1, 2 * WIN_W - 1), 0.1),
        "w_conv": nrm(ks[11], (L, CONV_W, D_CONV), CONV_W ** -0.5),
        "g_attn_out": gain(ks[12], (L, NA_HEADS, HEAD_DIM)),
        "g_conv_out": gain(ks[13], (L, CONV_GROUPS, D_CONV // CONV_GROUPS)),
        "w_out": nrm(ks[14], (L, D_MIX, D_MODEL), D_MIX ** -0.5),
        "g_norm2": gain(ks[15], (L, D_MODEL)),
        "w_pq": nrm(ks[16], (L, D_MODEL, PEER_HEADS * PEER_QDIM), D_MODEL ** -0.5),
        "sub_keys": nrm(ks[17], (L, PEER_HEADS, 2, N_KEYS, PEER_QDIM // 2), (PEER_QDIM // 2) ** -0.5),
        "u_experts": nrm(ks[18], (L, N_EXPERTS, D_MODEL), D_MODEL ** -0.5),
        "v_experts": nrm(ks[19], (L, N_EXPERTS, D_MODEL), PEER_HEADS ** -0.5),
    }


def reference(x, c, ctx, c_ctx, w_ada, b_ada, g_norm1, w_in, q_norm, k_norm, rpb, w_conv,
              g_attn_out, g_conv_out, w_out, g_norm2, w_pq, sub_keys, u_experts, v_experts):
    cond = jax.nn.silu(c)
    cond_ctx = jax.nn.silu(c_ctx)
    for l in range(DEPTH):
        update_ctx = l < DEPTH - 1
        mod = (cond @ w_ada[l] + b_ada[l])[:, None, :]
        mod_c = (cond_ctx @ w_ada[l] + b_ada[l])[None, None, :]
        sh1, sc1, gt1, sh2, sc2, gt2 = jnp.split(mod, N_MOD, axis=-1)
        sh1c, sc1c, gt1c, sh2c, sc2c, gt2c = jnp.split(mod_c, N_MOD, axis=-1)

        h = modulate(rms_norm(x, g_norm1[l]), sh1, sc1)
        q, k, v, bg, cg, u = split_proj(h @ w_in[l])
        q = rms_norm(to_heads(q), q_norm[l])
        k = rms_norm(to_heads(k), k_norm[l])
        v = to_heads(v)

        hc = modulate(rms_norm(ctx, g_norm1[l]), sh1c, sc1c)
        if update_ctx:
            qc, kc, vc, bgc, cgc, uc = split_proj(hc @ w_in[l])
        else:
            kc, vc = jnp.split(hc @ w_in[l][:, D_ATTN:3 * D_ATTN], 2, axis=-1)
        kc = rms_norm(to_heads(kc), k_norm[l])
        vc = to_heads(vc)

        o_attn = neighbourhood_attention(q, k, v, kc, vc, rpb[l])
        o_conv = short_conv(u, bg, cg, w_conv[l])
        y = jnp.concatenate([group_rms(o_attn, g_attn_out[l]), group_rms(o_conv, g_conv_out[l])], axis=-1) @ w_out[l]

        if update_ctx:
            oc_attn = context_attention(rms_norm(to_heads(qc), q_norm[l]), kc, vc)
            oc_conv = short_conv(uc, bgc, cgc, w_conv[l])
            yc = jnp.concatenate([group_rms(oc_attn, g_attn_out[l]), group_rms(oc_conv, g_conv_out[l])], axis=-1) @ w_out[l]
            ctx = ctx + gt1c * yc
            h2c = modulate(rms_norm(ctx, g_norm2[l]), sh2c, sc2c)
            ctx = ctx + gt2c * peer(h2c, w_pq[l], sub_keys[l], u_experts[l], v_experts[l])

        x = x + gt1 * y
        h2 = modulate(rms_norm(x, g_norm2[l]), sh2, sc2)
        x = x + gt2 * peer(h2, w_pq[l], sub_keys[l], u_experts[l], v_experts[l])
    return x
```

```cpp
#include <hip/hip_runtime.h>
#include <hip/hip_cooperative_groups.h>
#include <cstdio>
#include <cstdint>
namespace cg = cooperative_groups;
#define MK_N_LAUNCHES 1
namespace pg8 {
#define PG8_LAS __attribute__((address_space(3)))
typedef unsigned short bf16_t;
typedef short bf16x8 __attribute__((ext_vector_type(8)));
typedef float f32x4 __attribute__((ext_vector_type(4)));
typedef unsigned u32x4 __attribute__((ext_vector_type(4)));
constexpr int BM = 256, BK = 64, HALF = 128, HTB = HALF * BK * 2  , STAGE_BYTES = 8 * HTB, NXCD = 8, WGM = 8;

__host__ __device__ __forceinline__ int lds_byte(int r, int c) { const int st = (r >> 4) * 2 + (c >> 5), rr = r & 15, cc = c & 31, ob = rr * 64 + cc * 2; return st * 1024 + (ob ^ (((ob >> 9) & 1) << 5)); }
__host__ __device__ __forceinline__ void stage_rc(int b, int& R, int& C) { const int st = b / 1024, sb = b % 1024, swz = sb ^ (((sb >> 9) & 1) << 5); R = (st >> 1) * 16 + swz / 64; C = (st & 1) * 32 + (swz % 64) / 2; }
__host__ __device__ __forceinline__ int perm32(int rho) { const int n = rho >> 4, i = rho & 15; return 8 * (i >> 2) + 4 * n + (i & 3); }

struct Unit { int pm, pn; };
struct Gemm { const bf16_t* A; const bf16_t* Bt; int M, N, K; };

struct StaticOrder {
    int nM, nN, nwg, G, c;
    __host__ __device__ void init(int M, int N, int G_, int c_) { nM = M / BM; nN = N / BM; nwg = nM * nN; G = G_; c = c_; }
    __host__ __device__ bool next(int i, Unit& u) const {
        const long L = (long)i * G + c; if (L >= nwg) return false;
        int wgid = (int)L; { const int q = nwg / NXCD, r = nwg % NXCD, xcd = wgid % NXCD, off = wgid / NXCD; wgid = (xcd < r ? xcd * (q + 1) : r * (q + 1) + (xcd - r) * q) + off; }
        const int nig = WGM * nN, gid = wgid / nig, fm = gid * WGM, gsz = (nM - fm) < WGM ? (nM - fm) : WGM;
        u.pm = fm + ((wgid % nig) % gsz); u.pn = (wgid % nig) / gsz; return true;
    }
    __device__ __forceinline__ void a_ready(const Unit&) const {}
    __device__ __forceinline__ void done(const Unit&) const {}
};

__device__ __forceinline__ unsigned cvt_pk_bf16(float lo, float hi) { unsigned r; asm volatile("v_cvt_pk_bf16_f32 %0, %1, %2" : "=v"(r) : "v"(lo), "v"(hi)); return r; }
typedef float f32x2 __attribute__((ext_vector_type(2)));
template <class Epi, class Sched, bool ALIGN_EPI = false, bool SP2 = false>
__device__ __forceinline__ void gemm_phase(PG8_LAS unsigned char* lds, const Gemm g, const Sched& S, const Epi& E, const int wid) {
    int lane; asm volatile("v_mbcnt_lo_u32_b32 %0, -1, 0\n\tv_mbcnt_hi_u32_b32 %0, -1, %0" : "=v"(lane)); const int tid = wid * 64 + lane, wr = wid >> 2, wc = wid & 3, fr = lane & 15, fq = lane >> 4;
    const int K = g.K, nt = K / BK;
    unsigned voffA[2], voffB[2];
#pragma unroll
    for (int i = 0; i < 2; ++i) { int R, C; stage_rc(tid * 16 + i * 8192, R, C); const int Rb = Epi::PERM ? ((R & ~31) + perm32(R & 31)) : R;
        voffA[i] = (unsigned)(R * K + C) * 2u; voffB[i] = (unsigned)(Rb * K + C) * 2u; }
    const size_t kstep = (size_t)(BK * 2);
    const size_t hstep = (size_t)HALF * K * 2;
    const size_t tstep = 2 * hstep;
    const unsigned ldsw = (unsigned)wid * 1024u;
    const int aoff = lds_byte(wr * 64 + fr, fq * 8), boff = lds_byte(wc * 32 + fr, fq * 8);
#define PG8_SA(b, h) (((b) * 2 + (h)) * HTB)
#define PG8_SB(b, h) ((4 + (b) * 2 + (h)) * HTB)
#define PG8_STAGE(bufoff, gbase, voff) do { _Pragma("unroll") for (int _i = 0; _i < 2; ++_i) \
        __builtin_amdgcn_global_load_lds((const unsigned*)((const char*)(gbase) + (voff)[_i]), (PG8_LAS unsigned*)(lds + (bufoff) + ldsw + _i * 8192), 16, 0, 0); } while (0)
#define PG8_LDA(dst, b, h) do { _Pragma("unroll") for (int m = 0; m < 4; ++m) _Pragma("unroll") for (int k = 0; k < 2; ++k) dst[m][k] = *(const PG8_LAS bf16x8*)(lds + PG8_SA(b, h) + aoff + m * 2048 + k * 1024); } while (0)
#define PG8_LDB(dst, b, h) do { _Pragma("unroll") for (int n = 0; n < 2; ++n) _Pragma("unroll") for (int k = 0; k < 2; ++k) dst[n][k] = *(const PG8_LAS bf16x8*)(lds + PG8_SB(b, h) + boff + n * 2048 + k * 1024); } while (0)
#define PG8_MMA(ai, bj, At, Bt) do { __builtin_amdgcn_s_setprio(1); _Pragma("unroll") for (int m = 0; m < 4; ++m) _Pragma("unroll") for (int n = 0; n < 2; ++n) _Pragma("unroll") for (int k = 0; k < 2; ++k) \
        acc[ai][bj][m][n] = __builtin_amdgcn_mfma_f32_16x16x32_bf16(Bt[n][k], At[m][k], acc[ai][bj][m][n], 0, 0, 0); __builtin_amdgcn_s_setprio(0); } while (0)
#define PG8_WAIT_V(n) asm volatile("s_waitcnt vmcnt(" #n ")" ::: "memory")
#define PG8_WAIT_L(n) asm volatile("s_waitcnt lgkmcnt(" #n ")" ::: "memory")
#define PG8_BAR __builtin_amdgcn_s_barrier()
#define PG8_SCHED __builtin_amdgcn_sched_barrier(0)
    Unit cur, nxt; int ui = 0;
    if (!S.next(0, cur)) return;
    f32x4 acc[2][2][4][2];
#pragma unroll
    for (int a = 0; a < 2; ++a)
#pragma unroll
        for (int b = 0; b < 2; ++b)
#pragma unroll
            for (int m = 0; m < 4; ++m)
#pragma unroll
                for (int n = 0; n < 2; ++n) acc[a][b][m][n] = (f32x4){0.f, 0.f, 0.f, 0.f};
    bf16x8 At[4][2], B0[2][2], B1[2][2];
    const char* cA = (const char*)g.A + (size_t)cur.pm * tstep; const char* cB = (const char*)g.Bt + (size_t)cur.pn * tstep;
    S.a_ready(cur);
    if constexpr (SP2) {
        PG8_STAGE(PG8_SB(0, 0), cB, voffB); PG8_STAGE(PG8_SB(0, 1), cB + hstep, voffB); PG8_STAGE(PG8_SA(0, 0), cA, voffA); PG8_STAGE(PG8_SA(0, 1), cA + hstep, voffA);
        if (wr == 1) PG8_BAR;
        PG8_WAIT_V(2); PG8_BAR;
        PG8_STAGE(PG8_SB(1, 0), cB + kstep, voffB); PG8_STAGE(PG8_SA(1, 0), cA + kstep, voffA); PG8_STAGE(PG8_SB(1, 1), cB + hstep + kstep, voffB);
        PG8_WAIT_V(6); PG8_BAR;
    } else {
        PG8_STAGE(PG8_SB(0, 0), cB, voffB); PG8_STAGE(PG8_SA(0, 0), cA, voffA); PG8_STAGE(PG8_SB(0, 1), cB + hstep, voffB); PG8_STAGE(PG8_SA(0, 1), cA + hstep, voffA);
        if (wr == 1) PG8_BAR;
        PG8_WAIT_V(4); PG8_BAR;
        PG8_STAGE(PG8_SB(1, 0), cB + kstep, voffB); PG8_STAGE(PG8_SA(1, 0), cA + kstep, voffA); PG8_STAGE(PG8_SB(1, 1), cB + hstep + kstep, voffB);
        PG8_WAIT_V(6); PG8_BAR;
    }
    for (;;) {
        const bool has_next = S.next(ui + 1, nxt);
        const char* nA = has_next ? (const char*)g.A + (size_t)nxt.pm * tstep : cA; const char* nB = has_next ? (const char*)g.Bt + (size_t)nxt.pn * tstep : cB;
        for (int t = 0; t < nt; t += 2) {
            const bool last = (t == nt - 2);
            const char* a1 = cA + (size_t)(t + 1) * kstep;
            const char* a2 = last ? nA : cA + (size_t)(t + 2) * kstep; const char* b2 = last ? nB : cB + (size_t)(t + 2) * kstep;
            const char* a3 = a2 + kstep; const char* b3 = b2 + kstep;
            if (last && has_next) S.a_ready(nxt);
            if constexpr (SP2) {
            PG8_LDB(B0, 0, 0); PG8_LDB(B1, 0, 1); PG8_SCHED; PG8_LDA(At, 0, 0); PG8_STAGE(PG8_SA(1, 1), a1 + hstep, voffA);
            PG8_WAIT_V(8); PG8_WAIT_L(0); PG8_BAR; PG8_MMA(0, 0, At, B0); PG8_MMA(0, 1, At, B1); PG8_BAR; PG8_SCHED;
            PG8_LDA(At, 0, 1); PG8_STAGE(PG8_SB(0, 0), b2, voffB); PG8_STAGE(PG8_SB(0, 1), b2 + hstep, voffB); PG8_STAGE(PG8_SA(0, 0), a2, voffA);
            PG8_WAIT_V(8); PG8_WAIT_L(0); PG8_BAR; PG8_MMA(1, 0, At, B0); PG8_MMA(1, 1, At, B1); PG8_BAR; PG8_SCHED;
            PG8_LDB(B0, 1, 0); PG8_LDB(B1, 1, 1); PG8_SCHED; PG8_LDA(At, 1, 0); PG8_STAGE(PG8_SA(0, 1), a2 + hstep, voffA);
            PG8_WAIT_V(8); PG8_WAIT_L(0); PG8_BAR; PG8_MMA(0, 0, At, B0); PG8_MMA(0, 1, At, B1); PG8_BAR; PG8_SCHED;
            PG8_LDA(At, 1, 1); PG8_STAGE(PG8_SB(1, 0), b3, voffB); PG8_STAGE(PG8_SB(1, 1), b3 + hstep, voffB); PG8_STAGE(PG8_SA(1, 0), a3, voffA);
            PG8_WAIT_V(8); PG8_WAIT_L(0); PG8_BAR; PG8_MMA(1, 0, At, B0); PG8_MMA(1, 1, At, B1); PG8_BAR; PG8_SCHED;
            } else {
            PG8_LDB(B0, 0, 0); PG8_SCHED; PG8_LDA(At, 0, 0); PG8_STAGE(PG8_SA(1, 1), a1 + hstep, voffA);
            PG8_WAIT_L(8); PG8_BAR; PG8_WAIT_L(0); PG8_MMA(0, 0, At, B0); PG8_BAR; PG8_SCHED;
            PG8_LDB(B1, 0, 1); PG8_STAGE(PG8_SB(0, 0), b2, voffB);
            PG8_BAR; PG8_WAIT_L(0); PG8_MMA(0, 1, At, B1); PG8_BAR;
            PG8_LDA(At, 0, 1); PG8_STAGE(PG8_SA(0, 0), a2, voffA);
            PG8_BAR; PG8_WAIT_L(0); PG8_MMA(1, 0, At, B0); PG8_BAR; PG8_SCHED;
            PG8_STAGE(PG8_SB(0, 1), b2 + hstep, voffB);
            PG8_WAIT_V(6); PG8_BAR; PG8_MMA(1, 1, At, B1); PG8_BAR;
            PG8_LDB(B0, 1, 0); PG8_SCHED; PG8_LDA(At, 1, 0); PG8_STAGE(PG8_SA(0, 1), a2 + hstep, voffA);
            PG8_WAIT_L(8); PG8_BAR; PG8_WAIT_L(0); PG8_MMA(0, 0, At, B0); PG8_BAR; PG8_SCHED;
            PG8_LDB(B1, 1, 1); PG8_STAGE(PG8_SB(1, 0), b3, voffB);
            PG8_BAR; PG8_WAIT_L(0); PG8_MMA(0, 1, At, B1); PG8_BAR;
            PG8_LDA(At, 1, 1); PG8_STAGE(PG8_SA(1, 0), a3, voffA);
            PG8_BAR; PG8_WAIT_L(0); PG8_MMA(1, 0, At, B0); PG8_BAR; PG8_SCHED;
            PG8_STAGE(PG8_SB(1, 1), b3 + hstep, voffB);
            PG8_WAIT_V(6); PG8_BAR; PG8_MMA(1, 1, At, B1); PG8_BAR;
            }
        }
        if constexpr (ALIGN_EPI) { if (wr == 0) PG8_BAR; }
        if constexpr (!Epi::AFTER_DRAIN) { E(acc, cur, wr, wc, fr, fq); S.done(cur); }
        if (!has_next) break;
#pragma unroll
        for (int a = 0; a < 2; ++a)
#pragma unroll
            for (int b = 0; b < 2; ++b)
#pragma unroll
                for (int m = 0; m < 4; ++m)
#pragma unroll
                    for (int n = 0; n < 2; ++n) acc[a][b][m][n] = (f32x4){0.f, 0.f, 0.f, 0.f};
        cur = nxt; cA = nA; cB = nB; ++ui;
        if constexpr (ALIGN_EPI) { if (wr == 1) PG8_BAR; }
    }
    PG8_WAIT_V(0);
    if constexpr (!ALIGN_EPI) { if (wr == 0) PG8_BAR; }
    PG8_BAR;
    if constexpr (Epi::AFTER_DRAIN) { E.fused(acc, cur, wr, wc, fr, fq, lds, wid, lane); S.done(cur); }
#undef PG8_SA
#undef PG8_SB
#undef PG8_STAGE
#undef PG8_LDA
#undef PG8_LDB
#undef PG8_MMA
#undef PG8_WAIT_V
#undef PG8_WAIT_L
#undef PG8_BAR
#undef PG8_SCHED
}
}

#ifndef MK_N_LAUNCHES
#define MK_N_LAUNCHES 1
#endif
constexpr int NPHASE = 9;

constexpr int D = 2048, NB = 8, SEQ = 2048, M = NB * SEQ, CTXL = 256, MC = NB * CTXL;
constexpr int NH = 8, HD = 128, DA = 1024, NPROJ = 6144, GW = 64;
constexpr int NEXP = 16384, PH = 8, PK = 16, NKEYS = 128;
constexpr float EPS = 1e-6f, LOG2E = 1.4426950408889634f;
constexpr int NWAVES = 8;

constexpr size_t MiB = 1u << 20;
constexpr size_t WS_CTL = 0, WS_MOD = 1 * MiB, WS_SK = 2 * MiB, WS_WIN = 4 * MiB, WS_WOUT = 28 * MiB, WS_WPQ = 36 * MiB;
constexpr size_t WS_UT = 44 * MiB, WS_VT = 108 * MiB, WS_ACT = 172 * MiB, WS_HC = 236 * MiB;
constexpr size_t WS_Q = 244 * MiB, WS_K = 276 * MiB, WS_VTR = 308 * MiB, WS_BG = 340 * MiB, WS_CG = 372 * MiB, WS_U = 404 * MiB;
constexpr size_t WS_KC = 436 * MiB, WS_VCT = 440 * MiB, WS_QP = 244 * MiB  ;
constexpr size_t WS_SELI = 444 * MiB, WS_SELG = 452 * MiB, WS_AVW = 460 * MiB, WS_END = 468 * MiB;
constexpr size_t WS_U8 = WS_UT, WS_V8 = WS_UT + 32 * MiB, WS_SU = WS_VT, WS_SV = WS_VT + 64 * 1024, WS_H2S = WS_VT + 128 * 1024, WS_H2Q = WS_VT + 1 * MiB;

constexpr int LDS_BYTES = 147456;
constexpr int XCH_OFF = 131072;
constexpr int MISC_OFF = 131072 + 8192;
#ifndef MK_CG_SYNC
#define MK_CG_SYNC 1
#endif

#define GAS __attribute__((address_space(1)))
#define LAS __attribute__((address_space(3)))
typedef unsigned short bf16;
typedef unsigned v4u __attribute__((ext_vector_type(4)));
typedef unsigned v2u __attribute__((ext_vector_type(2)));
typedef float f32x4 __attribute__((ext_vector_type(4)));
typedef float f32x16 __attribute__((ext_vector_type(16)));
typedef short bf16x8 __attribute__((ext_vector_type(8)));
typedef __bf16 bf16x2 __attribute__((ext_vector_type(2)));
#define LDS_WAIT() asm volatile("s_waitcnt lgkmcnt(0)" ::: "memory")

__device__ __forceinline__ unsigned f2bf(float f) { unsigned u = __builtin_bit_cast(unsigned, f); return (u + 0x7fffu + ((u >> 16) & 1u)) >> 16; }
__device__ __forceinline__ unsigned pk2(float lo, float hi) { return pg8::cvt_pk_bf16(lo, hi); }
__device__ __forceinline__ float bflo(unsigned w) { return __builtin_bit_cast(float, w << 16); }
__device__ __forceinline__ float bfhi(unsigned w) { return __builtin_bit_cast(float, w & 0xffff0000u); }
__device__ __forceinline__ float dot2_bf16(unsigned w, unsigned x, float acc) { return __builtin_amdgcn_fdot2_f32_bf16(__builtin_bit_cast(bf16x2, w), __builtin_bit_cast(bf16x2, x), acc, false); }
__device__ __forceinline__ float wave_sum(float v) {
#pragma unroll
    for (int o = 1; o < 64; o <<= 1) v += __shfl_xor(v, o);
    return v;
}

struct Args { const float* in[20]; float* out; unsigned char* ws; int ph_lo, ph_hi; };
struct Frame {
    LAS unsigned char* lds;
    int wave, vcu, G;
};
__device__ __forceinline__ int lane_id() { int l; asm volatile("v_mbcnt_lo_u32_b32 %0, -1, 0\n\tv_mbcnt_hi_u32_b32 %0, -1, %0" : "=v"(l)); return l; }
#define F_LANE lane_id()
#define F_TID (F.wave * 64 + lane_id())
#define AP_x (A.in[0])
#define AP_c (A.in[1])
#define AP_ctx (A.in[2])
#define AP_c_ctx (A.in[3])
#define AP_w_ada (A.in[4])
#define AP_b_ada (A.in[5])
#define AP_g1 (A.in[6])
#define AP_w_in (A.in[7])
#define AP_qn (A.in[8])
#define AP_kn (A.in[9])
#define AP_rpb (A.in[10])
#define AP_w_conv (A.in[11])
#define AP_gao (A.in[12])
#define AP_gco (A.in[13])
#define AP_w_out (A.in[14])
#define AP_g2 (A.in[15])
#define AP_w_pq (A.in[16])
#define AP_subk (A.in[17])
#define AP_uex (A.in[18])
#define AP_vex (A.in[19])
#define AP_SK ((bf16*)(A.ws + WS_SK))
#define AP_WIN ((bf16*)(A.ws + WS_WIN))
#define AP_WOUT ((bf16*)(A.ws + WS_WOUT))
#define AP_WPQ ((bf16*)(A.ws + WS_WPQ))
#define AP_UT ((bf16*)(A.ws + WS_UT))
#define AP_VT ((bf16*)(A.ws + WS_VT))
#define AP_ACT ((bf16*)(A.ws + WS_ACT))
#define AP_HC ((bf16*)(A.ws + WS_HC))
#define AP_Q ((bf16*)(A.ws + WS_Q))
#define AP_K ((bf16*)(A.ws + WS_K))
#define AP_VTR ((bf16*)(A.ws + WS_VTR))
#define AP_BG ((bf16*)(A.ws + WS_BG))
#define AP_CG ((bf16*)(A.ws + WS_CG))
#define AP_U ((bf16*)(A.ws + WS_U))
#define AP_KC ((bf16*)(A.ws + WS_KC))
#define AP_VCT ((bf16*)(A.ws + WS_VCT))
#define AP_QP ((bf16*)(A.ws + WS_QP))
#define AP_MOD ((float*)(A.ws + WS_MOD))
#define AP_SELI ((int*)(A.ws + WS_SELI))
#define AP_SELG ((float*)(A.ws + WS_SELG))
#define AP_AVW ((float*)(A.ws + WS_AVW))
#define AP_X1B ((bf16*)(A.ws + WS_BG))
#define AP_out (A.out)
#define AP_U8 ((const unsigned char*)(A.ws + WS_U8))
#define AP_V8 ((const unsigned char*)(A.ws + WS_V8))
#define AP_SU ((float*)(A.ws + WS_SU))
#define AP_SV ((float*)(A.ws + WS_SV))
#define AP_H2S ((float*)(A.ws + WS_H2S))
#define AP_H2Q ((unsigned char*)(A.ws + WS_H2Q))


#define XB_TMO      128
#define XB_XCNT(j)  (256  + 64 * (j))
#define XB_XSUB(j)  (1280 + 64 * (j))
#define XB_XGEN(j)  (2304 + 64 * (j))
#define XB_TOP      3328
#define XB_TOPGEN   3392
#define XCD_BAR_WORDS 3456
#define XB_SPIN_CAP (1u << 22)
__device__ __forceinline__ unsigned xb_ld(unsigned* p)              { return __hip_atomic_load(p, __ATOMIC_RELAXED, __HIP_MEMORY_SCOPE_AGENT); }
__device__ __forceinline__ unsigned xb_add(unsigned* p, unsigned v) { return __hip_atomic_fetch_add(p, v, __ATOMIC_RELAXED, __HIP_MEMORY_SCOPE_AGENT); }
__device__ __forceinline__ unsigned xb_xcc_id() { return (unsigned)__builtin_amdgcn_s_getreg((3 << 11) | 20) & 0xFu; }
#define XB_SPIN(cond, bar) do { unsigned _sp = 0; while (cond) { __builtin_amdgcn_s_sleep(1); \
    if ((++_sp & 255u) == 0u) { if (xb_ld(&(bar)[XB_TMO])) break; if (_sp > XB_SPIN_CAP) { atomicAdd(&(bar)[XB_TMO], 1u); break; } } } } while (0)
struct XcdBarrier { unsigned* bar; unsigned x; volatile LAS unsigned* st; };
__device__ __forceinline__ void xcd_barrier_complete(unsigned* bar, unsigned x, unsigned G, unsigned& nloc, unsigned& nx) {
    unsigned sum, cnt, mine, sp = 0u;
    for (;;) {
        sum = 0u; cnt = 0u; mine = 0u;
#pragma unroll
        for (unsigned j = 0; j < 16; ++j) { const unsigned c = xb_ld(&bar[XB_XCNT(j)]); sum += c; cnt += (c > 0u) ? 1u : 0u; mine = (j == x) ? c : mine; }
        if (sum == G) break;
        __builtin_amdgcn_s_sleep(1);
        if ((++sp & 255u) == 0u) { if (xb_ld(&bar[XB_TMO])) break; if (sp > XB_SPIN_CAP) { atomicAdd(&bar[XB_TMO], 1u); break; } }
    }
    nloc = mine > 0u ? mine : 1u; nx = cnt > 0u ? cnt : 1u;
}
__device__ __forceinline__ void xcd_barrier(const XcdBarrier& b, const int wave, const unsigned G) {
    asm volatile("s_waitcnt vmcnt(0)" ::: "memory");
    __syncthreads();
    if (wave == 0 && lane_id() == 0) {
        unsigned* bar = b.bar;
        __builtin_amdgcn_s_waitcnt(0);
        unsigned nloc = b.st[0], nx = b.st[1];
        if (nloc == 0u) { xcd_barrier_complete(bar, b.x, G, nloc, nx); b.st[0] = nloc; b.st[1] = nx; }
        const unsigned old = xb_add(&bar[XB_XSUB(b.x)], 1u);
        const unsigned gen = old / nloc;
        if (old + 1u == (gen + 1u) * nloc) {
            __builtin_amdgcn_fence(__ATOMIC_RELEASE, "agent");
            asm volatile("s_waitcnt vmcnt(0)" ::: "memory");
            const unsigned og = xb_add(&bar[XB_TOP], 1u);
            const unsigned tg = og / nx;
            if (og + 1u == (tg + 1u) * nx) xb_add(&bar[XB_TOPGEN], 1u);
            else XB_SPIN(xb_ld(&bar[XB_TOPGEN]) == tg, bar);
            __builtin_amdgcn_fence(__ATOMIC_ACQUIRE, "agent");
            xb_add(&bar[XB_XGEN(b.x)], 1u);
            asm volatile("s_waitcnt vmcnt(0)" ::: "memory");
        } else {
            XB_SPIN(xb_ld(&bar[XB_XGEN(b.x)]) == gen, bar);
            __builtin_amdgcn_fence(__ATOMIC_ACQUIRE, "agent");
            asm volatile("s_waitcnt vmcnt(0)" ::: "memory");
        }
    }
    __syncthreads();
}

__device__ __forceinline__ void p0_mod(const Frame& F, const Args& A) {
    const int lane = lane_id(), tid = F.wave * 64 + lane; (void)tid;
    LAS float* sc = (LAS float*)F.lds;
    LAS float* red = (LAS float*)(F.lds + 9 * 2048 * 4);
    for (int i = tid; i < 9 * D; i += NWAVES * 64) { const int r = i >> 11, k = i & (D - 1); const float cv = (r < 8) ? AP_c[r * D + k] : AP_c_ctx[k]; sc[i] = cv / (1.f + __expf(-cv)); }
    __syncthreads();
    const int sr = lane >> 4, cq = lane & 15;
    for (int item = F.vcu; item < (6 * D) / 64; item += F.G) {
        const int n0 = item * 64;
        float acc[9][4];
#pragma unroll
        for (int r = 0; r < 9; ++r)
#pragma unroll
            for (int j = 0; j < 4; ++j) acc[r][j] = 0.f;
        const float* wp = AP_w_ada + (size_t)(F.wave * 4 + sr) * (6 * D) + n0 + 4 * cq;
#pragma unroll 8
        for (int step = 0; step < 64; ++step) {
            const int k = step * 32 + F.wave * 4 + sr;
            const f32x4 w = *(const f32x4*)(wp + (size_t)step * 32 * (6 * D));
#pragma unroll
            for (int r = 0; r < 9; ++r) { const float s = sc[r * D + k]; acc[r][0] += s * w.x; acc[r][1] += s * w.y; acc[r][2] += s * w.z; acc[r][3] += s * w.w; }
        }
#pragma unroll
        for (int r = 0; r < 9; ++r)
#pragma unroll
            for (int j = 0; j < 4; ++j) { float v = acc[r][j]; v += __shfl_xor(v, 16); v += __shfl_xor(v, 32); if (sr == 0) red[(F.wave * 9 + r) * 64 + 4 * cq + j] = v; }
        __syncthreads();
        for (int i = tid; i < 9 * 64; i += NWAVES * 64) { const int r = i >> 6, cc = i & 63; float s = 0.f;
#pragma unroll
            for (int w = 0; w < 8; ++w) s += red[(w * 9 + r) * 64 + cc];
            AP_MOD[r * (6 * D) + n0 + cc] = s + AP_b_ada[n0 + cc]; }
        __syncthreads();
    }
    __syncthreads();
}
__device__ __forceinline__ void p0_transpose_item(const float* W, int K, int N, bf16* WT, LAS float* scr, int item, int lane) {
    const int nblk = N / 32, kb = item / nblk, nb = item % nblk, k0 = 64 * kb, n0 = 32 * nb;
#pragma unroll 8
    for (int i = 0; i < 32; ++i) { const int kk = 2 * i + (lane >> 5); scr[kk * 33 + (lane & 31)] = W[(size_t)(k0 + kk) * N + n0 + (lane & 31)]; }
    LDS_WAIT(); asm volatile("" ::: "memory");
    const int c = lane & 7;
#pragma unroll
    for (int j = 0; j < 4; ++j) { const int n = (lane >> 3) + 8 * j; const LAS float* s = scr + (8 * c) * 33 + n;
        v4u o; o.x = pk2(s[0 * 33], s[1 * 33]); o.y = pk2(s[2 * 33], s[3 * 33]); o.z = pk2(s[4 * 33], s[5 * 33]); o.w = pk2(s[6 * 33], s[7 * 33]);
        *(v4u*)(WT + (size_t)(n0 + n) * K + k0 + 8 * c) = o; }
    LDS_WAIT(); asm volatile("" ::: "memory");
}
__device__ __forceinline__ void cvt_f32_bf16(const float* src, bf16* dst, size_t n, size_t gtid, size_t gthreads) {
    for (size_t i = gtid * 8; i < n; i += gthreads * 8) { const f32x4 a = *(const f32x4*)(src + i), b = *(const f32x4*)(src + i + 4);
        v4u o; o.x = pk2(a.x, a.y); o.y = pk2(a.z, a.w); o.z = pk2(b.x, b.y); o.w = pk2(b.z, b.w); *(v4u*)(dst + i) = o; }
}
__device__ __forceinline__ float wave_max(float v) {
#pragma unroll
    for (int o = 1; o < 64; o <<= 1) v = fmaxf(v, __shfl_xor(v, o));
    return v;
}
__device__ __forceinline__ unsigned q4(const f32x4 v, const float inv, const int off = 0) {
    const int a = (int)__builtin_rintf(v.x * inv) + off, b = (int)__builtin_rintf(v.y * inv) + off, c = (int)__builtin_rintf(v.z * inv) + off, d = (int)__builtin_rintf(v.w * inv) + off;
    return (unsigned)(a & 255) | ((unsigned)(b & 255) << 8) | ((unsigned)(c & 255) << 16) | ((unsigned)(d & 255) << 24);
}
__device__ __forceinline__ void quant_row(const float* src, unsigned char* dst, float* scale, int lane, const int off) {
    const f32x4* xr = (const f32x4*)src + lane; f32x4 v[8]; float mx = 0.f;
#pragma unroll
    for (int j = 0; j < 8; ++j) { v[j] = xr[64 * j]; mx = fmaxf(mx, fmaxf(fmaxf(fabsf(v[j].x), fabsf(v[j].y)), fmaxf(fabsf(v[j].z), fabsf(v[j].w)))); }
    mx = fmaxf(wave_max(mx), 1e-30f);
    const float inv = 127.f / mx;
    unsigned* o = (unsigned*)dst + lane;
#pragma unroll
    for (int j = 0; j < 8; ++j) o[64 * j] = q4(v[j], inv, off);
    if (lane == 0) *scale = mx * (1.f / 127.f);
}
__device__ __forceinline__ void p0_prologue(const Frame& F, const Args& A) {
    const int lane = lane_id(), tid = F.wave * 64 + lane; (void)tid;
    p0_mod(F, A);
    LAS float* scr = (LAS float*)(F.lds + F.wave * 16384);
    const int gw = F.vcu * NWAVES + F.wave, NGW = F.G * NWAVES;
    constexpr int I_IN = (D / 64) * (NPROJ / 32), I_SQ = (D / 64) * (D / 32);
    for (int it = gw; it < I_IN + 2 * I_SQ; it += NGW) {
        int r = it;
        if (r < I_IN) { p0_transpose_item(AP_w_in, D, NPROJ, AP_WIN, scr, r, lane); continue; } r -= I_IN;
        if (r < I_SQ) { p0_transpose_item(AP_w_out, D, D, AP_WOUT, scr, r, lane); continue; } r -= I_SQ;
        p0_transpose_item(AP_w_pq, D, D, AP_WPQ, scr, r, lane);
    }
    const size_t gtid = (size_t)F.vcu * (NWAVES * 64) + tid, gth = (size_t)F.G * NWAVES * 64;
    cvt_f32_bf16(AP_subk, AP_SK, (size_t)PH * 2 * NKEYS * 128, gtid, gth);
    for (int it = gw; it < 2 * NEXP; it += NGW) {
        const int e = it >> 1; const bool isv = it & 1;
        quant_row((isv ? AP_vex : AP_uex) + (size_t)e * D, (unsigned char*)(A.ws + (isv ? WS_V8 : WS_U8)) + (size_t)e * D, (isv ? AP_SV : AP_SU) + e, lane, 0);
    }
}

__device__ __forceinline__ void norm_rows(const float* X, size_t row0, int nrows, const float* g, const float* sh, const float* sc, bf16* out, int lane, unsigned char* q8 = nullptr, float* qs = nullptr) {
    f32x4 gs[8], shv[8];
#pragma unroll
    for (int j = 0; j < 8; ++j) { const int cI = j * 64 + lane; const f32x4 gg = ((const f32x4*)g)[cI], s1 = ((const f32x4*)sc)[cI]; gs[j] = gg * (1.f + s1); shv[j] = ((const f32x4*)sh)[cI]; }
    for (int r = 0; r < nrows; ++r) {
        const f32x4* xr = (const f32x4*)(X + (row0 + r) * D) + lane;
        f32x4 v[8]; float ss = 0.f;
#pragma unroll
        for (int j = 0; j < 8; ++j) { v[j] = xr[64 * j]; ss += (v[j].x * v[j].x + v[j].y * v[j].y) + (v[j].z * v[j].z + v[j].w * v[j].w); }
        const float rstd = __builtin_amdgcn_rsqf(wave_sum(ss) * (1.f / D) + EPS);
        v2u* o8 = (v2u*)(out + (row0 + r) * D) + lane; float mx = 0.f;
#pragma unroll
        for (int j = 0; j < 8; ++j) { const f32x4 y = v[j] * rstd * gs[j] + shv[j]; v[j] = y; v2u w; w.x = pk2(y.x, y.y); w.y = pk2(y.z, y.w); o8[64 * j] = w;
            mx = fmaxf(mx, fmaxf(fmaxf(fabsf(y.x), fabsf(y.y)), fmaxf(fabsf(y.z), fabsf(y.w)))); }
        if (q8) { mx = fmaxf(wave_max(mx), 1e-30f); const float inv = 127.f / mx; unsigned* oq = (unsigned*)(q8 + (row0 + r) * D) + lane;
#pragma unroll
            for (int j = 0; j < 8; ++j) oq[64 * j] = q4(v[j], inv);
            if (lane == 0) qs[row0 + r] = mx * (1.f / 127.f); }
    }
}
__device__ __forceinline__ void norm_rows_b(const bf16* X, size_t row0, int nrows, const float* g, const float* sh, const float* sc, bf16* out, int lane, unsigned char* q8, float* qs) {
    f32x4 gs[8], shv[8];
#pragma unroll
    for (int j = 0; j < 8; ++j) { const int cI = j * 64 + lane; const f32x4 gg = ((const f32x4*)g)[cI], s1 = ((const f32x4*)sc)[cI]; gs[j] = gg * (1.f + s1); shv[j] = ((const f32x4*)sh)[cI]; }
    for (int r = 0; r < nrows; ++r) {
        const v2u* xr = (const v2u*)(X + (row0 + r) * D) + lane;
        f32x4 v[8]; float ss = 0.f;
#pragma unroll
        for (int j = 0; j < 8; ++j) { const v2u w = xr[64 * j]; v[j].x = bflo(w.x); v[j].y = bfhi(w.x); v[j].z = bflo(w.y); v[j].w = bfhi(w.y); ss += (v[j].x * v[j].x + v[j].y * v[j].y) + (v[j].z * v[j].z + v[j].w * v[j].w); }
        const float rstd = __builtin_amdgcn_rsqf(wave_sum(ss) * (1.f / D) + EPS);
        v2u* o8 = (v2u*)(out + (row0 + r) * D) + lane; float mx = 0.f;
#pragma unroll
        for (int j = 0; j < 8; ++j) { const f32x4 y = v[j] * rstd * gs[j] + shv[j]; v[j] = y; v2u w; w.x = pk2(y.x, y.y); w.y = pk2(y.z, y.w); o8[64 * j] = w;
            mx = fmaxf(mx, fmaxf(fmaxf(fabsf(y.x), fabsf(y.y)), fmaxf(fabsf(y.z), fabsf(y.w)))); }
        mx = fmaxf(wave_max(mx), 1e-30f); const float inv = 127.f / mx; unsigned* oq = (unsigned*)(q8 + (row0 + r) * D) + lane;
#pragma unroll
        for (int j = 0; j < 8; ++j) oq[64 * j] = q4(v[j], inv);
        if (lane == 0) qs[row0 + r] = mx * (1.f / 127.f);
    }
}
__device__ __forceinline__ void p1_norm1(const Frame& F, const Args& A) {
    const int lane = lane_id(), tid = F.wave * 64 + lane; (void)tid;
    const int gw = F.vcu * NWAVES + F.wave, NGW = F.G * NWAVES;
    for (int it = gw; it < M / 8; it += NGW) { const size_t row0 = (size_t)it * 8; const int b = (int)(row0 >> 11);
        norm_rows(AP_x, row0, 8, AP_g1, AP_MOD + b * 6 * D + 0 * D, AP_MOD + b * 6 * D + 1 * D, AP_ACT, lane); }
    for (int it = gw; it < MC; it += NGW) norm_rows(AP_ctx, (size_t)it, 1, AP_g1, AP_MOD + 8 * 6 * D + 0 * D, AP_MOD + 8 * 6 * D + 1 * D, AP_HC, lane);
}
__device__ __forceinline__ void p5_norm2(const Frame& F, const Args& A) {
    const int lane = lane_id(), tid = F.wave * 64 + lane; (void)tid;
    const int gw = F.vcu * NWAVES + F.wave, NGW = F.G * NWAVES;
    for (int it = gw; it < M / 8; it += NGW) { const size_t row0 = (size_t)it * 8; const int b = (int)(row0 >> 11);
        norm_rows_b(AP_X1B, row0, 8, AP_g2, AP_MOD + b * 6 * D + 3 * D, AP_MOD + b * 6 * D + 4 * D, AP_ACT, lane, AP_H2Q, AP_H2S); }
}

struct EpiProj {
    static constexpr bool PERM = true, AFTER_DRAIN = false;
    bf16 *Q, *Kp, *VTp, *BG, *CG, *U; const float *qn, *kn; LAS float* xch; int region0, tshift; float qscale;
    __device__ __forceinline__ void operator()(const f32x4 (&acc)[2][2][4][2], const pg8::Unit& u, int wr, int wc, int fr, int fq) const {
        const int region = (u.pn >> 2) + region0, pnl = u.pn & 3;
        const int rowt = wr * 64 + fr;
        if (region <= 1) {
#pragma unroll
            for (int ai = 0; ai < 2; ++ai)
#pragma unroll
                for (int m = 0; m < 4; ++m)
#pragma unroll
                    for (int bj = 0; bj < 2; ++bj) { const f32x4 a = acc[ai][bj][m][0], b = acc[ai][bj][m][1];
                        float s = (a.x * a.x + a.y * a.y) + (a.z * a.z + a.w * a.w) + (b.x * b.x + b.y * b.y) + (b.z * b.z + b.w * b.w);
                        s += __shfl_xor(s, 16); s += __shfl_xor(s, 32);
                        if (fq == 0) xch[((ai * 128 + rowt + m * 16) * 2 + bj) * 4 + wc] = s; }
            asm volatile("s_waitcnt lgkmcnt(0)" ::: "memory"); __builtin_amdgcn_s_barrier(); asm volatile("" ::: "memory");
            const float* gain = (region == 0) ? qn : kn; const float mul = (region == 0) ? qscale : 1.f; bf16* O = (region == 0) ? Q : Kp;
            const f32x4 g0 = *(const f32x4*)(gain + 32 * wc + 8 * fq), g1 = *(const f32x4*)(gain + 32 * wc + 8 * fq + 4);
#pragma unroll
            for (int ai = 0; ai < 2; ++ai)
#pragma unroll
                for (int m = 0; m < 4; ++m) { const int rt = ai * 128 + rowt + m * 16; bf16* rowp = O + (size_t)(u.pm * 256 + rt) * DA + (2 * pnl) * HD + 32 * wc + 8 * fq;
#pragma unroll
                    for (int bj = 0; bj < 2; ++bj) { const f32x4 p = *(const LAS f32x4*)(xch + (rt * 2 + bj) * 4);
                        const float rstd = __builtin_amdgcn_rsqf(((p.x + p.y) + (p.z + p.w)) * (1.f / HD) + EPS) * mul;
                        const f32x4 v0 = acc[ai][bj][m][0] * rstd * g0, v1 = acc[ai][bj][m][1] * rstd * g1;
                        v4u w; w.x = pk2(v0.x, v0.y); w.y = pk2(v0.z, v0.w); w.z = pk2(v1.x, v1.y); w.w = pk2(v1.z, v1.w);
                        *(v4u*)(rowp + bj * HD) = w; } }
        } else if (region == 2) {
            const int tmask = (1 << tshift) - 1;
#pragma unroll
            for (int ai = 0; ai < 2; ++ai)
#pragma unroll
                for (int m = 0; m < 4; ++m) { const int row = u.pm * 256 + ai * 128 + rowt + m * 16; const int b = row >> tshift, t = row & tmask;
#pragma unroll
                    for (int bj = 0; bj < 2; ++bj) { const int head = 2 * pnl + bj; bf16* base = VTp + (((size_t)(b * NH + head) * HD + 32 * wc + 8 * fq) << tshift) + t;
#pragma unroll
                        for (int n = 0; n < 2; ++n) { const f32x4 a = acc[ai][bj][m][n]; const unsigned w0 = pk2(a.x, a.y), w1 = pk2(a.z, a.w);
                            base[(size_t)(4 * n + 0) << tshift] = (bf16)(w0 & 0xffffu); base[(size_t)(4 * n + 1) << tshift] = (bf16)(w0 >> 16);
                            base[(size_t)(4 * n + 2) << tshift] = (bf16)(w1 & 0xffffu); base[(size_t)(4 * n + 3) << tshift] = (bf16)(w1 >> 16); } } }
        } else {
            bf16* O = (region == 3) ? BG : (region == 4) ? CG : U;
#pragma unroll
            for (int ai = 0; ai < 2; ++ai)
#pragma unroll
                for (int m = 0; m < 4; ++m) { bf16* rowp = O + (size_t)(u.pm * 256 + ai * 128 + rowt + m * 16) * DA + pnl * 256 + 32 * wc + 8 * fq;
#pragma unroll
                    for (int bj = 0; bj < 2; ++bj) { const f32x4 v0 = acc[ai][bj][m][0], v1 = acc[ai][bj][m][1];
                        v4u w; w.x = pk2(v0.x, v0.y); w.y = pk2(v0.z, v0.w); w.z = pk2(v1.x, v1.y); w.w = pk2(v1.z, v1.w);
                        *(v4u*)(rowp + bj * HD) = w; } }
        }
    }
};
struct EpiBf16 {
    static constexpr bool PERM = true, AFTER_DRAIN = false;
    bf16* O; int ldc;
    __device__ __forceinline__ void operator()(const f32x4 (&acc)[2][2][4][2], const pg8::Unit& u, int wr, int wc, int fr, int fq) const {
        const int row0 = u.pm * 256 + wr * 64 + fr, col0 = u.pn * 256 + wc * 32 + 8 * fq;
#pragma unroll
        for (int ai = 0; ai < 2; ++ai)
#pragma unroll
            for (int m = 0; m < 4; ++m) { bf16* rowp = O + (size_t)(row0 + ai * 128 + m * 16) * ldc + col0;
#pragma unroll
                for (int bj = 0; bj < 2; ++bj) { const f32x4 v0 = acc[ai][bj][m][0], v1 = acc[ai][bj][m][1];
                    v4u w; w.x = pk2(v0.x, v0.y); w.y = pk2(v0.z, v0.w); w.z = pk2(v1.x, v1.y); w.w = pk2(v1.z, v1.w);
                    *(v4u*)(rowp + bj * 128) = w; } }
    }
};
struct EpiRes {
    static constexpr bool PERM = true, AFTER_DRAIN = false;
    const float* base; bf16* out; const float* mod; int gofs;
    __device__ __forceinline__ void operator()(const f32x4 (&acc)[2][2][4][2], const pg8::Unit& u, int wr, int wc, int fr, int fq) const {
        const int row0 = u.pm * 256 + wr * 64 + fr, col0 = u.pn * 256 + wc * 32 + 8 * fq;
        const float* gp = mod + (size_t)(u.pm >> 3) * 6 * D + gofs + col0;
        f32x4 gv[2][2];
#pragma unroll
        for (int bj = 0; bj < 2; ++bj)
#pragma unroll
            for (int n = 0; n < 2; ++n) gv[bj][n] = *(const f32x4*)(gp + bj * 128 + 4 * n);
#pragma unroll
        for (int ai = 0; ai < 2; ++ai)
#pragma unroll
            for (int m = 0; m < 4; ++m) { const size_t off = (size_t)(row0 + ai * 128 + m * 16) * D + col0;
#pragma unroll
                for (int bj = 0; bj < 2; ++bj) { const f32x4 b0 = *(const f32x4*)(base + off + bj * 128), b1 = *(const f32x4*)(base + off + bj * 128 + 4);
                    const f32x4 v0 = b0 + gv[bj][0] * acc[ai][bj][m][0], v1 = b1 + gv[bj][1] * acc[ai][bj][m][1];
                    v4u w; w.x = pk2(v0.x, v0.y); w.y = pk2(v0.z, v0.w); w.z = pk2(v1.x, v1.y); w.w = pk2(v1.z, v1.w);
                    *(v4u*)(out + off + bj * 128) = w; }
                asm volatile("" ::: "memory"); }
    }
};

__device__ __forceinline__ void attn_phase(const Frame& F, const Args& A) {
    const int lane = lane_id(), tid = F.wave * 64 + lane; (void)tid;
    LAS float* bias = (LAS float*)(F.lds + XCH_OFF);
    LAS unsigned char* kl = F.lds + F.wave * 16384;
    LAS unsigned char* vl = kl + 8192;
    const int bh = F.vcu >> 2, b = bh >> 3, h = bh & 7;
    for (int i = tid; i < 15 * 31; i += NWAVES * 64) bias[i] = AP_rpb[h * 465 + i] * LOG2E;
    __syncthreads();
    const int r = 8 * (F.vcu & 3) + F.wave;
    const int rs = min(max(r - 4, 0), 24);
    const int q = lane & 31, hh = lane >> 5;
    const int l4 = lane >> 4, c16 = lane & 15, l2 = lane >> 2, g4 = lane & 3;
    const unsigned char* Kb = (const unsigned char*)(AP_K + (size_t)b * SEQ * DA + h * HD);
    const unsigned char* VTb = (const unsigned char*)(AP_VTR + (size_t)(b * NH + h) * HD * SEQ);
    const unsigned char* KCb = (const unsigned char*)(AP_KC + (size_t)b * CTXL * DA + h * HD);
    const unsigned char* VCb = (const unsigned char*)(AP_VCT + (size_t)(b * NH + h) * HD * CTXL);
    for (int qh = 0; qh < 2; ++qh) {
        const int c0 = qh ? 24 : 0, qcol = qh * 32 + q, cs = min(max(qcol - 8, 0), 48);
        const bf16* qp = AP_Q + (size_t)(b * SEQ + r * GW + qcol) * DA + h * HD + 32 * hh;
        bf16x8 qf[8];
#pragma unroll
        for (int s = 0; s < 8; ++s) qf[s] = *(const bf16x8*)(qp + 64 * (s >> 2) + 8 * (s & 3));
        f32x16 o[4];
#pragma unroll
        for (int db = 0; db < 4; ++db)
#pragma unroll
            for (int i = 0; i < 16; ++i) o[db][i] = 0.f;
        float mrun = -1e30f, lrun = 0.f;
        const int gsw = g4 ^ ((l2 >> 2) & 3);
#define ATT_KDMA(KB_) do { const int kb_ = (KB_); \
            if (kb_ < 10) { \
                _Pragma("unroll") for (int i_ = 0; i_ < 8; ++i_) { const int rho_ = 4 * i_ + l4; const int kk_ = kb_ * 32 + (4 * ((i_ >> 1) & 1) + 8 * (i_ & 1) + 16 * (i_ >> 2)) + l4, krow_ = (kk_ * 205) >> 13, kc_ = c0 + kk_ - krow_ * 40; \
                    __builtin_amdgcn_global_load_lds((const unsigned*)(Kb + (unsigned)(((rs + krow_) * GW + kc_) * (DA * 2) + 16 * (c16 ^ (rho_ & 15)))), (LAS unsigned*)(kl + i_ * 1024), 16, 0, 0); } \
            } else { \
                _Pragma("unroll") for (int i_ = 0; i_ < 8; ++i_) { const int rho_ = 4 * i_ + l4; const int l_ = (kb_ - 10) * 32 + (4 * ((i_ >> 1) & 1) + 8 * (i_ & 1) + 16 * (i_ >> 2)) + l4; \
                    __builtin_amdgcn_global_load_lds((const unsigned*)(KCb + (unsigned)(l_ * (DA * 2) + 16 * (c16 ^ (rho_ & 15)))), (LAS unsigned*)(kl + i_ * 1024), 16, 0, 0); } \
            } } while (0)
#define ATT_VDMA(KB_) do { const int kb_ = (KB_); \
            if (kb_ < 10) { \
                const int k0_ = kb_ * 32 + 8 * gsw, vr_ = (k0_ * 205) >> 13, vc_ = c0 + k0_ - vr_ * 40; const unsigned vo_ = (unsigned)((l2 * SEQ + (rs + vr_) * GW + vc_) * 2); \
                _Pragma("unroll") for (int i_ = 0; i_ < 8; ++i_) __builtin_amdgcn_global_load_lds((const unsigned*)(VTb + vo_ + (unsigned)(i_ * 16 * SEQ * 2)), (LAS unsigned*)(vl + i_ * 1024), 16, 0, 0); \
            } else { \
                const unsigned vo_ = (unsigned)((l2 * CTXL + (kb_ - 10) * 32 + 8 * gsw) * 2); \
                _Pragma("unroll") for (int i_ = 0; i_ < 8; ++i_) __builtin_amdgcn_global_load_lds((const unsigned*)(VCb + vo_ + (unsigned)(i_ * 16 * CTXL * 2)), (LAS unsigned*)(vl + i_ * 1024), 16, 0, 0); \
            } } while (0)
        asm volatile("s_waitcnt vmcnt(0) lgkmcnt(0)" ::: "memory");
        ATT_KDMA(0); ATT_VDMA(0);
        for (int kb = 0; kb < 18; ++kb) {
            const bool win = kb < 10;
            asm volatile("s_waitcnt vmcnt(8)" ::: "memory");
            bf16x8 kf[8];
#pragma unroll
            for (int s = 0; s < 8; ++s) kf[s] = *(const LAS bf16x8*)(kl + q * 256 + 16 * ((8 * (s >> 2) + 4 * hh + (s & 3)) ^ (q & 15)));
            asm volatile("s_waitcnt lgkmcnt(0)" ::: "memory");
            if (kb + 1 < 18) ATT_KDMA(kb + 1);
            f32x16 sa;
#pragma unroll
            for (int i = 0; i < 16; ++i) sa[i] = 0.f;
#pragma unroll
            for (int s = 0; s < 8; ++s) sa = __builtin_amdgcn_mfma_f32_32x32x16_bf16(kf[s], qf[s], sa, 0, 0, 0);
            if (win) {
#pragma unroll
                for (int i = 0; i < 16; ++i) {
                    const int g = kb * 4 + 2 * (i >> 3) + hh, w = (i & 3) + 4 * ((i >> 2) & 1);
                    const int krow = (g * 205) >> 10, kcol = c0 + 8 * (g - 5 * krow) + w;
                    const int dr = rs + krow - r + 7;
                    const int dc = min(max(kcol - qcol, -15), 15) + 15;
                    const bool inw = (unsigned)(kcol - cs) < 16u;
                    sa[i] = inw ? sa[i] + bias[dr * 31 + dc] : -1e30f;
                }
            }
            float bm = sa[0];
#pragma unroll
            for (int i = 1; i < 16; ++i) bm = fmaxf(bm, sa[i]);
            bm = fmaxf(bm, __shfl_xor(bm, 32));
            const float mnew = fmaxf(mrun, bm), alpha = __builtin_amdgcn_exp2f(mrun - mnew);
            mrun = mnew;
            float ps = 0.f;
#pragma unroll
            for (int i = 0; i < 16; ++i) { sa[i] = __builtin_amdgcn_exp2f(sa[i] - mnew); ps += sa[i]; }
            lrun = lrun * alpha + ps;
#pragma unroll
            for (int db = 0; db < 4; ++db)
#pragma unroll
                for (int i = 0; i < 16; ++i) o[db][i] *= alpha;
            bf16x8 pf[2];
#pragma unroll
            for (int s2 = 0; s2 < 2; ++s2) { v4u w; w.x = pk2(sa[8 * s2 + 0], sa[8 * s2 + 1]); w.y = pk2(sa[8 * s2 + 2], sa[8 * s2 + 3]); w.z = pk2(sa[8 * s2 + 4], sa[8 * s2 + 5]); w.w = pk2(sa[8 * s2 + 6], sa[8 * s2 + 7]); pf[s2] = __builtin_bit_cast(bf16x8, w); }
            if (kb + 1 < 18) asm volatile("s_waitcnt vmcnt(8)" ::: "memory"); else asm volatile("s_waitcnt vmcnt(0)" ::: "memory");
            bf16x8 vf[4][2];
#pragma unroll
            for (int db = 0; db < 4; ++db) { const int dd = db * 32 + q;
                vf[db][0] = *(const LAS bf16x8*)(vl + dd * 64 + 16 * ((0 + hh) ^ ((dd >> 2) & 3))); vf[db][1] = *(const LAS bf16x8*)(vl + dd * 64 + 16 * ((2 + hh) ^ ((dd >> 2) & 3))); }
            asm volatile("s_waitcnt lgkmcnt(0)" ::: "memory");
            if (kb + 1 < 18) ATT_VDMA(kb + 1);
#pragma unroll
            for (int db = 0; db < 4; ++db) { o[db] = __builtin_amdgcn_mfma_f32_32x32x16_bf16(vf[db][0], pf[0], o[db], 0, 0, 0); o[db] = __builtin_amdgcn_mfma_f32_32x32x16_bf16(vf[db][1], pf[1], o[db], 0, 0, 0); }
        }
#undef ATT_KDMA
#undef ATT_VDMA
        const float ltot = lrun + __shfl_xor(lrun, 32), inv = 1.f / ltot;
        float ss = 0.f;
#pragma unroll
        for (int db = 0; db < 4; ++db)
#pragma unroll
            for (int i = 0; i < 16; ++i) { o[db][i] *= inv; ss += o[db][i] * o[db][i]; }
        ss += __shfl_xor(ss, 32);
        const float rstd = __builtin_amdgcn_rsqf(ss * (1.f / HD) + EPS);
        bf16* op = AP_ACT + (size_t)(b * SEQ + r * GW + qcol) * D + h * HD + 4 * hh;
        const float* gp = AP_gao + h * HD + 4 * hh;
#pragma unroll
        for (int db = 0; db < 4; ++db)
#pragma unroll
            for (int i4 = 0; i4 < 4; ++i4) { const f32x4 g = *(const f32x4*)(gp + db * 32 + 8 * i4);
                v2u w; w.x = pk2(o[db][4 * i4 + 0] * rstd * g.x, o[db][4 * i4 + 1] * rstd * g.y); w.y = pk2(o[db][4 * i4 + 2] * rstd * g.z, o[db][4 * i4 + 3] * rstd * g.w);
                *(v2u*)(op + db * 32 + 8 * i4) = w; }
    }
    __syncthreads();
}

__device__ __forceinline__ void unpack16(const v4u a, const v4u b, float (&f)[16]) {
    f[0] = bflo(a.x); f[1] = bfhi(a.x); f[2] = bflo(a.y); f[3] = bfhi(a.y); f[4] = bflo(a.z); f[5] = bfhi(a.z); f[6] = bflo(a.w); f[7] = bfhi(a.w);
    f[8] = bflo(b.x); f[9] = bfhi(b.x); f[10] = bflo(b.y); f[11] = bfhi(b.y); f[12] = bflo(b.z); f[13] = bfhi(b.z); f[14] = bflo(b.w); f[15] = bfhi(b.w);
}
__device__ __forceinline__ void load_z(const bf16* CGp, const bf16* Up, size_t m, int lane, float (&z)[16]) {
    const v4u* cp = (const v4u*)(CGp + m * DA + 16 * lane); const v4u* up = (const v4u*)(Up + m * DA + 16 * lane);
    const v4u c0 = cp[0], c1 = cp[1], u0 = up[0], u1 = up[1];
    float cf[16], uf[16]; unpack16(c0, c1, cf); unpack16(u0, u1, uf);
#pragma unroll
    for (int i = 0; i < 16; ++i) z[i] = cf[i] * uf[i];
}
__device__ __forceinline__ void conv_phase(const Frame& F, const Args& A) {
    const int lane = lane_id(), tid = F.wave * 64 + lane; (void)tid;
    const int gw = F.vcu * NWAVES + F.wave, NGW = F.G * NWAVES;
    float w0[16], w1[16], w2[16], gg[16];
#pragma unroll
    for (int i = 0; i < 16; ++i) { w0[i] = AP_w_conv[0 * DA + 16 * lane + i]; w1[i] = AP_w_conv[1 * DA + 16 * lane + i]; w2[i] = AP_w_conv[2 * DA + 16 * lane + i]; gg[i] = AP_gco[16 * lane + i]; }
    for (int it = gw; it < M / 8; it += NGW) {
        const size_t m0 = (size_t)it * 8;
        float zp[16], zc[16], zn[16];
        if ((m0 & (SEQ - 1)) == 0) {
#pragma unroll
            for (int i = 0; i < 16; ++i) zp[i] = 0.f;
        } else load_z(AP_CG, AP_U, m0 - 1, lane, zp);
        load_z(AP_CG, AP_U, m0, lane, zc);
        for (int j = 0; j < 8; ++j) {
            const size_t m = m0 + j;
            if ((m & (SEQ - 1)) == SEQ - 1) {
#pragma unroll
                for (int i = 0; i < 16; ++i) zn[i] = 0.f;
            } else load_z(AP_CG, AP_U, m + 1, lane, zn);
            const v4u* bp = (const v4u*)(AP_BG + m * DA + 16 * lane); const v4u b0 = bp[0], b1 = bp[1];
            float bf[16]; unpack16(b0, b1, bf);
            float y[16], ss = 0.f;
#pragma unroll
            for (int i = 0; i < 16; ++i) { y[i] = bf[i] * (w0[i] * zp[i] + w1[i] * zc[i] + w2[i] * zn[i]); ss += y[i] * y[i]; }
            ss += __shfl_xor(ss, 1); ss += __shfl_xor(ss, 2); ss += __shfl_xor(ss, 4);
            const float rstd = __builtin_amdgcn_rsqf(ss * (1.f / 128.f) + EPS);
            v4u o0, o1;
            o0.x = pk2(y[0] * rstd * gg[0], y[1] * rstd * gg[1]); o0.y = pk2(y[2] * rstd * gg[2], y[3] * rstd * gg[3]); o0.z = pk2(y[4] * rstd * gg[4], y[5] * rstd * gg[5]); o0.w = pk2(y[6] * rstd * gg[6], y[7] * rstd * gg[7]);
            o1.x = pk2(y[8] * rstd * gg[8], y[9] * rstd * gg[9]); o1.y = pk2(y[10] * rstd * gg[10], y[11] * rstd * gg[11]); o1.z = pk2(y[12] * rstd * gg[12], y[13] * rstd * gg[13]); o1.w = pk2(y[14] * rstd * gg[14], y[15] * rstd * gg[15]);
            v4u* op = (v4u*)(AP_ACT + m * D + DA + 16 * lane); op[0] = o0; op[1] = o1;
#pragma unroll
            for (int i = 0; i < 16; ++i) { zp[i] = zc[i]; zc[i] = zn[i]; }
        }
    }
}

__device__ __forceinline__ unsigned f2key(float f) { const unsigned u = __builtin_bit_cast(unsigned, f); return (u & 0x80000000u) ? ~u : (u | 0x80000000u); }
__device__ __forceinline__ float key2f(unsigned k) { const unsigned u = (k & 0x80000000u) ? (k & 0x7fffffffu) : ~k; return __builtin_bit_cast(float, u); }
__device__ __forceinline__ void peer_select_phase(const Frame& F, const Args& A) {
    const int lane = lane_id(), tid = F.wave * 64 + lane; (void)tid;
    const int gw = F.vcu * NWAVES + F.wave, NGW = F.G * NWAVES, tk = lane & 31, hh = lane >> 5;
    LAS int* ixs = (LAS int*)(F.lds + F.wave * 8192);
    unsigned nh4 = (unsigned)(1 - hh) << 2; asm volatile("" : "+v"(nh4));
    for (int task = gw; task < (M / 32) * PH; task += NGW) {
        const int h = task & 7, tb = task >> 3; const int token = tb * 32 + tk;
        unsigned best[2][16];
#pragma unroll
        for (int p = 0; p < 2; ++p) {
            const bf16* qp = AP_QP + (size_t)token * D + h * 256 + p * 128 + 32 * hh;
            bf16x8 qf[8];
#pragma unroll
            for (int s = 0; s < 8; ++s) qf[s] = *(const bf16x8*)(qp + 64 * (s >> 2) + 8 * (s & 3));
            unsigned ky[64];
#pragma unroll
            for (int kb = 0; kb < 4; ++kb) {
                const bf16* kp = AP_SK + (size_t)((h * 2 + p) * NKEYS + kb * 32 + tk) * 128 + 32 * hh;
                bf16x8 kf[8];
#pragma unroll
                for (int s = 0; s < 8; ++s) kf[s] = *(const bf16x8*)(kp + 64 * (s >> 2) + 8 * (s & 3));
                f32x16 sa;
#pragma unroll
                for (int i = 0; i < 16; ++i) sa[i] = 0.f;
#pragma unroll
                for (int s = 0; s < 8; ++s) sa = __builtin_amdgcn_mfma_f32_32x32x16_bf16(kf[s], qf[s], sa, 0, 0, 0);
#pragma unroll
                for (int i = 0; i < 16; ++i) { const unsigned ck = (unsigned)(127 - (kb * 32 + (i & 3) + 8 * (i >> 2))) & ~4u;
                    ky[kb * 16 + i] = ((f2key(sa[i]) & ~127u) | nh4) | ck; }
                asm volatile("" ::: "memory");
            }
#pragma unroll
            for (int rnd = 0; rnd < 16; ++rnd) {
                unsigned mx = ky[0];
#pragma unroll
                for (int i = 1; i < 64; ++i) mx = max(mx, ky[i]);
                const unsigned ot = (unsigned)__shfl_xor((int)mx, 32);
                mx = max(mx, ot);
                best[p][rnd] = mx;
#pragma unroll
                for (int i = 0; i < 64; ++i) ky[i] = (ky[i] == mx) ? 0u : ky[i];
            }
        }
        float s1[16], s2[16];
#pragma unroll
        for (int i = 0; i < 16; ++i) { s1[i] = key2f(best[0][i] & ~127u); s2[i] = key2f(best[1][i] & ~127u);
            ixs[i * 64 + lane] = 127 - (int)(best[0][i] & 127u); ixs[(16 + i) * 64 + lane] = 127 - (int)(best[1][i] & 127u); }
        unsigned cd[50]; { int n = 0;
#pragma unroll
            for (int i = 0; i < 16; ++i)
#pragma unroll
                for (int j = 0; j < 16; ++j) if ((i + 1) * (j + 1) <= 16) { cd[n] = (f2key(s1[i] + s2[j]) & ~255u) | (unsigned)(255 - (16 * i + j)); ++n; } }
        unsigned win[16];
#pragma unroll
        for (int rnd = 0; rnd < 16; ++rnd) {
            unsigned mx = cd[0];
#pragma unroll
            for (int i = 1; i < 50; ++i) mx = max(mx, cd[i]);
            win[rnd] = mx;
#pragma unroll
            for (int i = 0; i < 50; ++i) cd[i] = (cd[i] == mx) ? 0u : cd[i];
        }
        LDS_WAIT();
        const float vmax = key2f(win[0] & ~255u);
        float ev[16], es = 0.f;
#pragma unroll
        for (int rnd = 0; rnd < 16; ++rnd) { ev[rnd] = __expf(key2f(win[rnd] & ~255u) - vmax); es += ev[rnd]; }
        const float ies = 1.f / es;
        if (hh == 0) {
            int* ip = AP_SELI + (size_t)token * 128 + h * 16; float* gp = AP_SELG + (size_t)token * 128 + h * 16;
#pragma unroll
            for (int rnd = 0; rnd < 16; ++rnd) { const int pos = 255 - (int)(win[rnd] & 255u); const int i1 = ixs[(pos >> 4) * 64 + lane], i2 = ixs[(16 + (pos & 15)) * 64 + lane];
                ip[rnd] = i1 * NKEYS + i2; gp[rnd] = ev[rnd] * ies; }
        }
        LDS_WAIT();
    }
}

typedef int v4i __attribute__((ext_vector_type(4)));
__device__ __forceinline__ float gelu_as(const float v) {
    const float av = fabsf(v), t = __builtin_amdgcn_rcpf(av * 0.2316418882f + 1.0f);
    float q = t * 0.5307027145f + (-0.7265760135f); q = q * t + 0.7107068705f; q = q * t + (-0.142248368f); q = q * t + 0.127414796f; q = q * t;
    const float e = __builtin_amdgcn_exp2f((v * v) * (-0.72134752044f));
    const float m = v * (q * e);
    return v < 0.f ? m : v - m;
}
constexpr int PL_WAVE = 16384, PL_EL = 8192, PL_PACC = 10240, PL_AQ = 14336, PL_SA = 15360;
__device__ __forceinline__ float wave_maxf(float v) {
#pragma unroll
    for (int o = 1; o < 64; o <<= 1) v = fmaxf(v, __shfl_xor(v, o));
    return v;
}
__device__ __forceinline__ void peer_u_phase(const Frame& F, const Args& A, float (&sa)[8]) {
    const int lane = lane_id(), p = lane >> 2, sub = lane & 3;
    LAS unsigned short* elist = (LAS unsigned short*)(F.lds + F.wave * PL_WAVE + PL_EL);
    LAS int* pacc = (LAS int*)(F.lds + F.wave * PL_WAVE + PL_PACC);
    LAS signed char* aq = (LAS signed char*)(F.lds + F.wave * PL_WAVE + PL_AQ);
    const int tok0 = F.vcu * 64 + F.wave * 8;
    for (int it = 0; it < 16; ++it) { elist[it * 64 + lane] = (unsigned short)AP_SELI[(size_t)tok0 * 128 + it * 64 + lane]; pacc[it * 64 + lane] = 0; }
    LDS_WAIT();
    v4u G0[4], G1[4], G2[4], G3[4], hreg[4];
    const unsigned char* ub = AP_U8 + 16 * sub; const unsigned char* hb = AP_H2Q + (size_t)tok0 * D + 16 * sub;
#define PU_LOAD(G_, K_) do { const int kg_ = (K_); const unsigned e_ = elist[(kg_ & 63) * 16 + p]; const unsigned char* up_ = ub + (size_t)e_ * D + 256 * (kg_ >> 6); \
            _Pragma("unroll") for (int j_ = 0; j_ < 4; ++j_) G_[j_] = *(const v4u*)(up_ + 64 * j_); } while (0)
#define PU_COMPUTE(G_, K_) do { const int kc_ = (K_), t_ = kc_ & 63; \
            if ((t_ & 7) == 0) { const unsigned char* hp_ = hb + (size_t)(t_ >> 3) * D + 256 * (kc_ >> 6); _Pragma("unroll") for (int j_ = 0; j_ < 4; ++j_) hreg[j_] = *(const v4u*)(hp_ + 64 * j_); } \
            int d0_ = 0, d1_ = 0, d2_ = 0, d3_ = 0; \
            _Pragma("unroll") for (int j_ = 0; j_ < 4; ++j_) { d0_ = __builtin_amdgcn_sdot4((int)G_[j_].x, (int)hreg[j_].x, d0_, false); d1_ = __builtin_amdgcn_sdot4((int)G_[j_].y, (int)hreg[j_].y, d1_, false); \
                d2_ = __builtin_amdgcn_sdot4((int)G_[j_].z, (int)hreg[j_].z, d2_, false); d3_ = __builtin_amdgcn_sdot4((int)G_[j_].w, (int)hreg[j_].w, d3_, false); } \
            int v_ = (d0_ + d1_) + (d2_ + d3_); \
            v_ += __builtin_amdgcn_update_dpp(0, v_, 0xB1, 0xf, 0xf, true);        \
            v_ += __builtin_amdgcn_update_dpp(0, v_, 0x4E, 0xf, 0xf, true);        \
            if (sub == 0) (void)__hip_atomic_fetch_add(pacc + t_ * 16 + p, v_, __ATOMIC_RELAXED, __HIP_MEMORY_SCOPE_WORKGROUP); } while (0)
    PU_LOAD(G0, 0); PU_LOAD(G1, 1); PU_LOAD(G2, 2); PU_LOAD(G3, 3);
    for (int k = 0; k < 512; k += 4) {
        PU_COMPUTE(G0, k);     if (k + 4 < 512) PU_LOAD(G0, k + 4);
        PU_COMPUTE(G1, k + 1); if (k + 5 < 512) PU_LOAD(G1, k + 5);
        PU_COMPUTE(G2, k + 2); if (k + 6 < 512) PU_LOAD(G2, k + 6);
        PU_COMPUTE(G3, k + 3); if (k + 7 < 512) PU_LOAD(G3, k + 7);
        if ((k & 127) == 124) __builtin_amdgcn_s_barrier();
    }
#undef PU_LOAD
#undef PU_COMPUTE
    LDS_WAIT();
#pragma unroll
    for (int t = 0; t < 8; ++t) { const int token = tok0 + t; const float hs = AP_H2S[token]; float av[2];
#pragma unroll
        for (int hf = 0; hf < 2; ++hf) { const int p = t * 128 + hf * 64 + lane; const unsigned e = elist[p];
            av[hf] = gelu_as((float)pacc[p] * AP_SU[e] * hs) * AP_SELG[(size_t)tok0 * 128 + p] * AP_SV[e]; }
        const float mx = fmaxf(wave_maxf(fmaxf(fabsf(av[0]), fabsf(av[1]))), 1e-30f), inv = 127.f / mx;
        aq[t * 128 + lane] = (signed char)(int)__builtin_rintf(av[0] * inv); aq[t * 128 + 64 + lane] = (signed char)(int)__builtin_rintf(av[1] * inv);
        sa[t] = mx * (1.f / 127.f); }
    LDS_WAIT();
}
__device__ __forceinline__ void peer_v_phase(const Frame& F, const Args& A, const float (&sa)[8]) {
    const int lane = lane_id(), n = lane & 15, kq = lane >> 4, rr = n >> 2, cc = n & 3;
    LAS unsigned char* buf = F.lds + F.wave * PL_WAVE;
    const LAS unsigned short* elist = (const LAS unsigned short*)(F.lds + F.wave * PL_WAVE + PL_EL);
    const LAS signed char* aq = (const LAS signed char*)(F.lds + F.wave * PL_WAVE + PL_AQ);
    const int tok0 = F.vcu * 64 + F.wave * 8;
    const int fsw = (rr >> 1) | ((kq & 1) << 1);
    const unsigned trbase = (unsigned)(size_t)buf + (unsigned)((8 * kq + rr) * 128 + 8 * cc);
    const int r0 = lane >> 3, c8 = lane & 7;
    v4u G0[4], G1[4], G2[4], G3[4];
    v4i accE[4], accO[4];
#pragma unroll
    for (int q = 0; q < 4; ++q) { accE[q] = (v4i){0, 0, 0, 0}; accO[q] = (v4i){0, 0, 0, 0}; }
#define PV_LOAD(G_, K_) do { const int kg_ = (K_); _Pragma("unroll") for (int i_ = 0; i_ < 4; ++i_) { const unsigned e_ = elist[(kg_ & 31) * 32 + 8 * i_ + r0]; \
            const int f_ = ((r0 >> 1) & 1) | ((i_ & 1) << 1); \
            G_[i_] = *(const v4u*)(AP_V8 + (size_t)e_ * D + 128 * (kg_ >> 5) + 32 * ((c8 >> 1) ^ f_) + 16 * (c8 & 1)); } } while (0)
#define PV_STORE(G_, B_) do { _Pragma("unroll") for (int i_ = 0; i_ < 4; ++i_) *(LAS v4u*)(buf + (B_) * 4096 + i_ * 1024 + lane * 16) = G_[i_]; } while (0)
#define PV_COMPUTE(K_, B_) do { const int kc_ = (K_), b_ = kc_ & 31, slice_ = kc_ >> 5; \
            v2u a8_ = *(const LAS v2u*)(aq + b_ * 32 + 8 * kq);                        \
            if (n != (b_ >> 2)) a8_ = (v2u){0u, 0u};                                  \
            v4i AE_, AO_; \
            AE_.x = (int)__builtin_amdgcn_perm(0u, a8_.x, 0x0c010c00u); AE_.y = (int)__builtin_amdgcn_perm(0u, a8_.x, 0x0c030c02u); AE_.z = (int)__builtin_amdgcn_perm(0u, a8_.y, 0x0c010c00u); AE_.w = (int)__builtin_amdgcn_perm(0u, a8_.y, 0x0c030c02u); \
            AO_.x = (int)__builtin_amdgcn_perm(0u, a8_.x, 0x010c000cu); AO_.y = (int)__builtin_amdgcn_perm(0u, a8_.x, 0x030c020cu); AO_.z = (int)__builtin_amdgcn_perm(0u, a8_.y, 0x010c000cu); AO_.w = (int)__builtin_amdgcn_perm(0u, a8_.y, 0x030c020cu); \
            const unsigned tb_ = trbase + (unsigned)((B_) * 4096); \
            const unsigned t0_ = tb_ + 32u * (unsigned)(0 ^ fsw), t1_ = tb_ + 32u * (unsigned)(1 ^ fsw), t2_ = tb_ + 32u * (unsigned)(2 ^ fsw), t3_ = tb_ + 32u * (unsigned)(3 ^ fsw); \
            v2u R_[4][2]; \
            asm volatile("s_waitcnt lgkmcnt(0)\n\t" \
                         "ds_read_b64_tr_b16 %0, %8\n\tds_read_b64_tr_b16 %1, %8 offset:512\n\tds_read_b64_tr_b16 %2, %9\n\tds_read_b64_tr_b16 %3, %9 offset:512\n\t" \
                         "ds_read_b64_tr_b16 %4, %10\n\tds_read_b64_tr_b16 %5, %10 offset:512\n\tds_read_b64_tr_b16 %6, %11\n\tds_read_b64_tr_b16 %7, %11 offset:512\n\ts_waitcnt lgkmcnt(0)" \
                         : "=&v"(R_[0][0]), "=&v"(R_[0][1]), "=&v"(R_[1][0]), "=&v"(R_[1][1]), "=&v"(R_[2][0]), "=&v"(R_[2][1]), "=&v"(R_[3][0]), "=&v"(R_[3][1]) : "v"(t0_), "v"(t1_), "v"(t2_), "v"(t3_) : "memory"); \
            _Pragma("unroll") for (int q_ = 0; q_ < 4; ++q_) { const v4i Bq_ = {(int)R_[q_][0].x, (int)R_[q_][0].y, (int)R_[q_][1].x, (int)R_[q_][1].y}; \
                accE[q_] = __builtin_amdgcn_mfma_i32_16x16x64_i8(AE_, Bq_, accE[q_], 0, 0, 0); \
                accO[q_] = __builtin_amdgcn_mfma_i32_16x16x64_i8(AO_, Bq_, accO[q_], 0, 0, 0); } \
            if (b_ == 31) { \
                if (kq < 2) { \
                    _Pragma("unroll") for (int i_ = 0; i_ < 4; ++i_) { const int token_ = tok0 + 4 * kq + i_; const float sat_ = kq ? sa[4 + i_] : sa[i_]; \
                        const float* gtp_ = AP_MOD + (size_t)(token_ >> 11) * 6 * D + 5 * D + 128 * slice_ + 2 * n; float* op_ = AP_out + (size_t)token_ * D + 128 * slice_ + 2 * n; \
                        const bf16* xp_ = AP_X1B + (size_t)token_ * D + 128 * slice_ + 2 * n; \
                        _Pragma("unroll") for (int q_ = 0; q_ < 4; ++q_) { typedef float f32x2t __attribute__((ext_vector_type(2))); \
                            const unsigned xw_ = *(const unsigned*)(xp_ + 32 * q_); const f32x2t g0_ = *(const f32x2t*)(gtp_ + 32 * q_); \
                            f32x2t r_; r_.x = bflo(xw_) + g0_.x * (sat_ * (float)accE[q_][i_]); r_.y = bfhi(xw_) + g0_.y * (sat_ * (float)accO[q_][i_]); \
                            *(f32x2t*)(op_ + 32 * q_) = r_; } } } \
                _Pragma("unroll") for (int q_ = 0; q_ < 4; ++q_) { accE[q_] = (v4i){0, 0, 0, 0}; accO[q_] = (v4i){0, 0, 0, 0}; } \
                if ((slice_ & 1) == 1) __builtin_amdgcn_s_barrier(); } } while (0)
    PV_LOAD(G0, 0); PV_LOAD(G1, 1); PV_LOAD(G2, 2); PV_LOAD(G3, 3); PV_STORE(G0, 0);
    for (int k = 0; k < 512; k += 4) {
        if (k + 4 < 512) PV_LOAD(G0, k + 4);
        PV_COMPUTE(k, 0);     PV_STORE(G1, 1);
        if (k + 5 < 512) PV_LOAD(G1, k + 5);
        PV_COMPUTE(k + 1, 1); PV_STORE(G2, 0);
        if (k + 6 < 512) PV_LOAD(G2, k + 6);
        PV_COMPUTE(k + 2, 0); PV_STORE(G3, 1);
        if (k + 7 < 512) PV_LOAD(G3, k + 7);
        PV_COMPUTE(k + 3, 1); if (k + 4 < 512) PV_STORE(G0, 0);
    }
#undef PV_LOAD
#undef PV_STORE
#undef PV_COMPUTE
}
__device__ __forceinline__ void peer_eval_phase(const Frame& F, const Args& A) { float sa[8]; peer_u_phase(F, A, sa); peer_v_phase(F, A, sa); }

template <bool FUSED, int ONLY>
__global__ void __launch_bounds__(NWAVES * 64, 2) mk_fwd(Args args) {
    extern __shared__ __attribute__((aligned(16))) unsigned char lds[];
    Frame F;
    F.lds = (LAS unsigned char*)lds;
    F.wave = __builtin_amdgcn_readfirstlane((int)threadIdx.x >> 6);
    F.G = gridDim.x; { const int bx = blockIdx.x; F.vcu = (F.G % 8 == 0) ? (bx % 8) * (F.G / 8) + bx / 8 : bx; }
    const Args& A = args;
    const int lo = (ONLY >= 0) ? ONLY : args.ph_lo, hi = (ONLY >= 0) ? ONLY + 1 : args.ph_hi;
#define IN(k) ((ONLY < 0 || ONLY == (k)) && lo <= (k) && (k) < hi)
    XcdBarrier bar; bar.bar = (unsigned*)(args.ws + WS_CTL); bar.x = 0; bar.st = (volatile LAS unsigned*)(F.lds + MISC_OFF);
    if constexpr (FUSED) {
        if (MK_CG_SYNC) cg::this_grid().sync();
        bar.x = xb_xcc_id();
        if (F.wave == 0 && lane_id() == 0) { bar.st[0] = 0u; bar.st[1] = 0u; (void)xb_add(&bar.bar[XB_XCNT(bar.x)], 1u); }
        __syncthreads();
    }
#define SEAM(k) do { if (FUSED && IN(k) && IN((k) + 1)) { xcd_barrier(bar, F.wave, (unsigned)F.G); } } while (0)

    if (IN(0)) { p0_prologue(F, A); } SEAM(0);
    if (IN(1)) { p1_norm1(F, A); } SEAM(1);
    if (IN(2)) {
        { pg8::Gemm g{AP_ACT, AP_WIN, M, NPROJ, D}; pg8::StaticOrder S; S.init(M, NPROJ, F.G, (int)blockIdx.x);
          EpiProj E{AP_Q, AP_K, AP_VTR, AP_BG, AP_CG, AP_U, AP_qn, AP_kn, (LAS float*)(F.lds + XCH_OFF), 0, 11, 0.08838834764831845f * LOG2E};
          pg8::gemm_phase<EpiProj, pg8::StaticOrder, true, true>(F.lds, g, S, E, F.wave); }
        { pg8::Gemm g{AP_HC, AP_WIN + (size_t)DA * D, MC, 2 * DA, D}; pg8::StaticOrder S; S.init(MC, 2 * DA, F.G, (int)blockIdx.x);
          EpiProj E{nullptr, AP_KC, AP_VCT, nullptr, nullptr, nullptr, AP_qn, AP_kn, (LAS float*)(F.lds + XCH_OFF), 1, 8, 1.f};
          pg8::gemm_phase<EpiProj, pg8::StaticOrder, true, true>(F.lds, g, S, E, F.wave); }
    } SEAM(2);
    if (IN(3)) { attn_phase(F, A); conv_phase(F, A); } SEAM(3);
    if (IN(4)) { pg8::Gemm g{AP_ACT, AP_WOUT, M, D, D}; pg8::StaticOrder S; S.init(M, D, F.G, (int)blockIdx.x);
        EpiRes E{AP_x, AP_X1B, AP_MOD, 2 * D};
        pg8::gemm_phase<EpiRes, pg8::StaticOrder, true, true>(F.lds, g, S, E, F.wave); } SEAM(4);
    if (IN(5)) { p5_norm2(F, A); } SEAM(5);
    if (IN(6)) { pg8::Gemm g{AP_ACT, AP_WPQ, M, D, D}; pg8::StaticOrder S; S.init(M, D, F.G, (int)blockIdx.x);
        EpiBf16 E{AP_QP, D};
        pg8::gemm_phase<EpiBf16, pg8::StaticOrder, true, true>(F.lds, g, S, E, F.wave); } SEAM(6);
    if (IN(7)) { peer_select_phase(F, A); } SEAM(7);
    if (IN(8)) { peer_eval_phase(F, A); }
#undef IN
#undef SEAM
}

template <int PHS> static bool set_lds() { return hipFuncSetAttribute((const void*)mk_fwd<false, PHS>, hipFuncAttributeMaxDynamicSharedMemorySize, LDS_BYTES) == hipSuccess; }
template <int PHS> static void launch_one(int grid, hipStream_t stream, const Args& a) {
    hipLaunchKernelGGL((mk_fwd<false, PHS>), dim3(grid), dim3(NWAVES * 64), LDS_BYTES, stream, a);
    const hipError_t le = hipPeekAtLastError();
    if (le != hipSuccess) fprintf(stderr, "kernel_launch: launch %d failed: %s\n", PHS, hipGetErrorName(le));
}
extern "C" void kernel_launch(void* const* d_in, const int* in_sizes, int n_in, void* d_out, int out_size, void* d_ws, size_t ws_size, hipStream_t stream) {
    constexpr bool FUSED = (MK_N_LAUNCHES == 1);
    static int grid = 0;
    if (grid == 0) {
        if (n_in != 20 || in_sizes[0] != M * D || out_size != M * D || ws_size < WS_END) { fprintf(stderr, "kernel_launch: unexpected shapes (n_in %d, in0 %d, out %d, ws %zu < %zu); nothing launched\n", n_in, n_in > 0 ? in_sizes[0] : -1, out_size, ws_size, (size_t)WS_END); grid = -1; return; }
        int dev = 0, cus = 0, per_cu = 0;
        if (hipGetDevice(&dev) != hipSuccess || hipDeviceGetAttribute(&cus, hipDeviceAttributeMultiprocessorCount, dev) != hipSuccess) { grid = -1; return; }
        bool okattr = true;
        if constexpr (FUSED) okattr = hipFuncSetAttribute((const void*)mk_fwd<true, -1>, hipFuncAttributeMaxDynamicSharedMemorySize, LDS_BYTES) == hipSuccess;
        else { okattr &= set_lds<0>(); okattr &= set_lds<1>(); okattr &= set_lds<2>(); okattr &= set_lds<3>(); okattr &= set_lds<4>(); okattr &= set_lds<5>(); okattr &= set_lds<6>(); okattr &= set_lds<7>(); okattr &= set_lds<8>(); }
        if (!okattr) { fprintf(stderr, "kernel_launch: hipFuncSetAttribute failed\n"); grid = -1; return; }
        if (hipOccupancyMaxActiveBlocksPerMultiprocessor(&per_cu, (const void*)mk_fwd<FUSED, (FUSED ? -1 : 2)>, NWAVES * 64, LDS_BYTES) != hipSuccess || per_cu < 1) { fprintf(stderr, "kernel_launch: occupancy query says %d blocks per CU; nothing launched\n", per_cu); grid = -1; return; }
        (void)hipGetLastError();
        grid = cus;
        if (grid != 256) fprintf(stderr, "kernel_launch: note: %d CUs (built for 256)\n", grid);
    }
    if (grid < 0) return;
    Args a{};
    for (int i = 0; i < 20; ++i) a.in[i] = (const float*)d_in[i];
    a.out = (float*)d_out; a.ws = (unsigned char*)d_ws;
    if constexpr (FUSED) {
        a.ph_lo = 0; a.ph_hi = NPHASE;
        if (hipMemsetAsync((char*)d_ws + WS_CTL, 0, XCD_BAR_WORDS * 4, stream) != hipSuccess) { fprintf(stderr, "kernel_launch: memset of the barrier words failed\n"); return; }
        void* kargs[] = {&a};
        hipError_t e;
        if (MK_CG_SYNC) e = hipLaunchCooperativeKernel((const void*)mk_fwd<true, -1>, dim3(grid), dim3(NWAVES * 64), kargs, LDS_BYTES, stream);
        else { hipLaunchKernelGGL((mk_fwd<true, -1>), dim3(grid), dim3(NWAVES * 64), LDS_BYTES, stream, a); e = hipPeekAtLastError(); }
        if (e != hipSuccess) fprintf(stderr, "kernel_launch: launch failed: %s (grid %d)\n", hipGetErrorString(e), grid);
    } else {
        a.ph_lo = 0; a.ph_hi = NPHASE;
        launch_one<0>(grid, stream, a); launch_one<1>(grid, stream, a); launch_one<2>(grid, stream, a); launch_one<3>(grid, stream, a); launch_one<4>(grid, stream, a);
        launch_one<5>(grid, stream, a); launch_one<6>(grid, stream, a); launch_one<7>(grid, stream, a); launch_one<8>(grid, stream, a);
    }
}
```

```cpp
#include <hip/hip_runtime.h>
#include <hip/hip_cooperative_groups.h>
#include <cstdio>
#include <cstdint>
namespace cg = cooperative_groups;
#define MK_N_LAUNCHES 1
namespace pg8 {
#define PG8_LAS __attribute__((address_space(3)))
typedef unsigned short bf16_t;
typedef short bf16x8 __attribute__((ext_vector_type(8)));
typedef float f32x4 __attribute__((ext_vector_type(4)));
typedef unsigned u32x4 __attribute__((ext_vector_type(4)));
constexpr int BM = 256, BK = 64, HALF = 128, HTB = HALF * BK * 2  , STAGE_BYTES = 8 * HTB, NXCD = 8, WGM = 8;

__host__ __device__ __forceinline__ int lds_byte(int r, int c) { const int st = (r >> 4) * 2 + (c >> 5), rr = r & 15, cc = c & 31, ob = rr * 64 + cc * 2; return st * 1024 + (ob ^ (((ob >> 9) & 1) << 5)); }
__host__ __device__ __forceinline__ void stage_rc(int b, int& R, int& C) { const int st = b / 1024, sb = b % 1024, swz = sb ^ (((sb >> 9) & 1) << 5); R = (st >> 1) * 16 + swz / 64; C = (st & 1) * 32 + (swz % 64) / 2; }
__host__ __device__ __forceinline__ int perm32(int rho) { const int n = rho >> 4, i = rho & 15; return 8 * (i >> 2) + 4 * n + (i & 3); }

struct Unit { int pm, pn; };
struct Gemm { const bf16_t* A; const bf16_t* Bt; int M, N, K; };

struct StaticOrder {
    int nM, nN, nwg, G, c;
    __host__ __device__ void init(int M, int N, int G_, int c_) { nM = M / BM; nN = N / BM; nwg = nM * nN; G = G_; c = c_; }
    __host__ __device__ bool next(int i, Unit& u) const {
        const long L = (long)i * G + c; if (L >= nwg) return false;
        int wgid = (int)L; { const int q = nwg / NXCD, r = nwg % NXCD, xcd = wgid % NXCD, off = wgid / NXCD; wgid = (xcd < r ? xcd * (q + 1) : r * (q + 1) + (xcd - r) * q) + off; }
        const int nig = WGM * nN, gid = wgid / nig, fm = gid * WGM, gsz = (nM - fm) < WGM ? (nM - fm) : WGM;
        u.pm = fm + ((wgid % nig) % gsz); u.pn = (wgid % nig) / gsz; return true;
    }
    __device__ __forceinline__ void a_ready(const Unit&) const {}
    __device__ __forceinline__ void done(const Unit&) const {}
};

__device__ __forceinline__ unsigned cvt_pk_bf16(float lo, float hi) { unsigned r; asm volatile("v_cvt_pk_bf16_f32 %0, %1, %2" : "=v"(r) : "v"(lo), "v"(hi)); return r; }
typedef float f32x2 __attribute__((ext_vector_type(2)));
template <class Epi, class Sched, bool ALIGN_EPI = false, bool SP2 = false, bool I8 = false>
__device__ __forceinline__ void gemm_phase(PG8_LAS unsigned char* lds, const Gemm g, const Sched& S, const Epi& E, const int wid) {
    int lane; asm volatile("v_mbcnt_lo_u32_b32 %0, -1, 0\n\tv_mbcnt_hi_u32_b32 %0, -1, %0" : "=v"(lane)); const int tid = wid * 64 + lane, wr = wid >> 2, wc = wid & 3, fr = lane & 15, fq = lane >> 4;
    const int K = g.K, nt = K / BK;
    unsigned voffA[2], voffB[2];
#pragma unroll
    for (int i = 0; i < 2; ++i) { int R, C; stage_rc(tid * 16 + i * 8192, R, C); const int Rb = Epi::PERM ? ((R & ~31) + perm32(R & 31)) : R;
        voffA[i] = (unsigned)(R * K + C) * 2u; voffB[i] = (unsigned)(Rb * K + C) * 2u; }
    const size_t kstep = (size_t)(BK * 2);
    const size_t hstep = (size_t)HALF * K * 2;
    const size_t tstep = 2 * hstep;
    const unsigned ldsw = (unsigned)wid * 1024u;
    const int aoff = lds_byte(wr * 64 + fr, fq * 8), boff = lds_byte(wc * 32 + fr, fq * 8);
#define PG8_SA(b, h) (((b) * 2 + (h)) * HTB)
#define PG8_SB(b, h) ((4 + (b) * 2 + (h)) * HTB)
#define PG8_STAGE(bufoff, gbase, voff) do { _Pragma("unroll") for (int _i = 0; _i < 2; ++_i) \
        __builtin_amdgcn_global_load_lds((const unsigned*)((const char*)(gbase) + (voff)[_i]), (PG8_LAS unsigned*)(lds + (bufoff) + ldsw + _i * 8192), 16, 0, 0); } while (0)
#define PG8_LDA(dst, b, h) do { _Pragma("unroll") for (int m = 0; m < 4; ++m) _Pragma("unroll") for (int k = 0; k < 2; ++k) dst[m][k] = *(const PG8_LAS bf16x8*)(lds + PG8_SA(b, h) + aoff + m * 2048 + k * 1024); } while (0)
#define PG8_LDB(dst, b, h) do { _Pragma("unroll") for (int n = 0; n < 2; ++n) _Pragma("unroll") for (int k = 0; k < 2; ++k) dst[n][k] = *(const PG8_LAS bf16x8*)(lds + PG8_SB(b, h) + boff + n * 2048 + k * 1024); } while (0)
#define PG8_MMA(ai, bj, At, Bt) do { __builtin_amdgcn_s_setprio(1); _Pragma("unroll") for (int m = 0; m < 4; ++m) _Pragma("unroll") for (int n = 0; n < 2; ++n) _Pragma("unroll") for (int k = 0; k < 2; ++k) \
        { if constexpr (I8) { typedef int v4i_ __attribute__((ext_vector_type(4))); acc[ai][bj][m][n] = __builtin_bit_cast(f32x4, __builtin_amdgcn_mfma_i32_16x16x64_i8(__builtin_bit_cast(v4i_, Bt[n][k]), __builtin_bit_cast(v4i_, At[m][k]), __builtin_bit_cast(v4i_, acc[ai][bj][m][n]), 0, 0, 0)); } \
          else acc[ai][bj][m][n] = __builtin_amdgcn_mfma_f32_16x16x32_bf16(Bt[n][k], At[m][k], acc[ai][bj][m][n], 0, 0, 0); } __builtin_amdgcn_s_setprio(0); } while (0)
#define PG8_WAIT_V(n) asm volatile("s_waitcnt vmcnt(" #n ")" ::: "memory")
#define PG8_WAIT_L(n) asm volatile("s_waitcnt lgkmcnt(" #n ")" ::: "memory")
#define PG8_BAR __builtin_amdgcn_s_barrier()
#define PG8_SCHED __builtin_amdgcn_sched_barrier(0)
    Unit cur, nxt; int ui = 0;
    if (!S.next(0, cur)) return;
    f32x4 acc[2][2][4][2];
#pragma unroll
    for (int a = 0; a < 2; ++a)
#pragma unroll
        for (int b = 0; b < 2; ++b)
#pragma unroll
            for (int m = 0; m < 4; ++m)
#pragma unroll
                for (int n = 0; n < 2; ++n) acc[a][b][m][n] = (f32x4){0.f, 0.f, 0.f, 0.f};
    bf16x8 At[4][2], B0[2][2], B1[2][2];
    const char* cA = (const char*)g.A + (size_t)cur.pm * tstep; const char* cB = (const char*)g.Bt + (size_t)cur.pn * tstep;
    S.a_ready(cur);
    if constexpr (SP2) {
        PG8_STAGE(PG8_SB(0, 0), cB, voffB); PG8_STAGE(PG8_SB(0, 1), cB + hstep, voffB); PG8_STAGE(PG8_SA(0, 0), cA, voffA); PG8_STAGE(PG8_SA(0, 1), cA + hstep, voffA);
        if (wr == 1) PG8_BAR;
        PG8_WAIT_V(2); PG8_BAR;
        PG8_STAGE(PG8_SB(1, 0), cB + kstep, voffB); PG8_STAGE(PG8_SA(1, 0), cA + kstep, voffA); PG8_STAGE(PG8_SB(1, 1), cB + hstep + kstep, voffB);
        PG8_WAIT_V(6); PG8_BAR;
    } else {
        PG8_STAGE(PG8_SB(0, 0), cB, voffB); PG8_STAGE(PG8_SA(0, 0), cA, voffA); PG8_STAGE(PG8_SB(0, 1), cB + hstep, voffB); PG8_STAGE(PG8_SA(0, 1), cA + hstep, voffA);
        if (wr == 1) PG8_BAR;
        PG8_WAIT_V(4); PG8_BAR;
        PG8_STAGE(PG8_SB(1, 0), cB + kstep, voffB); PG8_STAGE(PG8_SA(1, 0), cA + kstep, voffA); PG8_STAGE(PG8_SB(1, 1), cB + hstep + kstep, voffB);
        PG8_WAIT_V(6); PG8_BAR;
    }
    for (;;) {
        const bool has_next = S.next(ui + 1, nxt);
        const char* nA = has_next ? (const char*)g.A + (size_t)nxt.pm * tstep : cA; const char* nB = has_next ? (const char*)g.Bt + (size_t)nxt.pn * tstep : cB;
        for (int t = 0; t < nt; t += 2) {
            const bool last = (t == nt - 2);
            const char* a1 = cA + (size_t)(t + 1) * kstep;
            const char* a2 = last ? nA : cA + (size_t)(t + 2) * kstep; const char* b2 = last ? nB : cB + (size_t)(t + 2) * kstep;
            const char* a3 = a2 + kstep; const char* b3 = b2 + kstep;
            if (last && has_next) S.a_ready(nxt);
            if constexpr (SP2) {
            PG8_LDB(B0, 0, 0); PG8_LDB(B1, 0, 1); PG8_SCHED; PG8_LDA(At, 0, 0); PG8_STAGE(PG8_SA(1, 1), a1 + hstep, voffA);
            PG8_WAIT_V(8); PG8_WAIT_L(0); PG8_BAR; PG8_MMA(0, 0, At, B0); PG8_MMA(0, 1, At, B1); PG8_BAR; PG8_SCHED;
            PG8_LDA(At, 0, 1); PG8_STAGE(PG8_SB(0, 0), b2, voffB); PG8_STAGE(PG8_SB(0, 1), b2 + hstep, voffB); PG8_STAGE(PG8_SA(0, 0), a2, voffA);
            PG8_WAIT_V(8); PG8_WAIT_L(0); PG8_BAR; PG8_MMA(1, 0, At, B0); PG8_MMA(1, 1, At, B1); PG8_BAR; PG8_SCHED;
            PG8_LDB(B0, 1, 0); PG8_LDB(B1, 1, 1); PG8_SCHED; PG8_LDA(At, 1, 0); PG8_STAGE(PG8_SA(0, 1), a2 + hstep, voffA);
            PG8_WAIT_V(8); PG8_WAIT_L(0); PG8_BAR; PG8_MMA(0, 0, At, B0); PG8_MMA(0, 1, At, B1); PG8_BAR; PG8_SCHED;
            PG8_LDA(At, 1, 1); PG8_STAGE(PG8_SB(1, 0), b3, voffB); PG8_STAGE(PG8_SB(1, 1), b3 + hstep, voffB); PG8_STAGE(PG8_SA(1, 0), a3, voffA);
            PG8_WAIT_V(8); PG8_WAIT_L(0); PG8_BAR; PG8_MMA(1, 0, At, B0); PG8_MMA(1, 1, At, B1); PG8_BAR; PG8_SCHED;
            } else {
            PG8_LDB(B0, 0, 0); PG8_SCHED; PG8_LDA(At, 0, 0); PG8_STAGE(PG8_SA(1, 1), a1 + hstep, voffA);
            PG8_WAIT_L(8); PG8_BAR; PG8_WAIT_L(0); PG8_MMA(0, 0, At, B0); PG8_BAR; PG8_SCHED;
            PG8_LDB(B1, 0, 1); PG8_STAGE(PG8_SB(0, 0), b2, voffB);
            PG8_BAR; PG8_WAIT_L(0); PG8_MMA(0, 1, At, B1); PG8_BAR;
            PG8_LDA(At, 0, 1); PG8_STAGE(PG8_SA(0, 0), a2, voffA);
            PG8_BAR; PG8_WAIT_L(0); PG8_MMA(1, 0, At, B0); PG8_BAR; PG8_SCHED;
            PG8_STAGE(PG8_SB(0, 1), b2 + hstep, voffB);
            PG8_WAIT_V(6); PG8_BAR; PG8_MMA(1, 1, At, B1); PG8_BAR;
            PG8_LDB(B0, 1, 0); PG8_SCHED; PG8_LDA(At, 1, 0); PG8_STAGE(PG8_SA(0, 1), a2 + hstep, voffA);
            PG8_WAIT_L(8); PG8_BAR; PG8_WAIT_L(0); PG8_MMA(0, 0, At, B0); PG8_BAR; PG8_SCHED;
            PG8_LDB(B1, 1, 1); PG8_STAGE(PG8_SB(1, 0), b3, voffB);
            PG8_BAR; PG8_WAIT_L(0); PG8_MMA(0, 1, At, B1); PG8_BAR;
            PG8_LDA(At, 1, 1); PG8_STAGE(PG8_SA(1, 0), a3, voffA);
            PG8_BAR; PG8_WAIT_L(0); PG8_MMA(1, 0, At, B0); PG8_BAR; PG8_SCHED;
            PG8_STAGE(PG8_SB(1, 1), b3 + hstep, voffB);
            PG8_WAIT_V(6); PG8_BAR; PG8_MMA(1, 1, At, B1); PG8_BAR;
            }
        }
        if constexpr (ALIGN_EPI) { if (wr == 0) PG8_BAR; }
        if constexpr (!Epi::AFTER_DRAIN) { E(acc, cur, wr, wc, fr, fq); S.done(cur); }
        if (!has_next) break;
#pragma unroll
        for (int a = 0; a < 2; ++a)
#pragma unroll
            for (int b = 0; b < 2; ++b)
#pragma unroll
                for (int m = 0; m < 4; ++m)
#pragma unroll
                    for (int n = 0; n < 2; ++n) acc[a][b][m][n] = (f32x4){0.f, 0.f, 0.f, 0.f};
        cur = nxt; cA = nA; cB = nB; ++ui;
        if constexpr (ALIGN_EPI) { if (wr == 1) PG8_BAR; }
    }
    PG8_WAIT_V(0);
    if constexpr (!ALIGN_EPI) { if (wr == 0) PG8_BAR; }
    PG8_BAR;
    if constexpr (Epi::AFTER_DRAIN) { E.fused(acc, cur, wr, wc, fr, fq, lds, wid, lane); S.done(cur); }
#undef PG8_SA
#undef PG8_SB
#undef PG8_STAGE
#undef PG8_LDA
#undef PG8_LDB
#undef PG8_MMA
#undef PG8_WAIT_V
#undef PG8_WAIT_L
#undef PG8_BAR
#undef PG8_SCHED
}
}

#ifndef MK_N_LAUNCHES
#define MK_N_LAUNCHES 1
#endif
constexpr int NPHASE = 9;

constexpr int D = 2048, NB = 8, SEQ = 2048, M = NB * SEQ, CTXL = 256, MC = NB * CTXL;
constexpr int NH = 8, HD = 128, DA = 1024, NPROJ = 6144, GW = 64;
constexpr int NEXP = 16384, PH = 8, PK = 16, NKEYS = 128;
constexpr float EPS = 1e-6f, LOG2E = 1.4426950408889634f;
constexpr int NWAVES = 8;

constexpr size_t MiB = 1u << 20;
constexpr size_t WS_CTL = 0, WS_MOD = 1 * MiB, WS_SK = 2 * MiB, WS_WIN = 4 * MiB, WS_WOUT = 28 * MiB, WS_WPQ = 36 * MiB;
constexpr size_t WS_UT = 44 * MiB, WS_VT = 108 * MiB, WS_ACT = 172 * MiB, WS_HC = 236 * MiB;
constexpr size_t WS_Q = 244 * MiB, WS_K = 276 * MiB, WS_VTR = 308 * MiB, WS_BG = 340 * MiB, WS_CG = 372 * MiB, WS_U = 404 * MiB;
constexpr size_t WS_KC = 436 * MiB, WS_VCT = 440 * MiB, WS_QP = 244 * MiB  ;
constexpr size_t WS_SELI = 444 * MiB, WS_SELG = 452 * MiB, WS_AVW = 460 * MiB, WS_END = 468 * MiB;
constexpr size_t WS_U8 = WS_UT, WS_V8 = WS_UT + 32 * MiB, WS_SU = WS_VT, WS_SV = WS_VT + 64 * 1024, WS_H2S = WS_VT + 128 * 1024, WS_H2Q = WS_VT + 1 * MiB;

constexpr int LDS_BYTES = 147456;
constexpr int XCH_OFF = 131072;
constexpr int MISC_OFF = 131072 + 8192;
#ifndef MK_CG_SYNC
#define MK_CG_SYNC 1
#endif

#define GAS __attribute__((address_space(1)))
#define LAS __attribute__((address_space(3)))
typedef unsigned short bf16;
typedef unsigned v4u __attribute__((ext_vector_type(4)));
typedef unsigned v2u __attribute__((ext_vector_type(2)));
typedef float f32x4 __attribute__((ext_vector_type(4)));
typedef float f32x16 __attribute__((ext_vector_type(16)));
typedef short bf16x8 __attribute__((ext_vector_type(8)));
typedef __bf16 bf16x2 __attribute__((ext_vector_type(2)));
#define LDS_WAIT() asm volatile("s_waitcnt lgkmcnt(0)" ::: "memory")

__device__ __forceinline__ unsigned f2bf(float f) { unsigned u = __builtin_bit_cast(unsigned, f); return (u + 0x7fffu + ((u >> 16) & 1u)) >> 16; }
__device__ __forceinline__ unsigned pk2(float lo, float hi) { return pg8::cvt_pk_bf16(lo, hi); }
__device__ __forceinline__ float bflo(unsigned w) { return __builtin_bit_cast(float, w << 16); }
__device__ __forceinline__ float bfhi(unsigned w) { return __builtin_bit_cast(float, w & 0xffff0000u); }
__device__ __forceinline__ float dot2_bf16(unsigned w, unsigned x, float acc) { return __builtin_amdgcn_fdot2_f32_bf16(__builtin_bit_cast(bf16x2, w), __builtin_bit_cast(bf16x2, x), acc, false); }
__device__ __forceinline__ float wave_sum(float v) {
#pragma unroll
    for (int o = 1; o < 64; o <<= 1) v += __shfl_xor(v, o);
    return v;
}

struct Args { const float* in[20]; float* out; unsigned char* ws; int ph_lo, ph_hi; };
struct Frame {
    LAS unsigned char* lds;
    int wave, vcu, G;
};
__device__ __forceinline__ int lane_id() { int l; asm volatile("v_mbcnt_lo_u32_b32 %0, -1, 0\n\tv_mbcnt_hi_u32_b32 %0, -1, %0" : "=v"(l)); return l; }
#define F_LANE lane_id()
#define F_TID (F.wave * 64 + lane_id())
#define AP_x (A.in[0])
#define AP_c (A.in[1])
#define AP_ctx (A.in[2])
#define AP_c_ctx (A.in[3])
#define AP_w_ada (A.in[4])
#define AP_b_ada (A.in[5])
#define AP_g1 (A.in[6])
#define AP_w_in (A.in[7])
#define AP_qn (A.in[8])
#define AP_kn (A.in[9])
#define AP_rpb (A.in[10])
#define AP_w_conv (A.in[11])
#define AP_gao (A.in[12])
#define AP_gco (A.in[13])
#define AP_w_out (A.in[14])
#define AP_g2 (A.in[15])
#define AP_w_pq (A.in[16])
#define AP_subk (A.in[17])
#define AP_uex (A.in[18])
#define AP_vex (A.in[19])
#define AP_SK ((bf16*)(A.ws + WS_SK))
#define AP_WIN ((bf16*)(A.ws + WS_WIN))
#define AP_WOUT ((bf16*)(A.ws + WS_WOUT))
#define AP_WPQ ((bf16*)(A.ws + WS_WPQ))
#define AP_UT ((bf16*)(A.ws + WS_UT))
#define AP_VT ((bf16*)(A.ws + WS_VT))
#define AP_ACT ((bf16*)(A.ws + WS_ACT))
#define AP_HC ((bf16*)(A.ws + WS_HC))
#define AP_Q ((bf16*)(A.ws + WS_Q))
#define AP_K ((bf16*)(A.ws + WS_K))
#define AP_VTR ((bf16*)(A.ws + WS_VTR))
#define AP_BG ((bf16*)(A.ws + WS_BG))
#define AP_CG ((bf16*)(A.ws + WS_CG))
#define AP_U ((bf16*)(A.ws + WS_U))
#define AP_KC ((bf16*)(A.ws + WS_KC))
#define AP_VCT ((bf16*)(A.ws + WS_VCT))
#define AP_QP ((bf16*)(A.ws + WS_QP))
#define AP_MOD ((float*)(A.ws + WS_MOD))
#define AP_SELI ((int*)(A.ws + WS_SELI))
#define AP_SELG ((float*)(A.ws + WS_SELG))
#define AP_AVW ((float*)(A.ws + WS_AVW))
#define AP_WIN8 ((unsigned char*)(A.ws + WS_WIN))
#define AP_WINS ((float*)(A.ws + WS_WIN + 16 * MiB))
#define AP_CPART ((float*)(A.ws + WS_WIN + 17 * MiB))
#define AP_H8 ((unsigned char*)(A.ws + WS_ACT))
#define AP_HC8 ((unsigned char*)(A.ws + WS_HC))
#define AP_HS ((float*)(A.ws + WS_HC + 4 * MiB))
#define AP_HCS ((float*)(A.ws + WS_HC + 4 * MiB + 65536))
#define AP_X1B ((bf16*)(A.ws + WS_BG))
#define AP_out (A.out)
#define AP_U8 ((const unsigned char*)(A.ws + WS_U8))
#define AP_V8 ((const unsigned char*)(A.ws + WS_V8))
#define AP_SU ((float*)(A.ws + WS_SU))
#define AP_SV ((float*)(A.ws + WS_SV))
#define AP_H2S ((float*)(A.ws + WS_H2S))
#define AP_H2Q ((unsigned char*)(A.ws + WS_H2Q))


#define XB_TMO      128
#define XB_XCNT(j)  (256  + 64 * (j))
#define XB_XSUB(j)  (1280 + 64 * (j))
#define XB_XGEN(j)  (2304 + 64 * (j))
#define XB_TOP      3328
#define XB_TOPGEN   3392
#define XCD_BAR_WORDS 3456
#define XB_SPIN_CAP (1u << 22)
__device__ __forceinline__ unsigned xb_ld(unsigned* p)              { return __hip_atomic_load(p, __ATOMIC_RELAXED, __HIP_MEMORY_SCOPE_AGENT); }
__device__ __forceinline__ unsigned xb_add(unsigned* p, unsigned v) { return __hip_atomic_fetch_add(p, v, __ATOMIC_RELAXED, __HIP_MEMORY_SCOPE_AGENT); }
__device__ __forceinline__ unsigned xb_xcc_id() { return (unsigned)__builtin_amdgcn_s_getreg((3 << 11) | 20) & 0xFu; }
#define XB_SPIN(cond, bar) do { unsigned _sp = 0; while (cond) { __builtin_amdgcn_s_sleep(1); \
    if ((++_sp & 255u) == 0u) { if (xb_ld(&(bar)[XB_TMO])) break; if (_sp > XB_SPIN_CAP) { atomicAdd(&(bar)[XB_TMO], 1u); break; } } } } while (0)
struct XcdBarrier { unsigned* bar; unsigned x; volatile LAS unsigned* st; };
__device__ __forceinline__ void xcd_barrier_complete(unsigned* bar, unsigned x, unsigned G, unsigned& nloc, unsigned& nx) {
    unsigned sum, cnt, mine, sp = 0u;
    for (;;) {
        sum = 0u; cnt = 0u; mine = 0u;
#pragma unroll
        for (unsigned j = 0; j < 16; ++j) { const unsigned c = xb_ld(&bar[XB_XCNT(j)]); sum += c; cnt += (c > 0u) ? 1u : 0u; mine = (j == x) ? c : mine; }
        if (sum == G) break;
        __builtin_amdgcn_s_sleep(1);
        if ((++sp & 255u) == 0u) { if (xb_ld(&bar[XB_TMO])) break; if (sp > XB_SPIN_CAP) { atomicAdd(&bar[XB_TMO], 1u); break; } }
    }
    nloc = mine > 0u ? mine : 1u; nx = cnt > 0u ? cnt : 1u;
}
__device__ __forceinline__ void xcd_barrier(const XcdBarrier& b, const int wave, const unsigned G) {
    asm volatile("s_waitcnt vmcnt(0)" ::: "memory");
    __syncthreads();
    if (wave == 0 && lane_id() == 0) {
        unsigned* bar = b.bar;
        __builtin_amdgcn_s_waitcnt(0);
        unsigned nloc = b.st[0], nx = b.st[1];
        if (nloc == 0u) { xcd_barrier_complete(bar, b.x, G, nloc, nx); b.st[0] = nloc; b.st[1] = nx; }
        const unsigned old = xb_add(&bar[XB_XSUB(b.x)], 1u);
        const unsigned gen = old / nloc;
        if (old + 1u == (gen + 1u) * nloc) {
            __builtin_amdgcn_fence(__ATOMIC_RELEASE, "agent");
            asm volatile("s_waitcnt vmcnt(0)" ::: "memory");
            const unsigned og = xb_add(&bar[XB_TOP], 1u);
            const unsigned tg = og / nx;
            if (og + 1u == (tg + 1u) * nx) xb_add(&bar[XB_TOPGEN], 1u);
            else XB_SPIN(xb_ld(&bar[XB_TOPGEN]) == tg, bar);
            __builtin_amdgcn_fence(__ATOMIC_ACQUIRE, "agent");
            xb_add(&bar[XB_XGEN(b.x)], 1u);
            asm volatile("s_waitcnt vmcnt(0)" ::: "memory");
        } else {
            XB_SPIN(xb_ld(&bar[XB_XGEN(b.x)]) == gen, bar);
            __builtin_amdgcn_fence(__ATOMIC_ACQUIRE, "agent");
            asm volatile("s_waitcnt vmcnt(0)" ::: "memory");
        }
    }
    __syncthreads();
}

__device__ __forceinline__ void p0_mod(const Frame& F, const Args& A) {
    const int lane = lane_id(), tid = F.wave * 64 + lane; (void)tid;
    LAS float* sc = (LAS float*)F.lds;
    LAS float* red = (LAS float*)(F.lds + 9 * 2048 * 4);
    for (int i = tid; i < 9 * D; i += NWAVES * 64) { const int r = i >> 11, k = i & (D - 1); const float cv = (r < 8) ? AP_c[r * D + k] : AP_c_ctx[k]; sc[i] = cv / (1.f + __expf(-cv)); }
    __syncthreads();
    const int sr = lane >> 4, cq = lane & 15;
    for (int item = F.vcu; item < (6 * D) / 64; item += F.G) {
        const int n0 = item * 64;
        float acc[9][4];
#pragma unroll
        for (int r = 0; r < 9; ++r)
#pragma unroll
            for (int j = 0; j < 4; ++j) acc[r][j] = 0.f;
        const float* wp = AP_w_ada + (size_t)(F.wave * 4 + sr) * (6 * D) + n0 + 4 * cq;
#pragma unroll 8
        for (int step = 0; step < 64; ++step) {
            const int k = step * 32 + F.wave * 4 + sr;
            const f32x4 w = *(const f32x4*)(wp + (size_t)step * 32 * (6 * D));
#pragma unroll
            for (int r = 0; r < 9; ++r) { const float s = sc[r * D + k]; acc[r][0] += s * w.x; acc[r][1] += s * w.y; acc[r][2] += s * w.z; acc[r][3] += s * w.w; }
        }
#pragma unroll
        for (int r = 0; r < 9; ++r)
#pragma unroll
            for (int j = 0; j < 4; ++j) { float v = acc[r][j]; v += __shfl_xor(v, 16); v += __shfl_xor(v, 32); if (sr == 0) red[(F.wave * 9 + r) * 64 + 4 * cq + j] = v; }
        __syncthreads();
        for (int i = tid; i < 9 * 64; i += NWAVES * 64) { const int r = i >> 6, cc = i & 63; float s = 0.f;
#pragma unroll
            for (int w = 0; w < 8; ++w) s += red[(w * 9 + r) * 64 + cc];
            AP_MOD[r * (6 * D) + n0 + cc] = s + AP_b_ada[n0 + cc]; }
        __syncthreads();
    }
    __syncthreads();
}
__device__ __forceinline__ void p0_transpose_item(const float* W, int K, int N, bf16* WT, LAS float* scr, int item, int lane) {
    const int nblk = N / 32, kb = item / nblk, nb = item % nblk, k0 = 64 * kb, n0 = 32 * nb;
#pragma unroll 8
    for (int i = 0; i < 32; ++i) { const int kk = 2 * i + (lane >> 5); scr[kk * 33 + (lane & 31)] = W[(size_t)(k0 + kk) * N + n0 + (lane & 31)]; }
    LDS_WAIT(); asm volatile("" ::: "memory");
    const int c = lane & 7;
#pragma unroll
    for (int j = 0; j < 4; ++j) { const int n = (lane >> 3) + 8 * j; const LAS float* s = scr + (8 * c) * 33 + n;
        v4u o; o.x = pk2(s[0 * 33], s[1 * 33]); o.y = pk2(s[2 * 33], s[3 * 33]); o.z = pk2(s[4 * 33], s[5 * 33]); o.w = pk2(s[6 * 33], s[7 * 33]);
        *(v4u*)(WT + (size_t)(n0 + n) * K + k0 + 8 * c) = o; }
    LDS_WAIT(); asm volatile("" ::: "memory");
}
__device__ __forceinline__ void cvt_f32_bf16(const float* src, bf16* dst, size_t n, size_t gtid, size_t gthreads) {
    for (size_t i = gtid * 8; i < n; i += gthreads * 8) { const f32x4 a = *(const f32x4*)(src + i), b = *(const f32x4*)(src + i + 4);
        v4u o; o.x = pk2(a.x, a.y); o.y = pk2(a.z, a.w); o.z = pk2(b.x, b.y); o.w = pk2(b.z, b.w); *(v4u*)(dst + i) = o; }
}
__device__ __forceinline__ float wave_max(float v) {
#pragma unroll
    for (int o = 1; o < 64; o <<= 1) v = fmaxf(v, __shfl_xor(v, o));
    return v;
}
__device__ __forceinline__ unsigned q4(const f32x4 v, const float inv, const int off = 0) {
    const int a = (int)fminf(fmaxf(__builtin_rintf(v.x * inv), -127.f), 127.f) + off, b = (int)fminf(fmaxf(__builtin_rintf(v.y * inv), -127.f), 127.f) + off, c = (int)fminf(fmaxf(__builtin_rintf(v.z * inv), -127.f), 127.f) + off, d = (int)fminf(fmaxf(__builtin_rintf(v.w * inv), -127.f), 127.f) + off;
    return (unsigned)(a & 255) | ((unsigned)(b & 255) << 8) | ((unsigned)(c & 255) << 16) | ((unsigned)(d & 255) << 24);
}
__device__ __forceinline__ void quant_row(const float* src, unsigned char* dst, float* scale, int lane, const int off) {
    const f32x4* xr = (const f32x4*)src + lane; f32x4 v[8]; float mx = 0.f;
#pragma unroll
    for (int j = 0; j < 8; ++j) { v[j] = xr[64 * j]; mx = fmaxf(mx, fmaxf(fmaxf(fabsf(v[j].x), fabsf(v[j].y)), fmaxf(fabsf(v[j].z), fabsf(v[j].w)))); }
    mx = fmaxf(wave_max(mx), 1e-30f);
    const float inv = 127.f / mx;
    unsigned* o = (unsigned*)dst + lane;
#pragma unroll
    for (int j = 0; j < 8; ++j) o[64 * j] = q4(v[j], inv, off);
    if (lane == 0) *scale = mx * (1.f / 127.f);
}
__device__ __forceinline__ void p1_transpose_item_i8(const float* W, int K, int N, unsigned char* WT, const float* cpart, float* wscale, LAS float* scr, int item, int lane) {
    const int nblk = N / 32, kb = item / nblk, nb = item % nblk, k0 = 64 * kb, n0 = 32 * nb;
    { float cm = 0.f;
#pragma unroll
      for (int p = 0; p < 16; ++p) cm = fmaxf(cm, cpart[(size_t)(16 * (lane >> 5) + p) * N + n0 + (lane & 31)]);
      cm = fmaxf(cm, __shfl_xor(cm, 32));
      scr[64 * 33 + (lane & 31)] = cm; }
#pragma unroll 8
    for (int i = 0; i < 32; ++i) { const int kk = 2 * i + (lane >> 5); scr[kk * 33 + (lane & 31)] = W[(size_t)(k0 + kk) * N + n0 + (lane & 31)]; }
    LDS_WAIT(); asm volatile("" ::: "memory");
    const int c = lane & 7;
#pragma unroll
    for (int j = 0; j < 4; ++j) { const int n = (lane >> 3) + 8 * j; const LAS float* sp = scr + (8 * c) * 33 + n;
        const float mx = fmaxf(scr[64 * 33 + n], 1e-30f), inv = 127.f / mx;
        f32x4 a = {sp[0 * 33], sp[1 * 33], sp[2 * 33], sp[3 * 33]}, b = {sp[4 * 33], sp[5 * 33], sp[6 * 33], sp[7 * 33]};
        v2u o; o.x = q4(a, inv); o.y = q4(b, inv);
        *(v2u*)(WT + (size_t)(n0 + n) * K + k0 + 8 * c) = o;
        if (kb == 0 && c == 0) wscale[n0 + n] = mx * (1.f / 127.f); }
    LDS_WAIT(); asm volatile("" ::: "memory");
}
__device__ __forceinline__ void p0_prologue(const Frame& F, const Args& A) {
    const int lane = lane_id(), tid = F.wave * 64 + lane; (void)tid;
    p0_mod(F, A);
    LAS float* scr = (LAS float*)(F.lds + F.wave * 16384);
    const int gw = F.vcu * NWAVES + F.wave, NGW = F.G * NWAVES;
    constexpr int I_SQ = (D / 64) * (D / 32);
    for (int it = gw; it < 2 * I_SQ; it += NGW) {
        int r = it;
        if (r < I_SQ) { p0_transpose_item(AP_w_out, D, D, AP_WOUT, scr, r, lane); continue; } r -= I_SQ;
        p0_transpose_item(AP_w_pq, D, D, AP_WPQ, scr, r, lane);
    }
    for (int it = gw; it < (NPROJ / 256) * (D / 64); it += NGW) { const int cb = it % (NPROJ / 256), kb = it / (NPROJ / 256);
        const f32x4* wp = (const f32x4*)(AP_w_in + (size_t)(kb * 64) * NPROJ + cb * 256) + lane; f32x4 mx = {0.f, 0.f, 0.f, 0.f};
#pragma unroll 8
        for (int k = 0; k < 64; ++k) { const f32x4 w = wp[(size_t)k * (NPROJ / 4)]; mx.x = fmaxf(mx.x, fabsf(w.x)); mx.y = fmaxf(mx.y, fabsf(w.y)); mx.z = fmaxf(mx.z, fabsf(w.z)); mx.w = fmaxf(mx.w, fabsf(w.w)); }
        *((f32x4*)(AP_CPART + (size_t)kb * NPROJ + cb * 256) + lane) = mx; }
    const size_t gtid = (size_t)F.vcu * (NWAVES * 64) + tid, gth = (size_t)F.G * NWAVES * 64;
    cvt_f32_bf16(AP_subk, AP_SK, (size_t)PH * 2 * NKEYS * 128, gtid, gth);
    for (int it = gw; it < 2 * NEXP; it += NGW) {
        const int e = it >> 1; const bool isv = it & 1;
        quant_row((isv ? AP_vex : AP_uex) + (size_t)e * D, (unsigned char*)(A.ws + (isv ? WS_V8 : WS_U8)) + (size_t)e * D, (isv ? AP_SV : AP_SU) + e, lane, 0);
    }
}

__device__ __forceinline__ void norm_rows(const float* X, size_t row0, int nrows, const float* g, const float* sh, const float* sc, bf16* out, int lane, unsigned char* q8 = nullptr, float* qs = nullptr) {
    f32x4 gs[8], shv[8];
#pragma unroll
    for (int j = 0; j < 8; ++j) { const int cI = j * 64 + lane; const f32x4 gg = ((const f32x4*)g)[cI], s1 = ((const f32x4*)sc)[cI]; gs[j] = gg * (1.f + s1); shv[j] = ((const f32x4*)sh)[cI]; }
    for (int r = 0; r < nrows; ++r) {
        const f32x4* xr = (const f32x4*)(X + (row0 + r) * D) + lane;
        f32x4 v[8]; float ss = 0.f;
#pragma unroll
        for (int j = 0; j < 8; ++j) { v[j] = xr[64 * j]; ss += (v[j].x * v[j].x + v[j].y * v[j].y) + (v[j].z * v[j].z + v[j].w * v[j].w); }
        const float rstd = __builtin_amdgcn_rsqf(wave_sum(ss) * (1.f / D) + EPS);
        v2u* o8 = (v2u*)(out + (row0 + r) * D) + lane; float mx = 0.f;
#pragma unroll
        for (int j = 0; j < 8; ++j) { const f32x4 y = v[j] * rstd * gs[j] + shv[j]; v[j] = y; if (out) { v2u w; w.x = pk2(y.x, y.y); w.y = pk2(y.z, y.w); o8[64 * j] = w; }
            mx = fmaxf(mx, fmaxf(fmaxf(fabsf(y.x), fabsf(y.y)), fmaxf(fabsf(y.z), fabsf(y.w)))); }
        if (q8) { mx = fmaxf(wave_max(mx), 1e-30f); const float inv = 127.f / mx; unsigned* oq = (unsigned*)(q8 + (row0 + r) * D) + lane;
#pragma unroll
            for (int j = 0; j < 8; ++j) oq[64 * j] = q4(v[j], inv);
            if (lane == 0) qs[row0 + r] = mx * (1.f / 127.f); }
    }
}
__device__ __forceinline__ void norm_rows_b(const bf16* X, size_t row0, int nrows, const float* g, const float* sh, const float* sc, bf16* out, int lane, unsigned char* q8, float* qs) {
    f32x4 gs[8], shv[8];
#pragma unroll
    for (int j = 0; j < 8; ++j) { const int cI = j * 64 + lane; const f32x4 gg = ((const f32x4*)g)[cI], s1 = ((const f32x4*)sc)[cI]; gs[j] = gg * (1.f + s1); shv[j] = ((const f32x4*)sh)[cI]; }
    for (int r = 0; r < nrows; ++r) {
        const v2u* xr = (const v2u*)(X + (row0 + r) * D) + lane;
        f32x4 v[8]; float ss = 0.f;
#pragma unroll
        for (int j = 0; j < 8; ++j) { const v2u w = xr[64 * j]; v[j].x = bflo(w.x); v[j].y = bfhi(w.x); v[j].z = bflo(w.y); v[j].w = bfhi(w.y); ss += (v[j].x * v[j].x + v[j].y * v[j].y) + (v[j].z * v[j].z + v[j].w * v[j].w); }
        const float rstd = __builtin_amdgcn_rsqf(wave_sum(ss) * (1.f / D) + EPS);
        v2u* o8 = (v2u*)(out + (row0 + r) * D) + lane; float mx = 0.f;
#pragma unroll
        for (int j = 0; j < 8; ++j) { const f32x4 y = v[j] * rstd * gs[j] + shv[j]; v[j] = y; v2u w; w.x = pk2(y.x, y.y); w.y = pk2(y.z, y.w); o8[64 * j] = w;
            mx = fmaxf(mx, fmaxf(fmaxf(fabsf(y.x), fabsf(y.y)), fmaxf(fabsf(y.z), fabsf(y.w)))); }
        mx = fmaxf(wave_max(mx), 1e-30f); const float inv = 127.f / mx; unsigned* oq = (unsigned*)(q8 + (row0 + r) * D) + lane;
#pragma unroll
        for (int j = 0; j < 8; ++j) oq[64 * j] = q4(v[j], inv);
        if (lane == 0) qs[row0 + r] = mx * (1.f / 127.f);
    }
}
__device__ __forceinline__ void p1_norm1(const Frame& F, const Args& A) {
    const int lane = lane_id(), tid = F.wave * 64 + lane; (void)tid;
    const int gw = F.vcu * NWAVES + F.wave, NGW = F.G * NWAVES;
    { LAS float* scr = (LAS float*)(F.lds + F.wave * 16384);
      for (int it = gw; it < (D / 64) * (NPROJ / 32); it += NGW) p1_transpose_item_i8(AP_w_in, D, NPROJ, AP_WIN8, AP_CPART, AP_WINS, scr, it, lane); }
    for (int it = gw; it < M / 8; it += NGW) { const size_t row0 = (size_t)it * 8; const int b = (int)(row0 >> 11);
        norm_rows(AP_x, row0, 8, AP_g1, AP_MOD + b * 6 * D + 0 * D, AP_MOD + b * 6 * D + 1 * D, nullptr, lane, AP_H8, AP_HS); }
    for (int it = gw; it < MC; it += NGW) norm_rows(AP_ctx, (size_t)it, 1, AP_g1, AP_MOD + 8 * 6 * D + 0 * D, AP_MOD + 8 * 6 * D + 1 * D, nullptr, lane, AP_HC8, AP_HCS);
}
__device__ __forceinline__ void p5_norm2(const Frame& F, const Args& A) {
    const int lane = lane_id(), tid = F.wave * 64 + lane; (void)tid;
    const int gw = F.vcu * NWAVES + F.wave, NGW = F.G * NWAVES;
    for (int it = gw; it < M / 8; it += NGW) { const size_t row0 = (size_t)it * 8; const int b = (int)(row0 >> 11);
        norm_rows_b(AP_X1B, row0, 8, AP_g2, AP_MOD + b * 6 * D + 3 * D, AP_MOD + b * 6 * D + 4 * D, AP_ACT, lane, AP_H2Q, AP_H2S); }
}

__device__ __forceinline__ f32x4 dq4(const f32x4 a, const f32x4 cs, const float rs) {
    typedef int v4i_ __attribute__((ext_vector_type(4))); const v4i_ iv = __builtin_bit_cast(v4i_, a);
    f32x4 r; r.x = (float)iv.x; r.y = (float)iv.y; r.z = (float)iv.z; r.w = (float)iv.w; return r * cs * rs;
}
struct EpiProj {
    static constexpr bool PERM = true, AFTER_DRAIN = false;
    bf16 *Q, *Kp, *VTp, *BG, *CG, *U; const float *qn, *kn; LAS float* xch; int region0, tshift; float qscale; const float *rs, *csb;
    __device__ __forceinline__ void operator()(const f32x4 (&acc)[2][2][4][2], const pg8::Unit& u, int wr, int wc, int fr, int fq) const {
        const int region = (u.pn >> 2) + region0, pnl = u.pn & 3;
        const int rowt = wr * 64 + fr;
        f32x4 cs_[2][2]; float rsc_[2][4];
#pragma unroll
        for (int bj = 0; bj < 2; ++bj)
#pragma unroll
            for (int n = 0; n < 2; ++n) cs_[bj][n] = *(const f32x4*)(csb + u.pn * 256 + bj * 128 + 32 * wc + 8 * fq + 4 * n);
#pragma unroll
        for (int ai = 0; ai < 2; ++ai)
#pragma unroll
            for (int m = 0; m < 4; ++m) rsc_[ai][m] = rs[u.pm * 256 + ai * 128 + rowt + m * 16];
#define DQ(ai_, bj_, m_, n_) dq4(acc[ai_][bj_][m_][n_], cs_[bj_][n_], rsc_[ai_][m_])
        if (region <= 1) {
#pragma unroll
            for (int ai = 0; ai < 2; ++ai)
#pragma unroll
                for (int m = 0; m < 4; ++m)
#pragma unroll
                    for (int bj = 0; bj < 2; ++bj) { const f32x4 a = DQ(ai, bj, m, 0), b = DQ(ai, bj, m, 1);
                        float s = (a.x * a.x + a.y * a.y) + (a.z * a.z + a.w * a.w) + (b.x * b.x + b.y * b.y) + (b.z * b.z + b.w * b.w);
                        s += __shfl_xor(s, 16); s += __shfl_xor(s, 32);
                        if (fq == 0) xch[((ai * 128 + rowt + m * 16) * 2 + bj) * 4 + wc] = s; }
            asm volatile("s_waitcnt lgkmcnt(0)" ::: "memory"); __builtin_amdgcn_s_barrier(); asm volatile("" ::: "memory");
            const float* gain = (region == 0) ? qn : kn; const float mul = (region == 0) ? qscale : 1.f; bf16* O = (region == 0) ? Q : Kp;
            const f32x4 g0 = *(const f32x4*)(gain + 32 * wc + 8 * fq), g1 = *(const f32x4*)(gain + 32 * wc + 8 * fq + 4);
#pragma unroll
            for (int ai = 0; ai < 2; ++ai)
#pragma unroll
                for (int m = 0; m < 4; ++m) { const int rt = ai * 128 + rowt + m * 16; bf16* rowp = O + (size_t)(u.pm * 256 + rt) * DA + (2 * pnl) * HD + 32 * wc + 8 * fq;
#pragma unroll
                    for (int bj = 0; bj < 2; ++bj) { const f32x4 p = *(const LAS f32x4*)(xch + (rt * 2 + bj) * 4);
                        const float rstd = __builtin_amdgcn_rsqf(((p.x + p.y) + (p.z + p.w)) * (1.f / HD) + EPS) * mul;
                        const f32x4 v0 = DQ(ai, bj, m, 0) * rstd * g0, v1 = DQ(ai, bj, m, 1) * rstd * g1;
                        v4u w; w.x = pk2(v0.x, v0.y); w.y = pk2(v0.z, v0.w); w.z = pk2(v1.x, v1.y); w.w = pk2(v1.z, v1.w);
                        *(v4u*)(rowp + bj * HD) = w; } }
        } else if (region == 2) {
            const int tmask = (1 << tshift) - 1;
#pragma unroll
            for (int ai = 0; ai < 2; ++ai)
#pragma unroll
                for (int m = 0; m < 4; ++m) { const int row = u.pm * 256 + ai * 128 + rowt + m * 16; const int b = row >> tshift, t = row & tmask;
#pragma unroll
                    for (int bj = 0; bj < 2; ++bj) { const int head = 2 * pnl + bj; bf16* base = VTp + (((size_t)(b * NH + head) * HD + 32 * wc + 8 * fq) << tshift) + t;
#pragma unroll
                        for (int n = 0; n < 2; ++n) { const f32x4 a = DQ(ai, bj, m, n); const unsigned w0 = pk2(a.x, a.y), w1 = pk2(a.z, a.w);
                            base[(size_t)(4 * n + 0) << tshift] = (bf16)(w0 & 0xffffu); base[(size_t)(4 * n + 1) << tshift] = (bf16)(w0 >> 16);
                            base[(size_t)(4 * n + 2) << tshift] = (bf16)(w1 & 0xffffu); base[(size_t)(4 * n + 3) << tshift] = (bf16)(w1 >> 16); } } }
        } else {
            bf16* O = (region == 3) ? BG : (region == 4) ? CG : U;
#pragma unroll
            for (int ai = 0; ai < 2; ++ai)
#pragma unroll
                for (int m = 0; m < 4; ++m) { bf16* rowp = O + (size_t)(u.pm * 256 + ai * 128 + rowt + m * 16) * DA + pnl * 256 + 32 * wc + 8 * fq;
#pragma unroll
                    for (int bj = 0; bj < 2; ++bj) { const f32x4 v0 = DQ(ai, bj, m, 0), v1 = DQ(ai, bj, m, 1);
                        v4u w; w.x = pk2(v0.x, v0.y); w.y = pk2(v0.z, v0.w); w.z = pk2(v1.x, v1.y); w.w = pk2(v1.z, v1.w);
                        *(v4u*)(rowp + bj * HD) = w; } }
        }
#undef DQ
    }
};
struct EpiBf16 {
    static constexpr bool PERM = true, AFTER_DRAIN = false;
    bf16* O; int ldc;
    __device__ __forceinline__ void operator()(const f32x4 (&acc)[2][2][4][2], const pg8::Unit& u, int wr, int wc, int fr, int fq) const {
        const int row0 = u.pm * 256 + wr * 64 + fr, col0 = u.pn * 256 + wc * 32 + 8 * fq;
#pragma unroll
        for (int ai = 0; ai < 2; ++ai)
#pragma unroll
            for (int m = 0; m < 4; ++m) { bf16* rowp = O + (size_t)(row0 + ai * 128 + m * 16) * ldc + col0;
#pragma unroll
                for (int bj = 0; bj < 2; ++bj) { const f32x4 v0 = acc[ai][bj][m][0], v1 = acc[ai][bj][m][1];
                    v4u w; w.x = pk2(v0.x, v0.y); w.y = pk2(v0.z, v0.w); w.z = pk2(v1.x, v1.y); w.w = pk2(v1.z, v1.w);
                    *(v4u*)(rowp + bj * 128) = w; } }
    }
};
struct EpiRes {
    static constexpr bool PERM = true, AFTER_DRAIN = false;
    const float* base; bf16* out; const float* mod; int gofs;
    __device__ __forceinline__ void operator()(const f32x4 (&acc)[2][2][4][2], const pg8::Unit& u, int wr, int wc, int fr, int fq) const {
        const int row0 = u.pm * 256 + wr * 64 + fr, col0 = u.pn * 256 + wc * 32 + 8 * fq;
        const float* gp = mod + (size_t)(u.pm >> 3) * 6 * D + gofs + col0;
        f32x4 gv[2][2];
#pragma unroll
        for (int bj = 0; bj < 2; ++bj)
#pragma unroll
            for (int n = 0; n < 2; ++n) gv[bj][n] = *(const f32x4*)(gp + bj * 128 + 4 * n);
#pragma unroll
        for (int ai = 0; ai < 2; ++ai)
#pragma unroll
            for (int m = 0; m < 4; ++m) { const size_t off = (size_t)(row0 + ai * 128 + m * 16) * D + col0;
#pragma unroll
                for (int bj = 0; bj < 2; ++bj) { const f32x4 b0 = *(const f32x4*)(base + off + bj * 128), b1 = *(const f32x4*)(base + off + bj * 128 + 4);
                    const f32x4 v0 = b0 + gv[bj][0] * acc[ai][bj][m][0], v1 = b1 + gv[bj][1] * acc[ai][bj][m][1];
                    v4u w; w.x = pk2(v0.x, v0.y); w.y = pk2(v0.z, v0.w); w.z = pk2(v1.x, v1.y); w.w = pk2(v1.z, v1.w);
                    *(v4u*)(out + off + bj * 128) = w; }
                asm volatile("" ::: "memory"); }
    }
};

__device__ __forceinline__ void attn_phase(const Frame& F, const Args& A) {
    const int lane = lane_id(), tid = F.wave * 64 + lane; (void)tid;
    LAS float* bias = (LAS float*)(F.lds + XCH_OFF);
    LAS unsigned char* kl = F.lds + F.wave * 16384;
    LAS unsigned char* vl = kl + 8192;
    const int bh = F.vcu >> 2, b = bh >> 3, h = bh & 7;
    for (int i = tid; i < 15 * 31; i += NWAVES * 64) bias[i] = AP_rpb[h * 465 + i] * LOG2E;
    __syncthreads();
    const int r = 8 * (F.vcu & 3) + F.wave;
    const int rs = min(max(r - 4, 0), 24);
    const int q = lane & 31, hh = lane >> 5;
    const int l4 = lane >> 4, c16 = lane & 15, l2 = lane >> 2, g4 = lane & 3;
    const unsigned char* Kb = (const unsigned char*)(AP_K + (size_t)b * SEQ * DA + h * HD);
    const unsigned char* VTb = (const unsigned char*)(AP_VTR + (size_t)(b * NH + h) * HD * SEQ);
    const unsigned char* KCb = (const unsigned char*)(AP_KC + (size_t)b * CTXL * DA + h * HD);
    const unsigned char* VCb = (const unsigned char*)(AP_VCT + (size_t)(b * NH + h) * HD * CTXL);
    for (int qh = 0; qh < 2; ++qh) {
        const int c0 = qh ? 24 : 0, qcol = qh * 32 + q, cs = min(max(qcol - 8, 0), 48);
        const bf16* qp = AP_Q + (size_t)(b * SEQ + r * GW + qcol) * DA + h * HD + 32 * hh;
        bf16x8 qf[8];
#pragma unroll
        for (int s = 0; s < 8; ++s) qf[s] = *(const bf16x8*)(qp + 64 * (s >> 2) + 8 * (s & 3));
        f32x16 o[4];
#pragma unroll
        for (int db = 0; db < 4; ++db)
#pragma unroll
            for (int i = 0; i < 16; ++i) o[db][i] = 0.f;
        float mrun = -1e30f, lrun = 0.f;
        const int gsw = g4 ^ ((l2 >> 2) & 3);
#define ATT_KDMA(KB_) do { const int kb_ = (KB_); \
            if (kb_ < 10) { \
                _Pragma("unroll") for (int i_ = 0; i_ < 8; ++i_) { const int rho_ = 4 * i_ + l4; const int kk_ = kb_ * 32 + (4 * ((i_ >> 1) & 1) + 8 * (i_ & 1) + 16 * (i_ >> 2)) + l4, krow_ = (kk_ * 205) >> 13, kc_ = c0 + kk_ - krow_ * 40; \
                    __builtin_amdgcn_global_load_lds((const unsigned*)(Kb + (unsigned)(((rs + krow_) * GW + kc_) * (DA * 2) + 16 * (c16 ^ (rho_ & 15)))), (LAS unsigned*)(kl + i_ * 1024), 16, 0, 0); } \
            } else { \
                _Pragma("unroll") for (int i_ = 0; i_ < 8; ++i_) { const int rho_ = 4 * i_ + l4; const int l_ = (kb_ - 10) * 32 + (4 * ((i_ >> 1) & 1) + 8 * (i_ & 1) + 16 * (i_ >> 2)) + l4; \
                    __builtin_amdgcn_global_load_lds((const unsigned*)(KCb + (unsigned)(l_ * (DA * 2) + 16 * (c16 ^ (rho_ & 15)))), (LAS unsigned*)(kl + i_ * 1024), 16, 0, 0); } \
            } } while (0)
#define ATT_VDMA(KB_) do { const int kb_ = (KB_); \
            if (kb_ < 10) { \
                const int k0_ = kb_ * 32 + 8 * gsw, vr_ = (k0_ * 205) >> 13, vc_ = c0 + k0_ - vr_ * 40; const unsigned vo_ = (unsigned)((l2 * SEQ + (rs + vr_) * GW + vc_) * 2); \
                _Pragma("unroll") for (int i_ = 0; i_ < 8; ++i_) __builtin_amdgcn_global_load_lds((const unsigned*)(VTb + vo_ + (unsigned)(i_ * 16 * SEQ * 2)), (LAS unsigned*)(vl + i_ * 1024), 16, 0, 0); \
            } else { \
                const unsigned vo_ = (unsigned)((l2 * CTXL + (kb_ - 10) * 32 + 8 * gsw) * 2); \
                _Pragma("unroll") for (int i_ = 0; i_ < 8; ++i_) __builtin_amdgcn_global_load_lds((const unsigned*)(VCb + vo_ + (unsigned)(i_ * 16 * CTXL * 2)), (LAS unsigned*)(vl + i_ * 1024), 16, 0, 0); \
            } } while (0)
        asm volatile("s_waitcnt vmcnt(0) lgkmcnt(0)" ::: "memory");
        ATT_KDMA(0); ATT_VDMA(0);
        for (int kb = 0; kb < 18; ++kb) {
            const bool win = kb < 10;
            asm volatile("s_waitcnt vmcnt(8)" ::: "memory");
            bf16x8 kf[8];
#pragma unroll
            for (int s = 0; s < 8; ++s) kf[s] = *(const LAS bf16x8*)(kl + q * 256 + 16 * ((8 * (s >> 2) + 4 * hh + (s & 3)) ^ (q & 15)));
            asm volatile("s_waitcnt lgkmcnt(0)" ::: "memory");
            if (kb + 1 < 18) ATT_KDMA(kb + 1);
            f32x16 sa;
#pragma unroll
            for (int i = 0; i < 16; ++i) sa[i] = 0.f;
#pragma unroll
            for (int s = 0; s < 8; ++s) sa = __builtin_amdgcn_mfma_f32_32x32x16_bf16(kf[s], qf[s], sa, 0, 0, 0);
            if (win) {
#pragma unroll
                for (int i = 0; i < 16; ++i) {
                    const int g = kb * 4 + 2 * (i >> 3) + hh, w = (i & 3) + 4 * ((i >> 2) & 1);
                    const int krow = (g * 205) >> 10, kcol = c0 + 8 * (g - 5 * krow) + w;
                    const int dr = rs + krow - r + 7;
                    const int dc = min(max(kcol - qcol, -15), 15) + 15;
                    const bool inw = (unsigned)(kcol - cs) < 16u;
                    sa[i] = inw ? sa[i] + bias[dr * 31 + dc] : -1e30f;
                }
            }
            float bm = sa[0];
#pragma unroll
            for (int i = 1; i < 16; ++i) bm = fmaxf(bm, sa[i]);
            bm = fmaxf(bm, __shfl_xor(bm, 32));
            const float mnew = fmaxf(mrun, bm), alpha = __builtin_amdgcn_exp2f(mrun - mnew);
            mrun = mnew;
            float ps = 0.f;
#pragma unroll
            for (int i = 0; i < 16; ++i) { sa[i] = __builtin_amdgcn_exp2f(sa[i] - mnew); ps += sa[i]; }
            lrun = lrun * alpha + ps;
#pragma unroll
            for (int db = 0; db < 4; ++db)
#pragma unroll
                for (int i = 0; i < 16; ++i) o[db][i] *= alpha;
            bf16x8 pf[2];
#pragma unroll
            for (int s2 = 0; s2 < 2; ++s2) { v4u w; w.x = pk2(sa[8 * s2 + 0], sa[8 * s2 + 1]); w.y = pk2(sa[8 * s2 + 2], sa[8 * s2 + 3]); w.z = pk2(sa[8 * s2 + 4], sa[8 * s2 + 5]); w.w = pk2(sa[8 * s2 + 6], sa[8 * s2 + 7]); pf[s2] = __builtin_bit_cast(bf16x8, w); }
            if (kb + 1 < 18) asm volatile("s_waitcnt vmcnt(8)" ::: "memory"); else asm volatile("s_waitcnt vmcnt(0)" ::: "memory");
            bf16x8 vf[4][2];
#pragma unroll
            for (int db = 0; db < 4; ++db) { const int dd = db * 32 + q;
                vf[db][0] = *(const LAS bf16x8*)(vl + dd * 64 + 16 * ((0 + hh) ^ ((dd >> 2) & 3))); vf[db][1] = *(const LAS bf16x8*)(vl + dd * 64 + 16 * ((2 + hh) ^ ((dd >> 2) & 3))); }
            asm volatile("s_waitcnt lgkmcnt(0)" ::: "memory");
            if (kb + 1 < 18) ATT_VDMA(kb + 1);
#pragma unroll
            for (int db = 0; db < 4; ++db) { o[db] = __builtin_amdgcn_mfma_f32_32x32x16_bf16(vf[db][0], pf[0], o[db], 0, 0, 0); o[db] = __builtin_amdgcn_mfma_f32_32x32x16_bf16(vf[db][1], pf[1], o[db], 0, 0, 0); }
        }
#undef ATT_KDMA
#undef ATT_VDMA
        const float ltot = lrun + __shfl_xor(lrun, 32), inv = 1.f / ltot;
        float ss = 0.f;
#pragma unroll
        for (int db = 0; db < 4; ++db)
#pragma unroll
            for (int i = 0; i < 16; ++i) { o[db][i] *= inv; ss += o[db][i] * o[db][i]; }
        ss += __shfl_xor(ss, 32);
        const float rstd = __builtin_amdgcn_rsqf(ss * (1.f / HD) + EPS);
        bf16* op = AP_ACT + (size_t)(b * SEQ + r * GW + qcol) * D + h * HD + 4 * hh;
        const float* gp = AP_gao + h * HD + 4 * hh;
#pragma unroll
        for (int db = 0; db < 4; ++db)
#pragma unroll
            for (int i4 = 0; i4 < 4; ++i4) { const f32x4 g = *(const f32x4*)(gp + db * 32 + 8 * i4);
                v2u w; w.x = pk2(o[db][4 * i4 + 0] * rstd * g.x, o[db][4 * i4 + 1] * rstd * g.y); w.y = pk2(o[db][4 * i4 + 2] * rstd * g.z, o[db][4 * i4 + 3] * rstd * g.w);
                *(v2u*)(op + db * 32 + 8 * i4) = w; }
    }
    __syncthreads();
}

__device__ __forceinline__ void unpack16(const v4u a, const v4u b, float (&f)[16]) {
    f[0] = bflo(a.x); f[1] = bfhi(a.x); f[2] = bflo(a.y); f[3] = bfhi(a.y); f[4] = bflo(a.z); f[5] = bfhi(a.z); f[6] = bflo(a.w); f[7] = bfhi(a.w);
    f[8] = bflo(b.x); f[9] = bfhi(b.x); f[10] = bflo(b.y); f[11] = bfhi(b.y); f[12] = bflo(b.z); f[13] = bfhi(b.z); f[14] = bflo(b.w); f[15] = bfhi(b.w);
}
__device__ __forceinline__ void load_z(const bf16* CGp, const bf16* Up, size_t m, int lane, float (&z)[16]) {
    const v4u* cp = (const v4u*)(CGp + m * DA + 16 * lane); const v4u* up = (const v4u*)(Up + m * DA + 16 * lane);
    const v4u c0 = cp[0], c1 = cp[1], u0 = up[0], u1 = up[1];
    float cf[16], uf[16]; unpack16(c0, c1, cf); unpack16(u0, u1, uf);
#pragma unroll
    for (int i = 0; i < 16; ++i) z[i] = cf[i] * uf[i];
}
__device__ __forceinline__ void conv_phase(const Frame& F, const Args& A) {
    const int lane = lane_id(), tid = F.wave * 64 + lane; (void)tid;
    const int gw = F.vcu * NWAVES + F.wave, NGW = F.G * NWAVES;
    float w0[16], w1[16], w2[16], gg[16];
#pragma unroll
    for (int i = 0; i < 16; ++i) { w0[i] = AP_w_conv[0 * DA + 16 * lane + i]; w1[i] = AP_w_conv[1 * DA + 16 * lane + i]; w2[i] = AP_w_conv[2 * DA + 16 * lane + i]; gg[i] = AP_gco[16 * lane + i]; }
    for (int it = gw; it < M / 8; it += NGW) {
        const size_t m0 = (size_t)it * 8;
        float zp[16], zc[16], zn[16];
        if ((m0 & (SEQ - 1)) == 0) {
#pragma unroll
            for (int i = 0; i < 16; ++i) zp[i] = 0.f;
        } else load_z(AP_CG, AP_U, m0 - 1, lane, zp);
        load_z(AP_CG, AP_U, m0, lane, zc);
        for (int j = 0; j < 8; ++j) {
            const size_t m = m0 + j;
            if ((m & (SEQ - 1)) == SEQ - 1) {
#pragma unroll
                for (int i = 0; i < 16; ++i) zn[i] = 0.f;
            } else load_z(AP_CG, AP_U, m + 1, lane, zn);
            const v4u* bp = (const v4u*)(AP_BG + m * DA + 16 * lane); const v4u b0 = bp[0], b1 = bp[1];
            float bf[16]; unpack16(b0, b1, bf);
            float y[16], ss = 0.f;
#pragma unroll
            for (int i = 0; i < 16; ++i) { y[i] = bf[i] * (w0[i] * zp[i] + w1[i] * zc[i] + w2[i] * zn[i]); ss += y[i] * y[i]; }
            ss += __shfl_xor(ss, 1); ss += __shfl_xor(ss, 2); ss += __shfl_xor(ss, 4);
            const float rstd = __builtin_amdgcn_rsqf(ss * (1.f / 128.f) + EPS);
            v4u o0, o1;
            o0.x = pk2(y[0] * rstd * gg[0], y[1] * rstd * gg[1]); o0.y = pk2(y[2] * rstd * gg[2], y[3] * rstd * gg[3]); o0.z = pk2(y[4] * rstd * gg[4], y[5] * rstd * gg[5]); o0.w = pk2(y[6] * rstd * gg[6], y[7] * rstd * gg[7]);
            o1.x = pk2(y[8] * rstd * gg[8], y[9] * rstd * gg[9]); o1.y = pk2(y[10] * rstd * gg[10], y[11] * rstd * gg[11]); o1.z = pk2(y[12] * rstd * gg[12], y[13] * rstd * gg[13]); o1.w = pk2(y[14] * rstd * gg[14], y[15] * rstd * gg[15]);
            v4u* op = (v4u*)(AP_ACT + m * D + DA + 16 * lane); op[0] = o0; op[1] = o1;
#pragma unroll
            for (int i = 0; i < 16; ++i) { zp[i] = zc[i]; zc[i] = zn[i]; }
        }
    }
}

__device__ __forceinline__ unsigned f2key(float f) { const unsigned u = __builtin_bit_cast(unsigned, f); return (u & 0x80000000u) ? ~u : (u | 0x80000000u); }
__device__ __forceinline__ float key2f(unsigned k) { const unsigned u = (k & 0x80000000u) ? (k & 0x7fffffffu) : ~k; return __builtin_bit_cast(float, u); }
__device__ __forceinline__ void peer_select_phase(const Frame& F, const Args& A) {
    const int lane = lane_id(), tid = F.wave * 64 + lane; (void)tid;
    const int gw = F.vcu * NWAVES + F.wave, NGW = F.G * NWAVES, tk = lane & 31, hh = lane >> 5;
    LAS int* ixs = (LAS int*)(F.lds + F.wave * 8192);
    unsigned nh4 = (unsigned)(1 - hh) << 2; asm volatile("" : "+v"(nh4));
    for (int task = gw; task < (M / 32) * PH; task += NGW) {
        const int h = task & 7, tb = task >> 3; const int token = tb * 32 + tk;
        unsigned best[2][16];
#pragma unroll
        for (int p = 0; p < 2; ++p) {
            const bf16* qp = AP_QP + (size_t)token * D + h * 256 + p * 128 + 32 * hh;
            bf16x8 qf[8];
#pragma unroll
            for (int s = 0; s < 8; ++s) qf[s] = *(const bf16x8*)(qp + 64 * (s >> 2) + 8 * (s & 3));
            unsigned ky[64];
#pragma unroll
            for (int kb = 0; kb < 4; ++kb) {
                const bf16* kp = AP_SK + (size_t)((h * 2 + p) * NKEYS + kb * 32 + tk) * 128 + 32 * hh;
                bf16x8 kf[8];
#pragma unroll
                for (int s = 0; s < 8; ++s) kf[s] = *(const bf16x8*)(kp + 64 * (s >> 2) + 8 * (s & 3));
                f32x16 sa;
#pragma unroll
                for (int i = 0; i < 16; ++i) sa[i] = 0.f;
#pragma unroll
                for (int s = 0; s < 8; ++s) sa = __builtin_amdgcn_mfma_f32_32x32x16_bf16(kf[s], qf[s], sa, 0, 0, 0);
#pragma unroll
                for (int i = 0; i < 16; ++i) { const unsigned ck = (unsigned)(127 - (kb * 32 + (i & 3) + 8 * (i >> 2))) & ~4u;
                    ky[kb * 16 + i] = ((f2key(sa[i]) & ~127u) | nh4) | ck; }
                asm volatile("" ::: "memory");
            }
#pragma unroll
            for (int rnd = 0; rnd < 16; ++rnd) {
                unsigned mx = ky[0];
#pragma unroll
                for (int i = 1; i < 64; ++i) mx = max(mx, ky[i]);
                const unsigned ot = (unsigned)__shfl_xor((int)mx, 32);
                mx = max(mx, ot);
                best[p][rnd] = mx;
#pragma unroll
                for (int i = 0; i < 64; ++i) ky[i] = (ky[i] == mx) ? 0u : ky[i];
            }
        }
        float s1[16], s2[16];
#pragma unroll
        for (int i = 0; i < 16; ++i) { s1[i] = key2f(best[0][i] & ~127u); s2[i] = key2f(best[1][i] & ~127u);
            ixs[i * 64 + lane] = 127 - (int)(best[0][i] & 127u); ixs[(16 + i) * 64 + lane] = 127 - (int)(best[1][i] & 127u); }
        unsigned cd[50]; { int n = 0;
#pragma unroll
            for (int i = 0; i < 16; ++i)
#pragma unroll
                for (int j = 0; j < 16; ++j) if ((i + 1) * (j + 1) <= 16) { cd[n] = (f2key(s1[i] + s2[j]) & ~255u) | (unsigned)(255 - (16 * i + j)); ++n; } }
        unsigned win[16];
#pragma unroll
        for (int rnd = 0; rnd < 16; ++rnd) {
            unsigned mx = cd[0];
#pragma unroll
            for (int i = 1; i < 50; ++i) mx = max(mx, cd[i]);
            win[rnd] = mx;
#pragma unroll
            for (int i = 0; i < 50; ++i) cd[i] = (cd[i] == mx) ? 0u : cd[i];
        }
        LDS_WAIT();
        const float vmax = key2f(win[0] & ~255u);
        float ev[16], es = 0.f;
#pragma unroll
        for (int rnd = 0; rnd < 16; ++rnd) { ev[rnd] = __expf(key2f(win[rnd] & ~255u) - vmax); es += ev[rnd]; }
        const float ies = 1.f / es;
        if (hh == 0) {
            int* ip = AP_SELI + (size_t)token * 128 + h * 16; float* gp = AP_SELG + (size_t)token * 128 + h * 16;
#pragma unroll
            for (int rnd = 0; rnd < 16; ++rnd) { const int pos = 255 - (int)(win[rnd] & 255u); const int i1 = ixs[(pos >> 4) * 64 + lane], i2 = ixs[(16 + (pos & 15)) * 64 + lane];
                ip[rnd] = i1 * NKEYS + i2; gp[rnd] = ev[rnd] * ies; }
        }
        LDS_WAIT();
    }
}

typedef int v4i __attribute__((ext_vector_type(4)));
__device__ __forceinline__ float gelu_as(const float v) {
    const float av = fabsf(v), t = __builtin_amdgcn_rcpf(av * 0.2316418882f + 1.0f);
    float q = t * 0.5307027145f + (-0.7265760135f); q = q * t + 0.7107068705f; q = q * t + (-0.142248368f); q = q * t + 0.127414796f; q = q * t;
    const float e = __builtin_amdgcn_exp2f((v * v) * (-0.72134752044f));
    const float m = v * (q * e);
    return v < 0.f ? m : v - m;
}
constexpr int PL_WAVE = 16384, PL_EL = 8192, PL_PACC = 10240, PL_AQ = 14336, PL_SA = 15360;
__device__ __forceinline__ float wave_maxf(float v) {
#pragma unroll
    for (int o = 1; o < 64; o <<= 1) v = fmaxf(v, __shfl_xor(v, o));
    return v;
}
__device__ __forceinline__ void peer_u_phase(const Frame& F, const Args& A, float (&sa)[8]) {
    const int lane = lane_id(), p = lane >> 2, sub = lane & 3;
    LAS unsigned short* elist = (LAS unsigned short*)(F.lds + F.wave * PL_WAVE + PL_EL);
    LAS int* pacc = (LAS int*)(F.lds + F.wave * PL_WAVE + PL_PACC);
    LAS signed char* aq = (LAS signed char*)(F.lds + F.wave * PL_WAVE + PL_AQ);
    const int tok0 = F.vcu * 64 + F.wave * 8;
    for (int it = 0; it < 16; ++it) { elist[it * 64 + lane] = (unsigned short)AP_SELI[(size_t)tok0 * 128 + it * 64 + lane]; pacc[it * 64 + lane] = 0; }
    LDS_WAIT();
    v4u G0[4], G1[4], G2[4], G3[4], hreg[4];
    const unsigned char* ub = AP_U8 + 16 * sub; const unsigned char* hb = AP_H2Q + (size_t)tok0 * D + 16 * sub;
#define PU_LOAD(G_, K_) do { const int kg_ = (K_); const unsigned e_ = elist[(kg_ & 63) * 16 + p]; const unsigned char* up_ = ub + (size_t)e_ * D + 256 * (kg_ >> 6); \
            _Pragma("unroll") for (int j_ = 0; j_ < 4; ++j_) G_[j_] = *(const v4u*)(up_ + 64 * j_); } while (0)
#define PU_COMPUTE(G_, K_) do { const int kc_ = (K_), t_ = kc_ & 63; \
            if ((t_ & 7) == 0) { const unsigned char* hp_ = hb + (size_t)(t_ >> 3) * D + 256 * (kc_ >> 6); _Pragma("unroll") for (int j_ = 0; j_ < 4; ++j_) hreg[j_] = *(const v4u*)(hp_ + 64 * j_); } \
            int d0_ = 0, d1_ = 0, d2_ = 0, d3_ = 0; \
            _Pragma("unroll") for (int j_ = 0; j_ < 4; ++j_) { d0_ = __builtin_amdgcn_sdot4((int)G_[j_].x, (int)hreg[j_].x, d0_, false); d1_ = __builtin_amdgcn_sdot4((int)G_[j_].y, (int)hreg[j_].y, d1_, false); \
                d2_ = __builtin_amdgcn_sdot4((int)G_[j_].z, (int)hreg[j_].z, d2_, false); d3_ = __builtin_amdgcn_sdot4((int)G_[j_].w, (int)hreg[j_].w, d3_, false); } \
            int v_ = (d0_ + d1_) + (d2_ + d3_); \
            v_ += __builtin_amdgcn_update_dpp(0, v_, 0xB1, 0xf, 0xf, true);        \
            v_ += __builtin_amdgcn_update_dpp(0, v_, 0x4E, 0xf, 0xf, true);        \
            if (sub == 0) (void)__hip_atomic_fetch_add(pacc + t_ * 16 + p, v_, __ATOMIC_RELAXED, __HIP_MEMORY_SCOPE_WORKGROUP); } while (0)
    PU_LOAD(G0, 0); PU_LOAD(G1, 1); PU_LOAD(G2, 2); PU_LOAD(G3, 3);
    for (int k = 0; k < 512; k += 4) {
        PU_COMPUTE(G0, k);     if (k + 4 < 512) PU_LOAD(G0, k + 4);
        PU_COMPUTE(G1, k + 1); if (k + 5 < 512) PU_LOAD(G1, k + 5);
        PU_COMPUTE(G2, k + 2); if (k + 6 < 512) PU_LOAD(G2, k + 6);
        PU_COMPUTE(G3, k + 3); if (k + 7 < 512) PU_LOAD(G3, k + 7);
        if ((k & 127) == 124) __builtin_amdgcn_s_barrier();
    }
#undef PU_LOAD
#undef PU_COMPUTE
    LDS_WAIT();
#pragma unroll
    for (int t = 0; t < 8; ++t) { const int token = tok0 + t; const float hs = AP_H2S[token]; float av[2];
#pragma unroll
        for (int hf = 0; hf < 2; ++hf) { const int p = t * 128 + hf * 64 + lane; const unsigned e = elist[p];
            av[hf] = gelu_as((float)pacc[p] * AP_SU[e] * hs) * AP_SELG[(size_t)tok0 * 128 + p] * AP_SV[e]; }
        const float mx = fmaxf(wave_maxf(fmaxf(fabsf(av[0]), fabsf(av[1]))), 1e-30f), inv = 127.f / mx;
        aq[t * 128 + lane] = (signed char)(int)__builtin_rintf(av[0] * inv); aq[t * 128 + 64 + lane] = (signed char)(int)__builtin_rintf(av[1] * inv);
        sa[t] = mx * (1.f / 127.f); }
    LDS_WAIT();
}
__device__ __forceinline__ void peer_v_phase(const Frame& F, const Args& A, const float (&sa)[8]) {
    const int lane = lane_id(), n = lane & 15, kq = lane >> 4, rr = n >> 2, cc = n & 3;
    LAS unsigned char* buf = F.lds + F.wave * PL_WAVE;
    const LAS unsigned short* elist = (const LAS unsigned short*)(F.lds + F.wave * PL_WAVE + PL_EL);
    const LAS signed char* aq = (const LAS signed char*)(F.lds + F.wave * PL_WAVE + PL_AQ);
    const int tok0 = F.vcu * 64 + F.wave * 8;
    const int fsw = (rr >> 1) | ((kq & 1) << 1);
    const unsigned trbase = (unsigned)(size_t)buf + (unsigned)((8 * kq + rr) * 128 + 8 * cc);
    const int r0 = lane >> 3, c8 = lane & 7;
    v4u G0[4], G1[4], G2[4], G3[4];
    v4i accE[4], accO[4];
#pragma unroll
    for (int q = 0; q < 4; ++q) { accE[q] = (v4i){0, 0, 0, 0}; accO[q] = (v4i){0, 0, 0, 0}; }
#define PV_LOAD(G_, K_) do { const int kg_ = (K_); _Pragma("unroll") for (int i_ = 0; i_ < 4; ++i_) { const unsigned e_ = elist[(kg_ & 31) * 32 + 8 * i_ + r0]; \
            const int f_ = ((r0 >> 1) & 1) | ((i_ & 1) << 1); \
            G_[i_] = *(const v4u*)(AP_V8 + (size_t)e_ * D + 128 * (kg_ >> 5) + 32 * ((c8 >> 1) ^ f_) + 16 * (c8 & 1)); } } while (0)
#define PV_STORE(G_, B_) do { _Pragma("unroll") for (int i_ = 0; i_ < 4; ++i_) *(LAS v4u*)(buf + (B_) * 4096 + i_ * 1024 + lane * 16) = G_[i_]; } while (0)
#define PV_COMPUTE(K_, B_) do { const int kc_ = (K_), b_ = kc_ & 31, slice_ = kc_ >> 5; \
            v2u a8_ = *(const LAS v2u*)(aq + b_ * 32 + 8 * kq);                        \
            if (n != (b_ >> 2)) a8_ = (v2u){0u, 0u};                                  \
            v4i AE_, AO_; \
            AE_.x = (int)__builtin_amdgcn_perm(0u, a8_.x, 0x0c010c00u); AE_.y = (int)__builtin_amdgcn_perm(0u, a8_.x, 0x0c030c02u); AE_.z = (int)__builtin_amdgcn_perm(0u, a8_.y, 0x0c010c00u); AE_.w = (int)__builtin_amdgcn_perm(0u, a8_.y, 0x0c030c02u); \
            AO_.x = (int)__builtin_amdgcn_perm(0u, a8_.x, 0x010c000cu); AO_.y = (int)__builtin_amdgcn_perm(0u, a8_.x, 0x030c020cu); AO_.z = (int)__builtin_amdgcn_perm(0u, a8_.y, 0x010c000cu); AO_.w = (int)__builtin_amdgcn_perm(0u, a8_.y, 0x030c020cu); \
            const unsigned tb_ = trbase + (unsigned)((B_) * 4096); \
            const unsigned t0_ = tb_ + 32u * (unsigned)(0 ^ fsw), t1_ = tb_ + 32u * (unsigned)(1 ^ fsw), t2_ = tb_ + 32u * (unsigned)(2 ^ fsw), t3_ = tb_ + 32u * (unsigned)(3 ^ fsw); \
            v2u R_[4][2]; \
            asm volatile("s_waitcnt lgkmcnt(0)\n\t" \
                         "ds_read_b64_tr_b16 %0, %8\n\tds_read_b64_tr_b16 %1, %8 offset:512\n\tds_read_b64_tr_b16 %2, %9\n\tds_read_b64_tr_b16 %3, %9 offset:512\n\t" \
                         "ds_read_b64_tr_b16 %4, %10\n\tds_read_b64_tr_b16 %5, %10 offset:512\n\tds_read_b64_tr_b16 %6, %11\n\tds_read_b64_tr_b16 %7, %11 offset:512\n\ts_waitcnt lgkmcnt(0)" \
                         : "=&v"(R_[0][0]), "=&v"(R_[0][1]), "=&v"(R_[1][0]), "=&v"(R_[1][1]), "=&v"(R_[2][0]), "=&v"(R_[2][1]), "=&v"(R_[3][0]), "=&v"(R_[3][1]) : "v"(t0_), "v"(t1_), "v"(t2_), "v"(t3_) : "memory"); \
            _Pragma("unroll") for (int q_ = 0; q_ < 4; ++q_) { const v4i Bq_ = {(int)R_[q_][0].x, (int)R_[q_][0].y, (int)R_[q_][1].x, (int)R_[q_][1].y}; \
                accE[q_] = __builtin_amdgcn_mfma_i32_16x16x64_i8(AE_, Bq_, accE[q_], 0, 0, 0); \
                accO[q_] = __builtin_amdgcn_mfma_i32_16x16x64_i8(AO_, Bq_, accO[q_], 0, 0, 0); } \
            if (b_ == 31) { \
                if (kq < 2) { \
                    _Pragma("unroll") for (int i_ = 0; i_ < 4; ++i_) { const int token_ = tok0 + 4 * kq + i_; const float sat_ = kq ? sa[4 + i_] : sa[i_]; \
                        const float* gtp_ = AP_MOD + (size_t)(token_ >> 11) * 6 * D + 5 * D + 128 * slice_ + 2 * n; float* op_ = AP_out + (size_t)token_ * D + 128 * slice_ + 2 * n; \
                        const bf16* xp_ = AP_X1B + (size_t)token_ * D + 128 * slice_ + 2 * n; \
                        _Pragma("unroll") for (int q_ = 0; q_ < 4; ++q_) { typedef float f32x2t __attribute__((ext_vector_type(2))); \
                            const unsigned xw_ = *(const unsigned*)(xp_ + 32 * q_); const f32x2t g0_ = *(const f32x2t*)(gtp_ + 32 * q_); \
                            f32x2t r_; r_.x = bflo(xw_) + g0_.x * (sat_ * (float)accE[q_][i_]); r_.y = bfhi(xw_) + g0_.y * (sat_ * (float)accO[q_][i_]); \
                            *(f32x2t*)(op_ + 32 * q_) = r_; } } } \
                _Pragma("unroll") for (int q_ = 0; q_ < 4; ++q_) { accE[q_] = (v4i){0, 0, 0, 0}; accO[q_] = (v4i){0, 0, 0, 0}; } \
                if ((slice_ & 1) == 1) __builtin_amdgcn_s_barrier(); } } while (0)
    PV_LOAD(G0, 0); PV_LOAD(G1, 1); PV_LOAD(G2, 2); PV_LOAD(G3, 3); PV_STORE(G0, 0);
    for (int k = 0; k < 512; k += 4) {
        if (k + 4 < 512) PV_LOAD(G0, k + 4);
        PV_COMPUTE(k, 0);     PV_STORE(G1, 1);
        if (k + 5 < 512) PV_LOAD(G1, k + 5);
        PV_COMPUTE(k + 1, 1); PV_STORE(G2, 0);
        if (k + 6 < 512) PV_LOAD(G2, k + 6);
        PV_COMPUTE(k + 2, 0); PV_STORE(G3, 1);
        if (k + 7 < 512) PV_LOAD(G3, k + 7);
        PV_COMPUTE(k + 3, 1); if (k + 4 < 512) PV_STORE(G0, 0);
    }
#undef PV_LOAD
#undef PV_STORE
#undef PV_COMPUTE
}
__device__ __forceinline__ void peer_eval_phase(const Frame& F, const Args& A) { float sa[8]; peer_u_phase(F, A, sa); peer_v_phase(F, A, sa); }

template <bool FUSED, int ONLY>
__global__ void __launch_bounds__(NWAVES * 64, 2) mk_fwd(Args args) {
    extern __shared__ __attribute__((aligned(16))) unsigned char lds[];
    Frame F;
    F.lds = (LAS unsigned char*)lds;
    F.wave = __builtin_amdgcn_readfirstlane((int)threadIdx.x >> 6);
    F.G = gridDim.x; { const int bx = blockIdx.x; F.vcu = (F.G % 8 == 0) ? (bx % 8) * (F.G / 8) + bx / 8 : bx; }
    const Args& A = args;
    const int lo = (ONLY >= 0) ? ONLY : args.ph_lo, hi = (ONLY >= 0) ? ONLY + 1 : args.ph_hi;
#define IN(k) ((ONLY < 0 || ONLY == (k)) && lo <= (k) && (k) < hi)
    XcdBarrier bar; bar.bar = (unsigned*)(args.ws + WS_CTL); bar.x = 0; bar.st = (volatile LAS unsigned*)(F.lds + MISC_OFF);
    if constexpr (FUSED) {
        if (MK_CG_SYNC) cg::this_grid().sync();
        bar.x = xb_xcc_id();
        if (F.wave == 0 && lane_id() == 0) { bar.st[0] = 0u; bar.st[1] = 0u; (void)xb_add(&bar.bar[XB_XCNT(bar.x)], 1u); }
        __syncthreads();
    }
#define SEAM(k) do { if (FUSED && IN(k) && IN((k) + 1)) { xcd_barrier(bar, F.wave, (unsigned)F.G); } } while (0)

    if (IN(0)) { p0_prologue(F, A); } SEAM(0);
    if (IN(1)) { p1_norm1(F, A); } SEAM(1);
    if (IN(2)) {
        { pg8::Gemm g{(const bf16*)AP_H8, (const bf16*)AP_WIN8, M, NPROJ, D / 2}; pg8::StaticOrder S; S.init(M, NPROJ, F.G, (int)blockIdx.x);
          EpiProj E{AP_Q, AP_K, AP_VTR, AP_BG, AP_CG, AP_U, AP_qn, AP_kn, (LAS float*)(F.lds + XCH_OFF), 0, 11, 0.08838834764831845f * LOG2E, AP_HS, AP_WINS};
          pg8::gemm_phase<EpiProj, pg8::StaticOrder, true, true, true>(F.lds, g, S, E, F.wave); }
        { pg8::Gemm g{(const bf16*)AP_HC8, (const bf16*)(AP_WIN8 + (size_t)DA * D), MC, 2 * DA, D / 2}; pg8::StaticOrder S; S.init(MC, 2 * DA, F.G, (int)blockIdx.x);
          EpiProj E{nullptr, AP_KC, AP_VCT, nullptr, nullptr, nullptr, AP_qn, AP_kn, (LAS float*)(F.lds + XCH_OFF), 1, 8, 1.f, AP_HCS, AP_WINS + DA};
          pg8::gemm_phase<EpiProj, pg8::StaticOrder, true, true, true>(F.lds, g, S, E, F.wave); }
    } SEAM(2);
    if (IN(3)) { attn_phase(F, A); conv_phase(F, A); } SEAM(3);
    if (IN(4)) { pg8::Gemm g{AP_ACT, AP_WOUT, M, D, D}; pg8::StaticOrder S; S.init(M, D, F.G, (int)blockIdx.x);
        EpiRes E{AP_x, AP_X1B, AP_MOD, 2 * D};
        pg8::gemm_phase<EpiRes, pg8::StaticOrder, true, true>(F.lds, g, S, E, F.wave); } SEAM(4);
    if (IN(5)) { p5_norm2(F, A); } SEAM(5);
    if (IN(6)) { pg8::Gemm g{AP_ACT, AP_WPQ, M, D, D}; pg8::StaticOrder S; S.init(M, D, F.G, (int)blockIdx.x);
        EpiBf16 E{AP_QP, D};
        pg8::gemm_phase<EpiBf16, pg8::StaticOrder, true, true>(F.lds, g, S, E, F.wave); } SEAM(6);
    if (IN(7)) { peer_select_phase(F, A); } SEAM(7);
    if (IN(8)) { peer_eval_phase(F, A); }
#undef IN
#undef SEAM
}

template <int PHS> static bool set_lds() { return hipFuncSetAttribute((const void*)mk_fwd<false, PHS>, hipFuncAttributeMaxDynamicSharedMemorySize, LDS_BYTES) == hipSuccess; }
template <int PHS> static void launch_one(int grid, hipStream_t stream, const Args& a) {
    hipLaunchKernelGGL((mk_fwd<false, PHS>), dim3(grid), dim3(NWAVES * 64), LDS_BYTES, stream, a);
    const hipError_t le = hipPeekAtLastError();
    if (le != hipSuccess) fprintf(stderr, "kernel_launch: launch %d failed: %s\n", PHS, hipGetErrorName(le));
}
extern "C" void kernel_launch(void* const* d_in, const int* in_sizes, int n_in, void* d_out, int out_size, void* d_ws, size_t ws_size, hipStream_t stream) {
    constexpr bool FUSED = (MK_N_LAUNCHES == 1);
    static int grid = 0;
    if (grid == 0) {
        if (n_in != 20 || in_sizes[0] != M * D || out_size != M * D || ws_size < WS_END) { fprintf(stderr, "kernel_launch: unexpected shapes (n_in %d, in0 %d, out %d, ws %zu < %zu); nothing launched\n", n_in, n_in > 0 ? in_sizes[0] : -1, out_size, ws_size, (size_t)WS_END); grid = -1; return; }
        int dev = 0, cus = 0, per_cu = 0;
        if (hipGetDevice(&dev) != hipSuccess || hipDeviceGetAttribute(&cus, hipDeviceAttributeMultiprocessorCount, dev) != hipSuccess) { grid = -1; return; }
        bool okattr = true;
        if constexpr (FUSED) okattr = hipFuncSetAttribute((const void*)mk_fwd<true, -1>, hipFuncAttributeMaxDynamicSharedMemorySize, LDS_BYTES) == hipSuccess;
        else { okattr &= set_lds<0>(); okattr &= set_lds<1>(); okattr &= set_lds<2>(); okattr &= set_lds<3>(); okattr &= set_lds<4>(); okattr &= set_lds<5>(); okattr &= set_lds<6>(); okattr &= set_lds<7>(); okattr &= set_lds<8>(); }
        if (!okattr) { fprintf(stderr, "kernel_launch: hipFuncSetAttribute failed\n"); grid = -1; return; }
        if (hipOccupancyMaxActiveBlocksPerMultiprocessor(&per_cu, (const void*)mk_fwd<FUSED, (FUSED ? -1 : 2)>, NWAVES * 64, LDS_BYTES) != hipSuccess || per_cu < 1) { fprintf(stderr, "kernel_launch: occupancy query says %d blocks per CU; nothing launched\n", per_cu); grid = -1; return; }
        (void)hipGetLastError();
        grid = cus;
        if (grid != 256) fprintf(stderr, "kernel_launch: note: %d CUs (built for 256)\n", grid);
    }
    if (grid < 0) return;
    Args a{};
    for (int i = 0; i < 20; ++i) a.in[i] = (const float*)d_in[i];
    a.out = (float*)d_out; a.ws = (unsigned char*)d_ws;
    if constexpr (FUSED) {
        a.ph_lo = 0; a.ph_hi = NPHASE;
        if (hipMemsetAsync((char*)d_ws + WS_CTL, 0, 128 * 1024, stream) != hipSuccess) { fprintf(stderr, "kernel_launch: memset of the barrier words failed\n"); return; }
        void* kargs[] = {&a};
        hipError_t e;
        if (MK_CG_SYNC) e = hipLaunchCooperativeKernel((const void*)mk_fwd<true, -1>, dim3(grid), dim3(NWAVES * 64), kargs, LDS_BYTES, stream);
        else { hipLaunchKernelGGL((mk_fwd<true, -1>), dim3(grid), dim3(NWAVES * 64), LDS_BYTES, stream, a); e = hipPeekAtLastError(); }
        if (e != hipSuccess) fprintf(stderr, "kernel_launch: launch failed: %s (grid %d)\n", hipGetErrorString(e), grid);
    } else {
        a.ph_lo = 0; a.ph_hi = NPHASE;
        launch_one<0>(grid, stream, a); launch_one<1>(grid, stream, a); launch_one<2>(grid, stream, a); launch_one<3>(grid, stream, a); launch_one<4>(grid, stream, a);
        launch_one<5>(grid, stream, a); launch_one<6>(grid, stream, a); launch_one<7>(grid, stream, a); launch_one<8>(grid, stream, a);
    }
}
```

```cpp
#include <hip/hip_runtime.h>
#include <hip/hip_cooperative_groups.h>
#include <cstdio>
#include <cstdint>
namespace cg = cooperative_groups;
#define MK_N_LAUNCHES 1
namespace pg8 {
#define PG8_LAS __attribute__((address_space(3)))
typedef unsigned short bf16_t;
typedef short bf16x8 __attribute__((ext_vector_type(8)));
typedef float f32x4 __attribute__((ext_vector_type(4)));
typedef unsigned u32x4 __attribute__((ext_vector_type(4)));
constexpr int BM = 256, BK = 64, HALF = 128, HTB = HALF * BK * 2  , STAGE_BYTES = 8 * HTB, NXCD = 8, WGM = 8;

__host__ __device__ __forceinline__ int lds_byte(int r, int c) { const int st = (r >> 4) * 2 + (c >> 5), rr = r & 15, cc = c & 31, ob = rr * 64 + cc * 2; return st * 1024 + (ob ^ (((ob >> 9) & 1) << 5)); }
__host__ __device__ __forceinline__ void stage_rc(int b, int& R, int& C) { const int st = b / 1024, sb = b % 1024, swz = sb ^ (((sb >> 9) & 1) << 5); R = (st >> 1) * 16 + swz / 64; C = (st & 1) * 32 + (swz % 64) / 2; }
__host__ __device__ __forceinline__ int perm32(int rho) { const int n = rho >> 4, i = rho & 15; return 8 * (i >> 2) + 4 * n + (i & 3); }

struct Unit { int pm, pn; };
struct Gemm { const bf16_t* A; const bf16_t* Bt; int M, N, K; };

struct StaticOrder {
    int nM, nN, nwg, G, c;
    __host__ __device__ void init(int M, int N, int G_, int c_) { nM = M / BM; nN = N / BM; nwg = nM * nN; G = G_; c = c_; }
    __host__ __device__ bool next(int i, Unit& u) const {
        const long L = (long)i * G + c; if (L >= nwg) return false;
        int wgid = (int)L; { const int q = nwg / NXCD, r = nwg % NXCD, xcd = wgid % NXCD, off = wgid / NXCD; wgid = (xcd < r ? xcd * (q + 1) : r * (q + 1) + (xcd - r) * q) + off; }
        const int nig = WGM * nN, gid = wgid / nig, fm = gid * WGM, gsz = (nM - fm) < WGM ? (nM - fm) : WGM;
        u.pm = fm + ((wgid % nig) % gsz); u.pn = (wgid % nig) / gsz; return true;
    }
    __device__ __forceinline__ void a_ready(const Unit&) const {}
    __device__ __forceinline__ void done(const Unit&) const {}
};

__device__ __forceinline__ unsigned cvt_pk_bf16(float lo, float hi) { unsigned r; asm volatile("v_cvt_pk_bf16_f32 %0, %1, %2" : "=v"(r) : "v"(lo), "v"(hi)); return r; }
typedef float f32x2 __attribute__((ext_vector_type(2)));
template <class Epi, class Sched, bool ALIGN_EPI = false, bool SP2 = false, bool I8 = false>
__device__ __forceinline__ void gemm_phase(PG8_LAS unsigned char* lds, const Gemm g, const Sched& S, const Epi& E, const int wid) {
    int lane; asm volatile("v_mbcnt_lo_u32_b32 %0, -1, 0\n\tv_mbcnt_hi_u32_b32 %0, -1, %0" : "=v"(lane)); const int tid = wid * 64 + lane, wr = wid >> 2, wc = wid & 3, fr = lane & 15, fq = lane >> 4;
    const int K = g.K, nt = K / BK;
    unsigned voffA[2], voffB[2];
#pragma unroll
    for (int i = 0; i < 2; ++i) { int R, C; stage_rc(tid * 16 + i * 8192, R, C); const int Rb = Epi::PERM ? ((R & ~31) + perm32(R & 31)) : R;
        voffA[i] = (unsigned)(R * K + C) * 2u; voffB[i] = (unsigned)(Rb * K + C) * 2u; }
    const size_t kstep = (size_t)(BK * 2);
    const size_t hstep = (size_t)HALF * K * 2;
    const size_t tstep = 2 * hstep;
    const unsigned ldsw = (unsigned)wid * 1024u;
    const int aoff = lds_byte(wr * 64 + fr, fq * 8), boff = lds_byte(wc * 32 + fr, fq * 8);
#define PG8_SA(b, h) (((b) * 2 + (h)) * HTB)
#define PG8_SB(b, h) ((4 + (b) * 2 + (h)) * HTB)
#define PG8_STAGE(bufoff, gbase, voff) do { _Pragma("unroll") for (int _i = 0; _i < 2; ++_i) \
        __builtin_amdgcn_global_load_lds((const unsigned*)((const char*)(gbase) + (voff)[_i]), (PG8_LAS unsigned*)(lds + (bufoff) + ldsw + _i * 8192), 16, 0, 0); } while (0)
#define PG8_LDA(dst, b, h) do { _Pragma("unroll") for (int m = 0; m < 4; ++m) _Pragma("unroll") for (int k = 0; k < 2; ++k) dst[m][k] = *(const PG8_LAS bf16x8*)(lds + PG8_SA(b, h) + aoff + m * 2048 + k * 1024); } while (0)
#define PG8_LDB(dst, b, h) do { _Pragma("unroll") for (int n = 0; n < 2; ++n) _Pragma("unroll") for (int k = 0; k < 2; ++k) dst[n][k] = *(const PG8_LAS bf16x8*)(lds + PG8_SB(b, h) + boff + n * 2048 + k * 1024); } while (0)
#define PG8_MMA(ai, bj, At, Bt) do { __builtin_amdgcn_s_setprio(1); _Pragma("unroll") for (int m = 0; m < 4; ++m) _Pragma("unroll") for (int n = 0; n < 2; ++n) _Pragma("unroll") for (int k = 0; k < 2; ++k) \
        { if constexpr (I8) { typedef int v4i_ __attribute__((ext_vector_type(4))); acc[ai][bj][m][n] = __builtin_bit_cast(f32x4, __builtin_amdgcn_mfma_i32_16x16x64_i8(__builtin_bit_cast(v4i_, Bt[n][k]), __builtin_bit_cast(v4i_, At[m][k]), __builtin_bit_cast(v4i_, acc[ai][bj][m][n]), 0, 0, 0)); } \
          else acc[ai][bj][m][n] = __builtin_amdgcn_mfma_f32_16x16x32_bf16(Bt[n][k], At[m][k], acc[ai][bj][m][n], 0, 0, 0); } __builtin_amdgcn_s_setprio(0); } while (0)
#define PG8_WAIT_V(n) asm volatile("s_waitcnt vmcnt(" #n ")" ::: "memory")
#define PG8_WAIT_L(n) asm volatile("s_waitcnt lgkmcnt(" #n ")" ::: "memory")
#define PG8_BAR __builtin_amdgcn_s_barrier()
#define PG8_SCHED __builtin_amdgcn_sched_barrier(0)
    Unit cur, nxt; int ui = 0;
    if (!S.next(0, cur)) return;
    f32x4 acc[2][2][4][2];
#pragma unroll
    for (int a = 0; a < 2; ++a)
#pragma unroll
        for (int b = 0; b < 2; ++b)
#pragma unroll
            for (int m = 0; m < 4; ++m)
#pragma unroll
                for (int n = 0; n < 2; ++n) acc[a][b][m][n] = (f32x4){0.f, 0.f, 0.f, 0.f};
    bf16x8 At[4][2], B0[2][2], B1[2][2];
    const char* cA = (const char*)g.A + (size_t)cur.pm * tstep; const char* cB = (const char*)g.Bt + (size_t)cur.pn * tstep;
    S.a_ready(cur);
    if constexpr (SP2) {
        PG8_STAGE(PG8_SB(0, 0), cB, voffB); PG8_STAGE(PG8_SB(0, 1), cB + hstep, voffB); PG8_STAGE(PG8_SA(0, 0), cA, voffA); PG8_STAGE(PG8_SA(0, 1), cA + hstep, voffA);
        if (wr == 1) PG8_BAR;
        PG8_WAIT_V(2); PG8_BAR;
        PG8_STAGE(PG8_SB(1, 0), cB + kstep, voffB); PG8_STAGE(PG8_SA(1, 0), cA + kstep, voffA); PG8_STAGE(PG8_SB(1, 1), cB + hstep + kstep, voffB);
        PG8_WAIT_V(6); PG8_BAR;
    } else {
        PG8_STAGE(PG8_SB(0, 0), cB, voffB); PG8_STAGE(PG8_SA(0, 0), cA, voffA); PG8_STAGE(PG8_SB(0, 1), cB + hstep, voffB); PG8_STAGE(PG8_SA(0, 1), cA + hstep, voffA);
        if (wr == 1) PG8_BAR;
        PG8_WAIT_V(4); PG8_BAR;
        PG8_STAGE(PG8_SB(1, 0), cB + kstep, voffB); PG8_STAGE(PG8_SA(1, 0), cA + kstep, voffA); PG8_STAGE(PG8_SB(1, 1), cB + hstep + kstep, voffB);
        PG8_WAIT_V(6); PG8_BAR;
    }
    for (;;) {
        const bool has_next = S.next(ui + 1, nxt);
        const char* nA = has_next ? (const char*)g.A + (size_t)nxt.pm * tstep : cA; const char* nB = has_next ? (const char*)g.Bt + (size_t)nxt.pn * tstep : cB;
        for (int t = 0; t < nt; t += 2) {
            const bool last = (t == nt - 2);
            const char* a1 = cA + (size_t)(t + 1) * kstep;
            const char* a2 = last ? nA : cA + (size_t)(t + 2) * kstep; const char* b2 = last ? nB : cB + (size_t)(t + 2) * kstep;
            const char* a3 = a2 + kstep; const char* b3 = b2 + kstep;
            if (last && has_next) S.a_ready(nxt);
            if constexpr (SP2) {
            PG8_LDB(B0, 0, 0); PG8_LDB(B1, 0, 1); PG8_SCHED; PG8_LDA(At, 0, 0); PG8_STAGE(PG8_SA(1, 1), a1 + hstep, voffA);
            PG8_WAIT_V(8); PG8_WAIT_L(0); PG8_BAR; PG8_MMA(0, 0, At, B0); PG8_MMA(0, 1, At, B1); PG8_BAR; PG8_SCHED;
            PG8_LDA(At, 0, 1); PG8_STAGE(PG8_SB(0, 0), b2, voffB); PG8_STAGE(PG8_SB(0, 1), b2 + hstep, voffB); PG8_STAGE(PG8_SA(0, 0), a2, voffA);
            PG8_WAIT_V(8); PG8_WAIT_L(0); PG8_BAR; PG8_MMA(1, 0, At, B0); PG8_MMA(1, 1, At, B1); PG8_BAR; PG8_SCHED;
            PG8_LDB(B0, 1, 0); PG8_LDB(B1, 1, 1); PG8_SCHED; PG8_LDA(At, 1, 0); PG8_STAGE(PG8_SA(0, 1), a2 + hstep, voffA);
            PG8_WAIT_V(8); PG8_WAIT_L(0); PG8_BAR; PG8_MMA(0, 0, At, B0); PG8_MMA(0, 1, At, B1); PG8_BAR; PG8_SCHED;
            PG8_LDA(At, 1, 1); PG8_STAGE(PG8_SB(1, 0), b3, voffB); PG8_STAGE(PG8_SB(1, 1), b3 + hstep, voffB); PG8_STAGE(PG8_SA(1, 0), a3, voffA);
            PG8_WAIT_V(8); PG8_WAIT_L(0); PG8_BAR; PG8_MMA(1, 0, At, B0); PG8_MMA(1, 1, At, B1); PG8_BAR; PG8_SCHED;
            } else {
            PG8_LDB(B0, 0, 0); PG8_SCHED; PG8_LDA(At, 0, 0); PG8_STAGE(PG8_SA(1, 1), a1 + hstep, voffA);
            PG8_WAIT_L(8); PG8_BAR; PG8_WAIT_L(0); PG8_MMA(0, 0, At, B0); PG8_BAR; PG8_SCHED;
            PG8_LDB(B1, 0, 1); PG8_STAGE(PG8_SB(0, 0), b2, voffB);
            PG8_BAR; PG8_WAIT_L(0); PG8_MMA(0, 1, At, B1); PG8_BAR;
            PG8_LDA(At, 0, 1); PG8_STAGE(PG8_SA(0, 0), a2, voffA);
            PG8_BAR; PG8_WAIT_L(0); PG8_MMA(1, 0, At, B0); PG8_BAR; PG8_SCHED;
            PG8_STAGE(PG8_SB(0, 1), b2 + hstep, voffB);
            PG8_WAIT_V(6); PG8_BAR; PG8_MMA(1, 1, At, B1); PG8_BAR;
            PG8_LDB(B0, 1, 0); PG8_SCHED; PG8_LDA(At, 1, 0); PG8_STAGE(PG8_SA(0, 1), a2 + hstep, voffA);
            PG8_WAIT_L(8); PG8_BAR; PG8_WAIT_L(0); PG8_MMA(0, 0, At, B0); PG8_BAR; PG8_SCHED;
            PG8_LDB(B1, 1, 1); PG8_STAGE(PG8_SB(1, 0), b3, voffB);
            PG8_BAR; PG8_WAIT_L(0); PG8_MMA(0, 1, At, B1); PG8_BAR;
            PG8_LDA(At, 1, 1); PG8_STAGE(PG8_SA(1, 0), a3, voffA);
            PG8_BAR; PG8_WAIT_L(0); PG8_MMA(1, 0, At, B0); PG8_BAR; PG8_SCHED;
            PG8_STAGE(PG8_SB(1, 1), b3 + hstep, voffB);
            PG8_WAIT_V(6); PG8_BAR; PG8_MMA(1, 1, At, B1); PG8_BAR;
            }
        }
        if constexpr (ALIGN_EPI) { if (wr == 0) PG8_BAR; }
        if constexpr (!Epi::AFTER_DRAIN) { E(acc, cur, wr, wc, fr, fq); S.done(cur); }
        if (!has_next) break;
#pragma unroll
        for (int a = 0; a < 2; ++a)
#pragma unroll
            for (int b = 0; b < 2; ++b)
#pragma unroll
                for (int m = 0; m < 4; ++m)
#pragma unroll
                    for (int n = 0; n < 2; ++n) acc[a][b][m][n] = (f32x4){0.f, 0.f, 0.f, 0.f};
        cur = nxt; cA = nA; cB = nB; ++ui;
        if constexpr (ALIGN_EPI) { if (wr == 1) PG8_BAR; }
    }
    PG8_WAIT_V(0);
    if constexpr (!ALIGN_EPI) { if (wr == 0) PG8_BAR; }
    PG8_BAR;
    if constexpr (Epi::AFTER_DRAIN) { E.fused(acc, cur, wr, wc, fr, fq, lds, wid, lane); S.done(cur); }
#undef PG8_SA
#undef PG8_SB
#undef PG8_STAGE
#undef PG8_LDA
#undef PG8_LDB
#undef PG8_MMA
#undef PG8_WAIT_V
#undef PG8_WAIT_L
#undef PG8_BAR
#undef PG8_SCHED
}
}

#ifndef MK_N_LAUNCHES
#define MK_N_LAUNCHES 1
#endif
constexpr int NPHASE = 9;

constexpr int D = 2048, NB = 8, SEQ = 2048, M = NB * SEQ, CTXL = 256, MC = NB * CTXL;
constexpr int NH = 8, HD = 128, DA = 1024, NPROJ = 6144, GW = 64;
constexpr int NEXP = 16384, PH = 8, PK = 16, NKEYS = 128;
constexpr float EPS = 1e-6f, LOG2E = 1.4426950408889634f;
constexpr int NWAVES = 8;

constexpr size_t MiB = 1u << 20;
constexpr size_t WS_CTL = 0, WS_MOD = 1 * MiB, WS_SK = 2 * MiB, WS_WIN = 4 * MiB, WS_WOUT = 28 * MiB, WS_WPQ = 36 * MiB;
constexpr size_t WS_UT = 44 * MiB, WS_VT = 108 * MiB, WS_ACT = 172 * MiB, WS_HC = 236 * MiB;
constexpr size_t WS_Q = 244 * MiB, WS_K = 276 * MiB, WS_VTR = 308 * MiB, WS_BG = 340 * MiB, WS_CG = 372 * MiB, WS_U = 404 * MiB;
constexpr size_t WS_KC = 436 * MiB, WS_VCT = 440 * MiB, WS_QP = 244 * MiB  ;
constexpr size_t WS_SELI = 444 * MiB, WS_SELG = 452 * MiB, WS_AVW = 460 * MiB, WS_END = 468 * MiB;
constexpr size_t WS_U8 = WS_UT, WS_V8 = WS_UT + 32 * MiB, WS_SU = WS_VT, WS_SV = WS_VT + 64 * 1024, WS_H2S = WS_VT + 128 * 1024, WS_H2Q = WS_VT + 1 * MiB;

constexpr int LDS_BYTES = 147456;
constexpr int XCH_OFF = 131072;
constexpr int MISC_OFF = 131072 + 8192;
#ifndef MK_CG_SYNC
#define MK_CG_SYNC 1
#endif

#define GAS __attribute__((address_space(1)))
#define LAS __attribute__((address_space(3)))
typedef unsigned short bf16;
typedef unsigned v4u __attribute__((ext_vector_type(4)));
typedef unsigned v2u __attribute__((ext_vector_type(2)));
typedef float f32x4 __attribute__((ext_vector_type(4)));
typedef float f32x16 __attribute__((ext_vector_type(16)));
typedef short bf16x8 __attribute__((ext_vector_type(8)));
typedef __bf16 bf16x2 __attribute__((ext_vector_type(2)));
#define LDS_WAIT() asm volatile("s_waitcnt lgkmcnt(0)" ::: "memory")

__device__ __forceinline__ unsigned f2bf(float f) { unsigned u = __builtin_bit_cast(unsigned, f); return (u + 0x7fffu + ((u >> 16) & 1u)) >> 16; }
__device__ __forceinline__ unsigned pk2(float lo, float hi) { return pg8::cvt_pk_bf16(lo, hi); }
__device__ __forceinline__ float bflo(unsigned w) { return __builtin_bit_cast(float, w << 16); }
__device__ __forceinline__ float bfhi(unsigned w) { return __builtin_bit_cast(float, w & 0xffff0000u); }
__device__ __forceinline__ float dot2_bf16(unsigned w, unsigned x, float acc) { return __builtin_amdgcn_fdot2_f32_bf16(__builtin_bit_cast(bf16x2, w), __builtin_bit_cast(bf16x2, x), acc, false); }
__device__ __forceinline__ float wave_sum(float v) {
#pragma unroll
    for (int o = 1; o < 64; o <<= 1) v += __shfl_xor(v, o);
    return v;
}

struct Args { const float* in[20]; float* out; unsigned char* ws; int ph_lo, ph_hi; };
struct Frame {
    LAS unsigned char* lds;
    int wave, vcu, G;
};
__device__ __forceinline__ int lane_id() { int l; asm volatile("v_mbcnt_lo_u32_b32 %0, -1, 0\n\tv_mbcnt_hi_u32_b32 %0, -1, %0" : "=v"(l)); return l; }
#define F_LANE lane_id()
#define F_TID (F.wave * 64 + lane_id())
#define AP_x (A.in[0])
#define AP_c (A.in[1])
#define AP_ctx (A.in[2])
#define AP_c_ctx (A.in[3])
#define AP_w_ada (A.in[4])
#define AP_b_ada (A.in[5])
#define AP_g1 (A.in[6])
#define AP_w_in (A.in[7])
#define AP_qn (A.in[8])
#define AP_kn (A.in[9])
#define AP_rpb (A.in[10])
#define AP_w_conv (A.in[11])
#define AP_gao (A.in[12])
#define AP_gco (A.in[13])
#define AP_w_out (A.in[14])
#define AP_g2 (A.in[15])
#define AP_w_pq (A.in[16])
#define AP_subk (A.in[17])
#define AP_uex (A.in[18])
#define AP_vex (A.in[19])
#define AP_SK ((bf16*)(A.ws + WS_SK))
#define AP_WIN ((bf16*)(A.ws + WS_WIN))
#define AP_WOUT ((bf16*)(A.ws + WS_WOUT))
#define AP_WPQ ((bf16*)(A.ws + WS_WPQ))
#define AP_UT ((bf16*)(A.ws + WS_UT))
#define AP_VT ((bf16*)(A.ws + WS_VT))
#define AP_ACT ((bf16*)(A.ws + WS_ACT))
#define AP_HC ((bf16*)(A.ws + WS_HC))
#define AP_Q ((bf16*)(A.ws + WS_Q))
#define AP_K ((bf16*)(A.ws + WS_K))
#define AP_VTR ((bf16*)(A.ws + WS_VTR))
#define AP_BG ((bf16*)(A.ws + WS_BG))
#define AP_CG ((bf16*)(A.ws + WS_CG))
#define AP_U ((bf16*)(A.ws + WS_U))
#define AP_KC ((bf16*)(A.ws + WS_KC))
#define AP_VCT ((bf16*)(A.ws + WS_VCT))
#define AP_QP ((bf16*)(A.ws + WS_QP))
#define AP_MOD ((float*)(A.ws + WS_MOD))
#define AP_SELI ((int*)(A.ws + WS_SELI))
#define AP_SELG ((float*)(A.ws + WS_SELG))
#define AP_AVW ((float*)(A.ws + WS_AVW))
#define AP_WIN8 ((unsigned char*)(A.ws + WS_WIN))
#define AP_WINS ((float*)(A.ws + WS_WIN + 16 * MiB))
#define AP_CPART ((float*)(A.ws + WS_WIN + 17 * MiB))
#define AP_H8 ((unsigned char*)(A.ws + WS_ACT))
#define AP_HC8 ((unsigned char*)(A.ws + WS_HC))
#define AP_HS ((float*)(A.ws + WS_HC + 4 * MiB))
#define AP_HCS ((float*)(A.ws + WS_HC + 4 * MiB + 65536))
#define AP_X1B ((bf16*)(A.ws + WS_BG))
#define AP_out (A.out)
#define AP_U8 ((const unsigned char*)(A.ws + WS_U8))
#define AP_V8 ((const unsigned char*)(A.ws + WS_V8))
#define AP_SU ((float*)(A.ws + WS_SU))
#define AP_SV ((float*)(A.ws + WS_SV))
#define AP_H2S ((float*)(A.ws + WS_H2S))
#define AP_H2Q ((unsigned char*)(A.ws + WS_H2Q))


#define XB_TMO      128
#define XB_XCNT(j)  (256  + 64 * (j))
#define XB_XSUB(j)  (1280 + 64 * (j))
#define XB_XGEN(j)  (2304 + 64 * (j))
#define XB_TOP      3328
#define XB_TOPGEN   3392
#define XCD_BAR_WORDS 3456
#define XB_SPIN_CAP (1u << 22)
__device__ __forceinline__ unsigned xb_ld(unsigned* p)              { return __hip_atomic_load(p, __ATOMIC_RELAXED, __HIP_MEMORY_SCOPE_AGENT); }
__device__ __forceinline__ unsigned xb_add(unsigned* p, unsigned v) { return __hip_atomic_fetch_add(p, v, __ATOMIC_RELAXED, __HIP_MEMORY_SCOPE_AGENT); }
__device__ __forceinline__ unsigned xb_xcc_id() { return (unsigned)__builtin_amdgcn_s_getreg((3 << 11) | 20) & 0xFu; }
#define XB_SPIN(cond, bar) do { unsigned _sp = 0; while (cond) { __builtin_amdgcn_s_sleep(1); \
    if ((++_sp & 255u) == 0u) { if (xb_ld(&(bar)[XB_TMO])) break; if (_sp > XB_SPIN_CAP) { atomicAdd(&(bar)[XB_TMO], 1u); break; } } } } while (0)
struct XcdBarrier { unsigned* bar; unsigned x; volatile LAS unsigned* st; };
__device__ __forceinline__ void xcd_barrier_complete(unsigned* bar, unsigned x, unsigned G, unsigned& nloc, unsigned& nx) {
    unsigned sum, cnt, mine, sp = 0u;
    for (;;) {
        sum = 0u; cnt = 0u; mine = 0u;
#pragma unroll
        for (unsigned j = 0; j < 16; ++j) { const unsigned c = xb_ld(&bar[XB_XCNT(j)]); sum += c; cnt += (c > 0u) ? 1u : 0u; mine = (j == x) ? c : mine; }
        if (sum == G) break;
        __builtin_amdgcn_s_sleep(1);
        if ((++sp & 255u) == 0u) { if (xb_ld(&bar[XB_TMO])) break; if (sp > XB_SPIN_CAP) { atomicAdd(&bar[XB_TMO], 1u); break; } }
    }
    nloc = mine > 0u ? mine : 1u; nx = cnt > 0u ? cnt : 1u;
}
__device__ __forceinline__ void xcd_barrier(const XcdBarrier& b, const int wave, const unsigned G) {
    asm volatile("s_waitcnt vmcnt(0)" ::: "memory");
    __syncthreads();
    if (wave == 0 && lane_id() == 0) {
        unsigned* bar = b.bar;
        __builtin_amdgcn_s_waitcnt(0);
        unsigned nloc = b.st[0], nx = b.st[1];
        if (nloc == 0u) { xcd_barrier_complete(bar, b.x, G, nloc, nx); b.st[0] = nloc; b.st[1] = nx; }
        const unsigned old = xb_add(&bar[XB_XSUB(b.x)], 1u);
        const unsigned gen = old / nloc;
        if (old + 1u == (gen + 1u) * nloc) {
            __builtin_amdgcn_fence(__ATOMIC_RELEASE, "agent");
            asm volatile("s_waitcnt vmcnt(0)" ::: "memory");
            const unsigned og = xb_add(&bar[XB_TOP], 1u);
            const unsigned tg = og / nx;
            if (og + 1u == (tg + 1u) * nx) xb_add(&bar[XB_TOPGEN], 1u);
            else XB_SPIN(xb_ld(&bar[XB_TOPGEN]) == tg, bar);
            __builtin_amdgcn_fence(__ATOMIC_ACQUIRE, "agent");
            xb_add(&bar[XB_XGEN(b.x)], 1u);
            asm volatile("s_waitcnt vmcnt(0)" ::: "memory");
        } else {
            XB_SPIN(xb_ld(&bar[XB_XGEN(b.x)]) == gen, bar);
            __builtin_amdgcn_fence(__ATOMIC_ACQUIRE, "agent");
            asm volatile("s_waitcnt vmcnt(0)" ::: "memory");
        }
    }
    __syncthreads();
}

__device__ __forceinline__ void p0_mod(const Frame& F, const Args& A) {
    const int lane = lane_id(), tid = F.wave * 64 + lane; (void)tid;
    LAS float* sc = (LAS float*)F.lds;
    LAS float* red = (LAS float*)(F.lds + 9 * 2048 * 4);
    for (int i = tid; i < 9 * D; i += NWAVES * 64) { const int r = i >> 11, k = i & (D - 1); const float cv = (r < 8) ? AP_c[r * D + k] : AP_c_ctx[k]; sc[i] = cv / (1.f + __expf(-cv)); }
    __syncthreads();
    const int sr = lane >> 4, cq = lane & 15;
    for (int item = F.vcu; item < (6 * D) / 64; item += F.G) {
        const int n0 = item * 64;
        float acc[9][4];
#pragma unroll
        for (int r = 0; r < 9; ++r)
#pragma unroll
            for (int j = 0; j < 4; ++j) acc[r][j] = 0.f;
        const float* wp = AP_w_ada + (size_t)(F.wave * 4 + sr) * (6 * D) + n0 + 4 * cq;
#pragma unroll 8
        for (int step = 0; step < 64; ++step) {
            const int k = step * 32 + F.wave * 4 + sr;
            const f32x4 w = *(const f32x4*)(wp + (size_t)step * 32 * (6 * D));
#pragma unroll
            for (int r = 0; r < 9; ++r) { const float s = sc[r * D + k]; acc[r][0] += s * w.x; acc[r][1] += s * w.y; acc[r][2] += s * w.z; acc[r][3] += s * w.w; }
        }
#pragma unroll
        for (int r = 0; r < 9; ++r)
#pragma unroll
            for (int j = 0; j < 4; ++j) { float v = acc[r][j]; v += __shfl_xor(v, 16); v += __shfl_xor(v, 32); if (sr == 0) red[(F.wave * 9 + r) * 64 + 4 * cq + j] = v; }
        __syncthreads();
        for (int i = tid; i < 9 * 64; i += NWAVES * 64) { const int r = i >> 6, cc = i & 63; float s = 0.f;
#pragma unroll
            for (int w = 0; w < 8; ++w) s += red[(w * 9 + r) * 64 + cc];
            AP_MOD[r * (6 * D) + n0 + cc] = s + AP_b_ada[n0 + cc]; }
        __syncthreads();
    }
    __syncthreads();
}
__device__ __forceinline__ void p0_transpose_item(const float* W, int K, int N, bf16* WT, LAS float* scr, int item, int lane) {
    const int nblk = N / 32, kb = item / nblk, nb = item % nblk, k0 = 64 * kb, n0 = 32 * nb;
#pragma unroll 8
    for (int i = 0; i < 32; ++i) { const int kk = 2 * i + (lane >> 5); scr[kk * 33 + (lane & 31)] = W[(size_t)(k0 + kk) * N + n0 + (lane & 31)]; }
    LDS_WAIT(); asm volatile("" ::: "memory");
    const int c = lane & 7;
#pragma unroll
    for (int j = 0; j < 4; ++j) { const int n = (lane >> 3) + 8 * j; const LAS float* s = scr + (8 * c) * 33 + n;
        v4u o; o.x = pk2(s[0 * 33], s[1 * 33]); o.y = pk2(s[2 * 33], s[3 * 33]); o.z = pk2(s[4 * 33], s[5 * 33]); o.w = pk2(s[6 * 33], s[7 * 33]);
        *(v4u*)(WT + (size_t)(n0 + n) * K + k0 + 8 * c) = o; }
    LDS_WAIT(); asm volatile("" ::: "memory");
}
__device__ __forceinline__ void cvt_f32_bf16(const float* src, bf16* dst, size_t n, size_t gtid, size_t gthreads) {
    for (size_t i = gtid * 8; i < n; i += gthreads * 8) { const f32x4 a = *(const f32x4*)(src + i), b = *(const f32x4*)(src + i + 4);
        v4u o; o.x = pk2(a.x, a.y); o.y = pk2(a.z, a.w); o.z = pk2(b.x, b.y); o.w = pk2(b.z, b.w); *(v4u*)(dst + i) = o; }
}
__device__ __forceinline__ float wave_max(float v) {
#pragma unroll
    for (int o = 1; o < 64; o <<= 1) v = fmaxf(v, __shfl_xor(v, o));
    return v;
}
__device__ __forceinline__ unsigned q4(const f32x4 v, const float inv, const int off = 0) {
    const int a = (int)fminf(fmaxf(__builtin_rintf(v.x * inv), -127.f), 127.f) + off, b = (int)fminf(fmaxf(__builtin_rintf(v.y * inv), -127.f), 127.f) + off, c = (int)fminf(fmaxf(__builtin_rintf(v.z * inv), -127.f), 127.f) + off, d = (int)fminf(fmaxf(__builtin_rintf(v.w * inv), -127.f), 127.f) + off;
    return (unsigned)(a & 255) | ((unsigned)(b & 255) << 8) | ((unsigned)(c & 255) << 16) | ((unsigned)(d & 255) << 24);
}
__device__ __forceinline__ void quant_row(const float* src, unsigned char* dst, float* scale, int lane, const int off) {
    const f32x4* xr = (const f32x4*)src + lane; f32x4 v[8]; float mx = 0.f;
#pragma unroll
    for (int j = 0; j < 8; ++j) { v[j] = xr[64 * j]; mx = fmaxf(mx, fmaxf(fmaxf(fabsf(v[j].x), fabsf(v[j].y)), fmaxf(fabsf(v[j].z), fabsf(v[j].w)))); }
    mx = fmaxf(wave_max(mx), 1e-30f);
    const float inv = 127.f / mx;
    unsigned* o = (unsigned*)dst + lane;
#pragma unroll
    for (int j = 0; j < 8; ++j) o[64 * j] = q4(v[j], inv, off);
    if (lane == 0) *scale = mx * (1.f / 127.f);
}
__device__ __forceinline__ void p1_transpose_item_i8(const float* W, int K, int N, unsigned char* WT, const float* cpart, float* wscale, LAS float* scr, int item, int lane) {
    const int nblk = N / 32, kb = item / nblk, nb = item % nblk, k0 = 64 * kb, n0 = 32 * nb;
    { float cm = 0.f;
#pragma unroll
      for (int p = 0; p < 16; ++p) cm = fmaxf(cm, cpart[(size_t)(16 * (lane >> 5) + p) * N + n0 + (lane & 31)]);
      cm = fmaxf(cm, __shfl_xor(cm, 32));
      scr[64 * 33 + (lane & 31)] = cm; }
#pragma unroll 8
    for (int i = 0; i < 32; ++i) { const int kk = 2 * i + (lane >> 5); scr[kk * 33 + (lane & 31)] = W[(size_t)(k0 + kk) * N + n0 + (lane & 31)]; }
    LDS_WAIT(); asm volatile("" ::: "memory");
    const int c = lane & 7;
#pragma unroll
    for (int j = 0; j < 4; ++j) { const int n = (lane >> 3) + 8 * j; const LAS float* sp = scr + (8 * c) * 33 + n;
        const float mx = fmaxf(scr[64 * 33 + n], 1e-30f), inv = 127.f / mx;
        f32x4 a = {sp[0 * 33], sp[1 * 33], sp[2 * 33], sp[3 * 33]}, b = {sp[4 * 33], sp[5 * 33], sp[6 * 33], sp[7 * 33]};
        v2u o; o.x = q4(a, inv); o.y = q4(b, inv);
        *(v2u*)(WT + (size_t)(n0 + n) * K + k0 + 8 * c) = o;
        if (kb == 0 && c == 0) wscale[n0 + n] = mx * (1.f / 127.f); }
    LDS_WAIT(); asm volatile("" ::: "memory");
}
__device__ __forceinline__ void p0_prologue(const Frame& F, const Args& A) {
    const int lane = lane_id(), tid = F.wave * 64 + lane; (void)tid;
    p0_mod(F, A);
    LAS float* scr = (LAS float*)(F.lds + F.wave * 16384);
    const int gw = F.vcu * NWAVES + F.wave, NGW = F.G * NWAVES;
    constexpr int I_SQ = (D / 64) * (D / 32);
    for (int it = gw; it < 2 * I_SQ; it += NGW) {
        int r = it;
        if (r < I_SQ) { p0_transpose_item(AP_w_out, D, D, AP_WOUT, scr, r, lane); continue; } r -= I_SQ;
        p0_transpose_item(AP_w_pq, D, D, AP_WPQ, scr, r, lane);
    }
    for (int it = gw; it < (NPROJ / 256) * (D / 64); it += NGW) { const int cb = it % (NPROJ / 256), kb = it / (NPROJ / 256);
        const f32x4* wp = (const f32x4*)(AP_w_in + (size_t)(kb * 64) * NPROJ + cb * 256) + lane; f32x4 mx = {0.f, 0.f, 0.f, 0.f};
#pragma unroll 8
        for (int k = 0; k < 64; ++k) { const f32x4 w = wp[(size_t)k * (NPROJ / 4)]; mx.x = fmaxf(mx.x, fabsf(w.x)); mx.y = fmaxf(mx.y, fabsf(w.y)); mx.z = fmaxf(mx.z, fabsf(w.z)); mx.w = fmaxf(mx.w, fabsf(w.w)); }
        *((f32x4*)(AP_CPART + (size_t)kb * NPROJ + cb * 256) + lane) = mx; }
    const size_t gtid = (size_t)F.vcu * (NWAVES * 64) + tid, gth = (size_t)F.G * NWAVES * 64;
    cvt_f32_bf16(AP_subk, AP_SK, (size_t)PH * 2 * NKEYS * 128, gtid, gth);
    for (int it = gw; it < 2 * NEXP; it += NGW) {
        const int e = it >> 1; const bool isv = it & 1;
        quant_row((isv ? AP_vex : AP_uex) + (size_t)e * D, (unsigned char*)(A.ws + (isv ? WS_V8 : WS_U8)) + (size_t)e * D, (isv ? AP_SV : AP_SU) + e, lane, 0);
    }
}

__device__ __forceinline__ void norm_rows(const float* X, size_t row0, int nrows, const float* g, const float* sh, const float* sc, bf16* out, int lane, unsigned char* q8 = nullptr, float* qs = nullptr) {
    f32x4 gs[8], shv[8];
#pragma unroll
    for (int j = 0; j < 8; ++j) { const int cI = j * 64 + lane; const f32x4 gg = ((const f32x4*)g)[cI], s1 = ((const f32x4*)sc)[cI]; gs[j] = gg * (1.f + s1); shv[j] = ((const f32x4*)sh)[cI]; }
    for (int r = 0; r < nrows; ++r) {
        const f32x4* xr = (const f32x4*)(X + (row0 + r) * D) + lane;
        f32x4 v[8]; float ss = 0.f;
#pragma unroll
        for (int j = 0; j < 8; ++j) { v[j] = xr[64 * j]; ss += (v[j].x * v[j].x + v[j].y * v[j].y) + (v[j].z * v[j].z + v[j].w * v[j].w); }
        const float rstd = __builtin_amdgcn_rsqf(wave_sum(ss) * (1.f / D) + EPS);
        v2u* o8 = (v2u*)(out + (row0 + r) * D) + lane; float mx = 0.f;
#pragma unroll
        for (int j = 0; j < 8; ++j) { const f32x4 y = v[j] * rstd * gs[j] + shv[j]; v[j] = y; if (out) { v2u w; w.x = pk2(y.x, y.y); w.y = pk2(y.z, y.w); o8[64 * j] = w; }
            mx = fmaxf(mx, fmaxf(fmaxf(fabsf(y.x), fabsf(y.y)), fmaxf(fabsf(y.z), fabsf(y.w)))); }
        if (q8) { mx = fmaxf(wave_max(mx), 1e-30f); const float inv = 127.f / mx; unsigned* oq = (unsigned*)(q8 + (row0 + r) * D) + lane;
#pragma unroll
            for (int j = 0; j < 8; ++j) oq[64 * j] = q4(v[j], inv);
            if (lane == 0) qs[row0 + r] = mx * (1.f / 127.f); }
    }
}
__device__ __forceinline__ void norm_rows_b(const bf16* X, size_t row0, int nrows, const float* g, const float* sh, const float* sc, bf16* out, int lane, unsigned char* q8, float* qs) {
    f32x4 gs[8], shv[8];
#pragma unroll
    for (int j = 0; j < 8; ++j) { const int cI = j * 64 + lane; const f32x4 gg = ((const f32x4*)g)[cI], s1 = ((const f32x4*)sc)[cI]; gs[j] = gg * (1.f + s1); shv[j] = ((const f32x4*)sh)[cI]; }
    for (int r = 0; r < nrows; ++r) {
        const v2u* xr = (const v2u*)(X + (row0 + r) * D) + lane;
        f32x4 v[8]; float ss = 0.f;
#pragma unroll
        for (int j = 0; j < 8; ++j) { const v2u w = xr[64 * j]; v[j].x = bflo(w.x); v[j].y = bfhi(w.x); v[j].z = bflo(w.y); v[j].w = bfhi(w.y); ss += (v[j].x * v[j].x + v[j].y * v[j].y) + (v[j].z * v[j].z + v[j].w * v[j].w); }
        const float rstd = __builtin_amdgcn_rsqf(wave_sum(ss) * (1.f / D) + EPS);
        v2u* o8 = (v2u*)(out + (row0 + r) * D) + lane; float mx = 0.f;
#pragma unroll
        for (int j = 0; j < 8; ++j) { const f32x4 y = v[j] * rstd * gs[j] + shv[j]; v[j] = y; v2u w; w.x = pk2(y.x, y.y); w.y = pk2(y.z, y.w); o8[64 * j] = w;
            mx = fmaxf(mx, fmaxf(fmaxf(fabsf(y.x), fabsf(y.y)), fmaxf(fabsf(y.z), fabsf(y.w)))); }
        mx = fmaxf(wave_max(mx), 1e-30f); const float inv = 127.f / mx; unsigned* oq = (unsigned*)(q8 + (row0 + r) * D) + lane;
#pragma unroll
        for (int j = 0; j < 8; ++j) oq[64 * j] = q4(v[j], inv);
        if (lane == 0) qs[row0 + r] = mx * (1.f / 127.f);
    }
}
__device__ __forceinline__ void p1_norm1(const Frame& F, const Args& A) {
    const int lane = lane_id(), tid = F.wave * 64 + lane; (void)tid;
    const int gw = F.vcu * NWAVES + F.wave, NGW = F.G * NWAVES;
    { LAS float* scr = (LAS float*)(F.lds + F.wave * 16384);
      for (int it = gw; it < (D / 64) * (NPROJ / 32); it += NGW) p1_transpose_item_i8(AP_w_in, D, NPROJ, AP_WIN8, AP_CPART, AP_WINS, scr, it, lane); }
    for (int it = gw; it < M / 8; it += NGW) { const size_t row0 = (size_t)it * 8; const int b = (int)(row0 >> 11);
        norm_rows(AP_x, row0, 8, AP_g1, AP_MOD + b * 6 * D + 0 * D, AP_MOD + b * 6 * D + 1 * D, nullptr, lane, AP_H8, AP_HS); }
    for (int it = gw; it < MC; it += NGW) norm_rows(AP_ctx, (size_t)it, 1, AP_g1, AP_MOD + 8 * 6 * D + 0 * D, AP_MOD + 8 * 6 * D + 1 * D, nullptr, lane, AP_HC8, AP_HCS);
}
__device__ __forceinline__ void p5_norm2(const Frame& F, const Args& A) {
    const int lane = lane_id(), tid = F.wave * 64 + lane; (void)tid;
    const int gw = F.vcu * NWAVES + F.wave, NGW = F.G * NWAVES;
    for (int it = gw; it < M / 8; it += NGW) { const size_t row0 = (size_t)it * 8; const int b = (int)(row0 >> 11);
        norm_rows_b(AP_X1B, row0, 8, AP_g2, AP_MOD + b * 6 * D + 3 * D, AP_MOD + b * 6 * D + 4 * D, AP_ACT, lane, AP_H2Q, AP_H2S); }
}

__device__ __forceinline__ f32x4 dq4(const f32x4 a, const f32x4 cs, const float rs) {
    typedef int v4i_ __attribute__((ext_vector_type(4))); const v4i_ iv = __builtin_bit_cast(v4i_, a);
    f32x4 r; r.x = (float)iv.x; r.y = (float)iv.y; r.z = (float)iv.z; r.w = (float)iv.w; return r * cs * rs;
}
struct EpiProj {
    static constexpr bool PERM = true, AFTER_DRAIN = false;
    bf16 *Q, *Kp, *VTp, *BG, *CG, *U; const float *qn, *kn; LAS float* xch; int region0, tshift; float qscale; const float *rs, *csb;
    __device__ __forceinline__ void operator()(const f32x4 (&acc)[2][2][4][2], const pg8::Unit& u, int wr, int wc, int fr, int fq) const {
        const int region = (u.pn >> 2) + region0, pnl = u.pn & 3;
        const int rowt = wr * 64 + fr;
        f32x4 cs_[2][2]; float rsc_[2][4];
#pragma unroll
        for (int bj = 0; bj < 2; ++bj)
#pragma unroll
            for (int n = 0; n < 2; ++n) cs_[bj][n] = *(const f32x4*)(csb + u.pn * 256 + bj * 128 + 32 * wc + 8 * fq + 4 * n);
#pragma unroll
        for (int ai = 0; ai < 2; ++ai)
#pragma unroll
            for (int m = 0; m < 4; ++m) rsc_[ai][m] = rs[u.pm * 256 + ai * 128 + rowt + m * 16];
#define DQ(ai_, bj_, m_, n_) dq4(acc[ai_][bj_][m_][n_], cs_[bj_][n_], rsc_[ai_][m_])
        if (region <= 1) {
#pragma unroll
            for (int ai = 0; ai < 2; ++ai)
#pragma unroll
                for (int m = 0; m < 4; ++m)
#pragma unroll
                    for (int bj = 0; bj < 2; ++bj) { const f32x4 a = DQ(ai, bj, m, 0), b = DQ(ai, bj, m, 1);
                        float s = (a.x * a.x + a.y * a.y) + (a.z * a.z + a.w * a.w) + (b.x * b.x + b.y * b.y) + (b.z * b.z + b.w * b.w);
                        s += __shfl_xor(s, 16); s += __shfl_xor(s, 32);
                        if (fq == 0) xch[((ai * 128 + rowt + m * 16) * 2 + bj) * 4 + wc] = s; }
            asm volatile("s_waitcnt lgkmcnt(0)" ::: "memory"); __builtin_amdgcn_s_barrier(); asm volatile("" ::: "memory");
            const float* gain = (region == 0) ? qn : kn; const float mul = (region == 0) ? qscale : 1.f; bf16* O = (region == 0) ? Q : Kp;
            const f32x4 g0 = *(const f32x4*)(gain + 32 * wc + 8 * fq), g1 = *(const f32x4*)(gain + 32 * wc + 8 * fq + 4);
#pragma unroll
            for (int ai = 0; ai < 2; ++ai)
#pragma unroll
                for (int m = 0; m < 4; ++m) { const int rt = ai * 128 + rowt + m * 16; bf16* rowp = O + (size_t)(u.pm * 256 + rt) * DA + (2 * pnl) * HD + 32 * wc + 8 * fq;
#pragma unroll
                    for (int bj = 0; bj < 2; ++bj) { const f32x4 p = *(const LAS f32x4*)(xch + (rt * 2 + bj) * 4);
                        const float rstd = __builtin_amdgcn_rsqf(((p.x + p.y) + (p.z + p.w)) * (1.f / HD) + EPS) * mul;
                        const f32x4 v0 = DQ(ai, bj, m, 0) * rstd * g0, v1 = DQ(ai, bj, m, 1) * rstd * g1;
                        v4u w; w.x = pk2(v0.x, v0.y); w.y = pk2(v0.z, v0.w); w.z = pk2(v1.x, v1.y); w.w = pk2(v1.z, v1.w);
                        *(v4u*)(rowp + bj * HD) = w; } }
        } else if (region == 2) {
            const int tmask = (1 << tshift) - 1;
#pragma unroll
            for (int ai = 0; ai < 2; ++ai)
#pragma unroll
                for (int m = 0; m < 4; ++m) { const int row = u.pm * 256 + ai * 128 + rowt + m * 16; const int b = row >> tshift, t = row & tmask;
#pragma unroll
                    for (int bj = 0; bj < 2; ++bj) { const int head = 2 * pnl + bj; bf16* base = VTp + (((size_t)(b * NH + head) * HD + 32 * wc + 8 * fq) << tshift) + t;
#pragma unroll
                        for (int n = 0; n < 2; ++n) { const f32x4 a = DQ(ai, bj, m, n); const unsigned w0 = pk2(a.x, a.y), w1 = pk2(a.z, a.w);
                            base[(size_t)(4 * n + 0) << tshift] = (bf16)(w0 & 0xffffu); base[(size_t)(4 * n + 1) << tshift] = (bf16)(w0 >> 16);
                            base[(size_t)(4 * n + 2) << tshift] = (bf16)(w1 & 0xffffu); base[(size_t)(4 * n + 3) << tshift] = (bf16)(w1 >> 16); } } }
        } else {
            bf16* O = (region == 3) ? BG : (region == 4) ? CG : U;
#pragma unroll
            for (int ai = 0; ai < 2; ++ai)
#pragma unroll
                for (int m = 0; m < 4; ++m) { bf16* rowp = O + (size_t)(u.pm * 256 + ai * 128 + rowt + m * 16) * DA + pnl * 256 + 32 * wc + 8 * fq;
#pragma unroll
                    for (int bj = 0; bj < 2; ++bj) { const f32x4 v0 = DQ(ai, bj, m, 0), v1 = DQ(ai, bj, m, 1);
                        v4u w; w.x = pk2(v0.x, v0.y); w.y = pk2(v0.z, v0.w); w.z = pk2(v1.x, v1.y); w.w = pk2(v1.z, v1.w);
                        *(v4u*)(rowp + bj * HD) = w; } }
        }
#undef DQ
    }
};
struct EpiBf16 {
    static constexpr bool PERM = true, AFTER_DRAIN = false;
    bf16* O; int ldc;
    __device__ __forceinline__ void operator()(const f32x4 (&acc)[2][2][4][2], const pg8::Unit& u, int wr, int wc, int fr, int fq) const {
        const int row0 = u.pm * 256 + wr * 64 + fr, col0 = u.pn * 256 + wc * 32 + 8 * fq;
#pragma unroll
        for (int ai = 0; ai < 2; ++ai)
#pragma unroll
            for (int m = 0; m < 4; ++m) { bf16* rowp = O + (size_t)(row0 + ai * 128 + m * 16) * ldc + col0;
#pragma unroll
                for (int bj = 0; bj < 2; ++bj) { const f32x4 v0 = acc[ai][bj][m][0], v1 = acc[ai][bj][m][1];
                    v4u w; w.x = pk2(v0.x, v0.y); w.y = pk2(v0.z, v0.w); w.z = pk2(v1.x, v1.y); w.w = pk2(v1.z, v1.w);
                    *(v4u*)(rowp + bj * 128) = w; } }
    }
};
struct EpiRes {
    static constexpr bool PERM = true, AFTER_DRAIN = false;
    const float* base; bf16* out; const float* mod; int gofs;
    __device__ __forceinline__ void operator()(const f32x4 (&acc)[2][2][4][2], const pg8::Unit& u, int wr, int wc, int fr, int fq) const {
        const int row0 = u.pm * 256 + wr * 64 + fr, col0 = u.pn * 256 + wc * 32 + 8 * fq;
        const float* gp = mod + (size_t)(u.pm >> 3) * 6 * D + gofs + col0;
        f32x4 gv[2][2];
#pragma unroll
        for (int bj = 0; bj < 2; ++bj)
#pragma unroll
            for (int n = 0; n < 2; ++n) gv[bj][n] = *(const f32x4*)(gp + bj * 128 + 4 * n);
#pragma unroll
        for (int ai = 0; ai < 2; ++ai)
#pragma unroll
            for (int m = 0; m < 4; ++m) { const size_t off = (size_t)(row0 + ai * 128 + m * 16) * D + col0;
#pragma unroll
                for (int bj = 0; bj < 2; ++bj) { const f32x4 b0 = *(const f32x4*)(base + off + bj * 128), b1 = *(const f32x4*)(base + off + bj * 128 + 4);
                    const f32x4 v0 = b0 + gv[bj][0] * acc[ai][bj][m][0], v1 = b1 + gv[bj][1] * acc[ai][bj][m][1];
                    v4u w; w.x = pk2(v0.x, v0.y); w.y = pk2(v0.z, v0.w); w.z = pk2(v1.x, v1.y); w.w = pk2(v1.z, v1.w);
                    *(v4u*)(out + off + bj * 128) = w; }
                asm volatile("" ::: "memory"); }
    }
};

__device__ __forceinline__ void attn_phase(const Frame& F, const Args& A) {
    const int lane = lane_id(), tid = F.wave * 64 + lane; (void)tid;
    LAS float* bias = (LAS float*)(F.lds + XCH_OFF);
    LAS unsigned char* kl = F.lds + F.wave * 16384;
    LAS unsigned char* vl = kl + 8192;
    const int bh = F.vcu >> 2, b = bh >> 3, h = bh & 7;
    for (int i = tid; i < 15 * 31; i += NWAVES * 64) bias[i] = AP_rpb[h * 465 + i] * LOG2E;
    __syncthreads();
    const int r = 8 * (F.vcu & 3) + F.wave;
    const int rs = min(max(r - 4, 0), 24);
    const int q = lane & 31, hh = lane >> 5;
    const int l4 = lane >> 4, c16 = lane & 15, l2 = lane >> 2, g4 = lane & 3;
    const unsigned char* Kb = (const unsigned char*)(AP_K + (size_t)b * SEQ * DA + h * HD);
    const unsigned char* VTb = (const unsigned char*)(AP_VTR + (size_t)(b * NH + h) * HD * SEQ);
    const unsigned char* KCb = (const unsigned char*)(AP_KC + (size_t)b * CTXL * DA + h * HD);
    const unsigned char* VCb = (const unsigned char*)(AP_VCT + (size_t)(b * NH + h) * HD * CTXL);
    for (int qh = 0; qh < 2; ++qh) {
        const int c0 = qh ? 24 : 0, qcol = qh * 32 + q, cs = min(max(qcol - 8, 0), 48);
        const bf16* qp = AP_Q + (size_t)(b * SEQ + r * GW + qcol) * DA + h * HD + 32 * hh;
        bf16x8 qf[8];
#pragma unroll
        for (int s = 0; s < 8; ++s) qf[s] = *(const bf16x8*)(qp + 64 * (s >> 2) + 8 * (s & 3));
        f32x16 o[4];
#pragma unroll
        for (int db = 0; db < 4; ++db)
#pragma unroll
            for (int i = 0; i < 16; ++i) o[db][i] = 0.f;
        float mrun = -1e30f, lrun = 0.f;
        const int gsw = g4 ^ ((l2 >> 2) & 3);
#define ATT_KDMA(KB_) do { const int kb_ = (KB_); \
            if (kb_ < 10) { \
                _Pragma("unroll") for (int i_ = 0; i_ < 8; ++i_) { const int rho_ = 4 * i_ + l4; const int kk_ = kb_ * 32 + (4 * ((i_ >> 1) & 1) + 8 * (i_ & 1) + 16 * (i_ >> 2)) + l4, krow_ = (kk_ * 205) >> 13, kc_ = c0 + kk_ - krow_ * 40; \
                    __builtin_amdgcn_global_load_lds((const unsigned*)(Kb + (unsigned)(((rs + krow_) * GW + kc_) * (DA * 2) + 16 * (c16 ^ (rho_ & 15)))), (LAS unsigned*)(kl + i_ * 1024), 16, 0, 0); } \
            } else { \
                _Pragma("unroll") for (int i_ = 0; i_ < 8; ++i_) { const int rho_ = 4 * i_ + l4; const int l_ = (kb_ - 10) * 32 + (4 * ((i_ >> 1) & 1) + 8 * (i_ & 1) + 16 * (i_ >> 2)) + l4; \
                    __builtin_amdgcn_global_load_lds((const unsigned*)(KCb + (unsigned)(l_ * (DA * 2) + 16 * (c16 ^ (rho_ & 15)))), (LAS unsigned*)(kl + i_ * 1024), 16, 0, 0); } \
            } } while (0)
#define ATT_VDMA(KB_) do { const int kb_ = (KB_); \
            if (kb_ < 10) { \
                const int k0_ = kb_ * 32 + 8 * gsw, vr_ = (k0_ * 205) >> 13, vc_ = c0 + k0_ - vr_ * 40; const unsigned vo_ = (unsigned)((l2 * SEQ + (rs + vr_) * GW + vc_) * 2); \
                _Pragma("unroll") for (int i_ = 0; i_ < 8; ++i_) __builtin_amdgcn_global_load_lds((const unsigned*)(VTb + vo_ + (unsigned)(i_ * 16 * SEQ * 2)), (LAS unsigned*)(vl + i_ * 1024), 16, 0, 0); \
            } else { \
                const unsigned vo_ = (unsigned)((l2 * CTXL + (kb_ - 10) * 32 + 8 * gsw) * 2); \
                _Pragma("unroll") for (int i_ = 0; i_ < 8; ++i_) __builtin_amdgcn_global_load_lds((const unsigned*)(VCb + vo_ + (unsigned)(i_ * 16 * CTXL * 2)), (LAS unsigned*)(vl + i_ * 1024), 16, 0, 0); \
            } } while (0)
        asm volatile("s_waitcnt vmcnt(0) lgkmcnt(0)" ::: "memory");
        ATT_KDMA(0); ATT_VDMA(0);
        for (int kb = 0; kb < 18; ++kb) {
            const bool win = kb < 10;
            asm volatile("s_waitcnt vmcnt(8)" ::: "memory");
            bf16x8 kf[8];
#pragma unroll
            for (int s = 0; s < 8; ++s) kf[s] = *(const LAS bf16x8*)(kl + q * 256 + 16 * ((8 * (s >> 2) + 4 * hh + (s & 3)) ^ (q & 15)));
            asm volatile("s_waitcnt lgkmcnt(0)" ::: "memory");
            if (kb + 1 < 18) ATT_KDMA(kb + 1);
            f32x16 sa;
#pragma unroll
            for (int i = 0; i < 16; ++i) sa[i] = 0.f;
#pragma unroll
            for (int s = 0; s < 8; ++s) sa = __builtin_amdgcn_mfma_f32_32x32x16_bf16(kf[s], qf[s], sa, 0, 0, 0);
            if (win) {
#pragma unroll
                for (int i = 0; i < 16; ++i) {
                    const int g = kb * 4 + 2 * (i >> 3) + hh, w = (i & 3) + 4 * ((i >> 2) & 1);
                    const int krow = (g * 205) >> 10, kcol = c0 + 8 * (g - 5 * krow) + w;
                    const int dr = rs + krow - r + 7;
                    const int dc = min(max(kcol - qcol, -15), 15) + 15;
                    const bool inw = (unsigned)(kcol - cs) < 16u;
                    sa[i] = inw ? sa[i] + bias[dr * 31 + dc] : -1e30f;
                }
            }
            float bm = sa[0];
#pragma unroll
            for (int i = 1; i < 16; ++i) bm = fmaxf(bm, sa[i]);
            bm = fmaxf(bm, __shfl_xor(bm, 32));
            const float mnew = fmaxf(mrun, bm), alpha = __builtin_amdgcn_exp2f(mrun - mnew);
            mrun = mnew;
            float ps = 0.f;
#pragma unroll
            for (int i = 0; i < 16; ++i) { sa[i] = __builtin_amdgcn_exp2f(sa[i] - mnew); ps += sa[i]; }
            lrun = lrun * alpha + ps;
#pragma unroll
            for (int db = 0; db < 4; ++db)
#pragma unroll
                for (int i = 0; i < 16; ++i) o[db][i] *= alpha;
            bf16x8 pf[2];
#pragma unroll
            for (int s2 = 0; s2 < 2; ++s2) { v4u w; w.x = pk2(sa[8 * s2 + 0], sa[8 * s2 + 1]); w.y = pk2(sa[8 * s2 + 2], sa[8 * s2 + 3]); w.z = pk2(sa[8 * s2 + 4], sa[8 * s2 + 5]); w.w = pk2(sa[8 * s2 + 6], sa[8 * s2 + 7]); pf[s2] = __builtin_bit_cast(bf16x8, w); }
            if (kb + 1 < 18) asm volatile("s_waitcnt vmcnt(8)" ::: "memory"); else asm volatile("s_waitcnt vmcnt(0)" ::: "memory");
            bf16x8 vf[4][2];
#pragma unroll
            for (int db = 0; db < 4; ++db) { const int dd = db * 32 + q;
                vf[db][0] = *(const LAS bf16x8*)(vl + dd * 64 + 16 * ((0 + hh) ^ ((dd >> 2) & 3))); vf[db][1] = *(const LAS bf16x8*)(vl + dd * 64 + 16 * ((2 + hh) ^ ((dd >> 2) & 3))); }
            asm volatile("s_waitcnt lgkmcnt(0)" ::: "memory");
            if (kb + 1 < 18) ATT_VDMA(kb + 1);
#pragma unroll
            for (int db = 0; db < 4; ++db) { o[db] = __builtin_amdgcn_mfma_f32_32x32x16_bf16(vf[db][0], pf[0], o[db], 0, 0, 0); o[db] = __builtin_amdgcn_mfma_f32_32x32x16_bf16(vf[db][1], pf[1], o[db], 0, 0, 0); }
        }
#undef ATT_KDMA
#undef ATT_VDMA
        const float ltot = lrun + __shfl_xor(lrun, 32), inv = 1.f / ltot;
        float ss = 0.f;
#pragma unroll
        for (int db = 0; db < 4; ++db)
#pragma unroll
            for (int i = 0; i < 16; ++i) { o[db][i] *= inv; ss += o[db][i] * o[db][i]; }
        ss += __shfl_xor(ss, 32);
        const float rstd = __builtin_amdgcn_rsqf(ss * (1.f / HD) + EPS);
        bf16* op = AP_ACT + (size_t)(b * SEQ + r * GW + qcol) * D + h * HD + 4 * hh;
        const float* gp = AP_gao + h * HD + 4 * hh;
#pragma unroll
        for (int db = 0; db < 4; ++db)
#pragma unroll
            for (int i4 = 0; i4 < 4; ++i4) { const f32x4 g = *(const f32x4*)(gp + db * 32 + 8 * i4);
                v2u w; w.x = pk2(o[db][4 * i4 + 0] * rstd * g.x, o[db][4 * i4 + 1] * rstd * g.y); w.y = pk2(o[db][4 * i4 + 2] * rstd * g.z, o[db][4 * i4 + 3] * rstd * g.w);
                *(v2u*)(op + db * 32 + 8 * i4) = w; }
    }
    __syncthreads();
}

__device__ __forceinline__ void unpack16(const v4u a, const v4u b, float (&f)[16]) {
    f[0] = bflo(a.x); f[1] = bfhi(a.x); f[2] = bflo(a.y); f[3] = bfhi(a.y); f[4] = bflo(a.z); f[5] = bfhi(a.z); f[6] = bflo(a.w); f[7] = bfhi(a.w);
    f[8] = bflo(b.x); f[9] = bfhi(b.x); f[10] = bflo(b.y); f[11] = bfhi(b.y); f[12] = bflo(b.z); f[13] = bfhi(b.z); f[14] = bflo(b.w); f[15] = bfhi(b.w);
}
__device__ __forceinline__ void load_z(const bf16* CGp, const bf16* Up, size_t m, int lane, float (&z)[16]) {
    const v4u* cp = (const v4u*)(CGp + m * DA + 16 * lane); const v4u* up = (const v4u*)(Up + m * DA + 16 * lane);
    const v4u c0 = cp[0], c1 = cp[1], u0 = up[0], u1 = up[1];
    float cf[16], uf[16]; unpack16(c0, c1, cf); unpack16(u0, u1, uf);
#pragma unroll
    for (int i = 0; i < 16; ++i) z[i] = cf[i] * uf[i];
}
__device__ __forceinline__ void conv_phase(const Frame& F, const Args& A) {
    const int lane = lane_id(), tid = F.wave * 64 + lane; (void)tid;
    const int gw = F.vcu * NWAVES + F.wave, NGW = F.G * NWAVES;
    float w0[16], w1[16], w2[16], gg[16];
#pragma unroll
    for (int i = 0; i < 16; ++i) { w0[i] = AP_w_conv[0 * DA + 16 * lane + i]; w1[i] = AP_w_conv[1 * DA + 16 * lane + i]; w2[i] = AP_w_conv[2 * DA + 16 * lane + i]; gg[i] = AP_gco[16 * lane + i]; }
    for (int it = gw; it < M / 8; it += NGW) {
        const size_t m0 = (size_t)it * 8;
        float zp[16], zc[16], zn[16];
        if ((m0 & (SEQ - 1)) == 0) {
#pragma unroll
            for (int i = 0; i < 16; ++i) zp[i] = 0.f;
        } else load_z(AP_CG, AP_U, m0 - 1, lane, zp);
        load_z(AP_CG, AP_U, m0, lane, zc);
        for (int j = 0; j < 8; ++j) {
            const size_t m = m0 + j;
            if ((m & (SEQ - 1)) == SEQ - 1) {
#pragma unroll
                for (int i = 0; i < 16; ++i) zn[i] = 0.f;
            } else load_z(AP_CG, AP_U, m + 1, lane, zn);
            const v4u* bp = (const v4u*)(AP_BG + m * DA + 16 * lane); const v4u b0 = bp[0], b1 = bp[1];
            float bf[16]; unpack16(b0, b1, bf);
            float y[16], ss = 0.f;
#pragma unroll
            for (int i = 0; i < 16; ++i) { y[i] = bf[i] * (w0[i] * zp[i] + w1[i] * zc[i] + w2[i] * zn[i]); ss += y[i] * y[i]; }
            ss += __shfl_xor(ss, 1); ss += __shfl_xor(ss, 2); ss += __shfl_xor(ss, 4);
            const float rstd = __builtin_amdgcn_rsqf(ss * (1.f / 128.f) + EPS);
            v4u o0, o1;
            o0.x = pk2(y[0] * rstd * gg[0], y[1] * rstd * gg[1]); o0.y = pk2(y[2] * rstd * gg[2], y[3] * rstd * gg[3]); o0.z = pk2(y[4] * rstd * gg[4], y[5] * rstd * gg[5]); o0.w = pk2(y[6] * rstd * gg[6], y[7] * rstd * gg[7]);
            o1.x = pk2(y[8] * rstd * gg[8], y[9] * rstd * gg[9]); o1.y = pk2(y[10] * rstd * gg[10], y[11] * rstd * gg[11]); o1.z = pk2(y[12] * rstd * gg[12], y[13] * rstd * gg[13]); o1.w = pk2(y[14] * rstd * gg[14], y[15] * rstd * gg[15]);
            v4u* op = (v4u*)(AP_ACT + m * D + DA + 16 * lane); op[0] = o0; op[1] = o1;
#pragma unroll
            for (int i = 0; i < 16; ++i) { zp[i] = zc[i]; zc[i] = zn[i]; }
        }
    }
}

__device__ __forceinline__ unsigned f2key(float f) { const unsigned u = __builtin_bit_cast(unsigned, f); return (u & 0x80000000u) ? ~u : (u | 0x80000000u); }
__device__ __forceinline__ float key2f(unsigned k) { const unsigned u = (k & 0x80000000u) ? (k & 0x7fffffffu) : ~k; return __builtin_bit_cast(float, u); }
__device__ __forceinline__ void peer_select_phase(const Frame& F, const Args& A) {
    const int lane = lane_id(), tid = F.wave * 64 + lane; (void)tid;
    const int gw = F.vcu * NWAVES + F.wave, NGW = F.G * NWAVES, tk = lane & 31, hh = lane >> 5;
    LAS int* ixs = (LAS int*)(F.lds + F.wave * 8192);
    unsigned nh4 = (unsigned)(1 - hh) << 2; asm volatile("" : "+v"(nh4));
    for (int task = gw; task < (M / 32) * PH; task += NGW) {
        const int h = task & 7, tb = task >> 3; const int token = tb * 32 + tk;
        unsigned best[2][16];
#pragma unroll
        for (int p = 0; p < 2; ++p) {
            const bf16* qp = AP_QP + (size_t)token * D + h * 256 + p * 128 + 32 * hh;
            bf16x8 qf[8];
#pragma unroll
            for (int s = 0; s < 8; ++s) qf[s] = *(const bf16x8*)(qp + 64 * (s >> 2) + 8 * (s & 3));
            unsigned ky[64];
#pragma unroll
            for (int kb = 0; kb < 4; ++kb) {
                const bf16* kp = AP_SK + (size_t)((h * 2 + p) * NKEYS + kb * 32 + tk) * 128 + 32 * hh;
                bf16x8 kf[8];
#pragma unroll
                for (int s = 0; s < 8; ++s) kf[s] = *(const bf16x8*)(kp + 64 * (s >> 2) + 8 * (s & 3));
                f32x16 sa;
#pragma unroll
                for (int i = 0; i < 16; ++i) sa[i] = 0.f;
#pragma unroll
                for (int s = 0; s < 8; ++s) sa = __builtin_amdgcn_mfma_f32_32x32x16_bf16(kf[s], qf[s], sa, 0, 0, 0);
#pragma unroll
                for (int i = 0; i < 16; ++i) { const unsigned ck = (unsigned)(127 - (kb * 32 + (i & 3) + 8 * (i >> 2))) & ~4u;
                    ky[kb * 16 + i] = ((f2key(sa[i]) & ~127u) | nh4) | ck; }
                asm volatile("" ::: "memory");
            }
#pragma unroll
            for (int rnd = 0; rnd < 16; ++rnd) {
                unsigned mx = ky[0];
#pragma unroll
                for (int i = 1; i < 64; ++i) mx = max(mx, ky[i]);
                const unsigned ot = (unsigned)__shfl_xor((int)mx, 32);
                mx = max(mx, ot);
                best[p][rnd] = mx;
#pragma unroll
                for (int i = 0; i < 64; ++i) ky[i] = (ky[i] == mx) ? 0u : ky[i];
            }
        }
        float s1[16], s2[16];
#pragma unroll
        for (int i = 0; i < 16; ++i) { s1[i] = key2f(best[0][i] & ~127u); s2[i] = key2f(best[1][i] & ~127u);
            ixs[i * 64 + lane] = 127 - (int)(best[0][i] & 127u); ixs[(16 + i) * 64 + lane] = 127 - (int)(best[1][i] & 127u); }
        unsigned cd[50]; { int n = 0;
#pragma unroll
            for (int i = 0; i < 16; ++i)
#pragma unroll
                for (int j = 0; j < 16; ++j) if ((i + 1) * (j + 1) <= 16) { cd[n] = (f2key(s1[i] + s2[j]) & ~255u) | (unsigned)(255 - (16 * i + j)); ++n; } }
        unsigned win[16];
#pragma unroll
        for (int rnd = 0; rnd < 16; ++rnd) {
            unsigned mx = cd[0];
#pragma unroll
            for (int i = 1; i < 50; ++i) mx = max(mx, cd[i]);
            win[rnd] = mx;
#pragma unroll
            for (int i = 0; i < 50; ++i) cd[i] = (cd[i] == mx) ? 0u : cd[i];
        }
        LDS_WAIT();
        const float vmax = key2f(win[0] & ~255u);
        float ev[16], es = 0.f;
#pragma unroll
        for (int rnd = 0; rnd < 16; ++rnd) { ev[rnd] = __expf(key2f(win[rnd] & ~255u) - vmax); es += ev[rnd]; }
        const float ies = 1.f / es;
        if (hh == 0) {
            int* ip = AP_SELI + (size_t)token * 128 + h * 16; float* gp = AP_SELG + (size_t)token * 128 + h * 16;
#pragma unroll
            for (int rnd = 0; rnd < 16; ++rnd) { const int pos = 255 - (int)(win[rnd] & 255u); const int i1 = ixs[(pos >> 4) * 64 + lane], i2 = ixs[(16 + (pos & 15)) * 64 + lane];
                ip[rnd] = i1 * NKEYS + i2; gp[rnd] = ev[rnd] * ies; }
        }
        LDS_WAIT();
    }
}

typedef int v4i __attribute__((ext_vector_type(4)));
__device__ __forceinline__ float gelu_as(const float v) {
    const float av = fabsf(v), t = __builtin_amdgcn_rcpf(av * 0.2316418882f + 1.0f);
    float q = t * 0.5307027145f + (-0.7265760135f); q = q * t + 0.7107068705f; q = q * t + (-0.142248368f); q = q * t + 0.127414796f; q = q * t;
    const float e = __builtin_amdgcn_exp2f((v * v) * (-0.72134752044f));
    const float m = v * (q * e);
    return v < 0.f ? m : v - m;
}
constexpr int PL_WAVE = 16384, PL_EL = 8192, PL_PACC = 10240, PL_AQ = 14336, PL_SA = 15360;
__device__ __forceinline__ float wave_maxf(float v) {
#pragma unroll
    for (int o = 1; o < 64; o <<= 1) v = fmaxf(v, __shfl_xor(v, o));
    return v;
}
__device__ __forceinline__ void peer_u_phase(const Frame& F, const Args& A, float (&sa)[8]) {
    const int lane = lane_id(), p = lane >> 2, sub = lane & 3;
    LAS unsigned short* elist = (LAS unsigned short*)(F.lds + F.wave * PL_WAVE + PL_EL);
    LAS int* pacc = (LAS int*)(F.lds + F.wave * PL_WAVE + PL_PACC);
    LAS signed char* aq = (LAS signed char*)(F.lds + F.wave * PL_WAVE + PL_AQ);
    const int tok0 = F.vcu * 64 + F.wave * 8;
    for (int it = 0; it < 16; ++it) { elist[it * 64 + lane] = (unsigned short)AP_SELI[(size_t)tok0 * 128 + it * 64 + lane]; pacc[it * 64 + lane] = 0; }
    LDS_WAIT();
    v4u G0[4], G1[4], G2[4], G3[4], hreg[2];
    const unsigned char* ub = AP_U8 + 16 * sub;
    LAS unsigned char* hst = F.lds + F.wave * PL_WAVE;
#define PU_LOAD(G_, K_) do { const int kg_ = (K_), tp_ = kg_ & 31; const unsigned ea_ = elist[(2 * tp_) * 16 + p], eb_ = elist[(2 * tp_ + 1) * 16 + p]; \
            const unsigned char* ua_ = ub + (size_t)ea_ * D + 128 * (kg_ >> 5); const unsigned char* ubb_ = ub + (size_t)eb_ * D + 128 * (kg_ >> 5); \
            G_[0] = *(const v4u*)(ua_); G_[1] = *(const v4u*)(ua_ + 64); G_[2] = *(const v4u*)(ubb_); G_[3] = *(const v4u*)(ubb_ + 64); } while (0)
#define PU_DOT8(A0_, A1_) ([&]() { int d0_ = 0, d1_ = 0, d2_ = 0, d3_ = 0; \
            d0_ = __builtin_amdgcn_sdot4((int)(A0_).x, (int)hreg[0].x, d0_, false); d1_ = __builtin_amdgcn_sdot4((int)(A0_).y, (int)hreg[0].y, d1_, false); \
            d2_ = __builtin_amdgcn_sdot4((int)(A0_).z, (int)hreg[0].z, d2_, false); d3_ = __builtin_amdgcn_sdot4((int)(A0_).w, (int)hreg[0].w, d3_, false); \
            d0_ = __builtin_amdgcn_sdot4((int)(A1_).x, (int)hreg[1].x, d0_, false); d1_ = __builtin_amdgcn_sdot4((int)(A1_).y, (int)hreg[1].y, d1_, false); \
            d2_ = __builtin_amdgcn_sdot4((int)(A1_).z, (int)hreg[1].z, d2_, false); d3_ = __builtin_amdgcn_sdot4((int)(A1_).w, (int)hreg[1].w, d3_, false); \
            int v_ = (d0_ + d1_) + (d2_ + d3_); \
            v_ += __builtin_amdgcn_update_dpp(0, v_, 0xB1, 0xf, 0xf, true); v_ += __builtin_amdgcn_update_dpp(0, v_, 0x4E, 0xf, 0xf, true); return v_; }())
#define PU_COMPUTE(G_, TP_) do { const int va_ = PU_DOT8(G_[0], G_[1]), vb_ = PU_DOT8(G_[2], G_[3]); \
            if (sub == 0) { (void)__hip_atomic_fetch_add(pacc + (2 * (TP_)) * 16 + p, va_, __ATOMIC_RELAXED, __HIP_MEMORY_SCOPE_WORKGROUP); \
                            (void)__hip_atomic_fetch_add(pacc + (2 * (TP_) + 1) * 16 + p, vb_, __ATOMIC_RELAXED, __HIP_MEMORY_SCOPE_WORKGROUP); } } while (0)
    PU_LOAD(G0, 0); PU_LOAD(G1, 1); PU_LOAD(G2, 2); PU_LOAD(G3, 3);
    for (int slice = 0; slice < 16; ++slice) {
        { const int tk_ = lane >> 3, pc_ = lane & 7;
          *(LAS v4u*)(hst + tk_ * 128 + 16 * pc_) = *(const v4u*)(AP_H2Q + (size_t)(tok0 + tk_) * D + 128 * slice + 16 * pc_); }
        for (int tk = 0; tk < 8; ++tk) {
            hreg[0] = *(const LAS v4u*)(hst + tk * 128 + 16 * sub); hreg[1] = *(const LAS v4u*)(hst + tk * 128 + 64 + 16 * sub);
            { const int tp = tk * 4, k = slice * 32 + tp;
                PU_COMPUTE(G0, tp);     PU_LOAD(G0, (k + 4) & 511);
                PU_COMPUTE(G1, tp + 1); PU_LOAD(G1, (k + 5) & 511);
                PU_COMPUTE(G2, tp + 2); PU_LOAD(G2, (k + 6) & 511);
                PU_COMPUTE(G3, tp + 3); PU_LOAD(G3, (k + 7) & 511);
            }
        }
        if ((slice & 3) == 3) __builtin_amdgcn_s_barrier();
    }
#undef PU_LOAD
#undef PU_COMPUTE
#undef PU_DOT8
    LDS_WAIT();
#pragma unroll
    for (int t = 0; t < 8; ++t) { const int token = tok0 + t; const float hs = AP_H2S[token]; float av[2];
#pragma unroll
        for (int hf = 0; hf < 2; ++hf) { const int p = t * 128 + hf * 64 + lane; const unsigned e = elist[p];
            av[hf] = gelu_as((float)pacc[p] * AP_SU[e] * hs) * AP_SELG[(size_t)tok0 * 128 + p] * AP_SV[e]; }
        const float mx = fmaxf(wave_maxf(fmaxf(fabsf(av[0]), fabsf(av[1]))), 1e-30f), inv = 127.f / mx;
        aq[t * 128 + lane] = (signed char)(int)__builtin_rintf(av[0] * inv); aq[t * 128 + 64 + lane] = (signed char)(int)__builtin_rintf(av[1] * inv);
        sa[t] = mx * (1.f / 127.f); }
    LDS_WAIT();
}
__device__ __forceinline__ void peer_v_phase(const Frame& F, const Args& A, const float (&sa)[8]) {
    const int lane = lane_id(), n = lane & 15, kq = lane >> 4, rr = n >> 2, cc = n & 3;
    LAS unsigned char* buf = F.lds + F.wave * PL_WAVE;
    const LAS unsigned short* elist = (const LAS unsigned short*)(F.lds + F.wave * PL_WAVE + PL_EL);
    const LAS signed char* aq = (const LAS signed char*)(F.lds + F.wave * PL_WAVE + PL_AQ);
    const int tok0 = F.vcu * 64 + F.wave * 8;
    const int fsw = (rr >> 1) | ((kq & 1) << 1);
    const unsigned trbase = (unsigned)(size_t)buf + (unsigned)((8 * kq + rr) * 128 + 8 * cc);
    const int r0 = lane >> 3, c8 = lane & 7;
    v4u G0[4], G1[4], G2[4], G3[4];
    v4i accE[4], accO[4];
#pragma unroll
    for (int q = 0; q < 4; ++q) { accE[q] = (v4i){0, 0, 0, 0}; accO[q] = (v4i){0, 0, 0, 0}; }
#define PV_EREAD(K_) do { const int ke_ = (K_); _Pragma("unroll") for (int i_ = 0; i_ < 4; ++i_) en[i_] = elist[(ke_ & 31) * 32 + 8 * i_ + r0]; } while (0)
#define PV_LOAD(G_, K_) do { const int kg_ = (K_); _Pragma("unroll") for (int i_ = 0; i_ < 4; ++i_) { const unsigned e_ = en[i_]; \
            const int f_ = ((r0 >> 1) & 1) | ((i_ & 1) << 1); \
            G_[i_] = *(const v4u*)(AP_V8 + (size_t)e_ * D + 128 * (kg_ >> 5) + 32 * ((c8 >> 1) ^ f_) + 16 * (c8 & 1)); } } while (0)
#define PV_STORE(G_, B_) do { _Pragma("unroll") for (int i_ = 0; i_ < 4; ++i_) *(LAS v4u*)(buf + (B_) * 4096 + i_ * 1024 + lane * 16) = G_[i_]; } while (0)
#define PV_TR(B_) do { const unsigned tb_ = trbase + (unsigned)((B_) * 4096); \
            const unsigned t0_ = tb_ + 32u * (unsigned)(0 ^ fsw), t1_ = tb_ + 32u * (unsigned)(1 ^ fsw), t2_ = tb_ + 32u * (unsigned)(2 ^ fsw), t3_ = tb_ + 32u * (unsigned)(3 ^ fsw); \
            asm volatile("s_waitcnt lgkmcnt(0)\n\t" \
                         "ds_read_b64_tr_b16 %0, %8\n\tds_read_b64_tr_b16 %1, %8 offset:512\n\tds_read_b64_tr_b16 %2, %9\n\tds_read_b64_tr_b16 %3, %9 offset:512\n\t" \
                         "ds_read_b64_tr_b16 %4, %10\n\tds_read_b64_tr_b16 %5, %10 offset:512\n\tds_read_b64_tr_b16 %6, %11\n\tds_read_b64_tr_b16 %7, %11 offset:512" \
                         : "=&v"(RR[0][0]), "=&v"(RR[0][1]), "=&v"(RR[1][0]), "=&v"(RR[1][1]), "=&v"(RR[2][0]), "=&v"(RR[2][1]), "=&v"(RR[3][0]), "=&v"(RR[3][1]) : "v"(t0_), "v"(t1_), "v"(t2_), "v"(t3_) : "memory"); } while (0)
#define PV_MMA(K_) do { const int kc_ = (K_), b_ = kc_ & 31; \
            v2u a8_ = *(const LAS v2u*)(aq + b_ * 32 + 8 * kq);                        \
            if (n != (b_ >> 2)) a8_ = (v2u){0u, 0u};                                  \
            v4i AE_, AO_; \
            AE_.x = (int)__builtin_amdgcn_perm(0u, a8_.x, 0x0c010c00u); AE_.y = (int)__builtin_amdgcn_perm(0u, a8_.x, 0x0c030c02u); AE_.z = (int)__builtin_amdgcn_perm(0u, a8_.y, 0x0c010c00u); AE_.w = (int)__builtin_amdgcn_perm(0u, a8_.y, 0x0c030c02u); \
            AO_.x = (int)__builtin_amdgcn_perm(0u, a8_.x, 0x010c000cu); AO_.y = (int)__builtin_amdgcn_perm(0u, a8_.x, 0x030c020cu); AO_.z = (int)__builtin_amdgcn_perm(0u, a8_.y, 0x010c000cu); AO_.w = (int)__builtin_amdgcn_perm(0u, a8_.y, 0x030c020cu); \
            asm volatile("s_waitcnt lgkmcnt(0)" : "+v"(RR[0][0]), "+v"(RR[0][1]), "+v"(RR[1][0]), "+v"(RR[1][1]), "+v"(RR[2][0]), "+v"(RR[2][1]), "+v"(RR[3][0]), "+v"(RR[3][1]) : : "memory"); \
            _Pragma("unroll") for (int q_ = 0; q_ < 4; ++q_) { const v4i Bq_ = {(int)RR[q_][0].x, (int)RR[q_][0].y, (int)RR[q_][1].x, (int)RR[q_][1].y}; \
                accE[q_] = __builtin_amdgcn_mfma_i32_16x16x64_i8(AE_, Bq_, accE[q_], 0, 0, 0); \
                accO[q_] = __builtin_amdgcn_mfma_i32_16x16x64_i8(AO_, Bq_, accO[q_], 0, 0, 0); } } while (0)
    v2u RR[4][2]; unsigned en[4];
    PV_EREAD(0); PV_LOAD(G0, 0); PV_EREAD(1); PV_LOAD(G1, 1); PV_EREAD(2); PV_LOAD(G2, 2); PV_EREAD(3); PV_LOAD(G3, 3); PV_EREAD(4); PV_STORE(G0, 0);
    for (int slice = 0; slice < 16; ++slice) {
        for (int k = slice * 32; k < slice * 32 + 32; k += 4) {
            PV_TR(0); PV_STORE(G1, 1); PV_LOAD(G0, (k + 4) & 511); PV_EREAD((k + 5) & 511); PV_MMA(k);
            PV_TR(1); PV_STORE(G2, 0); PV_LOAD(G1, (k + 5) & 511); PV_EREAD((k + 6) & 511); PV_MMA(k + 1);
            PV_TR(0); PV_STORE(G3, 1); PV_LOAD(G2, (k + 6) & 511); PV_EREAD((k + 7) & 511); PV_MMA(k + 2);
            PV_TR(1); PV_STORE(G0, 0); PV_LOAD(G3, (k + 7) & 511); PV_EREAD((k + 8) & 511); PV_MMA(k + 3);
        }
        if (kq < 2) {
#pragma unroll
            for (int i = 0; i < 4; ++i) { const int token = tok0 + 4 * kq + i; const float sat = kq ? sa[4 + i] : sa[i];
                const float* gtp = AP_MOD + (size_t)(token >> 11) * 6 * D + 5 * D + 128 * slice + 2 * n; float* op = AP_out + (size_t)token * D + 128 * slice + 2 * n;
                const bf16* xp = AP_X1B + (size_t)token * D + 128 * slice + 2 * n;
#pragma unroll
                for (int q = 0; q < 4; ++q) { typedef float f32x2t __attribute__((ext_vector_type(2)));
                    const unsigned xw = *(const unsigned*)(xp + 32 * q); const f32x2t g0 = *(const f32x2t*)(gtp + 32 * q);
                    f32x2t rv; rv.x = bflo(xw) + g0.x * (sat * (float)accE[q][i]); rv.y = bfhi(xw) + g0.y * (sat * (float)accO[q][i]);
                    *(f32x2t*)(op + 32 * q) = rv; } }
        }
#pragma unroll
        for (int q = 0; q < 4; ++q) { accE[q] = (v4i){0, 0, 0, 0}; accO[q] = (v4i){0, 0, 0, 0}; }
        if ((slice & 1) == 1) __builtin_amdgcn_s_barrier();
    }
#undef PV_TR
#undef PV_MMA
#undef PV_LOAD
#undef PV_EREAD
#undef PV_STORE

}
__device__ __forceinline__ void peer_eval_phase(const Frame& F, const Args& A) { float sa[8]; peer_u_phase(F, A, sa); peer_v_phase(F, A, sa); }

template <bool FUSED, int ONLY>
__global__ void __launch_bounds__(NWAVES * 64, 2) mk_fwd(Args args) {
    extern __shared__ __attribute__((aligned(16))) unsigned char lds[];
    Frame F;
    F.lds = (LAS unsigned char*)lds;
    F.wave = __builtin_amdgcn_readfirstlane((int)threadIdx.x >> 6);
    F.G = gridDim.x; { const int bx = blockIdx.x; F.vcu = (F.G % 8 == 0) ? (bx % 8) * (F.G / 8) + bx / 8 : bx; }
    const Args& A = args;
    const int lo = (ONLY >= 0) ? ONLY : args.ph_lo, hi = (ONLY >= 0) ? ONLY + 1 : args.ph_hi;
#define IN(k) ((ONLY < 0 || ONLY == (k)) && lo <= (k) && (k) < hi)
    XcdBarrier bar; bar.bar = (unsigned*)(args.ws + WS_CTL); bar.x = 0; bar.st = (volatile LAS unsigned*)(F.lds + MISC_OFF);
    if constexpr (FUSED) {
        if (MK_CG_SYNC) cg::this_grid().sync();
        bar.x = xb_xcc_id();
        if (F.wave == 0 && lane_id() == 0) { bar.st[0] = 0u; bar.st[1] = 0u; (void)xb_add(&bar.bar[XB_XCNT(bar.x)], 1u); }
        __syncthreads();
    }
#define SEAM(k) do { if (FUSED && IN(k) && IN((k) + 1)) { xcd_barrier(bar, F.wave, (unsigned)F.G); } } while (0)

    if (IN(0)) { p0_prologue(F, A); } SEAM(0);
    if (IN(1)) { p1_norm1(F, A); } SEAM(1);
    if (IN(2)) {
        { pg8::Gemm g{(const bf16*)AP_H8, (const bf16*)AP_WIN8, M, NPROJ, D / 2}; pg8::StaticOrder S; S.init(M, NPROJ, F.G, (int)blockIdx.x);
          EpiProj E{AP_Q, AP_K, AP_VTR, AP_BG, AP_CG, AP_U, AP_qn, AP_kn, (LAS float*)(F.lds + XCH_OFF), 0, 11, 0.08838834764831845f * LOG2E, AP_HS, AP_WINS};
          pg8::gemm_phase<EpiProj, pg8::StaticOrder, true, true, true>(F.lds, g, S, E, F.wave); }
        { pg8::Gemm g{(const bf16*)AP_HC8, (const bf16*)(AP_WIN8 + (size_t)DA * D), MC, 2 * DA, D / 2}; pg8::StaticOrder S; S.init(MC, 2 * DA, F.G, (int)blockIdx.x);
          EpiProj E{nullptr, AP_KC, AP_VCT, nullptr, nullptr, nullptr, AP_qn, AP_kn, (LAS float*)(F.lds + XCH_OFF), 1, 8, 1.f, AP_HCS, AP_WINS + DA};
          pg8::gemm_phase<EpiProj, pg8::StaticOrder, true, true, true>(F.lds, g, S, E, F.wave); }
    } SEAM(2);
    if (IN(3)) { attn_phase(F, A); conv_phase(F, A); } SEAM(3);
    if (IN(4)) { pg8::Gemm g{AP_ACT, AP_WOUT, M, D, D}; pg8::StaticOrder S; S.init(M, D, F.G, (int)blockIdx.x);
        EpiRes E{AP_x, AP_X1B, AP_MOD, 2 * D};
        pg8::gemm_phase<EpiRes, pg8::StaticOrder, true, true>(F.lds, g, S, E, F.wave); } SEAM(4);
    if (IN(5)) { p5_norm2(F, A); } SEAM(5);
    if (IN(6)) { pg8::Gemm g{AP_ACT, AP_WPQ, M, D, D}; pg8::StaticOrder S; S.init(M, D, F.G, (int)blockIdx.x);
        EpiBf16 E{AP_QP, D};
        pg8::gemm_phase<EpiBf16, pg8::StaticOrder, true, true>(F.lds, g, S, E, F.wave); } SEAM(6);
    if (IN(7)) { peer_select_phase(F, A); } SEAM(7);
    if (IN(8)) { peer_eval_phase(F, A); }
#undef IN
#undef SEAM
}

template <int PHS> static bool set_lds() { return hipFuncSetAttribute((const void*)mk_fwd<false, PHS>, hipFuncAttributeMaxDynamicSharedMemorySize, LDS_BYTES) == hipSuccess; }
template <int PHS> static void launch_one(int grid, hipStream_t stream, const Args& a) {
    hipLaunchKernelGGL((mk_fwd<false, PHS>), dim3(grid), dim3(NWAVES * 64), LDS_BYTES, stream, a);
    const hipError_t le = hipPeekAtLastError();
    if (le != hipSuccess) fprintf(stderr, "kernel_launch: launch %d failed: %s\n", PHS, hipGetErrorName(le));
}
extern "C" void kernel_launch(void* const* d_in, const int* in_sizes, int n_in, void* d_out, int out_size, void* d_ws, size_t ws_size, hipStream_t stream) {
    constexpr bool FUSED = (MK_N_LAUNCHES == 1);
    static int grid = 0;
    if (grid == 0) {
        if (n_in != 20 || in_sizes[0] != M * D || out_size != M * D || ws_size < WS_END) { fprintf(stderr, "kernel_launch: unexpected shapes (n_in %d, in0 %d, out %d, ws %zu < %zu); nothing launched\n", n_in, n_in > 0 ? in_sizes[0] : -1, out_size, ws_size, (size_t)WS_END); grid = -1; return; }
        int dev = 0, cus = 0, per_cu = 0;
        if (hipGetDevice(&dev) != hipSuccess || hipDeviceGetAttribute(&cus, hipDeviceAttributeMultiprocessorCount, dev) != hipSuccess) { grid = -1; return; }
        bool okattr = true;
        if constexpr (FUSED) okattr = hipFuncSetAttribute((const void*)mk_fwd<true, -1>, hipFuncAttributeMaxDynamicSharedMemorySize, LDS_BYTES) == hipSuccess;
        else { okattr &= set_lds<0>(); okattr &= set_lds<1>(); okattr &= set_lds<2>(); okattr &= set_lds<3>(); okattr &= set_lds<4>(); okattr &= set_lds<5>(); okattr &= set_lds<6>(); okattr &= set_lds<7>(); okattr &= set_lds<8>(); }
        if (!okattr) { fprintf(stderr, "kernel_launch: hipFuncSetAttribute failed\n"); grid = -1; return; }
        if (hipOccupancyMaxActiveBlocksPerMultiprocessor(&per_cu, (const void*)mk_fwd<FUSED, (FUSED ? -1 : 2)>, NWAVES * 64, LDS_BYTES) != hipSuccess || per_cu < 1) { fprintf(stderr, "kernel_launch: occupancy query says %d blocks per CU; nothing launched\n", per_cu); grid = -1; return; }
        (void)hipGetLastError();
        grid = cus;
        if (grid != 256) fprintf(stderr, "kernel_launch: note: %d CUs (built for 256)\n", grid);
    }
    if (grid < 0) return;
    Args a{};
    for (int i = 0; i < 20; ++i) a.in[i] = (const float*)d_in[i];
    a.out = (float*)d_out; a.ws = (unsigned char*)d_ws;
    if constexpr (FUSED) {
        a.ph_lo = 0; a.ph_hi = NPHASE;
        if (hipMemsetAsync((char*)d_ws + WS_CTL, 0, 128 * 1024, stream) != hipSuccess) { fprintf(stderr, "kernel_launch: memset of the barrier words failed\n"); return; }
        void* kargs[] = {&a};
        hipError_t e;
        if (MK_CG_SYNC) e = hipLaunchCooperativeKernel((const void*)mk_fwd<true, -1>, dim3(grid), dim3(NWAVES * 64), kargs, LDS_BYTES, stream);
        else { hipLaunchKernelGGL((mk_fwd<true, -1>), dim3(grid), dim3(NWAVES * 64), LDS_BYTES, stream, a); e = hipPeekAtLastError(); }
        if (e != hipSuccess) fprintf(stderr, "kernel_launch: launch failed: %s (grid %d)\n", hipGetErrorString(e), grid);
    } else {
        a.ph_lo = 0; a.ph_hi = NPHASE;
        launch_one<0>(grid, stream, a); launch_one<1>(grid, stream, a); launch_one<2>(grid, stream, a); launch_one<3>(grid, stream, a); launch_one<4>(grid, stream, a);
        launch_one<5>(grid, stream, a); launch_one<6>(grid, stream, a); launch_one<7>(grid, stream, a); launch_one<8>(grid, stream, a);
    }
}
```

```cpp
#include <hip/hip_runtime.h>
#include <hip/hip_cooperative_groups.h>
#include <cstdio>
#include <cstdint>
namespace cg = cooperative_groups;
#define MK_N_LAUNCHES 1
namespace pg8 {
#define PG8_LAS __attribute__((address_space(3)))
typedef unsigned short bf16_t;
typedef short bf16x8 __attribute__((ext_vector_type(8)));
typedef float f32x4 __attribute__((ext_vector_type(4)));
typedef unsigned u32x4 __attribute__((ext_vector_type(4)));
constexpr int BM = 256, BK = 64, HALF = 128, HTB = HALF * BK * 2  , STAGE_BYTES = 8 * HTB, NXCD = 8, WGM = 8;

__host__ __device__ __forceinline__ int lds_byte(int r, int c) { const int st = (r >> 4) * 2 + (c >> 5), rr = r & 15, cc = c & 31, ob = rr * 64 + cc * 2; return st * 1024 + (ob ^ (((ob >> 9) & 1) << 5)); }
__host__ __device__ __forceinline__ void stage_rc(int b, int& R, int& C) { const int st = b / 1024, sb = b % 1024, swz = sb ^ (((sb >> 9) & 1) << 5); R = (st >> 1) * 16 + swz / 64; C = (st & 1) * 32 + (swz % 64) / 2; }
__host__ __device__ __forceinline__ int perm32(int rho) { const int n = rho >> 4, i = rho & 15; return 8 * (i >> 2) + 4 * n + (i & 3); }

struct Unit { int pm, pn; };
struct Gemm { const bf16_t* A; const bf16_t* Bt; int M, N, K; };

struct StaticOrder {
    int nM, nN, nwg, G, c;
    __host__ __device__ void init(int M, int N, int G_, int c_) { nM = M / BM; nN = N / BM; nwg = nM * nN; G = G_; c = c_; }
    __host__ __device__ bool next(int i, Unit& u) const {
        const long L = (long)i * G + c; if (L >= nwg) return false;
        int wgid = (int)L; { const int q = nwg / NXCD, r = nwg % NXCD, xcd = wgid % NXCD, off = wgid / NXCD; wgid = (xcd < r ? xcd * (q + 1) : r * (q + 1) + (xcd - r) * q) + off; }
        const int nig = WGM * nN, gid = wgid / nig, fm = gid * WGM, gsz = (nM - fm) < WGM ? (nM - fm) : WGM;
        u.pm = fm + ((wgid % nig) % gsz); u.pn = (wgid % nig) / gsz; return true;
    }
    __device__ __forceinline__ void a_ready(const Unit&) const {}
    __device__ __forceinline__ void done(const Unit&) const {}
};

__device__ __forceinline__ unsigned cvt_pk_bf16(float lo, float hi) { unsigned r; asm volatile("v_cvt_pk_bf16_f32 %0, %1, %2" : "=v"(r) : "v"(lo), "v"(hi)); return r; }
typedef float f32x2 __attribute__((ext_vector_type(2)));
template <class Epi, class Sched, bool ALIGN_EPI = false, bool SP2 = false, bool I8 = false>
__device__ __forceinline__ void gemm_phase(PG8_LAS unsigned char* lds, const Gemm g, const Sched& S, const Epi& E, const int wid) {
    int lane; asm volatile("v_mbcnt_lo_u32_b32 %0, -1, 0\n\tv_mbcnt_hi_u32_b32 %0, -1, %0" : "=v"(lane)); const int tid = wid * 64 + lane, wr = wid >> 2, wc = wid & 3, fr = lane & 15, fq = lane >> 4;
    const int K = g.K, nt = K / BK;
    unsigned voffA[2], voffB[2];
#pragma unroll
    for (int i = 0; i < 2; ++i) { int R, C; stage_rc(tid * 16 + i * 8192, R, C); const int Rb = Epi::PERM ? ((R & ~31) + perm32(R & 31)) : R;
        voffA[i] = (unsigned)(R * K + C) * 2u; voffB[i] = (unsigned)(Rb * K + C) * 2u; }
    const size_t kstep = (size_t)(BK * 2);
    const size_t hstep = (size_t)HALF * K * 2;
    const size_t tstep = 2 * hstep;
    const unsigned ldsw = (unsigned)wid * 1024u;
    const int aoff = lds_byte(wr * 64 + fr, fq * 8), boff = lds_byte(wc * 32 + fr, fq * 8);
#define PG8_SA(b, h) (((b) * 2 + (h)) * HTB)
#define PG8_SB(b, h) ((4 + (b) * 2 + (h)) * HTB)
#define PG8_STAGE(bufoff, gbase, voff) do { _Pragma("unroll") for (int _i = 0; _i < 2; ++_i) \
        __builtin_amdgcn_global_load_lds((const unsigned*)((const char*)(gbase) + (voff)[_i]), (PG8_LAS unsigned*)(lds + (bufoff) + ldsw + _i * 8192), 16, 0, 0); } while (0)
#define PG8_LDA(dst, b, h) do { _Pragma("unroll") for (int m = 0; m < 4; ++m) _Pragma("unroll") for (int k = 0; k < 2; ++k) dst[m][k] = *(const PG8_LAS bf16x8*)(lds + PG8_SA(b, h) + aoff + m * 2048 + k * 1024); } while (0)
#define PG8_LDB(dst, b, h) do { _Pragma("unroll") for (int n = 0; n < 2; ++n) _Pragma("unroll") for (int k = 0; k < 2; ++k) dst[n][k] = *(const PG8_LAS bf16x8*)(lds + PG8_SB(b, h) + boff + n * 2048 + k * 1024); } while (0)
#define PG8_MMA(ai, bj, At, Bt) do { __builtin_amdgcn_s_setprio(1); _Pragma("unroll") for (int m = 0; m < 4; ++m) _Pragma("unroll") for (int n = 0; n < 2; ++n) _Pragma("unroll") for (int k = 0; k < 2; ++k) \
        { if constexpr (I8) { typedef int v4i_ __attribute__((ext_vector_type(4))); acc[ai][bj][m][n] = __builtin_bit_cast(f32x4, __builtin_amdgcn_mfma_i32_16x16x64_i8(__builtin_bit_cast(v4i_, Bt[n][k]), __builtin_bit_cast(v4i_, At[m][k]), __builtin_bit_cast(v4i_, acc[ai][bj][m][n]), 0, 0, 0)); } \
          else acc[ai][bj][m][n] = __builtin_amdgcn_mfma_f32_16x16x32_bf16(Bt[n][k], At[m][k], acc[ai][bj][m][n], 0, 0, 0); } __builtin_amdgcn_s_setprio(0); } while (0)
#define PG8_WAIT_V(n) asm volatile("s_waitcnt vmcnt(" #n ")" ::: "memory")
#define PG8_WAIT_L(n) asm volatile("s_waitcnt lgkmcnt(" #n ")" ::: "memory")
#define PG8_BAR __builtin_amdgcn_s_barrier()
#define PG8_SCHED __builtin_amdgcn_sched_barrier(0)
    Unit cur, nxt; int ui = 0;
    if (!S.next(0, cur)) return;
    f32x4 acc[2][2][4][2];
#pragma unroll
    for (int a = 0; a < 2; ++a)
#pragma unroll
        for (int b = 0; b < 2; ++b)
#pragma unroll
            for (int m = 0; m < 4; ++m)
#pragma unroll
                for (int n = 0; n < 2; ++n) acc[a][b][m][n] = (f32x4){0.f, 0.f, 0.f, 0.f};
    bf16x8 At[4][2], B0[2][2], B1[2][2];
    const char* cA = (const char*)g.A + (size_t)cur.pm * tstep; const char* cB = (const char*)g.Bt + (size_t)cur.pn * tstep;
    S.a_ready(cur);
    if constexpr (SP2) {
        PG8_STAGE(PG8_SB(0, 0), cB, voffB); PG8_STAGE(PG8_SB(0, 1), cB + hstep, voffB); PG8_STAGE(PG8_SA(0, 0), cA, voffA); PG8_STAGE(PG8_SA(0, 1), cA + hstep, voffA);
        if (wr == 1) PG8_BAR;
        PG8_WAIT_V(2); PG8_BAR;
        PG8_STAGE(PG8_SB(1, 0), cB + kstep, voffB); PG8_STAGE(PG8_SA(1, 0), cA + kstep, voffA); PG8_STAGE(PG8_SB(1, 1), cB + hstep + kstep, voffB);
        PG8_WAIT_V(6); PG8_BAR;
    } else {
        PG8_STAGE(PG8_SB(0, 0), cB, voffB); PG8_STAGE(PG8_SA(0, 0), cA, voffA); PG8_STAGE(PG8_SB(0, 1), cB + hstep, voffB); PG8_STAGE(PG8_SA(0, 1), cA + hstep, voffA);
        if (wr == 1) PG8_BAR;
        PG8_WAIT_V(4); PG8_BAR;
        PG8_STAGE(PG8_SB(1, 0), cB + kstep, voffB); PG8_STAGE(PG8_SA(1, 0), cA + kstep, voffA); PG8_STAGE(PG8_SB(1, 1), cB + hstep + kstep, voffB);
        PG8_WAIT_V(6); PG8_BAR;
    }
    for (;;) {
        const bool has_next = S.next(ui + 1, nxt);
        const char* nA = has_next ? (const char*)g.A + (size_t)nxt.pm * tstep : cA; const char* nB = has_next ? (const char*)g.Bt + (size_t)nxt.pn * tstep : cB;
        for (int t = 0; t < nt; t += 2) {
            const bool last = (t == nt - 2);
            const char* a1 = cA + (size_t)(t + 1) * kstep;
            const char* a2 = last ? nA : cA + (size_t)(t + 2) * kstep; const char* b2 = last ? nB : cB + (size_t)(t + 2) * kstep;
            const char* a3 = a2 + kstep; const char* b3 = b2 + kstep;
            if (last && has_next) S.a_ready(nxt);
            if constexpr (SP2) {
            PG8_LDB(B0, 0, 0); PG8_LDB(B1, 0, 1); PG8_SCHED; PG8_LDA(At, 0, 0); PG8_STAGE(PG8_SA(1, 1), a1 + hstep, voffA);
            PG8_WAIT_V(8); PG8_WAIT_L(0); PG8_BAR; PG8_MMA(0, 0, At, B0); PG8_MMA(0, 1, At, B1); PG8_BAR; PG8_SCHED;
            PG8_LDA(At, 0, 1); PG8_STAGE(PG8_SB(0, 0), b2, voffB); PG8_STAGE(PG8_SB(0, 1), b2 + hstep, voffB); PG8_STAGE(PG8_SA(0, 0), a2, voffA);
            PG8_WAIT_V(8); PG8_WAIT_L(0); PG8_BAR; PG8_MMA(1, 0, At, B0); PG8_MMA(1, 1, At, B1); PG8_BAR; PG8_SCHED;
            PG8_LDB(B0, 1, 0); PG8_LDB(B1, 1, 1); PG8_SCHED; PG8_LDA(At, 1, 0); PG8_STAGE(PG8_SA(0, 1), a2 + hstep, voffA);
            PG8_WAIT_V(8); PG8_WAIT_L(0); PG8_BAR; PG8_MMA(0, 0, At, B0); PG8_MMA(0, 1, At, B1); PG8_BAR; PG8_SCHED;
            PG8_LDA(At, 1, 1); PG8_STAGE(PG8_SB(1, 0), b3, voffB); PG8_STAGE(PG8_SB(1, 1), b3 + hstep, voffB); PG8_STAGE(PG8_SA(1, 0), a3, voffA);
            PG8_WAIT_V(8); PG8_WAIT_L(0); PG8_BAR; PG8_MMA(1, 0, At, B0); PG8_MMA(1, 1, At, B1); PG8_BAR; PG8_SCHED;
            } else {
            PG8_LDB(B0, 0, 0); PG8_SCHED; PG8_LDA(At, 0, 0); PG8_STAGE(PG8_SA(1, 1), a1 + hstep, voffA);
            PG8_WAIT_L(8); PG8_BAR; PG8_WAIT_L(0); PG8_MMA(0, 0, At, B0); PG8_BAR; PG8_SCHED;
            PG8_LDB(B1, 0, 1); PG8_STAGE(PG8_SB(0, 0), b2, voffB);
            PG8_BAR; PG8_WAIT_L(0); PG8_MMA(0, 1, At, B1); PG8_BAR;
            PG8_LDA(At, 0, 1); PG8_STAGE(PG8_SA(0, 0), a2, voffA);
            PG8_BAR; PG8_WAIT_L(0); PG8_MMA(1, 0, At, B0); PG8_BAR; PG8_SCHED;
            PG8_STAGE(PG8_SB(0, 1), b2 + hstep, voffB);
            PG8_WAIT_V(6); PG8_BAR; PG8_MMA(1, 1, At, B1); PG8_BAR;
            PG8_LDB(B0, 1, 0); PG8_SCHED; PG8_LDA(At, 1, 0); PG8_STAGE(PG8_SA(0, 1), a2 + hstep, voffA);
            PG8_WAIT_L(8); PG8_BAR; PG8_WAIT_L(0); PG8_MMA(0, 0, At, B0); PG8_BAR; PG8_SCHED;
            PG8_LDB(B1, 1, 1); PG8_STAGE(PG8_SB(1, 0), b3, voffB);
            PG8_BAR; PG8_WAIT_L(0); PG8_MMA(0, 1, At, B1); PG8_BAR;
            PG8_LDA(At, 1, 1); PG8_STAGE(PG8_SA(1, 0), a3, voffA);
            PG8_BAR; PG8_WAIT_L(0); PG8_MMA(1, 0, At, B0); PG8_BAR; PG8_SCHED;
            PG8_STAGE(PG8_SB(1, 1), b3 + hstep, voffB);
            PG8_WAIT_V(6); PG8_BAR; PG8_MMA(1, 1, At, B1); PG8_BAR;
            }
        }
        if constexpr (ALIGN_EPI) { if (wr == 0) PG8_BAR; }
        if constexpr (!Epi::AFTER_DRAIN) { E(acc, cur, wr, wc, fr, fq); S.done(cur); }
        if (!has_next) break;
#pragma unroll
        for (int a = 0; a < 2; ++a)
#pragma unroll
            for (int b = 0; b < 2; ++b)
#pragma unroll
                for (int m = 0; m < 4; ++m)
#pragma unroll
                    for (int n = 0; n < 2; ++n) acc[a][b][m][n] = (f32x4){0.f, 0.f, 0.f, 0.f};
        cur = nxt; cA = nA; cB = nB; ++ui;
        if constexpr (ALIGN_EPI) { if (wr == 1) PG8_BAR; }
    }
    PG8_WAIT_V(0);
    if constexpr (!ALIGN_EPI) { if (wr == 0) PG8_BAR; }
    PG8_BAR;
    if constexpr (Epi::AFTER_DRAIN) { E.fused(acc, cur, wr, wc, fr, fq, lds, wid, lane); S.done(cur); }
#undef PG8_SA
#undef PG8_SB
#undef PG8_STAGE
#undef PG8_LDA
#undef PG8_LDB
#undef PG8_MMA
#undef PG8_WAIT_V
#undef PG8_WAIT_L
#undef PG8_BAR
#undef PG8_SCHED
}
}

#ifndef MK_N_LAUNCHES
#define MK_N_LAUNCHES 1
#endif
constexpr int NPHASE = 9;

constexpr int D = 2048, NB = 8, SEQ = 2048, M = NB * SEQ, CTXL = 256, MC = NB * CTXL;
constexpr int NH = 8, HD = 128, DA = 1024, NPROJ = 6144, GW = 64;
constexpr int NEXP = 16384, PH = 8, PK = 16, NKEYS = 128;
constexpr float EPS = 1e-6f, LOG2E = 1.4426950408889634f;
constexpr int NWAVES = 8;
constexpr float A2_SCALE = 12.0f / 127.0f, A2_INV = 127.0f / 12.0f;

constexpr size_t MiB = 1u << 20;
constexpr size_t WS_CTL = 0, WS_MOD = 1 * MiB, WS_SK = 2 * MiB, WS_WIN = 4 * MiB, WS_WOUT = 28 * MiB, WS_WPQ = 36 * MiB;
constexpr size_t WS_UT = 44 * MiB, WS_VT = 108 * MiB, WS_ACT = 172 * MiB, WS_HC = 236 * MiB;
constexpr size_t WS_Q = 244 * MiB, WS_K = 276 * MiB, WS_VTR = 308 * MiB, WS_BG = 340 * MiB, WS_CG = 372 * MiB, WS_U = 404 * MiB;
constexpr size_t WS_KC = 436 * MiB, WS_VCT = 440 * MiB, WS_QP = 244 * MiB  ;
constexpr size_t WS_SELI = 444 * MiB, WS_SELG = 452 * MiB, WS_AVW = 460 * MiB, WS_END = 468 * MiB;
constexpr size_t WS_U8 = WS_UT, WS_V8 = WS_UT + 32 * MiB, WS_SU = WS_VT, WS_SV = WS_VT + 64 * 1024, WS_H2S = WS_VT + 128 * 1024, WS_H2Q = WS_VT + 1 * MiB;

constexpr int LDS_BYTES = 147456;
constexpr int XCH_OFF = 131072;
constexpr int MISC_OFF = 131072 + 8192;
#ifndef MK_CG_SYNC
#define MK_CG_SYNC 1
#endif

#define GAS __attribute__((address_space(1)))
#define LAS __attribute__((address_space(3)))
typedef unsigned short bf16;
typedef unsigned v4u __attribute__((ext_vector_type(4)));
typedef unsigned v2u __attribute__((ext_vector_type(2)));
typedef float f32x4 __attribute__((ext_vector_type(4)));
typedef float f32x16 __attribute__((ext_vector_type(16)));
typedef short bf16x8 __attribute__((ext_vector_type(8)));
typedef __bf16 bf16x2 __attribute__((ext_vector_type(2)));
#define LDS_WAIT() asm volatile("s_waitcnt lgkmcnt(0)" ::: "memory")

__device__ __forceinline__ unsigned f2bf(float f) { unsigned u = __builtin_bit_cast(unsigned, f); return (u + 0x7fffu + ((u >> 16) & 1u)) >> 16; }
__device__ __forceinline__ unsigned pk2(float lo, float hi) { return pg8::cvt_pk_bf16(lo, hi); }
__device__ __forceinline__ float bflo(unsigned w) { return __builtin_bit_cast(float, w << 16); }
__device__ __forceinline__ float bfhi(unsigned w) { return __builtin_bit_cast(float, w & 0xffff0000u); }
__device__ __forceinline__ float dot2_bf16(unsigned w, unsigned x, float acc) { return __builtin_amdgcn_fdot2_f32_bf16(__builtin_bit_cast(bf16x2, w), __builtin_bit_cast(bf16x2, x), acc, false); }
__device__ __forceinline__ float wave_sum(float v) {
#pragma unroll
    for (int o = 1; o < 64; o <<= 1) v += __shfl_xor(v, o);
    return v;
}

struct Args { const float* in[20]; float* out; unsigned char* ws; int ph_lo, ph_hi; };
struct Frame {
    LAS unsigned char* lds;
    int wave, vcu, G;
};
__device__ __forceinline__ int lane_id() { int l; asm volatile("v_mbcnt_lo_u32_b32 %0, -1, 0\n\tv_mbcnt_hi_u32_b32 %0, -1, %0" : "=v"(l)); return l; }
#define F_LANE lane_id()
#define F_TID (F.wave * 64 + lane_id())
#define AP_x (A.in[0])
#define AP_c (A.in[1])
#define AP_ctx (A.in[2])
#define AP_c_ctx (A.in[3])
#define AP_w_ada (A.in[4])
#define AP_b_ada (A.in[5])
#define AP_g1 (A.in[6])
#define AP_w_in (A.in[7])
#define AP_qn (A.in[8])
#define AP_kn (A.in[9])
#define AP_rpb (A.in[10])
#define AP_w_conv (A.in[11])
#define AP_gao (A.in[12])
#define AP_gco (A.in[13])
#define AP_w_out (A.in[14])
#define AP_g2 (A.in[15])
#define AP_w_pq (A.in[16])
#define AP_subk (A.in[17])
#define AP_uex (A.in[18])
#define AP_vex (A.in[19])
#define AP_SK ((bf16*)(A.ws + WS_SK))
#define AP_WIN ((bf16*)(A.ws + WS_WIN))
#define AP_WOUT ((bf16*)(A.ws + WS_WOUT))
#define AP_WPQ ((bf16*)(A.ws + WS_WPQ))
#define AP_UT ((bf16*)(A.ws + WS_UT))
#define AP_VT ((bf16*)(A.ws + WS_VT))
#define AP_ACT ((bf16*)(A.ws + WS_ACT))
#define AP_HC ((bf16*)(A.ws + WS_HC))
#define AP_Q ((bf16*)(A.ws + WS_Q))
#define AP_K ((bf16*)(A.ws + WS_K))
#define AP_VTR ((bf16*)(A.ws + WS_VTR))
#define AP_BG ((bf16*)(A.ws + WS_BG))
#define AP_CG ((bf16*)(A.ws + WS_CG))
#define AP_U ((bf16*)(A.ws + WS_U))
#define AP_KC ((bf16*)(A.ws + WS_KC))
#define AP_VCT ((bf16*)(A.ws + WS_VCT))
#define AP_QP ((bf16*)(A.ws + WS_QP))
#define AP_MOD ((float*)(A.ws + WS_MOD))
#define AP_SELI ((int*)(A.ws + WS_SELI))
#define AP_SELG ((float*)(A.ws + WS_SELG))
#define AP_AVW ((float*)(A.ws + WS_AVW))
#define AP_WIN8 ((unsigned char*)(A.ws + WS_WIN))
#define AP_WINS ((float*)(A.ws + WS_WIN + 16 * MiB))
#define AP_WOUT8 ((unsigned char*)(A.ws + WS_WOUT))
#define AP_WOUTS ((float*)(A.ws + WS_WOUT + 5 * MiB))
#define AP_CPARTO ((float*)(A.ws + WS_WOUT + 6 * MiB))
#define AP_A28 ((unsigned char*)(A.ws + WS_ACT))
#define AP_CPART ((float*)(A.ws + WS_WIN + 17 * MiB))
#define AP_H8 ((unsigned char*)(A.ws + WS_ACT))
#define AP_HC8 ((unsigned char*)(A.ws + WS_HC))
#define AP_HS ((float*)(A.ws + WS_HC + 4 * MiB))
#define AP_HCS ((float*)(A.ws + WS_HC + 4 * MiB + 65536))
#define AP_X1B ((bf16*)(A.ws + WS_BG))
#define AP_out (A.out)
#define AP_U8 ((const unsigned char*)(A.ws + WS_U8))
#define AP_V8 ((const unsigned char*)(A.ws + WS_V8))
#define AP_SU ((float*)(A.ws + WS_SU))
#define AP_SV ((float*)(A.ws + WS_SV))
#define AP_H2S ((float*)(A.ws + WS_H2S))
#define AP_H2Q ((unsigned char*)(A.ws + WS_H2Q))


#define XB_TMO      128
#define XB_XCNT(j)  (256  + 64 * (j))
#define XB_XSUB(j)  (1280 + 64 * (j))
#define XB_XGEN(j)  (2304 + 64 * (j))
#define XB_TOP      3328
#define XB_TOPGEN   3392
#define XCD_BAR_WORDS 3456
#define XB_SPIN_CAP (1u << 22)
__device__ __forceinline__ unsigned xb_ld(unsigned* p)              { return __hip_atomic_load(p, __ATOMIC_RELAXED, __HIP_MEMORY_SCOPE_AGENT); }
__device__ __forceinline__ unsigned xb_add(unsigned* p, unsigned v) { return __hip_atomic_fetch_add(p, v, __ATOMIC_RELAXED, __HIP_MEMORY_SCOPE_AGENT); }
__device__ __forceinline__ unsigned xb_xcc_id() { return (unsigned)__builtin_amdgcn_s_getreg((3 << 11) | 20) & 0xFu; }
#define XB_SPIN(cond, bar) do { unsigned _sp = 0; while (cond) { __builtin_amdgcn_s_sleep(1); \
    if ((++_sp & 255u) == 0u) { if (xb_ld(&(bar)[XB_TMO])) break; if (_sp > XB_SPIN_CAP) { atomicAdd(&(bar)[XB_TMO], 1u); break; } } } } while (0)
struct XcdBarrier { unsigned* bar; unsigned x; volatile LAS unsigned* st; };
__device__ __forceinline__ void xcd_barrier_complete(unsigned* bar, unsigned x, unsigned G, unsigned& nloc, unsigned& nx) {
    unsigned sum, cnt, mine, sp = 0u;
    for (;;) {
        sum = 0u; cnt = 0u; mine = 0u;
#pragma unroll
        for (unsigned j = 0; j < 16; ++j) { const unsigned c = xb_ld(&bar[XB_XCNT(j)]); sum += c; cnt += (c > 0u) ? 1u : 0u; mine = (j == x) ? c : mine; }
        if (sum == G) break;
        __builtin_amdgcn_s_sleep(1);
        if ((++sp & 255u) == 0u) { if (xb_ld(&bar[XB_TMO])) break; if (sp > XB_SPIN_CAP) { atomicAdd(&bar[XB_TMO], 1u); break; } }
    }
    nloc = mine > 0u ? mine : 1u; nx = cnt > 0u ? cnt : 1u;
}
__device__ __forceinline__ void xcd_barrier(const XcdBarrier& b, const int wave, const unsigned G) {
    asm volatile("s_waitcnt vmcnt(0)" ::: "memory");
    __syncthreads();
    if (wave == 0 && lane_id() == 0) {
        unsigned* bar = b.bar;
        __builtin_amdgcn_s_waitcnt(0);
        unsigned nloc = b.st[0], nx = b.st[1];
        if (nloc == 0u) { xcd_barrier_complete(bar, b.x, G, nloc, nx); b.st[0] = nloc; b.st[1] = nx; }
        const unsigned old = xb_add(&bar[XB_XSUB(b.x)], 1u);
        const unsigned gen = old / nloc;
        if (old + 1u == (gen + 1u) * nloc) {
            __builtin_amdgcn_fence(__ATOMIC_RELEASE, "agent");
            asm volatile("s_waitcnt vmcnt(0)" ::: "memory");
            const unsigned og = xb_add(&bar[XB_TOP], 1u);
            const unsigned tg = og / nx;
            if (og + 1u == (tg + 1u) * nx) xb_add(&bar[XB_TOPGEN], 1u);
            else XB_SPIN(xb_ld(&bar[XB_TOPGEN]) == tg, bar);
            __builtin_amdgcn_fence(__ATOMIC_ACQUIRE, "agent");
            xb_add(&bar[XB_XGEN(b.x)], 1u);
            asm volatile("s_waitcnt vmcnt(0)" ::: "memory");
        } else {
            XB_SPIN(xb_ld(&bar[XB_XGEN(b.x)]) == gen, bar);
            __builtin_amdgcn_fence(__ATOMIC_ACQUIRE, "agent");
            asm volatile("s_waitcnt vmcnt(0)" ::: "memory");
        }
    }
    __syncthreads();
}

__device__ __forceinline__ void p0_mod(const Frame& F, const Args& A) {
    const int lane = lane_id(), tid = F.wave * 64 + lane; (void)tid;
    LAS float* sc = (LAS float*)F.lds;
    LAS float* red = (LAS float*)(F.lds + 9 * 2048 * 4);
    for (int i = tid; i < 9 * D; i += NWAVES * 64) { const int r = i >> 11, k = i & (D - 1); const float cv = (r < 8) ? AP_c[r * D + k] : AP_c_ctx[k]; sc[i] = cv / (1.f + __expf(-cv)); }
    __syncthreads();
    const int sr = lane >> 4, cq = lane & 15;
    for (int item = F.vcu; item < (6 * D) / 64; item += F.G) {
        const int n0 = item * 64;
        float acc[9][4];
#pragma unroll
        for (int r = 0; r < 9; ++r)
#pragma unroll
            for (int j = 0; j < 4; ++j) acc[r][j] = 0.f;
        const float* wp = AP_w_ada + (size_t)(F.wave * 4 + sr) * (6 * D) + n0 + 4 * cq;
#pragma unroll 8
        for (int step = 0; step < 64; ++step) {
            const int k = step * 32 + F.wave * 4 + sr;
            const f32x4 w = *(const f32x4*)(wp + (size_t)step * 32 * (6 * D));
#pragma unroll
            for (int r = 0; r < 9; ++r) { const float s = sc[r * D + k]; acc[r][0] += s * w.x; acc[r][1] += s * w.y; acc[r][2] += s * w.z; acc[r][3] += s * w.w; }
        }
#pragma unroll
        for (int r = 0; r < 9; ++r)
#pragma unroll
            for (int j = 0; j < 4; ++j) { float v = acc[r][j]; v += __shfl_xor(v, 16); v += __shfl_xor(v, 32); if (sr == 0) red[(F.wave * 9 + r) * 64 + 4 * cq + j] = v; }
        __syncthreads();
        for (int i = tid; i < 9 * 64; i += NWAVES * 64) { const int r = i >> 6, cc = i & 63; float s = 0.f;
#pragma unroll
            for (int w = 0; w < 8; ++w) s += red[(w * 9 + r) * 64 + cc];
            AP_MOD[r * (6 * D) + n0 + cc] = s + AP_b_ada[n0 + cc]; }
        __syncthreads();
    }
    __syncthreads();
}
__device__ __forceinline__ void p0_transpose_item(const float* W, int K, int N, bf16* WT, LAS float* scr, int item, int lane) {
    const int nblk = N / 32, kb = item / nblk, nb = item % nblk, k0 = 64 * kb, n0 = 32 * nb;
#pragma unroll 8
    for (int i = 0; i < 32; ++i) { const int kk = 2 * i + (lane >> 5); scr[kk * 33 + (lane & 31)] = W[(size_t)(k0 + kk) * N + n0 + (lane & 31)]; }
    LDS_WAIT(); asm volatile("" ::: "memory");
    const int c = lane & 7;
#pragma unroll
    for (int j = 0; j < 4; ++j) { const int n = (lane >> 3) + 8 * j; const LAS float* s = scr + (8 * c) * 33 + n;
        v4u o; o.x = pk2(s[0 * 33], s[1 * 33]); o.y = pk2(s[2 * 33], s[3 * 33]); o.z = pk2(s[4 * 33], s[5 * 33]); o.w = pk2(s[6 * 33], s[7 * 33]);
        *(v4u*)(WT + (size_t)(n0 + n) * K + k0 + 8 * c) = o; }
    LDS_WAIT(); asm volatile("" ::: "memory");
}
__device__ __forceinline__ void cvt_f32_bf16(const float* src, bf16* dst, size_t n, size_t gtid, size_t gthreads) {
    for (size_t i = gtid * 8; i < n; i += gthreads * 8) { const f32x4 a = *(const f32x4*)(src + i), b = *(const f32x4*)(src + i + 4);
        v4u o; o.x = pk2(a.x, a.y); o.y = pk2(a.z, a.w); o.z = pk2(b.x, b.y); o.w = pk2(b.z, b.w); *(v4u*)(dst + i) = o; }
}
__device__ __forceinline__ float wave_max(float v) {
#pragma unroll
    for (int o = 1; o < 64; o <<= 1) v = fmaxf(v, __shfl_xor(v, o));
    return v;
}
__device__ __forceinline__ unsigned q4(const f32x4 v, const float inv, const int off = 0) {
    const int a = (int)fminf(fmaxf(__builtin_rintf(v.x * inv), -127.f), 127.f) + off, b = (int)fminf(fmaxf(__builtin_rintf(v.y * inv), -127.f), 127.f) + off, c = (int)fminf(fmaxf(__builtin_rintf(v.z * inv), -127.f), 127.f) + off, d = (int)fminf(fmaxf(__builtin_rintf(v.w * inv), -127.f), 127.f) + off;
    return (unsigned)(a & 255) | ((unsigned)(b & 255) << 8) | ((unsigned)(c & 255) << 16) | ((unsigned)(d & 255) << 24);
}
__device__ __forceinline__ void quant_row(const float* src, unsigned char* dst, float* scale, int lane, const int off) {
    const f32x4* xr = (const f32x4*)src + lane; f32x4 v[8]; float mx = 0.f;
#pragma unroll
    for (int j = 0; j < 8; ++j) { v[j] = xr[64 * j]; mx = fmaxf(mx, fmaxf(fmaxf(fabsf(v[j].x), fabsf(v[j].y)), fmaxf(fabsf(v[j].z), fabsf(v[j].w)))); }
    mx = fmaxf(wave_max(mx), 1e-30f);
    const float inv = 127.f / mx;
    unsigned* o = (unsigned*)dst + lane;
#pragma unroll
    for (int j = 0; j < 8; ++j) o[64 * j] = q4(v[j], inv, off);
    if (lane == 0) *scale = mx * (1.f / 127.f);
}
__device__ __forceinline__ void p1_transpose_item_i8(const float* W, int K, int N, unsigned char* WT, const float* cpart, float* wscale, LAS float* scr, int item, int lane) {
    const int nblk = N / 32, kb = item / nblk, nb = item % nblk, k0 = 64 * kb, n0 = 32 * nb;
    { float cm = 0.f;
#pragma unroll
      for (int p = 0; p < 16; ++p) cm = fmaxf(cm, cpart[(size_t)(16 * (lane >> 5) + p) * N + n0 + (lane & 31)]);
      cm = fmaxf(cm, __shfl_xor(cm, 32));
      scr[64 * 33 + (lane & 31)] = cm; }
#pragma unroll 8
    for (int i = 0; i < 32; ++i) { const int kk = 2 * i + (lane >> 5); scr[kk * 33 + (lane & 31)] = W[(size_t)(k0 + kk) * N + n0 + (lane & 31)]; }
    LDS_WAIT(); asm volatile("" ::: "memory");
    const int c = lane & 7;
#pragma unroll
    for (int j = 0; j < 4; ++j) { const int n = (lane >> 3) + 8 * j; const LAS float* sp = scr + (8 * c) * 33 + n;
        const float mx = fmaxf(scr[64 * 33 + n], 1e-30f), inv = 127.f / mx;
        f32x4 a = {sp[0 * 33], sp[1 * 33], sp[2 * 33], sp[3 * 33]}, b = {sp[4 * 33], sp[5 * 33], sp[6 * 33], sp[7 * 33]};
        v2u o; o.x = q4(a, inv); o.y = q4(b, inv);
        *(v2u*)(WT + (size_t)(n0 + n) * K + k0 + 8 * c) = o;
        if (kb == 0 && c == 0) wscale[n0 + n] = mx * (1.f / 127.f); }
    LDS_WAIT(); asm volatile("" ::: "memory");
}
__device__ __forceinline__ void p0_prologue(const Frame& F, const Args& A) {
    const int lane = lane_id(), tid = F.wave * 64 + lane; (void)tid;
    p0_mod(F, A);
    LAS float* scr = (LAS float*)(F.lds + F.wave * 16384);
    const int gw = F.vcu * NWAVES + F.wave, NGW = F.G * NWAVES;
    constexpr int I_SQ = (D / 64) * (D / 32);
    for (int it = gw; it < I_SQ; it += NGW) p0_transpose_item(AP_w_pq, D, D, AP_WPQ, scr, it, lane);
    for (int it = gw; it < (D / 256) * (D / 64); it += NGW) { const int cb = it % (D / 256), kb = it / (D / 256);
        const f32x4* wp = (const f32x4*)(AP_w_out + (size_t)(kb * 64) * D + cb * 256) + lane; f32x4 mx = {0.f, 0.f, 0.f, 0.f};
#pragma unroll 8
        for (int k = 0; k < 64; ++k) { const f32x4 w = wp[(size_t)k * (D / 4)]; mx.x = fmaxf(mx.x, fabsf(w.x)); mx.y = fmaxf(mx.y, fabsf(w.y)); mx.z = fmaxf(mx.z, fabsf(w.z)); mx.w = fmaxf(mx.w, fabsf(w.w)); }
        *((f32x4*)(AP_CPARTO + (size_t)kb * D + cb * 256) + lane) = mx; }
    for (int it = gw; it < (NPROJ / 256) * (D / 64); it += NGW) { const int cb = it % (NPROJ / 256), kb = it / (NPROJ / 256);
        const f32x4* wp = (const f32x4*)(AP_w_in + (size_t)(kb * 64) * NPROJ + cb * 256) + lane; f32x4 mx = {0.f, 0.f, 0.f, 0.f};
#pragma unroll 8
        for (int k = 0; k < 64; ++k) { const f32x4 w = wp[(size_t)k * (NPROJ / 4)]; mx.x = fmaxf(mx.x, fabsf(w.x)); mx.y = fmaxf(mx.y, fabsf(w.y)); mx.z = fmaxf(mx.z, fabsf(w.z)); mx.w = fmaxf(mx.w, fabsf(w.w)); }
        *((f32x4*)(AP_CPART + (size_t)kb * NPROJ + cb * 256) + lane) = mx; }
    const size_t gtid = (size_t)F.vcu * (NWAVES * 64) + tid, gth = (size_t)F.G * NWAVES * 64;
    cvt_f32_bf16(AP_subk, AP_SK, (size_t)PH * 2 * NKEYS * 128, gtid, gth);
    for (int it = gw; it < 2 * NEXP; it += NGW) {
        const int e = it >> 1; const bool isv = it & 1;
        quant_row((isv ? AP_vex : AP_uex) + (size_t)e * D, (unsigned char*)(A.ws + (isv ? WS_V8 : WS_U8)) + (size_t)e * D, (isv ? AP_SV : AP_SU) + e, lane, 0);
    }
}

__device__ __forceinline__ void norm_rows(const float* X, size_t row0, int nrows, const float* g, const float* sh, const float* sc, bf16* out, int lane, unsigned char* q8 = nullptr, float* qs = nullptr) {
    f32x4 gs[8], shv[8];
#pragma unroll
    for (int j = 0; j < 8; ++j) { const int cI = j * 64 + lane; const f32x4 gg = ((const f32x4*)g)[cI], s1 = ((const f32x4*)sc)[cI]; gs[j] = gg * (1.f + s1); shv[j] = ((const f32x4*)sh)[cI]; }
    for (int r = 0; r < nrows; ++r) {
        const f32x4* xr = (const f32x4*)(X + (row0 + r) * D) + lane;
        f32x4 v[8]; float ss = 0.f;
#pragma unroll
        for (int j = 0; j < 8; ++j) { v[j] = xr[64 * j]; ss += (v[j].x * v[j].x + v[j].y * v[j].y) + (v[j].z * v[j].z + v[j].w * v[j].w); }
        const float rstd = __builtin_amdgcn_rsqf(wave_sum(ss) * (1.f / D) + EPS);
        v2u* o8 = (v2u*)(out + (row0 + r) * D) + lane; float mx = 0.f;
#pragma unroll
        for (int j = 0; j < 8; ++j) { const f32x4 y = v[j] * rstd * gs[j] + shv[j]; v[j] = y; if (out) { v2u w; w.x = pk2(y.x, y.y); w.y = pk2(y.z, y.w); o8[64 * j] = w; }
            mx = fmaxf(mx, fmaxf(fmaxf(fabsf(y.x), fabsf(y.y)), fmaxf(fabsf(y.z), fabsf(y.w)))); }
        if (q8) { mx = fmaxf(wave_max(mx), 1e-30f); const float inv = 127.f / mx; unsigned* oq = (unsigned*)(q8 + (row0 + r) * D) + lane;
#pragma unroll
            for (int j = 0; j < 8; ++j) oq[64 * j] = q4(v[j], inv);
            if (lane == 0) qs[row0 + r] = mx * (1.f / 127.f); }
    }
}
__device__ __forceinline__ void norm_rows_b(const bf16* X, size_t row0, int nrows, const float* g, const float* sh, const float* sc, bf16* out, int lane, unsigned char* q8, float* qs) {
    f32x4 gs[8], shv[8];
#pragma unroll
    for (int j = 0; j < 8; ++j) { const int cI = j * 64 + lane; const f32x4 gg = ((const f32x4*)g)[cI], s1 = ((const f32x4*)sc)[cI]; gs[j] = gg * (1.f + s1); shv[j] = ((const f32x4*)sh)[cI]; }
    for (int r = 0; r < nrows; ++r) {
        const v2u* xr = (const v2u*)(X + (row0 + r) * D) + lane;
        f32x4 v[8]; float ss = 0.f;
#pragma unroll
        for (int j = 0; j < 8; ++j) { const v2u w = xr[64 * j]; v[j].x = bflo(w.x); v[j].y = bfhi(w.x); v[j].z = bflo(w.y); v[j].w = bfhi(w.y); ss += (v[j].x * v[j].x + v[j].y * v[j].y) + (v[j].z * v[j].z + v[j].w * v[j].w); }
        const float rstd = __builtin_amdgcn_rsqf(wave_sum(ss) * (1.f / D) + EPS);
        v2u* o8 = (v2u*)(out + (row0 + r) * D) + lane; float mx = 0.f;
#pragma unroll
        for (int j = 0; j < 8; ++j) { const f32x4 y = v[j] * rstd * gs[j] + shv[j]; v[j] = y; v2u w; w.x = pk2(y.x, y.y); w.y = pk2(y.z, y.w); o8[64 * j] = w;
            mx = fmaxf(mx, fmaxf(fmaxf(fabsf(y.x), fabsf(y.y)), fmaxf(fabsf(y.z), fabsf(y.w)))); }
        mx = fmaxf(wave_max(mx), 1e-30f); const float inv = 127.f / mx; unsigned* oq = (unsigned*)(q8 + (row0 + r) * D) + lane;
#pragma unroll
        for (int j = 0; j < 8; ++j) oq[64 * j] = q4(v[j], inv);
        if (lane == 0) qs[row0 + r] = mx * (1.f / 127.f);
    }
}
__device__ __forceinline__ void p1_norm1(const Frame& F, const Args& A) {
    const int lane = lane_id(), tid = F.wave * 64 + lane; (void)tid;
    const int gw = F.vcu * NWAVES + F.wave, NGW = F.G * NWAVES;
    { LAS float* scr = (LAS float*)(F.lds + F.wave * 16384);
      for (int it = gw; it < (D / 64) * (NPROJ / 32); it += NGW) p1_transpose_item_i8(AP_w_in, D, NPROJ, AP_WIN8, AP_CPART, AP_WINS, scr, it, lane);
      for (int it = gw; it < (D / 64) * (D / 32); it += NGW) p1_transpose_item_i8(AP_w_out, D, D, AP_WOUT8, AP_CPARTO, AP_WOUTS, scr, it, lane); }
    for (int it = gw; it < M / 8; it += NGW) { const size_t row0 = (size_t)it * 8; const int b = (int)(row0 >> 11);
        norm_rows(AP_x, row0, 8, AP_g1, AP_MOD + b * 6 * D + 0 * D, AP_MOD + b * 6 * D + 1 * D, nullptr, lane, AP_H8, AP_HS); }
    for (int it = gw; it < MC; it += NGW) norm_rows(AP_ctx, (size_t)it, 1, AP_g1, AP_MOD + 8 * 6 * D + 0 * D, AP_MOD + 8 * 6 * D + 1 * D, nullptr, lane, AP_HC8, AP_HCS);
}
__device__ __forceinline__ void p5_norm2(const Frame& F, const Args& A) {
    const int lane = lane_id(), tid = F.wave * 64 + lane; (void)tid;
    const int gw = F.vcu * NWAVES + F.wave, NGW = F.G * NWAVES;
    for (int it = gw; it < M / 8; it += NGW) { const size_t row0 = (size_t)it * 8; const int b = (int)(row0 >> 11);
        norm_rows_b(AP_X1B, row0, 8, AP_g2, AP_MOD + b * 6 * D + 3 * D, AP_MOD + b * 6 * D + 4 * D, AP_ACT, lane, AP_H2Q, AP_H2S); }
}

__device__ __forceinline__ f32x4 dq4(const f32x4 a, const f32x4 cs, const float rs) {
    typedef int v4i_ __attribute__((ext_vector_type(4))); const v4i_ iv = __builtin_bit_cast(v4i_, a);
    f32x4 r; r.x = (float)iv.x; r.y = (float)iv.y; r.z = (float)iv.z; r.w = (float)iv.w; return r * cs * rs;
}
struct EpiProj {
    static constexpr bool PERM = true, AFTER_DRAIN = false;
    bf16 *Q, *Kp, *VTp, *BG, *CG, *U; const float *qn, *kn; LAS float* xch; int region0, tshift; float qscale; const float *rs, *csb;
    __device__ __forceinline__ void operator()(const f32x4 (&acc)[2][2][4][2], const pg8::Unit& u, int wr, int wc, int fr, int fq) const {
        const int region = (u.pn >> 2) + region0, pnl = u.pn & 3;
        const int rowt = wr * 64 + fr;
        f32x4 cs_[2][2]; float rsc_[2][4];
#pragma unroll
        for (int bj = 0; bj < 2; ++bj)
#pragma unroll
            for (int n = 0; n < 2; ++n) cs_[bj][n] = *(const f32x4*)(csb + u.pn * 256 + bj * 128 + 32 * wc + 8 * fq + 4 * n);
#pragma unroll
        for (int ai = 0; ai < 2; ++ai)
#pragma unroll
            for (int m = 0; m < 4; ++m) rsc_[ai][m] = rs[u.pm * 256 + ai * 128 + rowt + m * 16];
#define DQ(ai_, bj_, m_, n_) dq4(acc[ai_][bj_][m_][n_], cs_[bj_][n_], rsc_[ai_][m_])
        if (region <= 1) {
#pragma unroll
            for (int ai = 0; ai < 2; ++ai)
#pragma unroll
                for (int m = 0; m < 4; ++m)
#pragma unroll
                    for (int bj = 0; bj < 2; ++bj) { const f32x4 a = DQ(ai, bj, m, 0), b = DQ(ai, bj, m, 1);
                        float s = (a.x * a.x + a.y * a.y) + (a.z * a.z + a.w * a.w) + (b.x * b.x + b.y * b.y) + (b.z * b.z + b.w * b.w);
                        s += __shfl_xor(s, 16); s += __shfl_xor(s, 32);
                        if (fq == 0) xch[((ai * 128 + rowt + m * 16) * 2 + bj) * 4 + wc] = s; }
            asm volatile("s_waitcnt lgkmcnt(0)" ::: "memory"); __builtin_amdgcn_s_barrier(); asm volatile("" ::: "memory");
            const float* gain = (region == 0) ? qn : kn; const float mul = (region == 0) ? qscale : 1.f; bf16* O = (region == 0) ? Q : Kp;
            const f32x4 g0 = *(const f32x4*)(gain + 32 * wc + 8 * fq), g1 = *(const f32x4*)(gain + 32 * wc + 8 * fq + 4);
#pragma unroll
            for (int ai = 0; ai < 2; ++ai)
#pragma unroll
                for (int m = 0; m < 4; ++m) { const int rt = ai * 128 + rowt + m * 16; bf16* rowp = O + (size_t)(u.pm * 256 + rt) * DA + (2 * pnl) * HD + 32 * wc + 8 * fq;
#pragma unroll
                    for (int bj = 0; bj < 2; ++bj) { const f32x4 p = *(const LAS f32x4*)(xch + (rt * 2 + bj) * 4);
                        const float rstd = __builtin_amdgcn_rsqf(((p.x + p.y) + (p.z + p.w)) * (1.f / HD) + EPS) * mul;
                        const f32x4 v0 = DQ(ai, bj, m, 0) * rstd * g0, v1 = DQ(ai, bj, m, 1) * rstd * g1;
                        v4u w; w.x = pk2(v0.x, v0.y); w.y = pk2(v0.z, v0.w); w.z = pk2(v1.x, v1.y); w.w = pk2(v1.z, v1.w);
                        *(v4u*)(rowp + bj * HD) = w; } }
        } else if (region == 2) {
            const int tmask = (1 << tshift) - 1;
#pragma unroll
            for (int ai = 0; ai < 2; ++ai)
#pragma unroll
                for (int m = 0; m < 4; ++m) { const int row = u.pm * 256 + ai * 128 + rowt + m * 16; const int b = row >> tshift, t = row & tmask;
#pragma unroll
                    for (int bj = 0; bj < 2; ++bj) { const int head = 2 * pnl + bj; bf16* base = VTp + (((size_t)(b * NH + head) * HD + 32 * wc + 8 * fq) << tshift) + t;
#pragma unroll
                        for (int n = 0; n < 2; ++n) { const f32x4 a = DQ(ai, bj, m, n); const unsigned w0 = pk2(a.x, a.y), w1 = pk2(a.z, a.w);
                            base[(size_t)(4 * n + 0) << tshift] = (bf16)(w0 & 0xffffu); base[(size_t)(4 * n + 1) << tshift] = (bf16)(w0 >> 16);
                            base[(size_t)(4 * n + 2) << tshift] = (bf16)(w1 & 0xffffu); base[(size_t)(4 * n + 3) << tshift] = (bf16)(w1 >> 16); } } }
        } else {
            bf16* O = (region == 3) ? BG : (region == 4) ? CG : U;
#pragma unroll
            for (int ai = 0; ai < 2; ++ai)
#pragma unroll
                for (int m = 0; m < 4; ++m) { bf16* rowp = O + (size_t)(u.pm * 256 + ai * 128 + rowt + m * 16) * DA + pnl * 256 + 32 * wc + 8 * fq;
#pragma unroll
                    for (int bj = 0; bj < 2; ++bj) { const f32x4 v0 = DQ(ai, bj, m, 0), v1 = DQ(ai, bj, m, 1);
                        v4u w; w.x = pk2(v0.x, v0.y); w.y = pk2(v0.z, v0.w); w.z = pk2(v1.x, v1.y); w.w = pk2(v1.z, v1.w);
                        *(v4u*)(rowp + bj * HD) = w; } }
        }
#undef DQ
    }
};
struct EpiBf16 {
    static constexpr bool PERM = true, AFTER_DRAIN = false;
    bf16* O; int ldc;
    __device__ __forceinline__ void operator()(const f32x4 (&acc)[2][2][4][2], const pg8::Unit& u, int wr, int wc, int fr, int fq) const {
        const int row0 = u.pm * 256 + wr * 64 + fr, col0 = u.pn * 256 + wc * 32 + 8 * fq;
#pragma unroll
        for (int ai = 0; ai < 2; ++ai)
#pragma unroll
            for (int m = 0; m < 4; ++m) { bf16* rowp = O + (size_t)(row0 + ai * 128 + m * 16) * ldc + col0;
#pragma unroll
                for (int bj = 0; bj < 2; ++bj) { const f32x4 v0 = acc[ai][bj][m][0], v1 = acc[ai][bj][m][1];
                    v4u w; w.x = pk2(v0.x, v0.y); w.y = pk2(v0.z, v0.w); w.z = pk2(v1.x, v1.y); w.w = pk2(v1.z, v1.w);
                    *(v4u*)(rowp + bj * 128) = w; } }
    }
};
struct EpiRes {
    static constexpr bool PERM = true, AFTER_DRAIN = false;
    const float* base; bf16* out; const float* mod; int gofs; const float* csb; float sa;
    __device__ __forceinline__ void operator()(const f32x4 (&acc)[2][2][4][2], const pg8::Unit& u, int wr, int wc, int fr, int fq) const {
        const int row0 = u.pm * 256 + wr * 64 + fr, col0 = u.pn * 256 + wc * 32 + 8 * fq;
        const float* gp = mod + (size_t)(u.pm >> 3) * 6 * D + gofs + col0;
        f32x4 gv[2][2];
#pragma unroll
        for (int bj = 0; bj < 2; ++bj)
#pragma unroll
            for (int n = 0; n < 2; ++n) gv[bj][n] = *(const f32x4*)(gp + bj * 128 + 4 * n);
        f32x4 cs_[2][2];
#pragma unroll
        for (int bj = 0; bj < 2; ++bj)
#pragma unroll
            for (int n = 0; n < 2; ++n) cs_[bj][n] = *(const f32x4*)(csb + col0 + bj * 128 + 4 * n);
#pragma unroll
        for (int ai = 0; ai < 2; ++ai)
#pragma unroll
            for (int m = 0; m < 4; ++m) { const size_t off = (size_t)(row0 + ai * 128 + m * 16) * D + col0;
#pragma unroll
                for (int bj = 0; bj < 2; ++bj) { const f32x4 b0 = *(const f32x4*)(base + off + bj * 128), b1 = *(const f32x4*)(base + off + bj * 128 + 4);
                    const f32x4 v0 = b0 + gv[bj][0] * dq4(acc[ai][bj][m][0], cs_[bj][0], sa), v1 = b1 + gv[bj][1] * dq4(acc[ai][bj][m][1], cs_[bj][1], sa);
                    v4u w; w.x = pk2(v0.x, v0.y); w.y = pk2(v0.z, v0.w); w.z = pk2(v1.x, v1.y); w.w = pk2(v1.z, v1.w);
                    *(v4u*)(out + off + bj * 128) = w; }
                asm volatile("" ::: "memory"); }
    }
};

__device__ __forceinline__ void attn_phase(const Frame& F, const Args& A) {
    const int lane = lane_id(), tid = F.wave * 64 + lane; (void)tid;
    LAS float* bias = (LAS float*)(F.lds + XCH_OFF);
    LAS unsigned char* kl = F.lds + F.wave * 16384;
    LAS unsigned char* vl = kl + 8192;
    const int bh = F.vcu >> 2, b = bh >> 3, h = bh & 7;
    for (int i = tid; i < 15 * 31; i += NWAVES * 64) bias[i] = AP_rpb[h * 465 + i] * LOG2E;
    __syncthreads();
    const int r = 8 * (F.vcu & 3) + F.wave;
    const int rs = min(max(r - 4, 0), 24);
    const int q = lane & 31, hh = lane >> 5;
    const int l4 = lane >> 4, c16 = lane & 15, l2 = lane >> 2, g4 = lane & 3;
    const unsigned char* Kb = (const unsigned char*)(AP_K + (size_t)b * SEQ * DA + h * HD);
    const unsigned char* VTb = (const unsigned char*)(AP_VTR + (size_t)(b * NH + h) * HD * SEQ);
    const unsigned char* KCb = (const unsigned char*)(AP_KC + (size_t)b * CTXL * DA + h * HD);
    const unsigned char* VCb = (const unsigned char*)(AP_VCT + (size_t)(b * NH + h) * HD * CTXL);
    for (int qh = 0; qh < 2; ++qh) {
        const int c0 = qh ? 24 : 0, qcol = qh * 32 + q, cs = min(max(qcol - 8, 0), 48);
        const bf16* qp = AP_Q + (size_t)(b * SEQ + r * GW + qcol) * DA + h * HD + 32 * hh;
        bf16x8 qf[8];
#pragma unroll
        for (int s = 0; s < 8; ++s) qf[s] = *(const bf16x8*)(qp + 64 * (s >> 2) + 8 * (s & 3));
        f32x16 o[4];
#pragma unroll
        for (int db = 0; db < 4; ++db)
#pragma unroll
            for (int i = 0; i < 16; ++i) o[db][i] = 0.f;
        float mrun = -1e30f, lrun = 0.f;
        const int gsw = g4 ^ ((l2 >> 2) & 3);
#define ATT_KDMA(KB_) do { const int kb_ = (KB_); \
            if (kb_ < 10) { \
                _Pragma("unroll") for (int i_ = 0; i_ < 8; ++i_) { const int rho_ = 4 * i_ + l4; const int kk_ = kb_ * 32 + (4 * ((i_ >> 1) & 1) + 8 * (i_ & 1) + 16 * (i_ >> 2)) + l4, krow_ = (kk_ * 205) >> 13, kc_ = c0 + kk_ - krow_ * 40; \
                    __builtin_amdgcn_global_load_lds((const unsigned*)(Kb + (unsigned)(((rs + krow_) * GW + kc_) * (DA * 2) + 16 * (c16 ^ (rho_ & 15)))), (LAS unsigned*)(kl + i_ * 1024), 16, 0, 0); } \
            } else { \
                _Pragma("unroll") for (int i_ = 0; i_ < 8; ++i_) { const int rho_ = 4 * i_ + l4; const int l_ = (kb_ - 10) * 32 + (4 * ((i_ >> 1) & 1) + 8 * (i_ & 1) + 16 * (i_ >> 2)) + l4; \
                    __builtin_amdgcn_global_load_lds((const unsigned*)(KCb + (unsigned)(l_ * (DA * 2) + 16 * (c16 ^ (rho_ & 15)))), (LAS unsigned*)(kl + i_ * 1024), 16, 0, 0); } \
            } } while (0)
#define ATT_VDMA(KB_) do { const int kb_ = (KB_); \
            if (kb_ < 10) { \
                const int k0_ = kb_ * 32 + 8 * gsw, vr_ = (k0_ * 205) >> 13, vc_ = c0 + k0_ - vr_ * 40; const unsigned vo_ = (unsigned)((l2 * SEQ + (rs + vr_) * GW + vc_) * 2); \
                _Pragma("unroll") for (int i_ = 0; i_ < 8; ++i_) __builtin_amdgcn_global_load_lds((const unsigned*)(VTb + vo_ + (unsigned)(i_ * 16 * SEQ * 2)), (LAS unsigned*)(vl + i_ * 1024), 16, 0, 0); \
            } else { \
                const unsigned vo_ = (unsigned)((l2 * CTXL + (kb_ - 10) * 32 + 8 * gsw) * 2); \
                _Pragma("unroll") for (int i_ = 0; i_ < 8; ++i_) __builtin_amdgcn_global_load_lds((const unsigned*)(VCb + vo_ + (unsigned)(i_ * 16 * CTXL * 2)), (LAS unsigned*)(vl + i_ * 1024), 16, 0, 0); \
            } } while (0)
        asm volatile("s_waitcnt vmcnt(0) lgkmcnt(0)" ::: "memory");
        ATT_KDMA(0); ATT_VDMA(0);
        for (int kb = 0; kb < 18; ++kb) {
            const bool win = kb < 10;
            asm volatile("s_waitcnt vmcnt(8)" ::: "memory");
            bf16x8 kf[8];
#pragma unroll
            for (int s = 0; s < 8; ++s) kf[s] = *(const LAS bf16x8*)(kl + q * 256 + 16 * ((8 * (s >> 2) + 4 * hh + (s & 3)) ^ (q & 15)));
            asm volatile("s_waitcnt lgkmcnt(0)" ::: "memory");
            if (kb + 1 < 18) ATT_KDMA(kb + 1);
            f32x16 sa;
#pragma unroll
            for (int i = 0; i < 16; ++i) sa[i] = 0.f;
#pragma unroll
            for (int s = 0; s < 8; ++s) sa = __builtin_amdgcn_mfma_f32_32x32x16_bf16(kf[s], qf[s], sa, 0, 0, 0);
            if (win) {
#pragma unroll
                for (int i = 0; i < 16; ++i) {
                    const int g = kb * 4 + 2 * (i >> 3) + hh, w = (i & 3) + 4 * ((i >> 2) & 1);
                    const int krow = (g * 205) >> 10, kcol = c0 + 8 * (g - 5 * krow) + w;
                    const int dr = rs + krow - r + 7;
                    const int dc = min(max(kcol - qcol, -15), 15) + 15;
                    const bool inw = (unsigned)(kcol - cs) < 16u;
                    sa[i] = inw ? sa[i] + bias[dr * 31 + dc] : -1e30f;
                }
            }
            float bm = sa[0];
#pragma unroll
            for (int i = 1; i < 16; ++i) bm = fmaxf(bm, sa[i]);
            bm = fmaxf(bm, __shfl_xor(bm, 32));
            const float mnew = fmaxf(mrun, bm), alpha = __builtin_amdgcn_exp2f(mrun - mnew);
            mrun = mnew;
            float ps = 0.f;
#pragma unroll
            for (int i = 0; i < 16; ++i) { sa[i] = __builtin_amdgcn_exp2f(sa[i] - mnew); ps += sa[i]; }
            lrun = lrun * alpha + ps;
#pragma unroll
            for (int db = 0; db < 4; ++db)
#pragma unroll
                for (int i = 0; i < 16; ++i) o[db][i] *= alpha;
            bf16x8 pf[2];
#pragma unroll
            for (int s2 = 0; s2 < 2; ++s2) { v4u w; w.x = pk2(sa[8 * s2 + 0], sa[8 * s2 + 1]); w.y = pk2(sa[8 * s2 + 2], sa[8 * s2 + 3]); w.z = pk2(sa[8 * s2 + 4], sa[8 * s2 + 5]); w.w = pk2(sa[8 * s2 + 6], sa[8 * s2 + 7]); pf[s2] = __builtin_bit_cast(bf16x8, w); }
            if (kb + 1 < 18) asm volatile("s_waitcnt vmcnt(8)" ::: "memory"); else asm volatile("s_waitcnt vmcnt(0)" ::: "memory");
            bf16x8 vf[4][2];
#pragma unroll
            for (int db = 0; db < 4; ++db) { const int dd = db * 32 + q;
                vf[db][0] = *(const LAS bf16x8*)(vl + dd * 64 + 16 * ((0 + hh) ^ ((dd >> 2) & 3))); vf[db][1] = *(const LAS bf16x8*)(vl + dd * 64 + 16 * ((2 + hh) ^ ((dd >> 2) & 3))); }
            asm volatile("s_waitcnt lgkmcnt(0)" ::: "memory");
            if (kb + 1 < 18) ATT_VDMA(kb + 1);
#pragma unroll
            for (int db = 0; db < 4; ++db) { o[db] = __builtin_amdgcn_mfma_f32_32x32x16_bf16(vf[db][0], pf[0], o[db], 0, 0, 0); o[db] = __builtin_amdgcn_mfma_f32_32x32x16_bf16(vf[db][1], pf[1], o[db], 0, 0, 0); }
        }
#undef ATT_KDMA
#undef ATT_VDMA
        const float ltot = lrun + __shfl_xor(lrun, 32), inv = 1.f / ltot;
        float ss = 0.f;
#pragma unroll
        for (int db = 0; db < 4; ++db)
#pragma unroll
            for (int i = 0; i < 16; ++i) { o[db][i] *= inv; ss += o[db][i] * o[db][i]; }
        ss += __shfl_xor(ss, 32);
        const float rstd = __builtin_amdgcn_rsqf(ss * (1.f / HD) + EPS);
        unsigned char* op = AP_A28 + (size_t)(b * SEQ + r * GW + qcol) * D + h * HD + 4 * hh;
        const float* gp = AP_gao + h * HD + 4 * hh; const float rq = rstd * A2_INV;
#pragma unroll
        for (int db = 0; db < 4; ++db)
#pragma unroll
            for (int i4 = 0; i4 < 4; ++i4) { const f32x4 g = *(const f32x4*)(gp + db * 32 + 8 * i4);
                f32x4 y; y.x = o[db][4 * i4 + 0] * g.x; y.y = o[db][4 * i4 + 1] * g.y; y.z = o[db][4 * i4 + 2] * g.z; y.w = o[db][4 * i4 + 3] * g.w;
                *(unsigned*)(op + db * 32 + 8 * i4) = q4(y, rq); }
    }
    __syncthreads();
}

__device__ __forceinline__ void unpack16(const v4u a, const v4u b, float (&f)[16]) {
    f[0] = bflo(a.x); f[1] = bfhi(a.x); f[2] = bflo(a.y); f[3] = bfhi(a.y); f[4] = bflo(a.z); f[5] = bfhi(a.z); f[6] = bflo(a.w); f[7] = bfhi(a.w);
    f[8] = bflo(b.x); f[9] = bfhi(b.x); f[10] = bflo(b.y); f[11] = bfhi(b.y); f[12] = bflo(b.z); f[13] = bfhi(b.z); f[14] = bflo(b.w); f[15] = bfhi(b.w);
}
__device__ __forceinline__ void load_z(const bf16* CGp, const bf16* Up, size_t m, int lane, float (&z)[16]) {
    const v4u* cp = (const v4u*)(CGp + m * DA + 16 * lane); const v4u* up = (const v4u*)(Up + m * DA + 16 * lane);
    const v4u c0 = cp[0], c1 = cp[1], u0 = up[0], u1 = up[1];
    float cf[16], uf[16]; unpack16(c0, c1, cf); unpack16(u0, u1, uf);
#pragma unroll
    for (int i = 0; i < 16; ++i) z[i] = cf[i] * uf[i];
}
__device__ __forceinline__ void conv_phase(const Frame& F, const Args& A) {
    const int lane = lane_id(), tid = F.wave * 64 + lane; (void)tid;
    const int gw = F.vcu * NWAVES + F.wave, NGW = F.G * NWAVES;
    float w0[16], w1[16], w2[16], gg[16];
#pragma unroll
    for (int i = 0; i < 16; ++i) { w0[i] = AP_w_conv[0 * DA + 16 * lane + i]; w1[i] = AP_w_conv[1 * DA + 16 * lane + i]; w2[i] = AP_w_conv[2 * DA + 16 * lane + i]; gg[i] = AP_gco[16 * lane + i]; }
    for (int it = gw; it < M / 8; it += NGW) {
        const size_t m0 = (size_t)it * 8;
        float zp[16], zc[16], zn[16];
        if ((m0 & (SEQ - 1)) == 0) {
#pragma unroll
            for (int i = 0; i < 16; ++i) zp[i] = 0.f;
        } else load_z(AP_CG, AP_U, m0 - 1, lane, zp);
        load_z(AP_CG, AP_U, m0, lane, zc);
        for (int j = 0; j < 8; ++j) {
            const size_t m = m0 + j;
            if ((m & (SEQ - 1)) == SEQ - 1) {
#pragma unroll
                for (int i = 0; i < 16; ++i) zn[i] = 0.f;
            } else load_z(AP_CG, AP_U, m + 1, lane, zn);
            const v4u* bp = (const v4u*)(AP_BG + m * DA + 16 * lane); const v4u b0 = bp[0], b1 = bp[1];
            float bf[16]; unpack16(b0, b1, bf);
            float y[16], ss = 0.f;
#pragma unroll
            for (int i = 0; i < 16; ++i) { y[i] = bf[i] * (w0[i] * zp[i] + w1[i] * zc[i] + w2[i] * zn[i]); ss += y[i] * y[i]; }
            ss += __shfl_xor(ss, 1); ss += __shfl_xor(ss, 2); ss += __shfl_xor(ss, 4);
            const float rstd = __builtin_amdgcn_rsqf(ss * (1.f / 128.f) + EPS);
            const float rq = rstd * A2_INV; v4u o0;
            { f32x4 t0 = {y[0] * gg[0], y[1] * gg[1], y[2] * gg[2], y[3] * gg[3]}, t1 = {y[4] * gg[4], y[5] * gg[5], y[6] * gg[6], y[7] * gg[7]};
              f32x4 t2 = {y[8] * gg[8], y[9] * gg[9], y[10] * gg[10], y[11] * gg[11]}, t3 = {y[12] * gg[12], y[13] * gg[13], y[14] * gg[14], y[15] * gg[15]};
              o0.x = q4(t0, rq); o0.y = q4(t1, rq); o0.z = q4(t2, rq); o0.w = q4(t3, rq); }
            *(v4u*)(AP_A28 + m * D + DA + 16 * lane) = o0;
#pragma unroll
            for (int i = 0; i < 16; ++i) { zp[i] = zc[i]; zc[i] = zn[i]; }
        }
    }
}

__device__ __forceinline__ unsigned f2key(float f) { const unsigned u = __builtin_bit_cast(unsigned, f); return (u & 0x80000000u) ? ~u : (u | 0x80000000u); }
__device__ __forceinline__ float key2f(unsigned k) { const unsigned u = (k & 0x80000000u) ? (k & 0x7fffffffu) : ~k; return __builtin_bit_cast(float, u); }
__device__ __forceinline__ void ce_desc(unsigned& a, unsigned& b) { const unsigned hi = max(a, b), lo = min(a, b); a = hi; b = lo; }
template <int BASE> __device__ __forceinline__ void sort16_desc(unsigned (&v)[64]) {
#pragma unroll
    for (int k = 2; k <= 16; k <<= 1)
#pragma unroll
        for (int j = k >> 1; j >= 1; j >>= 1)
#pragma unroll
            for (int i = 0; i < 16; ++i) { const int l = i ^ j; if (l > i) { if ((i & k) == 0) ce_desc(v[BASE + i], v[BASE + l]); else ce_desc(v[BASE + l], v[BASE + i]); } }
}
template <int A_, int B_> __device__ __forceinline__ void merge_top16(unsigned (&v)[64]) {
#pragma unroll
    for (int i = 0; i < 16; ++i) v[A_ + i] = max(v[A_ + i], v[B_ + 15 - i]);
#pragma unroll
    for (int j = 8; j >= 1; j >>= 1)
#pragma unroll
        for (int i = 0; i < 16; ++i) { const int l = i ^ j; if (l > i) ce_desc(v[A_ + i], v[A_ + l]); }
}
__device__ __forceinline__ void top16_of_64(unsigned (&v)[64]) {
    sort16_desc<0>(v); sort16_desc<16>(v); sort16_desc<32>(v); sort16_desc<48>(v);
    merge_top16<0, 16>(v); merge_top16<32, 48>(v); merge_top16<0, 32>(v);
}
__device__ __forceinline__ void peer_select_phase(const Frame& F, const Args& A) {
    const int lane = lane_id(), tid = F.wave * 64 + lane; (void)tid;
    const int gw = F.vcu * NWAVES + F.wave, NGW = F.G * NWAVES, tk = lane & 31, hh = lane >> 5;
    LAS int* ixs = (LAS int*)(F.lds + F.wave * 8192);
    unsigned nh4 = (unsigned)(1 - hh) << 2; asm volatile("" : "+v"(nh4));
    for (int task = gw; task < (M / 32) * PH; task += NGW) {
        const int h = task & 7, tb = task >> 3; const int token = tb * 32 + tk;
        unsigned best[2][16];
#pragma unroll
        for (int p = 0; p < 2; ++p) {
            const bf16* qp = AP_QP + (size_t)token * D + h * 256 + p * 128 + 32 * hh;
            bf16x8 qf[8];
#pragma unroll
            for (int s = 0; s < 8; ++s) qf[s] = *(const bf16x8*)(qp + 64 * (s >> 2) + 8 * (s & 3));
            unsigned ky[64];
#pragma unroll
            for (int kb = 0; kb < 4; ++kb) {
                const bf16* kp = AP_SK + (size_t)((h * 2 + p) * NKEYS + kb * 32 + tk) * 128 + 32 * hh;
                bf16x8 kf[8];
#pragma unroll
                for (int s = 0; s < 8; ++s) kf[s] = *(const bf16x8*)(kp + 64 * (s >> 2) + 8 * (s & 3));
                f32x16 sa;
#pragma unroll
                for (int i = 0; i < 16; ++i) sa[i] = 0.f;
#pragma unroll
                for (int s = 0; s < 8; ++s) sa = __builtin_amdgcn_mfma_f32_32x32x16_bf16(kf[s], qf[s], sa, 0, 0, 0);
#pragma unroll
                for (int i = 0; i < 16; ++i) { const unsigned ck = (unsigned)(127 - (kb * 32 + (i & 3) + 8 * (i >> 2))) & ~4u;
                    ky[kb * 16 + i] = ((f2key(sa[i]) & ~127u) | nh4) | ck; }
                asm volatile("" ::: "memory");
            }
            top16_of_64(ky);
#pragma unroll
            for (int i = 0; i < 16; ++i) ky[16 + i] = (unsigned)__shfl_xor((int)ky[i], 32);
            merge_top16<0, 16>(ky);
#pragma unroll
            for (int i = 0; i < 16; ++i) best[p][i] = ky[i];
        }
        float s1[16], s2[16];
#pragma unroll
        for (int i = 0; i < 16; ++i) { s1[i] = key2f(best[0][i] & ~127u); s2[i] = key2f(best[1][i] & ~127u);
            ixs[i * 64 + lane] = 127 - (int)(best[0][i] & 127u); ixs[(16 + i) * 64 + lane] = 127 - (int)(best[1][i] & 127u); }
        unsigned cd[64]; { int n = 0;
#pragma unroll
            for (int i = 0; i < 16; ++i)
#pragma unroll
                for (int j = 0; j < 16; ++j) if ((i + 1) * (j + 1) <= 16) { cd[n] = (f2key(s1[i] + s2[j]) & ~255u) | (unsigned)(255 - (16 * i + j)); ++n; }
#pragma unroll
            for (int i = 50; i < 64; ++i) cd[i] = 0u; }
        top16_of_64(cd);
        unsigned win[16];
#pragma unroll
        for (int i = 0; i < 16; ++i) win[i] = cd[i];
        LDS_WAIT();
        const float vmax = key2f(win[0] & ~255u);
        float ev[16], es = 0.f;
#pragma unroll
        for (int rnd = 0; rnd < 16; ++rnd) { ev[rnd] = __expf(key2f(win[rnd] & ~255u) - vmax); es += ev[rnd]; }
        const float ies = 1.f / es;
        if (hh == 0) {
            int* ip = AP_SELI + (size_t)token * 128 + h * 16; float* gp = AP_SELG + (size_t)token * 128 + h * 16;
#pragma unroll
            for (int rnd = 0; rnd < 16; ++rnd) { const int pos = 255 - (int)(win[rnd] & 255u); const int i1 = ixs[(pos >> 4) * 64 + lane], i2 = ixs[(16 + (pos & 15)) * 64 + lane];
                ip[rnd] = i1 * NKEYS + i2; gp[rnd] = ev[rnd] * ies; }
        }
        LDS_WAIT();
    }
}

typedef int v4i __attribute__((ext_vector_type(4)));
__device__ __forceinline__ float gelu_as(const float v) {
    const float av = fabsf(v), t = __builtin_amdgcn_rcpf(av * 0.2316418882f + 1.0f);
    float q = t * 0.5307027145f + (-0.7265760135f); q = q * t + 0.7107068705f; q = q * t + (-0.142248368f); q = q * t + 0.127414796f; q = q * t;
    const float e = __builtin_amdgcn_exp2f((v * v) * (-0.72134752044f));
    const float m = v * (q * e);
    return v < 0.f ? m : v - m;
}
constexpr int PL_WAVE = 16384, PL_EL = 8192, PL_PACC = 10240, PL_AQ = 14336, PL_SA = 15360;
__device__ __forceinline__ float wave_maxf(float v) {
#pragma unroll
    for (int o = 1; o < 64; o <<= 1) v = fmaxf(v, __shfl_xor(v, o));
    return v;
}
__device__ __forceinline__ void peer_u_phase(const Frame& F, const Args& A, float (&sa)[8]) {
    const int lane = lane_id(), p = lane >> 2, sub = lane & 3;
    LAS unsigned short* elist = (LAS unsigned short*)(F.lds + F.wave * PL_WAVE + PL_EL);
    LAS int* pacc = (LAS int*)(F.lds + F.wave * PL_WAVE + PL_PACC);
    LAS signed char* aq = (LAS signed char*)(F.lds + F.wave * PL_WAVE + PL_AQ);
    const int tok0 = F.vcu * 64 + F.wave * 8;
    for (int it = 0; it < 16; ++it) { elist[it * 64 + lane] = (unsigned short)AP_SELI[(size_t)tok0 * 128 + it * 64 + lane]; pacc[it * 64 + lane] = 0; }
    LDS_WAIT();
    v4u G0[4], G1[4], G2[4], G3[4], hreg[2];
    const unsigned char* ub = AP_U8 + 16 * sub;
    LAS unsigned char* hst = F.lds + F.wave * PL_WAVE;
#define PU_LOAD(G_, K_) do { const int kg_ = (K_), tp_ = kg_ & 31; const unsigned ea_ = elist[(2 * tp_) * 16 + p], eb_ = elist[(2 * tp_ + 1) * 16 + p]; \
            const unsigned char* ua_ = ub + (size_t)ea_ * D + 128 * (kg_ >> 5); const unsigned char* ubb_ = ub + (size_t)eb_ * D + 128 * (kg_ >> 5); \
            G_[0] = *(const v4u*)(ua_); G_[1] = *(const v4u*)(ua_ + 64); G_[2] = *(const v4u*)(ubb_); G_[3] = *(const v4u*)(ubb_ + 64); } while (0)
#define PU_DOT8(A0_, A1_) ([&]() { int d0_ = 0, d1_ = 0, d2_ = 0, d3_ = 0; \
            d0_ = __builtin_amdgcn_sdot4((int)(A0_).x, (int)hreg[0].x, d0_, false); d1_ = __builtin_amdgcn_sdot4((int)(A0_).y, (int)hreg[0].y, d1_, false); \
            d2_ = __builtin_amdgcn_sdot4((int)(A0_).z, (int)hreg[0].z, d2_, false); d3_ = __builtin_amdgcn_sdot4((int)(A0_).w, (int)hreg[0].w, d3_, false); \
            d0_ = __builtin_amdgcn_sdot4((int)(A1_).x, (int)hreg[1].x, d0_, false); d1_ = __builtin_amdgcn_sdot4((int)(A1_).y, (int)hreg[1].y, d1_, false); \
            d2_ = __builtin_amdgcn_sdot4((int)(A1_).z, (int)hreg[1].z, d2_, false); d3_ = __builtin_amdgcn_sdot4((int)(A1_).w, (int)hreg[1].w, d3_, false); \
            int v_ = (d0_ + d1_) + (d2_ + d3_); \
            v_ += __builtin_amdgcn_update_dpp(0, v_, 0xB1, 0xf, 0xf, true); v_ += __builtin_amdgcn_update_dpp(0, v_, 0x4E, 0xf, 0xf, true); return v_; }())
#define PU_COMPUTE(G_, TP_) do { const int va_ = PU_DOT8(G_[0], G_[1]), vb_ = PU_DOT8(G_[2], G_[3]); \
            if (sub == 0) { (void)__hip_atomic_fetch_add(pacc + (2 * (TP_)) * 16 + p, va_, __ATOMIC_RELAXED, __HIP_MEMORY_SCOPE_WORKGROUP); \
                            (void)__hip_atomic_fetch_add(pacc + (2 * (TP_) + 1) * 16 + p, vb_, __ATOMIC_RELAXED, __HIP_MEMORY_SCOPE_WORKGROUP); } } while (0)
    PU_LOAD(G0, 0); PU_LOAD(G1, 1); PU_LOAD(G2, 2); PU_LOAD(G3, 3);
    for (int slice = 0; slice < 16; ++slice) {
        { const int tk_ = lane >> 3, pc_ = lane & 7;
          *(LAS v4u*)(hst + tk_ * 128 + 16 * pc_) = *(const v4u*)(AP_H2Q + (size_t)(tok0 + tk_) * D + 128 * slice + 16 * pc_); }
        for (int tk = 0; tk < 8; ++tk) {
            hreg[0] = *(const LAS v4u*)(hst + tk * 128 + 16 * sub); hreg[1] = *(const LAS v4u*)(hst + tk * 128 + 64 + 16 * sub);
            { const int tp = tk * 4, k = slice * 32 + tp;
                PU_COMPUTE(G0, tp);     PU_LOAD(G0, (k + 4) & 511);
                PU_COMPUTE(G1, tp + 1); PU_LOAD(G1, (k + 5) & 511);
                PU_COMPUTE(G2, tp + 2); PU_LOAD(G2, (k + 6) & 511);
                PU_COMPUTE(G3, tp + 3); PU_LOAD(G3, (k + 7) & 511);
            }
        }
        if ((slice & 3) == 3) __builtin_amdgcn_s_barrier();
    }
#undef PU_LOAD
#undef PU_COMPUTE
#undef PU_DOT8
    LDS_WAIT();
#pragma unroll
    for (int t = 0; t < 8; ++t) { const int token = tok0 + t; const float hs = AP_H2S[token]; float av[2];
#pragma unroll
        for (int hf = 0; hf < 2; ++hf) { const int p = t * 128 + hf * 64 + lane; const unsigned e = elist[p];
            av[hf] = gelu_as((float)pacc[p] * AP_SU[e] * hs) * AP_SELG[(size_t)tok0 * 128 + p] * AP_SV[e]; }
        const float mx = fmaxf(wave_maxf(fmaxf(fabsf(av[0]), fabsf(av[1]))), 1e-30f), inv = 127.f / mx;
        aq[t * 128 + lane] = (signed char)(int)__builtin_rintf(av[0] * inv); aq[t * 128 + 64 + lane] = (signed char)(int)__builtin_rintf(av[1] * inv);
        sa[t] = mx * (1.f / 127.f); }
    LDS_WAIT();
}
__device__ __forceinline__ void peer_v_phase(const Frame& F, const Args& A, const float (&sa)[8]) {
    const int lane = lane_id(), n = lane & 15, kq = lane >> 4, rr = n >> 2, cc = n & 3;
    LAS unsigned char* buf = F.lds + F.wave * PL_WAVE;
    const LAS unsigned short* elist = (const LAS unsigned short*)(F.lds + F.wave * PL_WAVE + PL_EL);
    const LAS signed char* aq = (const LAS signed char*)(F.lds + F.wave * PL_WAVE + PL_AQ);
    const int tok0 = F.vcu * 64 + F.wave * 8;
    const int fsw = (rr >> 1) | ((kq & 1) << 1);
    const unsigned trbase = (unsigned)(size_t)buf + (unsigned)((8 * kq + rr) * 128 + 8 * cc);
    const int r0 = lane >> 3, c8 = lane & 7;
    v4u G0[4], G1[4], G2[4], G3[4];
    v4i accE[4], accO[4];
#pragma unroll
    for (int q = 0; q < 4; ++q) { accE[q] = (v4i){0, 0, 0, 0}; accO[q] = (v4i){0, 0, 0, 0}; }
#define PV_EREAD(K_) do { const int ke_ = (K_); _Pragma("unroll") for (int i_ = 0; i_ < 4; ++i_) en[i_] = elist[(ke_ & 31) * 32 + 8 * i_ + r0]; } while (0)
#define PV_LOAD(G_, K_) do { const int kg_ = (K_); _Pragma("unroll") for (int i_ = 0; i_ < 4; ++i_) { const unsigned e_ = en[i_]; \
            const int f_ = ((r0 >> 1) & 1) | ((i_ & 1) << 1); \
            G_[i_] = *(const v4u*)(AP_V8 + (size_t)e_ * D + 128 * (kg_ >> 5) + 32 * ((c8 >> 1) ^ f_) + 16 * (c8 & 1)); } } while (0)
#define PV_STORE(G_, B_) do { _Pragma("unroll") for (int i_ = 0; i_ < 4; ++i_) *(LAS v4u*)(buf + (B_) * 4096 + i_ * 1024 + lane * 16) = G_[i_]; } while (0)
#define PV_TR(B_) do { const unsigned tb_ = trbase + (unsigned)((B_) * 4096); \
            const unsigned t0_ = tb_ + 32u * (unsigned)(0 ^ fsw), t1_ = tb_ + 32u * (unsigned)(1 ^ fsw), t2_ = tb_ + 32u * (unsigned)(2 ^ fsw), t3_ = tb_ + 32u * (unsigned)(3 ^ fsw); \
            asm volatile("s_waitcnt lgkmcnt(0)\n\t" \
                         "ds_read_b64_tr_b16 %0, %8\n\tds_read_b64_tr_b16 %1, %8 offset:512\n\tds_read_b64_tr_b16 %2, %9\n\tds_read_b64_tr_b16 %3, %9 offset:512\n\t" \
                         "ds_read_b64_tr_b16 %4, %10\n\tds_read_b64_tr_b16 %5, %10 offset:512\n\tds_read_b64_tr_b16 %6, %11\n\tds_read_b64_tr_b16 %7, %11 offset:512" \
                         : "=&v"(RR[0][0]), "=&v"(RR[0][1]), "=&v"(RR[1][0]), "=&v"(RR[1][1]), "=&v"(RR[2][0]), "=&v"(RR[2][1]), "=&v"(RR[3][0]), "=&v"(RR[3][1]) : "v"(t0_), "v"(t1_), "v"(t2_), "v"(t3_) : "memory"); } while (0)
#define PV_MMA(K_) do { const int kc_ = (K_), b_ = kc_ & 31; \
            v2u a8_ = *(const LAS v2u*)(aq + b_ * 32 + 8 * kq);                        \
            if (n != (b_ >> 2)) a8_ = (v2u){0u, 0u};                                  \
            v4i AE_, AO_; \
            AE_.x = (int)__builtin_amdgcn_perm(0u, a8_.x, 0x0c010c00u); AE_.y = (int)__builtin_amdgcn_perm(0u, a8_.x, 0x0c030c02u); AE_.z = (int)__builtin_amdgcn_perm(0u, a8_.y, 0x0c010c00u); AE_.w = (int)__builtin_amdgcn_perm(0u, a8_.y, 0x0c030c02u); \
            AO_.x = (int)__builtin_amdgcn_perm(0u, a8_.x, 0x010c000cu); AO_.y = (int)__builtin_amdgcn_perm(0u, a8_.x, 0x030c020cu); AO_.z = (int)__builtin_amdgcn_perm(0u, a8_.y, 0x010c000cu); AO_.w = (int)__builtin_amdgcn_perm(0u, a8_.y, 0x030c020cu); \
            asm volatile("s_waitcnt lgkmcnt(0)" : "+v"(RR[0][0]), "+v"(RR[0][1]), "+v"(RR[1][0]), "+v"(RR[1][1]), "+v"(RR[2][0]), "+v"(RR[2][1]), "+v"(RR[3][0]), "+v"(RR[3][1]) : : "memory"); \
            _Pragma("unroll") for (int q_ = 0; q_ < 4; ++q_) { const v4i Bq_ = {(int)RR[q_][0].x, (int)RR[q_][0].y, (int)RR[q_][1].x, (int)RR[q_][1].y}; \
                accE[q_] = __builtin_amdgcn_mfma_i32_16x16x64_i8(AE_, Bq_, accE[q_], 0, 0, 0); \
                accO[q_] = __builtin_amdgcn_mfma_i32_16x16x64_i8(AO_, Bq_, accO[q_], 0, 0, 0); } } while (0)
    v2u RR[4][2]; unsigned en[4];
    PV_EREAD(0); PV_LOAD(G0, 0); PV_EREAD(1); PV_LOAD(G1, 1); PV_EREAD(2); PV_LOAD(G2, 2); PV_EREAD(3); PV_LOAD(G3, 3); PV_EREAD(4); PV_STORE(G0, 0);
    for (int slice = 0; slice < 16; ++slice) {
        for (int k = slice * 32; k < slice * 32 + 32; k += 4) {
            PV_TR(0); PV_STORE(G1, 1); PV_LOAD(G0, (k + 4) & 511); PV_EREAD((k + 5) & 511); PV_MMA(k);
            PV_TR(1); PV_STORE(G2, 0); PV_LOAD(G1, (k + 5) & 511); PV_EREAD((k + 6) & 511); PV_MMA(k + 1);
            PV_TR(0); PV_STORE(G3, 1); PV_LOAD(G2, (k + 6) & 511); PV_EREAD((k + 7) & 511); PV_MMA(k + 2);
            PV_TR(1); PV_STORE(G0, 0); PV_LOAD(G3, (k + 7) & 511); PV_EREAD((k + 8) & 511); PV_MMA(k + 3);
        }
        if (kq < 2) {
#pragma unroll
            for (int i = 0; i < 4; ++i) { const int token = tok0 + 4 * kq + i; const float sat = kq ? sa[4 + i] : sa[i];
                const float* gtp = AP_MOD + (size_t)(token >> 11) * 6 * D + 5 * D + 128 * slice + 2 * n; float* op = AP_out + (size_t)token * D + 128 * slice + 2 * n;
                const bf16* xp = AP_X1B + (size_t)token * D + 128 * slice + 2 * n;
#pragma unroll
                for (int q = 0; q < 4; ++q) { typedef float f32x2t __attribute__((ext_vector_type(2)));
                    const unsigned xw = *(const unsigned*)(xp + 32 * q); const f32x2t g0 = *(const f32x2t*)(gtp + 32 * q);
                    f32x2t rv; rv.x = bflo(xw) + g0.x * (sat * (float)accE[q][i]); rv.y = bfhi(xw) + g0.y * (sat * (float)accO[q][i]);
                    *(f32x2t*)(op + 32 * q) = rv; } }
        }
#pragma unroll
        for (int q = 0; q < 4; ++q) { accE[q] = (v4i){0, 0, 0, 0}; accO[q] = (v4i){0, 0, 0, 0}; }
        if ((slice & 1) == 1) __builtin_amdgcn_s_barrier();
    }
#undef PV_TR
#undef PV_MMA
#undef PV_LOAD
#undef PV_EREAD
#undef PV_STORE

}
__device__ __forceinline__ void peer_eval_phase(const Frame& F, const Args& A) { float sa[8]; peer_u_phase(F, A, sa); peer_v_phase(F, A, sa); }

template <bool FUSED, int ONLY>
__global__ void __launch_bounds__(NWAVES * 64, 2) mk_fwd(Args args) {
    extern __shared__ __attribute__((aligned(16))) unsigned char lds[];
    Frame F;
    F.lds = (LAS unsigned char*)lds;
    F.wave = __builtin_amdgcn_readfirstlane((int)threadIdx.x >> 6);
    F.G = gridDim.x; { const int bx = blockIdx.x; F.vcu = (F.G % 8 == 0) ? (bx % 8) * (F.G / 8) + bx / 8 : bx; }
    const Args& A = args;
    const int lo = (ONLY >= 0) ? ONLY : args.ph_lo, hi = (ONLY >= 0) ? ONLY + 1 : args.ph_hi;
#define IN(k) ((ONLY < 0 || ONLY == (k)) && lo <= (k) && (k) < hi)
    XcdBarrier bar; bar.bar = (unsigned*)(args.ws + WS_CTL); bar.x = 0; bar.st = (volatile LAS unsigned*)(F.lds + MISC_OFF);
    if constexpr (FUSED) {
        if (MK_CG_SYNC) cg::this_grid().sync();
        bar.x = xb_xcc_id();
        if (F.wave == 0 && lane_id() == 0) { bar.st[0] = 0u; bar.st[1] = 0u; (void)xb_add(&bar.bar[XB_XCNT(bar.x)], 1u); }
        __syncthreads();
    }
#define SEAM(k) do { if (FUSED && IN(k) && IN((k) + 1)) { xcd_barrier(bar, F.wave, (unsigned)F.G); } } while (0)

    if (IN(0)) { p0_prologue(F, A); } SEAM(0);
    if (IN(1)) { p1_norm1(F, A); } SEAM(1);
    if (IN(2)) {
        { pg8::Gemm g{(const bf16*)AP_H8, (const bf16*)AP_WIN8, M, NPROJ, D / 2}; pg8::StaticOrder S; S.init(M, NPROJ, F.G, (int)blockIdx.x);
          EpiProj E{AP_Q, AP_K, AP_VTR, AP_BG, AP_CG, AP_U, AP_qn, AP_kn, (LAS float*)(F.lds + XCH_OFF), 0, 11, 0.08838834764831845f * LOG2E, AP_HS, AP_WINS};
          pg8::gemm_phase<EpiProj, pg8::StaticOrder, true, true, true>(F.lds, g, S, E, F.wave); }
        { pg8::Gemm g{(const bf16*)AP_HC8, (const bf16*)(AP_WIN8 + (size_t)DA * D), MC, 2 * DA, D / 2}; pg8::StaticOrder S; S.init(MC, 2 * DA, F.G, (int)blockIdx.x);
          EpiProj E{nullptr, AP_KC, AP_VCT, nullptr, nullptr, nullptr, AP_qn, AP_kn, (LAS float*)(F.lds + XCH_OFF), 1, 8, 1.f, AP_HCS, AP_WINS + DA};
          pg8::gemm_phase<EpiProj, pg8::StaticOrder, true, true, true>(F.lds, g, S, E, F.wave); }
    } SEAM(2);
    if (IN(3)) { attn_phase(F, A); conv_phase(F, A); } SEAM(3);
    if (IN(4)) { pg8::Gemm g{(const bf16*)AP_A28, (const bf16*)AP_WOUT8, M, D, D / 2}; pg8::StaticOrder S; S.init(M, D, F.G, (int)blockIdx.x);
        EpiRes E{AP_x, AP_X1B, AP_MOD, 2 * D, AP_WOUTS, A2_SCALE};
        pg8::gemm_phase<EpiRes, pg8::StaticOrder, true, true, true>(F.lds, g, S, E, F.wave); } SEAM(4);
    if (IN(5)) { p5_norm2(F, A); } SEAM(5);
    if (IN(6)) { pg8::Gemm g{AP_ACT, AP_WPQ, M, D, D}; pg8::StaticOrder S; S.init(M, D, F.G, (int)blockIdx.x);
        EpiBf16 E{AP_QP, D};
        pg8::gemm_phase<EpiBf16, pg8::StaticOrder, true, true>(F.lds, g, S, E, F.wave); } SEAM(6);
    if (IN(7)) { peer_select_phase(F, A); } SEAM(7);
    if (IN(8)) { peer_eval_phase(F, A); }
#undef IN
#undef SEAM
}

template <int PHS> static bool set_lds() { return hipFuncSetAttribute((const void*)mk_fwd<false, PHS>, hipFuncAttributeMaxDynamicSharedMemorySize, LDS_BYTES) == hipSuccess; }
template <int PHS> static void launch_one(int grid, hipStream_t stream, const Args& a) {
    hipLaunchKernelGGL((mk_fwd<false, PHS>), dim3(grid), dim3(NWAVES * 64), LDS_BYTES, stream, a);
    const hipError_t le = hipPeekAtLastError();
    if (le != hipSuccess) fprintf(stderr, "kernel_launch: launch %d failed: %s\n", PHS, hipGetErrorName(le));
}
extern "C" void kernel_launch(void* const* d_in, const int* in_sizes, int n_in, void* d_out, int out_size, void* d_ws, size_t ws_size, hipStream_t stream) {
    constexpr bool FUSED = (MK_N_LAUNCHES == 1);
    static int grid = 0;
    if (grid == 0) {
        if (n_in != 20 || in_sizes[0] != M * D || out_size != M * D || ws_size < WS_END) { fprintf(stderr, "kernel_launch: unexpected shapes (n_in %d, in0 %d, out %d, ws %zu < %zu); nothing launched\n", n_in, n_in > 0 ? in_sizes[0] : -1, out_size, ws_size, (size_t)WS_END); grid = -1; return; }
        int dev = 0, cus = 0, per_cu = 0;
        if (hipGetDevice(&dev) != hipSuccess || hipDeviceGetAttribute(&cus, hipDeviceAttributeMultiprocessorCount, dev) != hipSuccess) { grid = -1; return; }
        bool okattr = true;
        if constexpr (FUSED) okattr = hipFuncSetAttribute((const void*)mk_fwd<true, -1>, hipFuncAttributeMaxDynamicSharedMemorySize, LDS_BYTES) == hipSuccess;
        else { okattr &= set_lds<0>(); okattr &= set_lds<1>(); okattr &= set_lds<2>(); okattr &= set_lds<3>(); okattr &= set_lds<4>(); okattr &= set_lds<5>(); okattr &= set_lds<6>(); okattr &= set_lds<7>(); okattr &= set_lds<8>(); }
        if (!okattr) { fprintf(stderr, "kernel_launch: hipFuncSetAttribute failed\n"); grid = -1; return; }
        if (hipOccupancyMaxActiveBlocksPerMultiprocessor(&per_cu, (const void*)mk_fwd<FUSED, (FUSED ? -1 : 2)>, NWAVES * 64, LDS_BYTES) != hipSuccess || per_cu < 1) { fprintf(stderr, "kernel_launch: occupancy query says %d blocks per CU; nothing launched\n", per_cu); grid = -1; return; }
        (void)hipGetLastError();
        grid = cus;
        if (grid != 256) fprintf(stderr, "kernel_launch: note: %d CUs (built for 256)\n", grid);
    }
    if (grid < 0) return;
    Args a{};
    for (int i = 0; i < 20; ++i) a.in[i] = (const float*)d_in[i];
    a.out = (float*)d_out; a.ws = (unsigned char*)d_ws;
    if constexpr (FUSED) {
        a.ph_lo = 0; a.ph_hi = NPHASE;
        if (hipMemsetAsync((char*)d_ws + WS_CTL, 0, 128 * 1024, stream) != hipSuccess) { fprintf(stderr, "kernel_launch: memset of the barrier words failed\n"); return; }
        void* kargs[] = {&a};
        hipError_t e;
        if (MK_CG_SYNC) e = hipLaunchCooperativeKernel((const void*)mk_fwd<true, -1>, dim3(grid), dim3(NWAVES * 64), kargs, LDS_BYTES, stream);
        else { hipLaunchKernelGGL((mk_fwd<true, -1>), dim3(grid), dim3(NWAVES * 64), LDS_BYTES, stream, a); e = hipPeekAtLastError(); }
        if (e != hipSuccess) fprintf(stderr, "kernel_launch: launch failed: %s (grid %d)\n", hipGetErrorString(e), grid);
    } else {
        a.ph_lo = 0; a.ph_hi = NPHASE;
        launch_one<0>(grid, stream, a); launch_one<1>(grid, stream, a); launch_one<2>(grid, stream, a); launch_one<3>(grid, stream, a); launch_one<4>(grid, stream, a);
        launch_one<5>(grid, stream, a); launch_one<6>(grid, stream, a); launch_one<7>(grid, stream, a); launch_one<8>(grid, stream, a);
    }
}
```

```cpp
#include <hip/hip_runtime.h>
#include <hip/hip_cooperative_groups.h>
#include <cstdio>
#include <cstdint>
namespace cg = cooperative_groups;
#define MK_N_LAUNCHES 1
namespace pg8 {
#define PG8_LAS __attribute__((address_space(3)))
typedef unsigned short bf16_t;
typedef short bf16x8 __attribute__((ext_vector_type(8)));
typedef float f32x4 __attribute__((ext_vector_type(4)));
typedef unsigned u32x4 __attribute__((ext_vector_type(4)));
constexpr int BM = 256, BK = 64, HALF = 128, HTB = HALF * BK * 2  , STAGE_BYTES = 8 * HTB, NXCD = 8, WGM = 8;

__host__ __device__ __forceinline__ int lds_byte(int r, int c) { const int st = (r >> 4) * 2 + (c >> 5), rr = r & 15, cc = c & 31, ob = rr * 64 + cc * 2; return st * 1024 + (ob ^ (((ob >> 9) & 1) << 5)); }
__host__ __device__ __forceinline__ void stage_rc(int b, int& R, int& C) { const int st = b / 1024, sb = b % 1024, swz = sb ^ (((sb >> 9) & 1) << 5); R = (st >> 1) * 16 + swz / 64; C = (st & 1) * 32 + (swz % 64) / 2; }
__host__ __device__ __forceinline__ int perm32(int rho) { const int n = rho >> 4, i = rho & 15; return 8 * (i >> 2) + 4 * n + (i & 3); }

struct Unit { int pm, pn; };
struct Gemm { const bf16_t* A; const bf16_t* Bt; int M, N, K; };

struct StaticOrder {
    int nM, nN, nwg, G, c;
    __host__ __device__ void init(int M, int N, int G_, int c_) { nM = M / BM; nN = N / BM; nwg = nM * nN; G = G_; c = c_; }
    __host__ __device__ bool next(int i, Unit& u) const {
        const long L = (long)i * G + c; if (L >= nwg) return false;
        int wgid = (int)L; { const int q = nwg / NXCD, r = nwg % NXCD, xcd = wgid % NXCD, off = wgid / NXCD; wgid = (xcd < r ? xcd * (q + 1) : r * (q + 1) + (xcd - r) * q) + off; }
        const int nig = WGM * nN, gid = wgid / nig, fm = gid * WGM, gsz = (nM - fm) < WGM ? (nM - fm) : WGM;
        u.pm = fm + ((wgid % nig) % gsz); u.pn = (wgid % nig) / gsz; return true;
    }
    __device__ __forceinline__ void a_ready(const Unit&) const {}
    __device__ __forceinline__ void done(const Unit&) const {}
};

__device__ __forceinline__ unsigned cvt_pk_bf16(float lo, float hi) { unsigned r; asm volatile("v_cvt_pk_bf16_f32 %0, %1, %2" : "=v"(r) : "v"(lo), "v"(hi)); return r; }
typedef float f32x2 __attribute__((ext_vector_type(2)));
template <class Epi, class Sched, bool ALIGN_EPI = false, bool SP2 = false, bool I8 = false>
__device__ __forceinline__ void gemm_phase(PG8_LAS unsigned char* lds, const Gemm g, const Sched& S, const Epi& E, const int wid) {
    int lane; asm volatile("v_mbcnt_lo_u32_b32 %0, -1, 0\n\tv_mbcnt_hi_u32_b32 %0, -1, %0" : "=v"(lane)); const int tid = wid * 64 + lane, wr = wid >> 2, wc = wid & 3, fr = lane & 15, fq = lane >> 4;
    const int K = g.K, nt = K / BK;
    unsigned voffA[2], voffB[2];
#pragma unroll
    for (int i = 0; i < 2; ++i) { int R, C; stage_rc(tid * 16 + i * 8192, R, C); const int Rb = Epi::PERM ? ((R & ~31) + perm32(R & 31)) : R;
        voffA[i] = (unsigned)(R * K + C) * 2u; voffB[i] = (unsigned)(Rb * K + C) * 2u; }
    const size_t kstep = (size_t)(BK * 2);
    const size_t hstep = (size_t)HALF * K * 2;
    const size_t tstep = 2 * hstep;
    const unsigned ldsw = (unsigned)wid * 1024u;
    const int aoff = lds_byte(wr * 64 + fr, fq * 8), boff = lds_byte(wc * 32 + fr, fq * 8);
#define PG8_SA(b, h) (((b) * 2 + (h)) * HTB)
#define PG8_SB(b, h) ((4 + (b) * 2 + (h)) * HTB)
#define PG8_STAGE(bufoff, gbase, voff) do { _Pragma("unroll") for (int _i = 0; _i < 2; ++_i) \
        __builtin_amdgcn_global_load_lds((const unsigned*)((const char*)(gbase) + (voff)[_i]), (PG8_LAS unsigned*)(lds + (bufoff) + ldsw + _i * 8192), 16, 0, 0); } while (0)
#define PG8_LDA(dst, b, h) do { _Pragma("unroll") for (int m = 0; m < 4; ++m) _Pragma("unroll") for (int k = 0; k < 2; ++k) dst[m][k] = *(const PG8_LAS bf16x8*)(lds + PG8_SA(b, h) + aoff + m * 2048 + k * 1024); } while (0)
#define PG8_LDB(dst, b, h) do { _Pragma("unroll") for (int n = 0; n < 2; ++n) _Pragma("unroll") for (int k = 0; k < 2; ++k) dst[n][k] = *(const PG8_LAS bf16x8*)(lds + PG8_SB(b, h) + boff + n * 2048 + k * 1024); } while (0)
#define PG8_MMA(ai, bj, At, Bt) do { __builtin_amdgcn_s_setprio(1); _Pragma("unroll") for (int m = 0; m < 4; ++m) _Pragma("unroll") for (int n = 0; n < 2; ++n) _Pragma("unroll") for (int k = 0; k < 2; ++k) \
        { if constexpr (I8) { typedef int v4i_ __attribute__((ext_vector_type(4))); acc[ai][bj][m][n] = __builtin_bit_cast(f32x4, __builtin_amdgcn_mfma_i32_16x16x64_i8(__builtin_bit_cast(v4i_, Bt[n][k]), __builtin_bit_cast(v4i_, At[m][k]), __builtin_bit_cast(v4i_, acc[ai][bj][m][n]), 0, 0, 0)); } \
          else acc[ai][bj][m][n] = __builtin_amdgcn_mfma_f32_16x16x32_bf16(Bt[n][k], At[m][k], acc[ai][bj][m][n], 0, 0, 0); } __builtin_amdgcn_s_setprio(0); } while (0)
#define PG8_WAIT_V(n) asm volatile("s_waitcnt vmcnt(" #n ")" ::: "memory")
#define PG8_WAIT_L(n) asm volatile("s_waitcnt lgkmcnt(" #n ")" ::: "memory")
#define PG8_BAR __builtin_amdgcn_s_barrier()
#define PG8_SCHED __builtin_amdgcn_sched_barrier(0)
    Unit cur, nxt; int ui = 0;
    if (!S.next(0, cur)) return;
    f32x4 acc[2][2][4][2];
#pragma unroll
    for (int a = 0; a < 2; ++a)
#pragma unroll
        for (int b = 0; b < 2; ++b)
#pragma unroll
            for (int m = 0; m < 4; ++m)
#pragma unroll
                for (int n = 0; n < 2; ++n) acc[a][b][m][n] = (f32x4){0.f, 0.f, 0.f, 0.f};
    bf16x8 At[4][2], B0[2][2], B1[2][2];
    const char* cA = (const char*)g.A + (size_t)cur.pm * tstep; const char* cB = (const char*)g.Bt + (size_t)cur.pn * tstep;
    S.a_ready(cur);
    if constexpr (SP2) {
        PG8_STAGE(PG8_SB(0, 0), cB, voffB); PG8_STAGE(PG8_SB(0, 1), cB + hstep, voffB); PG8_STAGE(PG8_SA(0, 0), cA, voffA); PG8_STAGE(PG8_SA(0, 1), cA + hstep, voffA);
        if (wr == 1) PG8_BAR;
        PG8_WAIT_V(2); PG8_BAR;
        PG8_STAGE(PG8_SB(1, 0), cB + kstep, voffB); PG8_STAGE(PG8_SA(1, 0), cA + kstep, voffA); PG8_STAGE(PG8_SB(1, 1), cB + hstep + kstep, voffB);
        PG8_WAIT_V(6); PG8_BAR;
    } else {
        PG8_STAGE(PG8_SB(0, 0), cB, voffB); PG8_STAGE(PG8_SA(0, 0), cA, voffA); PG8_STAGE(PG8_SB(0, 1), cB + hstep, voffB); PG8_STAGE(PG8_SA(0, 1), cA + hstep, voffA);
        if (wr == 1) PG8_BAR;
        PG8_WAIT_V(4); PG8_BAR;
        PG8_STAGE(PG8_SB(1, 0), cB + kstep, voffB); PG8_STAGE(PG8_SA(1, 0), cA + kstep, voffA); PG8_STAGE(PG8_SB(1, 1), cB + hstep + kstep, voffB);
        PG8_WAIT_V(6); PG8_BAR;
    }
    for (;;) {
        const bool has_next = S.next(ui + 1, nxt);
        const char* nA = has_next ? (const char*)g.A + (size_t)nxt.pm * tstep : cA; const char* nB = has_next ? (const char*)g.Bt + (size_t)nxt.pn * tstep : cB;
        for (int t = 0; t < nt; t += 2) {
            const bool last = (t == nt - 2);
            const char* a1 = cA + (size_t)(t + 1) * kstep;
            const char* a2 = last ? nA : cA + (size_t)(t + 2) * kstep; const char* b2 = last ? nB : cB + (size_t)(t + 2) * kstep;
            const char* a3 = a2 + kstep; const char* b3 = b2 + kstep;
            if (last && has_next) S.a_ready(nxt);
            if constexpr (SP2) {
            PG8_LDB(B0, 0, 0); PG8_LDB(B1, 0, 1); PG8_SCHED; PG8_LDA(At, 0, 0); PG8_STAGE(PG8_SA(1, 1), a1 + hstep, voffA);
            PG8_WAIT_V(8); PG8_WAIT_L(0); PG8_BAR; PG8_MMA(0, 0, At, B0); PG8_MMA(0, 1, At, B1); PG8_BAR; PG8_SCHED;
            PG8_LDA(At, 0, 1); PG8_STAGE(PG8_SB(0, 0), b2, voffB); PG8_STAGE(PG8_SB(0, 1), b2 + hstep, voffB); PG8_STAGE(PG8_SA(0, 0), a2, voffA);
            PG8_WAIT_V(8); PG8_WAIT_L(0); PG8_BAR; PG8_MMA(1, 0, At, B0); PG8_MMA(1, 1, At, B1); PG8_BAR; PG8_SCHED;
            PG8_LDB(B0, 1, 0); PG8_LDB(B1, 1, 1); PG8_SCHED; PG8_LDA(At, 1, 0); PG8_STAGE(PG8_SA(0, 1), a2 + hstep, voffA);
            PG8_WAIT_V(8); PG8_WAIT_L(0); PG8_BAR; PG8_MMA(0, 0, At, B0); PG8_MMA(0, 1, At, B1); PG8_BAR; PG8_SCHED;
            PG8_LDA(At, 1, 1); PG8_STAGE(PG8_SB(1, 0), b3, voffB); PG8_STAGE(PG8_SB(1, 1), b3 + hstep, voffB); PG8_STAGE(PG8_SA(1, 0), a3, voffA);
            PG8_WAIT_V(8); PG8_WAIT_L(0); PG8_BAR; PG8_MMA(1, 0, At, B0); PG8_MMA(1, 1, At, B1); PG8_BAR; PG8_SCHED;
            } else {
            PG8_LDB(B0, 0, 0); PG8_SCHED; PG8_LDA(At, 0, 0); PG8_STAGE(PG8_SA(1, 1), a1 + hstep, voffA);
            PG8_WAIT_L(8); PG8_BAR; PG8_WAIT_L(0); PG8_MMA(0, 0, At, B0); PG8_BAR; PG8_SCHED;
            PG8_LDB(B1, 0, 1); PG8_STAGE(PG8_SB(0, 0), b2, voffB);
            PG8_BAR; PG8_WAIT_L(0); PG8_MMA(0, 1, At, B1); PG8_BAR;
            PG8_LDA(At, 0, 1); PG8_STAGE(PG8_SA(0, 0), a2, voffA);
            PG8_BAR; PG8_WAIT_L(0); PG8_MMA(1, 0, At, B0); PG8_BAR; PG8_SCHED;
            PG8_STAGE(PG8_SB(0, 1), b2 + hstep, voffB);
            PG8_WAIT_V(6); PG8_BAR; PG8_MMA(1, 1, At, B1); PG8_BAR;
            PG8_LDB(B0, 1, 0); PG8_SCHED; PG8_LDA(At, 1, 0); PG8_STAGE(PG8_SA(0, 1), a2 + hstep, voffA);
            PG8_WAIT_L(8); PG8_BAR; PG8_WAIT_L(0); PG8_MMA(0, 0, At, B0); PG8_BAR; PG8_SCHED;
            PG8_LDB(B1, 1, 1); PG8_STAGE(PG8_SB(1, 0), b3, voffB);
            PG8_BAR; PG8_WAIT_L(0); PG8_MMA(0, 1, At, B1); PG8_BAR;
            PG8_LDA(At, 1, 1); PG8_STAGE(PG8_SA(1, 0), a3, voffA);
            PG8_BAR; PG8_WAIT_L(0); PG8_MMA(1, 0, At, B0); PG8_BAR; PG8_SCHED;
            PG8_STAGE(PG8_SB(1, 1), b3 + hstep, voffB);
            PG8_WAIT_V(6); PG8_BAR; PG8_MMA(1, 1, At, B1); PG8_BAR;
            }
        }
        if constexpr (ALIGN_EPI) { if (wr == 0) PG8_BAR; }
        if constexpr (!Epi::AFTER_DRAIN) { E(acc, cur, wr, wc, fr, fq); S.done(cur); }
        if (!has_next) break;
#pragma unroll
        for (int a = 0; a < 2; ++a)
#pragma unroll
            for (int b = 0; b < 2; ++b)
#pragma unroll
                for (int m = 0; m < 4; ++m)
#pragma unroll
                    for (int n = 0; n < 2; ++n) acc[a][b][m][n] = (f32x4){0.f, 0.f, 0.f, 0.f};
        cur = nxt; cA = nA; cB = nB; ++ui;
        if constexpr (ALIGN_EPI) { if (wr == 1) PG8_BAR; }
    }
    PG8_WAIT_V(0);
    if constexpr (!ALIGN_EPI) { if (wr == 0) PG8_BAR; }
    PG8_BAR;
    if constexpr (Epi::AFTER_DRAIN) { E.fused(acc, cur, wr, wc, fr, fq, lds, wid, lane); S.done(cur); }
#undef PG8_SA
#undef PG8_SB
#undef PG8_STAGE
#undef PG8_LDA
#undef PG8_LDB
#undef PG8_MMA
#undef PG8_WAIT_V
#undef PG8_WAIT_L
#undef PG8_BAR
#undef PG8_SCHED
}
}

#ifndef MK_N_LAUNCHES
#define MK_N_LAUNCHES 1
#endif
constexpr int NPHASE = 9;

constexpr int D = 2048, NB = 8, SEQ = 2048, M = NB * SEQ, CTXL = 256, MC = NB * CTXL;
constexpr int NH = 8, HD = 128, DA = 1024, NPROJ = 6144, GW = 64;
constexpr int NEXP = 16384, PH = 8, PK = 16, NKEYS = 128;
constexpr float EPS = 1e-6f, LOG2E = 1.4426950408889634f;
constexpr int NWAVES = 8;
constexpr float A2_SCALE = 10.0f / 127.0f, A2_INV = 127.0f / 10.0f;

constexpr size_t MiB = 1u << 20;
constexpr size_t WS_CTL = 0, WS_MOD = 1 * MiB, WS_SK = 2 * MiB, WS_WIN = 4 * MiB, WS_WOUT = 28 * MiB, WS_WPQ = 36 * MiB;
constexpr size_t WS_UT = 44 * MiB, WS_VT = 108 * MiB, WS_ACT = 172 * MiB, WS_HC = 236 * MiB;
constexpr size_t WS_Q = 244 * MiB, WS_K = 276 * MiB, WS_VTR = 308 * MiB, WS_BG = 340 * MiB, WS_CG = 372 * MiB, WS_U = 404 * MiB;
constexpr size_t WS_KC = 436 * MiB, WS_VCT = 440 * MiB, WS_QP = 244 * MiB  ;
constexpr size_t WS_SELI = 444 * MiB, WS_SELG = 452 * MiB, WS_AVW = 460 * MiB, WS_END = 468 * MiB;
constexpr size_t WS_U8 = WS_UT, WS_V8 = WS_UT + 32 * MiB, WS_SU = WS_VT, WS_SV = WS_VT + 64 * 1024, WS_H2S = WS_VT + 128 * 1024, WS_H2Q = WS_VT + 1 * MiB;

constexpr int LDS_BYTES = 147456;
constexpr int XCH_OFF = 131072;
constexpr int MISC_OFF = 131072 + 8192;
#ifndef MK_CG_SYNC
#define MK_CG_SYNC 1
#endif

#define GAS __attribute__((address_space(1)))
#define LAS __attribute__((address_space(3)))
typedef unsigned short bf16;
typedef unsigned v4u __attribute__((ext_vector_type(4)));
typedef unsigned v2u __attribute__((ext_vector_type(2)));
typedef float f32x4 __attribute__((ext_vector_type(4)));
typedef float f32x16 __attribute__((ext_vector_type(16)));
typedef short bf16x8 __attribute__((ext_vector_type(8)));
typedef __bf16 bf16x2 __attribute__((ext_vector_type(2)));
#define LDS_WAIT() asm volatile("s_waitcnt lgkmcnt(0)" ::: "memory")

__device__ __forceinline__ unsigned f2bf(float f) { unsigned u = __builtin_bit_cast(unsigned, f); return (u + 0x7fffu + ((u >> 16) & 1u)) >> 16; }
__device__ __forceinline__ unsigned pk2(float lo, float hi) { return pg8::cvt_pk_bf16(lo, hi); }
__device__ __forceinline__ float bflo(unsigned w) { return __builtin_bit_cast(float, w << 16); }
__device__ __forceinline__ float bfhi(unsigned w) { return __builtin_bit_cast(float, w & 0xffff0000u); }
__device__ __forceinline__ float dot2_bf16(unsigned w, unsigned x, float acc) { return __builtin_amdgcn_fdot2_f32_bf16(__builtin_bit_cast(bf16x2, w), __builtin_bit_cast(bf16x2, x), acc, false); }
__device__ __forceinline__ float wave_sum(float v) {
#pragma unroll
    for (int o = 1; o < 64; o <<= 1) v += __shfl_xor(v, o);
    return v;
}

struct Args { const float* in[20]; float* out; unsigned char* ws; int ph_lo, ph_hi; };
struct Frame {
    LAS unsigned char* lds;
    int wave, vcu, G;
};
__device__ __forceinline__ int lane_id() { int l; asm volatile("v_mbcnt_lo_u32_b32 %0, -1, 0\n\tv_mbcnt_hi_u32_b32 %0, -1, %0" : "=v"(l)); return l; }
#define F_LANE lane_id()
#define F_TID (F.wave * 64 + lane_id())
#define AP_x (A.in[0])
#define AP_c (A.in[1])
#define AP_ctx (A.in[2])
#define AP_c_ctx (A.in[3])
#define AP_w_ada (A.in[4])
#define AP_b_ada (A.in[5])
#define AP_g1 (A.in[6])
#define AP_w_in (A.in[7])
#define AP_qn (A.in[8])
#define AP_kn (A.in[9])
#define AP_rpb (A.in[10])
#define AP_w_conv (A.in[11])
#define AP_gao (A.in[12])
#define AP_gco (A.in[13])
#define AP_w_out (A.in[14])
#define AP_g2 (A.in[15])
#define AP_w_pq (A.in[16])
#define AP_subk (A.in[17])
#define AP_uex (A.in[18])
#define AP_vex (A.in[19])
#define AP_SK ((bf16*)(A.ws + WS_SK))
#define AP_WIN ((bf16*)(A.ws + WS_WIN))
#define AP_WOUT ((bf16*)(A.ws + WS_WOUT))
#define AP_WPQ ((bf16*)(A.ws + WS_WPQ))
#define AP_UT ((bf16*)(A.ws + WS_UT))
#define AP_VT ((bf16*)(A.ws + WS_VT))
#define AP_ACT ((bf16*)(A.ws + WS_ACT))
#define AP_HC ((bf16*)(A.ws + WS_HC))
#define AP_Q ((bf16*)(A.ws + WS_Q))
#define AP_K ((bf16*)(A.ws + WS_K))
#define AP_VTR ((bf16*)(A.ws + WS_VTR))
#define AP_BG ((bf16*)(A.ws + WS_BG))
#define AP_CG ((bf16*)(A.ws + WS_CG))
#define AP_U ((bf16*)(A.ws + WS_U))
#define AP_KC ((bf16*)(A.ws + WS_KC))
#define AP_VCT ((bf16*)(A.ws + WS_VCT))
#define AP_QP ((bf16*)(A.ws + WS_QP))
#define AP_MOD ((float*)(A.ws + WS_MOD))
#define AP_SELI ((int*)(A.ws + WS_SELI))
#define AP_SELG ((float*)(A.ws + WS_SELG))
#define AP_AVW ((float*)(A.ws + WS_AVW))
#define AP_WIN8 ((unsigned char*)(A.ws + WS_WIN))
#define AP_WINS ((float*)(A.ws + WS_WIN + 16 * MiB))
#define AP_WOUT8 ((unsigned char*)(A.ws + WS_WOUT))
#define AP_WOUTS ((float*)(A.ws + WS_WOUT + 5 * MiB))
#define AP_CPARTO ((float*)(A.ws + WS_WOUT + 6 * MiB))
#define AP_A28 ((unsigned char*)(A.ws + WS_ACT))
#define AP_CPART ((float*)(A.ws + WS_WIN + 17 * MiB))
#define AP_H8 ((unsigned char*)(A.ws + WS_ACT))
#define AP_HC8 ((unsigned char*)(A.ws + WS_HC))
#define AP_HS ((float*)(A.ws + WS_HC + 4 * MiB))
#define AP_HCS ((float*)(A.ws + WS_HC + 4 * MiB + 65536))
#define AP_X1B ((bf16*)(A.ws + WS_BG))
#define AP_out (A.out)
#define AP_U8 ((const unsigned char*)(A.ws + WS_U8))
#define AP_V8 ((const unsigned char*)(A.ws + WS_V8))
#define AP_SU ((float*)(A.ws + WS_SU))
#define AP_SV ((float*)(A.ws + WS_SV))
#define AP_H2S ((float*)(A.ws + WS_H2S))
#define AP_H2Q ((unsigned char*)(A.ws + WS_H2Q))


#define XB_TMO      128
#define XB_XCNT(j)  (256  + 64 * (j))
#define XB_XSUB(j)  (1280 + 64 * (j))
#define XB_XGEN(j)  (2304 + 64 * (j))
#define XB_TOP      3328
#define XB_TOPGEN   3392
#define XCD_BAR_WORDS 3456
#define XB_SPIN_CAP (1u << 22)
__device__ __forceinline__ unsigned xb_ld(unsigned* p)              { return __hip_atomic_load(p, __ATOMIC_RELAXED, __HIP_MEMORY_SCOPE_AGENT); }
__device__ __forceinline__ unsigned xb_add(unsigned* p, unsigned v) { return __hip_atomic_fetch_add(p, v, __ATOMIC_RELAXED, __HIP_MEMORY_SCOPE_AGENT); }
__device__ __forceinline__ unsigned xb_xcc_id() { return (unsigned)__builtin_amdgcn_s_getreg((3 << 11) | 20) & 0xFu; }
#define XB_SPIN(cond, bar) do { unsigned _sp = 0; while (cond) { __builtin_amdgcn_s_sleep(1); \
    if ((++_sp & 255u) == 0u) { if (xb_ld(&(bar)[XB_TMO])) break; if (_sp > XB_SPIN_CAP) { atomicAdd(&(bar)[XB_TMO], 1u); break; } } } } while (0)
struct XcdBarrier { unsigned* bar; unsigned x; volatile LAS unsigned* st; };
__device__ __forceinline__ void xcd_barrier_complete(unsigned* bar, unsigned x, unsigned G, unsigned& nloc, unsigned& nx) {
    unsigned sum, cnt, mine, sp = 0u;
    for (;;) {
        sum = 0u; cnt = 0u; mine = 0u;
#pragma unroll
        for (unsigned j = 0; j < 16; ++j) { const unsigned c = xb_ld(&bar[XB_XCNT(j)]); sum += c; cnt += (c > 0u) ? 1u : 0u; mine = (j == x) ? c : mine; }
        if (sum == G) break;
        __builtin_amdgcn_s_sleep(1);
        if ((++sp & 255u) == 0u) { if (xb_ld(&bar[XB_TMO])) break; if (sp > XB_SPIN_CAP) { atomicAdd(&bar[XB_TMO], 1u); break; } }
    }
    nloc = mine > 0u ? mine : 1u; nx = cnt > 0u ? cnt : 1u;
}
__device__ __forceinline__ void xcd_barrier(const XcdBarrier& b, const int wave, const unsigned G) {
    asm volatile("s_waitcnt vmcnt(0)" ::: "memory");
    __syncthreads();
    if (wave == 0 && lane_id() == 0) {
        unsigned* bar = b.bar;
        __builtin_amdgcn_s_waitcnt(0);
        unsigned nloc = b.st[0], nx = b.st[1];
        if (nloc == 0u) { xcd_barrier_complete(bar, b.x, G, nloc, nx); b.st[0] = nloc; b.st[1] = nx; }
        const unsigned old = xb_add(&bar[XB_XSUB(b.x)], 1u);
        const unsigned gen = old / nloc;
        if (old + 1u == (gen + 1u) * nloc) {
            __builtin_amdgcn_fence(__ATOMIC_RELEASE, "agent");
            asm volatile("s_waitcnt vmcnt(0)" ::: "memory");
            const unsigned og = xb_add(&bar[XB_TOP], 1u);
            const unsigned tg = og / nx;
            if (og + 1u == (tg + 1u) * nx) xb_add(&bar[XB_TOPGEN], 1u);
            else XB_SPIN(xb_ld(&bar[XB_TOPGEN]) == tg, bar);
            __builtin_amdgcn_fence(__ATOMIC_ACQUIRE, "agent");
            xb_add(&bar[XB_XGEN(b.x)], 1u);
            asm volatile("s_waitcnt vmcnt(0)" ::: "memory");
        } else {
            XB_SPIN(xb_ld(&bar[XB_XGEN(b.x)]) == gen, bar);
            __builtin_amdgcn_fence(__ATOMIC_ACQUIRE, "agent");
            asm volatile("s_waitcnt vmcnt(0)" ::: "memory");
        }
    }
    __syncthreads();
}

__device__ __forceinline__ void p0_mod(const Frame& F, const Args& A) {
    const int lane = lane_id(), tid = F.wave * 64 + lane; (void)tid;
    LAS float* sc = (LAS float*)F.lds;
    LAS float* red = (LAS float*)(F.lds + 9 * 2048 * 4);
    for (int i = tid; i < 9 * D; i += NWAVES * 64) { const int r = i >> 11, k = i & (D - 1); const float cv = (r < 8) ? AP_c[r * D + k] : AP_c_ctx[k]; sc[i] = cv / (1.f + __expf(-cv)); }
    __syncthreads();
    const int sr = lane >> 4, cq = lane & 15;
    for (int item = F.vcu; item < (6 * D) / 64; item += F.G) {
        const int n0 = item * 64;
        float acc[9][4];
#pragma unroll
        for (int r = 0; r < 9; ++r)
#pragma unroll
            for (int j = 0; j < 4; ++j) acc[r][j] = 0.f;
        const float* wp = AP_w_ada + (size_t)(F.wave * 4 + sr) * (6 * D) + n0 + 4 * cq;
#pragma unroll 8
        for (int step = 0; step < 64; ++step) {
            const int k = step * 32 + F.wave * 4 + sr;
            const f32x4 w = *(const f32x4*)(wp + (size_t)step * 32 * (6 * D));
#pragma unroll
            for (int r = 0; r < 9; ++r) { const float s = sc[r * D + k]; acc[r][0] += s * w.x; acc[r][1] += s * w.y; acc[r][2] += s * w.z; acc[r][3] += s * w.w; }
        }
#pragma unroll
        for (int r = 0; r < 9; ++r)
#pragma unroll
            for (int j = 0; j < 4; ++j) { float v = acc[r][j]; v += __shfl_xor(v, 16); v += __shfl_xor(v, 32); if (sr == 0) red[(F.wave * 9 + r) * 64 + 4 * cq + j] = v; }
        __syncthreads();
        for (int i = tid; i < 9 * 64; i += NWAVES * 64) { const int r = i >> 6, cc = i & 63; float s = 0.f;
#pragma unroll
            for (int w = 0; w < 8; ++w) s += red[(w * 9 + r) * 64 + cc];
            AP_MOD[r * (6 * D) + n0 + cc] = s + AP_b_ada[n0 + cc]; }
        __syncthreads();
    }
    __syncthreads();
}
__device__ __forceinline__ void p0_transpose_item(const float* W, int K, int N, bf16* WT, LAS float* scr, int item, int lane) {
    const int nblk = N / 32, kb = item / nblk, nb = item % nblk, k0 = 64 * kb, n0 = 32 * nb;
#pragma unroll 8
    for (int i = 0; i < 32; ++i) { const int kk = 2 * i + (lane >> 5); scr[kk * 33 + (lane & 31)] = W[(size_t)(k0 + kk) * N + n0 + (lane & 31)]; }
    LDS_WAIT(); asm volatile("" ::: "memory");
    const int c = lane & 7;
#pragma unroll
    for (int j = 0; j < 4; ++j) { const int n = (lane >> 3) + 8 * j; const LAS float* s = scr + (8 * c) * 33 + n;
        v4u o; o.x = pk2(s[0 * 33], s[1 * 33]); o.y = pk2(s[2 * 33], s[3 * 33]); o.z = pk2(s[4 * 33], s[5 * 33]); o.w = pk2(s[6 * 33], s[7 * 33]);
        *(v4u*)(WT + (size_t)(n0 + n) * K + k0 + 8 * c) = o; }
    LDS_WAIT(); asm volatile("" ::: "memory");
}
__device__ __forceinline__ void cvt_f32_bf16(const float* src, bf16* dst, size_t n, size_t gtid, size_t gthreads) {
    for (size_t i = gtid * 8; i < n; i += gthreads * 8) { const f32x4 a = *(const f32x4*)(src + i), b = *(const f32x4*)(src + i + 4);
        v4u o; o.x = pk2(a.x, a.y); o.y = pk2(a.z, a.w); o.z = pk2(b.x, b.y); o.w = pk2(b.z, b.w); *(v4u*)(dst + i) = o; }
}
__device__ __forceinline__ float wave_max(float v) {
#pragma unroll
    for (int o = 1; o < 64; o <<= 1) v = fmaxf(v, __shfl_xor(v, o));
    return v;
}
__device__ __forceinline__ unsigned q4(const f32x4 v, const float inv, const int off = 0) {
    const int a = (int)fminf(fmaxf(__builtin_rintf(v.x * inv), -127.f), 127.f) + off, b = (int)fminf(fmaxf(__builtin_rintf(v.y * inv), -127.f), 127.f) + off, c = (int)fminf(fmaxf(__builtin_rintf(v.z * inv), -127.f), 127.f) + off, d = (int)fminf(fmaxf(__builtin_rintf(v.w * inv), -127.f), 127.f) + off;
    return (unsigned)(a & 255) | ((unsigned)(b & 255) << 8) | ((unsigned)(c & 255) << 16) | ((unsigned)(d & 255) << 24);
}
__device__ __forceinline__ void quant_row(const float* src, unsigned char* dst, float* scale, int lane, const int off) {
    const f32x4* xr = (const f32x4*)src + lane; f32x4 v[8]; float mx = 0.f;
#pragma unroll
    for (int j = 0; j < 8; ++j) { v[j] = xr[64 * j]; mx = fmaxf(mx, fmaxf(fmaxf(fabsf(v[j].x), fabsf(v[j].y)), fmaxf(fabsf(v[j].z), fabsf(v[j].w)))); }
    mx = fmaxf(wave_max(mx), 1e-30f);
    const float inv = 127.f / mx;
    unsigned* o = (unsigned*)dst + lane;
#pragma unroll
    for (int j = 0; j < 8; ++j) o[64 * j] = q4(v[j], inv, off);
    if (lane == 0) *scale = mx * (1.f / 127.f);
}
__device__ __forceinline__ void p1_transpose_item_i8(const float* W, int K, int N, unsigned char* WT, const float* cpart, float* wscale, LAS float* scr, int item, int lane) {
    const int nblk = N / 32, kb = item / nblk, nb = item % nblk, k0 = 64 * kb, n0 = 32 * nb;
    { float cm = 0.f;
#pragma unroll
      for (int p = 0; p < 16; ++p) cm = fmaxf(cm, cpart[(size_t)(16 * (lane >> 5) + p) * N + n0 + (lane & 31)]);
      cm = fmaxf(cm, __shfl_xor(cm, 32));
      scr[64 * 33 + (lane & 31)] = cm; }
#pragma unroll 8
    for (int i = 0; i < 32; ++i) { const int kk = 2 * i + (lane >> 5); scr[kk * 33 + (lane & 31)] = W[(size_t)(k0 + kk) * N + n0 + (lane & 31)]; }
    LDS_WAIT(); asm volatile("" ::: "memory");
    const int c = lane & 7;
#pragma unroll
    for (int j = 0; j < 4; ++j) { const int n = (lane >> 3) + 8 * j; const LAS float* sp = scr + (8 * c) * 33 + n;
        const float mx = fmaxf(scr[64 * 33 + n], 1e-30f), inv = 127.f / mx;
        f32x4 a = {sp[0 * 33], sp[1 * 33], sp[2 * 33], sp[3 * 33]}, b = {sp[4 * 33], sp[5 * 33], sp[6 * 33], sp[7 * 33]};
        v2u o; o.x = q4(a, inv); o.y = q4(b, inv);
        *(v2u*)(WT + (size_t)(n0 + n) * K + k0 + 8 * c) = o;
        if (kb == 0 && c == 0) wscale[n0 + n] = mx * (1.f / 127.f); }
    LDS_WAIT(); asm volatile("" ::: "memory");
}
__device__ __forceinline__ void p0_prologue(const Frame& F, const Args& A) {
    const int lane = lane_id(), tid = F.wave * 64 + lane; (void)tid;
    p0_mod(F, A);
    LAS float* scr = (LAS float*)(F.lds + F.wave * 16384);
    const int gw = F.vcu * NWAVES + F.wave, NGW = F.G * NWAVES;
    constexpr int I_SQ = (D / 64) * (D / 32);
    for (int it = gw; it < I_SQ; it += NGW) p0_transpose_item(AP_w_pq, D, D, AP_WPQ, scr, it, lane);
    for (int it = gw; it < (D / 256) * (D / 64); it += NGW) { const int cb = it % (D / 256), kb = it / (D / 256);
        const f32x4* wp = (const f32x4*)(AP_w_out + (size_t)(kb * 64) * D + cb * 256) + lane; f32x4 mx = {0.f, 0.f, 0.f, 0.f};
#pragma unroll 8
        for (int k = 0; k < 64; ++k) { const f32x4 w = wp[(size_t)k * (D / 4)]; mx.x = fmaxf(mx.x, fabsf(w.x)); mx.y = fmaxf(mx.y, fabsf(w.y)); mx.z = fmaxf(mx.z, fabsf(w.z)); mx.w = fmaxf(mx.w, fabsf(w.w)); }
        *((f32x4*)(AP_CPARTO + (size_t)kb * D + cb * 256) + lane) = mx; }
    for (int it = gw; it < (NPROJ / 256) * (D / 64); it += NGW) { const int cb = it % (NPROJ / 256), kb = it / (NPROJ / 256);
        const f32x4* wp = (const f32x4*)(AP_w_in + (size_t)(kb * 64) * NPROJ + cb * 256) + lane; f32x4 mx = {0.f, 0.f, 0.f, 0.f};
#pragma unroll 8
        for (int k = 0; k < 64; ++k) { const f32x4 w = wp[(size_t)k * (NPROJ / 4)]; mx.x = fmaxf(mx.x, fabsf(w.x)); mx.y = fmaxf(mx.y, fabsf(w.y)); mx.z = fmaxf(mx.z, fabsf(w.z)); mx.w = fmaxf(mx.w, fabsf(w.w)); }
        *((f32x4*)(AP_CPART + (size_t)kb * NPROJ + cb * 256) + lane) = mx; }
    const size_t gtid = (size_t)F.vcu * (NWAVES * 64) + tid, gth = (size_t)F.G * NWAVES * 64;
    cvt_f32_bf16(AP_subk, AP_SK, (size_t)PH * 2 * NKEYS * 128, gtid, gth);
    for (int it = gw; it < 2 * NEXP; it += NGW) {
        const int e = it >> 1; const bool isv = it & 1;
        quant_row((isv ? AP_vex : AP_uex) + (size_t)e * D, (unsigned char*)(A.ws + (isv ? WS_V8 : WS_U8)) + (size_t)e * D, (isv ? AP_SV : AP_SU) + e, lane, 0);
    }
}

__device__ __forceinline__ void norm_rows(const float* X, size_t row0, int nrows, const float* g, const float* sh, const float* sc, bf16* out, int lane, unsigned char* q8 = nullptr, float* qs = nullptr) {
    f32x4 gs[8], shv[8];
#pragma unroll
    for (int j = 0; j < 8; ++j) { const int cI = j * 64 + lane; const f32x4 gg = ((const f32x4*)g)[cI], s1 = ((const f32x4*)sc)[cI]; gs[j] = gg * (1.f + s1); shv[j] = ((const f32x4*)sh)[cI]; }
    for (int r = 0; r < nrows; ++r) {
        const f32x4* xr = (const f32x4*)(X + (row0 + r) * D) + lane;
        f32x4 v[8]; float ss = 0.f;
#pragma unroll
        for (int j = 0; j < 8; ++j) { v[j] = xr[64 * j]; ss += (v[j].x * v[j].x + v[j].y * v[j].y) + (v[j].z * v[j].z + v[j].w * v[j].w); }
        const float rstd = __builtin_amdgcn_rsqf(wave_sum(ss) * (1.f / D) + EPS);
        v2u* o8 = (v2u*)(out + (row0 + r) * D) + lane; float mx = 0.f;
#pragma unroll
        for (int j = 0; j < 8; ++j) { const f32x4 y = v[j] * rstd * gs[j] + shv[j]; v[j] = y; if (out) { v2u w; w.x = pk2(y.x, y.y); w.y = pk2(y.z, y.w); o8[64 * j] = w; }
            mx = fmaxf(mx, fmaxf(fmaxf(fabsf(y.x), fabsf(y.y)), fmaxf(fabsf(y.z), fabsf(y.w)))); }
        if (q8) { mx = fmaxf(wave_max(mx), 1e-30f); const float inv = 127.f / mx; unsigned* oq = (unsigned*)(q8 + (row0 + r) * D) + lane;
#pragma unroll
            for (int j = 0; j < 8; ++j) oq[64 * j] = q4(v[j], inv);
            if (lane == 0) qs[row0 + r] = mx * (1.f / 127.f); }
    }
}
__device__ __forceinline__ void norm_rows_b(const bf16* X, size_t row0, int nrows, const float* g, const float* sh, const float* sc, bf16* out, int lane, unsigned char* q8, float* qs) {
    f32x4 gs[8], shv[8];
#pragma unroll
    for (int j = 0; j < 8; ++j) { const int cI = j * 64 + lane; const f32x4 gg = ((const f32x4*)g)[cI], s1 = ((const f32x4*)sc)[cI]; gs[j] = gg * (1.f + s1); shv[j] = ((const f32x4*)sh)[cI]; }
    for (int r = 0; r < nrows; ++r) {
        const v2u* xr = (const v2u*)(X + (row0 + r) * D) + lane;
        f32x4 v[8]; float ss = 0.f;
#pragma unroll
        for (int j = 0; j < 8; ++j) { const v2u w = xr[64 * j]; v[j].x = bflo(w.x); v[j].y = bfhi(w.x); v[j].z = bflo(w.y); v[j].w = bfhi(w.y); ss += (v[j].x * v[j].x + v[j].y * v[j].y) + (v[j].z * v[j].z + v[j].w * v[j].w); }
        const float rstd = __builtin_amdgcn_rsqf(wave_sum(ss) * (1.f / D) + EPS);
        v2u* o8 = (v2u*)(out + (row0 + r) * D) + lane; float mx = 0.f;
#pragma unroll
        for (int j = 0; j < 8; ++j) { const f32x4 y = v[j] * rstd * gs[j] + shv[j]; v[j] = y; v2u w; w.x = pk2(y.x, y.y); w.y = pk2(y.z, y.w); o8[64 * j] = w;
            mx = fmaxf(mx, fmaxf(fmaxf(fabsf(y.x), fabsf(y.y)), fmaxf(fabsf(y.z), fabsf(y.w)))); }
        mx = fmaxf(wave_max(mx), 1e-30f); const float inv = 127.f / mx; unsigned* oq = (unsigned*)(q8 + (row0 + r) * D) + lane;
#pragma unroll
        for (int j = 0; j < 8; ++j) oq[64 * j] = q4(v[j], inv);
        if (lane == 0) qs[row0 + r] = mx * (1.f / 127.f);
    }
}
__device__ __forceinline__ void p1_norm1(const Frame& F, const Args& A) {
    const int lane = lane_id(), tid = F.wave * 64 + lane; (void)tid;
    const int gw = F.vcu * NWAVES + F.wave, NGW = F.G * NWAVES;
    { LAS float* scr = (LAS float*)(F.lds + F.wave * 16384);
      for (int it = gw; it < (D / 64) * (NPROJ / 32); it += NGW) p1_transpose_item_i8(AP_w_in, D, NPROJ, AP_WIN8, AP_CPART, AP_WINS, scr, it, lane);
      for (int it = gw; it < (D / 64) * (D / 32); it += NGW) p1_transpose_item_i8(AP_w_out, D, D, AP_WOUT8, AP_CPARTO, AP_WOUTS, scr, it, lane); }
    for (int it = gw; it < M / 8; it += NGW) { const size_t row0 = (size_t)it * 8; const int b = (int)(row0 >> 11);
        norm_rows(AP_x, row0, 8, AP_g1, AP_MOD + b * 6 * D + 0 * D, AP_MOD + b * 6 * D + 1 * D, nullptr, lane, AP_H8, AP_HS); }
    for (int it = gw; it < MC; it += NGW) norm_rows(AP_ctx, (size_t)it, 1, AP_g1, AP_MOD + 8 * 6 * D + 0 * D, AP_MOD + 8 * 6 * D + 1 * D, nullptr, lane, AP_HC8, AP_HCS);
}
__device__ __forceinline__ void p5_norm2(const Frame& F, const Args& A) {
    const int lane = lane_id(), tid = F.wave * 64 + lane; (void)tid;
    const int gw = F.vcu * NWAVES + F.wave, NGW = F.G * NWAVES;
    for (int it = gw; it < M / 8; it += NGW) { const size_t row0 = (size_t)it * 8; const int b = (int)(row0 >> 11);
        norm_rows_b(AP_X1B, row0, 8, AP_g2, AP_MOD + b * 6 * D + 3 * D, AP_MOD + b * 6 * D + 4 * D, AP_ACT, lane, AP_H2Q, AP_H2S); }
}

__device__ __forceinline__ f32x4 dq4(const f32x4 a, const f32x4 cs, const float rs) {
    typedef int v4i_ __attribute__((ext_vector_type(4))); const v4i_ iv = __builtin_bit_cast(v4i_, a);
    f32x4 r; r.x = (float)iv.x; r.y = (float)iv.y; r.z = (float)iv.z; r.w = (float)iv.w; return r * cs * rs;
}
struct EpiProj {
    static constexpr bool PERM = true, AFTER_DRAIN = false;
    bf16 *Q, *Kp, *VTp, *BG, *CG, *U; const float *qn, *kn; LAS float* xch; int region0, tshift; float qscale; const float *rs, *csb;
    __device__ __forceinline__ void operator()(const f32x4 (&acc)[2][2][4][2], const pg8::Unit& u, int wr, int wc, int fr, int fq) const {
        const int region = (u.pn >> 2) + region0, pnl = u.pn & 3;
        const int rowt = wr * 64 + fr;
        f32x4 cs_[2][2]; float rsc_[2][4];
#pragma unroll
        for (int bj = 0; bj < 2; ++bj)
#pragma unroll
            for (int n = 0; n < 2; ++n) cs_[bj][n] = *(const f32x4*)(csb + u.pn * 256 + bj * 128 + 32 * wc + 8 * fq + 4 * n);
#pragma unroll
        for (int ai = 0; ai < 2; ++ai)
#pragma unroll
            for (int m = 0; m < 4; ++m) rsc_[ai][m] = rs[u.pm * 256 + ai * 128 + rowt + m * 16];
#define DQ(ai_, bj_, m_, n_) dq4(acc[ai_][bj_][m_][n_], cs_[bj_][n_], rsc_[ai_][m_])
        if (region <= 1) {
#pragma unroll
            for (int ai = 0; ai < 2; ++ai)
#pragma unroll
                for (int m = 0; m < 4; ++m)
#pragma unroll
                    for (int bj = 0; bj < 2; ++bj) { const f32x4 a = DQ(ai, bj, m, 0), b = DQ(ai, bj, m, 1);
                        float s = (a.x * a.x + a.y * a.y) + (a.z * a.z + a.w * a.w) + (b.x * b.x + b.y * b.y) + (b.z * b.z + b.w * b.w);
                        s += __shfl_xor(s, 16); s += __shfl_xor(s, 32);
                        if (fq == 0) xch[((ai * 128 + rowt + m * 16) * 2 + bj) * 4 + wc] = s; }
            asm volatile("s_waitcnt lgkmcnt(0)" ::: "memory"); __builtin_amdgcn_s_barrier(); asm volatile("" ::: "memory");
            const float* gain = (region == 0) ? qn : kn; const float mul = (region == 0) ? qscale : 1.f; bf16* O = (region == 0) ? Q : Kp;
            const f32x4 g0 = *(const f32x4*)(gain + 32 * wc + 8 * fq), g1 = *(const f32x4*)(gain + 32 * wc + 8 * fq + 4);
#pragma unroll
            for (int ai = 0; ai < 2; ++ai)
#pragma unroll
                for (int m = 0; m < 4; ++m) { const int rt = ai * 128 + rowt + m * 16; bf16* rowp = O + (size_t)(u.pm * 256 + rt) * DA + (2 * pnl) * HD + 32 * wc + 8 * fq;
#pragma unroll
                    for (int bj = 0; bj < 2; ++bj) { const f32x4 p = *(const LAS f32x4*)(xch + (rt * 2 + bj) * 4);
                        const float rstd = __builtin_amdgcn_rsqf(((p.x + p.y) + (p.z + p.w)) * (1.f / HD) + EPS) * mul;
                        const f32x4 v0 = DQ(ai, bj, m, 0) * rstd * g0, v1 = DQ(ai, bj, m, 1) * rstd * g1;
                        v4u w; w.x = pk2(v0.x, v0.y); w.y = pk2(v0.z, v0.w); w.z = pk2(v1.x, v1.y); w.w = pk2(v1.z, v1.w);
                        *(v4u*)(rowp + bj * HD) = w; } }
        } else if (region == 2) {
            const int tmask = (1 << tshift) - 1;
#pragma unroll
            for (int ai = 0; ai < 2; ++ai)
#pragma unroll
                for (int m = 0; m < 4; ++m) { const int row = u.pm * 256 + ai * 128 + rowt + m * 16; const int b = row >> tshift, t = row & tmask;
#pragma unroll
                    for (int bj = 0; bj < 2; ++bj) { const int head = 2 * pnl + bj; bf16* base = VTp + (((size_t)(b * NH + head) * HD + 32 * wc + 8 * fq) << tshift) + t;
#pragma unroll
                        for (int n = 0; n < 2; ++n) { const f32x4 a = DQ(ai, bj, m, n); const unsigned w0 = pk2(a.x, a.y), w1 = pk2(a.z, a.w);
                            base[(size_t)(4 * n + 0) << tshift] = (bf16)(w0 & 0xffffu); base[(size_t)(4 * n + 1) << tshift] = (bf16)(w0 >> 16);
                            base[(size_t)(4 * n + 2) << tshift] = (bf16)(w1 & 0xffffu); base[(size_t)(4 * n + 3) << tshift] = (bf16)(w1 >> 16); } } }
        } else {
            bf16* O = (region == 3) ? BG : (region == 4) ? CG : U;
#pragma unroll
            for (int ai = 0; ai < 2; ++ai)
#pragma unroll
                for (int m = 0; m < 4; ++m) { bf16* rowp = O + (size_t)(u.pm * 256 + ai * 128 + rowt + m * 16) * DA + pnl * 256 + 32 * wc + 8 * fq;
#pragma unroll
                    for (int bj = 0; bj < 2; ++bj) { const f32x4 v0 = DQ(ai, bj, m, 0), v1 = DQ(ai, bj, m, 1);
                        v4u w; w.x = pk2(v0.x, v0.y); w.y = pk2(v0.z, v0.w); w.z = pk2(v1.x, v1.y); w.w = pk2(v1.z, v1.w);
                        *(v4u*)(rowp + bj * HD) = w; } }
        }
#undef DQ
    }
};
struct EpiBf16 {
    static constexpr bool PERM = true, AFTER_DRAIN = false;
    bf16* O; int ldc;
    __device__ __forceinline__ void operator()(const f32x4 (&acc)[2][2][4][2], const pg8::Unit& u, int wr, int wc, int fr, int fq) const {
        const int row0 = u.pm * 256 + wr * 64 + fr, col0 = u.pn * 256 + wc * 32 + 8 * fq;
#pragma unroll
        for (int ai = 0; ai < 2; ++ai)
#pragma unroll
            for (int m = 0; m < 4; ++m) { bf16* rowp = O + (size_t)(row0 + ai * 128 + m * 16) * ldc + col0;
#pragma unroll
                for (int bj = 0; bj < 2; ++bj) { const f32x4 v0 = acc[ai][bj][m][0], v1 = acc[ai][bj][m][1];
                    v4u w; w.x = pk2(v0.x, v0.y); w.y = pk2(v0.z, v0.w); w.z = pk2(v1.x, v1.y); w.w = pk2(v1.z, v1.w);
                    *(v4u*)(rowp + bj * 128) = w; } }
    }
};
struct EpiRes {
    static constexpr bool PERM = true, AFTER_DRAIN = false;
    const float* base; bf16* out; const float* mod; int gofs; const float* csb; float sa;
    __device__ __forceinline__ void operator()(const f32x4 (&acc)[2][2][4][2], const pg8::Unit& u, int wr, int wc, int fr, int fq) const {
        const int row0 = u.pm * 256 + wr * 64 + fr, col0 = u.pn * 256 + wc * 32 + 8 * fq;
        const float* gp = mod + (size_t)(u.pm >> 3) * 6 * D + gofs + col0;
        f32x4 gv[2][2];
#pragma unroll
        for (int bj = 0; bj < 2; ++bj)
#pragma unroll
            for (int n = 0; n < 2; ++n) gv[bj][n] = *(const f32x4*)(gp + bj * 128 + 4 * n);
        f32x4 cs_[2][2];
#pragma unroll
        for (int bj = 0; bj < 2; ++bj)
#pragma unroll
            for (int n = 0; n < 2; ++n) cs_[bj][n] = *(const f32x4*)(csb + col0 + bj * 128 + 4 * n);
#pragma unroll
        for (int ai = 0; ai < 2; ++ai)
#pragma unroll
            for (int m = 0; m < 4; ++m) { const size_t off = (size_t)(row0 + ai * 128 + m * 16) * D + col0;
#pragma unroll
                for (int bj = 0; bj < 2; ++bj) { const f32x4 b0 = *(const f32x4*)(base + off + bj * 128), b1 = *(const f32x4*)(base + off + bj * 128 + 4);
                    const f32x4 v0 = b0 + gv[bj][0] * dq4(acc[ai][bj][m][0], cs_[bj][0], sa), v1 = b1 + gv[bj][1] * dq4(acc[ai][bj][m][1], cs_[bj][1], sa);
                    v4u w; w.x = pk2(v0.x, v0.y); w.y = pk2(v0.z, v0.w); w.z = pk2(v1.x, v1.y); w.w = pk2(v1.z, v1.w);
                    *(v4u*)(out + off + bj * 128) = w; }
                asm volatile("" ::: "memory"); }
    }
};

__device__ __forceinline__ void attn_phase(const Frame& F, const Args& A) {
    const int lane = lane_id(), tid = F.wave * 64 + lane; (void)tid;
    LAS float* bias = (LAS float*)(F.lds + XCH_OFF);
    LAS unsigned char* kl = F.lds + F.wave * 16384;
    LAS unsigned char* vl = kl + 8192;
    const int bh = F.vcu >> 2, b = bh >> 3, h = bh & 7;
    for (int i = tid; i < 15 * 31; i += NWAVES * 64) bias[i] = AP_rpb[h * 465 + i] * LOG2E;
    __syncthreads();
    const int r = 8 * (F.vcu & 3) + F.wave;
    const int rs = min(max(r - 4, 0), 24);
    const int q = lane & 31, hh = lane >> 5;
    const int l4 = lane >> 4, c16 = lane & 15, l2 = lane >> 2, g4 = lane & 3;
    const unsigned char* Kb = (const unsigned char*)(AP_K + (size_t)b * SEQ * DA + h * HD);
    const unsigned char* VTb = (const unsigned char*)(AP_VTR + (size_t)(b * NH + h) * HD * SEQ);
    const unsigned char* KCb = (const unsigned char*)(AP_KC + (size_t)b * CTXL * DA + h * HD);
    const unsigned char* VCb = (const unsigned char*)(AP_VCT + (size_t)(b * NH + h) * HD * CTXL);
    for (int qh = 0; qh < 2; ++qh) {
        const int c0 = qh ? 24 : 0, qcol = qh * 32 + q, cs = min(max(qcol - 8, 0), 48);
        const bf16* qp = AP_Q + (size_t)(b * SEQ + r * GW + qcol) * DA + h * HD + 32 * hh;
        bf16x8 qf[8];
#pragma unroll
        for (int s = 0; s < 8; ++s) qf[s] = *(const bf16x8*)(qp + 64 * (s >> 2) + 8 * (s & 3));
        f32x16 o[4];
#pragma unroll
        for (int db = 0; db < 4; ++db)
#pragma unroll
            for (int i = 0; i < 16; ++i) o[db][i] = 0.f;
        float mrun = -1e30f, lrun = 0.f;
        const int gsw = g4 ^ ((l2 >> 2) & 3);
#define ATT_KDMA(KB_) do { const int kb_ = (KB_); \
            if (kb_ < 10) { \
                _Pragma("unroll") for (int i_ = 0; i_ < 8; ++i_) { const int rho_ = 4 * i_ + l4; const int kk_ = kb_ * 32 + (4 * ((i_ >> 1) & 1) + 8 * (i_ & 1) + 16 * (i_ >> 2)) + l4, krow_ = (kk_ * 205) >> 13, kc_ = c0 + kk_ - krow_ * 40; \
                    __builtin_amdgcn_global_load_lds((const unsigned*)(Kb + (unsigned)(((rs + krow_) * GW + kc_) * (DA * 2) + 16 * (c16 ^ (rho_ & 15)))), (LAS unsigned*)(kl + i_ * 1024), 16, 0, 0); } \
            } else { \
                _Pragma("unroll") for (int i_ = 0; i_ < 8; ++i_) { const int rho_ = 4 * i_ + l4; const int l_ = (kb_ - 10) * 32 + (4 * ((i_ >> 1) & 1) + 8 * (i_ & 1) + 16 * (i_ >> 2)) + l4; \
                    __builtin_amdgcn_global_load_lds((const unsigned*)(KCb + (unsigned)(l_ * (DA * 2) + 16 * (c16 ^ (rho_ & 15)))), (LAS unsigned*)(kl + i_ * 1024), 16, 0, 0); } \
            } } while (0)
#define ATT_VDMA(KB_) do { const int kb_ = (KB_); \
            if (kb_ < 10) { \
                const int k0_ = kb_ * 32 + 8 * gsw, vr_ = (k0_ * 205) >> 13, vc_ = c0 + k0_ - vr_ * 40; const unsigned vo_ = (unsigned)((l2 * SEQ + (rs + vr_) * GW + vc_) * 2); \
                _Pragma("unroll") for (int i_ = 0; i_ < 8; ++i_) __builtin_amdgcn_global_load_lds((const unsigned*)(VTb + vo_ + (unsigned)(i_ * 16 * SEQ * 2)), (LAS unsigned*)(vl + i_ * 1024), 16, 0, 0); \
            } else { \
                const unsigned vo_ = (unsigned)((l2 * CTXL + (kb_ - 10) * 32 + 8 * gsw) * 2); \
                _Pragma("unroll") for (int i_ = 0; i_ < 8; ++i_) __builtin_amdgcn_global_load_lds((const unsigned*)(VCb + vo_ + (unsigned)(i_ * 16 * CTXL * 2)), (LAS unsigned*)(vl + i_ * 1024), 16, 0, 0); \
            } } while (0)
        asm volatile("s_waitcnt vmcnt(0) lgkmcnt(0)" ::: "memory");
        ATT_KDMA(0); ATT_VDMA(0);
        for (int kb = 0; kb < 18; ++kb) {
            const bool win = kb < 10;
            asm volatile("s_waitcnt vmcnt(8)" ::: "memory");
            bf16x8 kf[8];
#pragma unroll
            for (int s = 0; s < 8; ++s) kf[s] = *(const LAS bf16x8*)(kl + q * 256 + 16 * ((8 * (s >> 2) + 4 * hh + (s & 3)) ^ (q & 15)));
            asm volatile("s_waitcnt lgkmcnt(0)" ::: "memory");
            if (kb + 1 < 18) ATT_KDMA(kb + 1);
            f32x16 sa;
#pragma unroll
            for (int i = 0; i < 16; ++i) sa[i] = 0.f;
#pragma unroll
            for (int s = 0; s < 8; ++s) sa = __builtin_amdgcn_mfma_f32_32x32x16_bf16(kf[s], qf[s], sa, 0, 0, 0);
            if (win) {
#pragma unroll
                for (int i = 0; i < 16; ++i) {
                    const int g = kb * 4 + 2 * (i >> 3) + hh, w = (i & 3) + 4 * ((i >> 2) & 1);
                    const int krow = (g * 205) >> 10, kcol = c0 + 8 * (g - 5 * krow) + w;
                    const int dr = rs + krow - r + 7;
                    const int dc = min(max(kcol - qcol, -15), 15) + 15;
                    const bool inw = (unsigned)(kcol - cs) < 16u;
                    sa[i] = inw ? sa[i] + bias[dr * 31 + dc] : -1e30f;
                }
            }
            float bm = sa[0];
#pragma unroll
            for (int i = 1; i < 16; ++i) bm = fmaxf(bm, sa[i]);
            bm = fmaxf(bm, __shfl_xor(bm, 32));
            if (!__all(bm - mrun <= 6.0f)) {
                const float mnew = fmaxf(mrun, bm), alpha = __builtin_amdgcn_exp2f(mrun - mnew);
                mrun = mnew; lrun *= alpha;
#pragma unroll
                for (int db = 0; db < 4; ++db)
#pragma unroll
                    for (int i = 0; i < 16; ++i) o[db][i] *= alpha;
            }
            float ps = 0.f;
#pragma unroll
            for (int i = 0; i < 16; ++i) { sa[i] = __builtin_amdgcn_exp2f(sa[i] - mrun); ps += sa[i]; }
            lrun += ps;
            bf16x8 pf[2];
#pragma unroll
            for (int s2 = 0; s2 < 2; ++s2) { v4u w; w.x = pk2(sa[8 * s2 + 0], sa[8 * s2 + 1]); w.y = pk2(sa[8 * s2 + 2], sa[8 * s2 + 3]); w.z = pk2(sa[8 * s2 + 4], sa[8 * s2 + 5]); w.w = pk2(sa[8 * s2 + 6], sa[8 * s2 + 7]); pf[s2] = __builtin_bit_cast(bf16x8, w); }
            if (kb + 1 < 18) asm volatile("s_waitcnt vmcnt(8)" ::: "memory"); else asm volatile("s_waitcnt vmcnt(0)" ::: "memory");
            bf16x8 vf[4][2];
#pragma unroll
            for (int db = 0; db < 4; ++db) { const int dd = db * 32 + q;
                vf[db][0] = *(const LAS bf16x8*)(vl + dd * 64 + 16 * ((0 + hh) ^ ((dd >> 2) & 3))); vf[db][1] = *(const LAS bf16x8*)(vl + dd * 64 + 16 * ((2 + hh) ^ ((dd >> 2) & 3))); }
            asm volatile("s_waitcnt lgkmcnt(0)" ::: "memory");
            if (kb + 1 < 18) ATT_VDMA(kb + 1);
#pragma unroll
            for (int db = 0; db < 4; ++db) { o[db] = __builtin_amdgcn_mfma_f32_32x32x16_bf16(vf[db][0], pf[0], o[db], 0, 0, 0); o[db] = __builtin_amdgcn_mfma_f32_32x32x16_bf16(vf[db][1], pf[1], o[db], 0, 0, 0); }
        }
#undef ATT_KDMA
#undef ATT_VDMA
        const float ltot = lrun + __shfl_xor(lrun, 32), inv = 1.f / ltot;
        float ss = 0.f;
#pragma unroll
        for (int db = 0; db < 4; ++db)
#pragma unroll
            for (int i = 0; i < 16; ++i) { o[db][i] *= inv; ss += o[db][i] * o[db][i]; }
        ss += __shfl_xor(ss, 32);
        const float rstd = __builtin_amdgcn_rsqf(ss * (1.f / HD) + EPS);
        unsigned char* op = AP_A28 + (size_t)(b * SEQ + r * GW + qcol) * D + h * HD + 4 * hh;
        const float* gp = AP_gao + h * HD + 4 * hh; const float rq = rstd * A2_INV;
#pragma unroll
        for (int db = 0; db < 4; ++db)
#pragma unroll
            for (int i4 = 0; i4 < 4; ++i4) { const f32x4 g = *(const f32x4*)(gp + db * 32 + 8 * i4);
                f32x4 y; y.x = o[db][4 * i4 + 0] * g.x; y.y = o[db][4 * i4 + 1] * g.y; y.z = o[db][4 * i4 + 2] * g.z; y.w = o[db][4 * i4 + 3] * g.w;
                *(unsigned*)(op + db * 32 + 8 * i4) = q4(y, rq); }
    }
    __syncthreads();
}

__device__ __forceinline__ void unpack16(const v4u a, const v4u b, float (&f)[16]) {
    f[0] = bflo(a.x); f[1] = bfhi(a.x); f[2] = bflo(a.y); f[3] = bfhi(a.y); f[4] = bflo(a.z); f[5] = bfhi(a.z); f[6] = bflo(a.w); f[7] = bfhi(a.w);
    f[8] = bflo(b.x); f[9] = bfhi(b.x); f[10] = bflo(b.y); f[11] = bfhi(b.y); f[12] = bflo(b.z); f[13] = bfhi(b.z); f[14] = bflo(b.w); f[15] = bfhi(b.w);
}
__device__ __forceinline__ void load_z(const bf16* CGp, const bf16* Up, size_t m, int lane, float (&z)[16]) {
    const v4u* cp = (const v4u*)(CGp + m * DA + 16 * lane); const v4u* up = (const v4u*)(Up + m * DA + 16 * lane);
    const v4u c0 = cp[0], c1 = cp[1], u0 = up[0], u1 = up[1];
    float cf[16], uf[16]; unpack16(c0, c1, cf); unpack16(u0, u1, uf);
#pragma unroll
    for (int i = 0; i < 16; ++i) z[i] = cf[i] * uf[i];
}
__device__ __forceinline__ void conv_phase(const Frame& F, const Args& A) {
    const int lane = lane_id(), tid = F.wave * 64 + lane; (void)tid;
    const int gw = F.vcu * NWAVES + F.wave, NGW = F.G * NWAVES;
    float w0[16], w1[16], w2[16], gg[16];
#pragma unroll
    for (int i = 0; i < 16; ++i) { w0[i] = AP_w_conv[0 * DA + 16 * lane + i]; w1[i] = AP_w_conv[1 * DA + 16 * lane + i]; w2[i] = AP_w_conv[2 * DA + 16 * lane + i]; gg[i] = AP_gco[16 * lane + i]; }
    for (int it = gw; it < M / 8; it += NGW) {
        const size_t m0 = (size_t)it * 8;
        float zp[16], zc[16], zn[16];
        if ((m0 & (SEQ - 1)) == 0) {
#pragma unroll
            for (int i = 0; i < 16; ++i) zp[i] = 0.f;
        } else load_z(AP_CG, AP_U, m0 - 1, lane, zp);
        load_z(AP_CG, AP_U, m0, lane, zc);
        for (int j = 0; j < 8; ++j) {
            const size_t m = m0 + j;
            if ((m & (SEQ - 1)) == SEQ - 1) {
#pragma unroll
                for (int i = 0; i < 16; ++i) zn[i] = 0.f;
            } else load_z(AP_CG, AP_U, m + 1, lane, zn);
            const v4u* bp = (const v4u*)(AP_BG + m * DA + 16 * lane); const v4u b0 = bp[0], b1 = bp[1];
            float bf[16]; unpack16(b0, b1, bf);
            float y[16], ss = 0.f;
#pragma unroll
            for (int i = 0; i < 16; ++i) { y[i] = bf[i] * (w0[i] * zp[i] + w1[i] * zc[i] + w2[i] * zn[i]); ss += y[i] * y[i]; }
            ss += __shfl_xor(ss, 1); ss += __shfl_xor(ss, 2); ss += __shfl_xor(ss, 4);
            const float rstd = __builtin_amdgcn_rsqf(ss * (1.f / 128.f) + EPS);
            const float rq = rstd * A2_INV; v4u o0;
            { f32x4 t0 = {y[0] * gg[0], y[1] * gg[1], y[2] * gg[2], y[3] * gg[3]}, t1 = {y[4] * gg[4], y[5] * gg[5], y[6] * gg[6], y[7] * gg[7]};
              f32x4 t2 = {y[8] * gg[8], y[9] * gg[9], y[10] * gg[10], y[11] * gg[11]}, t3 = {y[12] * gg[12], y[13] * gg[13], y[14] * gg[14], y[15] * gg[15]};
              o0.x = q4(t0, rq); o0.y = q4(t1, rq); o0.z = q4(t2, rq); o0.w = q4(t3, rq); }
            *(v4u*)(AP_A28 + m * D + DA + 16 * lane) = o0;
#pragma unroll
            for (int i = 0; i < 16; ++i) { zp[i] = zc[i]; zc[i] = zn[i]; }
        }
    }
}

__device__ __forceinline__ unsigned f2key(float f) { const unsigned u = __builtin_bit_cast(unsigned, f); return (u & 0x80000000u) ? ~u : (u | 0x80000000u); }
__device__ __forceinline__ float key2f(unsigned k) { const unsigned u = (k & 0x80000000u) ? (k & 0x7fffffffu) : ~k; return __builtin_bit_cast(float, u); }
__device__ __forceinline__ void ce_desc(unsigned& a, unsigned& b) { const unsigned hi = max(a, b), lo = min(a, b); a = hi; b = lo; }
template <int BASE> __device__ __forceinline__ void sort16_desc(unsigned (&v)[64]) {
#pragma unroll
    for (int k = 2; k <= 16; k <<= 1)
#pragma unroll
        for (int j = k >> 1; j >= 1; j >>= 1)
#pragma unroll
            for (int i = 0; i < 16; ++i) { const int l = i ^ j; if (l > i) { if ((i & k) == 0) ce_desc(v[BASE + i], v[BASE + l]); else ce_desc(v[BASE + l], v[BASE + i]); } }
}
template <int A_, int B_> __device__ __forceinline__ void merge_top16(unsigned (&v)[64]) {
#pragma unroll
    for (int i = 0; i < 16; ++i) v[A_ + i] = max(v[A_ + i], v[B_ + 15 - i]);
#pragma unroll
    for (int j = 8; j >= 1; j >>= 1)
#pragma unroll
        for (int i = 0; i < 16; ++i) { const int l = i ^ j; if (l > i) ce_desc(v[A_ + i], v[A_ + l]); }
}
__device__ __forceinline__ void top16_of_64(unsigned (&v)[64]) {
    sort16_desc<0>(v); sort16_desc<16>(v); sort16_desc<32>(v); sort16_desc<48>(v);
    merge_top16<0, 16>(v); merge_top16<32, 48>(v); merge_top16<0, 32>(v);
}
__device__ __forceinline__ void peer_select_phase(const Frame& F, const Args& A) {
    const int lane = lane_id(), tid = F.wave * 64 + lane; (void)tid;
    const int gw = F.vcu * NWAVES + F.wave, NGW = F.G * NWAVES, tk = lane & 31, hh = lane >> 5;
    LAS unsigned char* qimg = F.lds + F.wave * 16384;
    LAS unsigned char* kimg = qimg + 8192;
    LAS int* ixs = (LAS int*)qimg;
    const int l4 = lane >> 4, c16 = lane & 15;
    unsigned nh4 = (unsigned)(1 - hh) << 2; asm volatile("" : "+v"(nh4));
    for (int task = gw; task < (M / 32) * PH; task += NGW) {
        const int h = task & 7, tb = task >> 3; const int token = tb * 32 + tk;
        unsigned best[2][16];
#pragma unroll
        for (int p = 0; p < 2; ++p) {
            const unsigned char* qsrc = (const unsigned char*)(AP_QP + (size_t)(tb * 32) * D + h * 256 + p * 128);
            const unsigned char* ksrc = (const unsigned char*)(AP_SK + (size_t)((h * 2 + p) * NKEYS) * 128);
            unsigned bq = (unsigned)(l4 * (D * 2) + 16 * (c16 ^ l4)), bk = (unsigned)(l4 * 256 + 16 * (c16 ^ l4));
            asm volatile("s_waitcnt vmcnt(0) lgkmcnt(0)" : "+v"(bq), "+v"(bk) : : "memory");
#pragma unroll
            for (int i = 0; i < 8; ++i) __builtin_amdgcn_global_load_lds((const unsigned*)(qsrc + ((bq ^ (unsigned)(64 * (i & 3))) + (unsigned)(i * 4 * D * 2))), (LAS unsigned*)(qimg + i * 1024), 16, 0, 0);
#define PS_KDMA(KB_) do { _Pragma("unroll") for (int i_ = 0; i_ < 8; ++i_) \
                __builtin_amdgcn_global_load_lds((const unsigned*)(ksrc + ((bk ^ (unsigned)(64 * (i_ & 3))) + (unsigned)((KB_) * 8192 + i_ * 1024))), (LAS unsigned*)(kimg + i_ * 1024), 16, 0, 0); } while (0)
            PS_KDMA(0);
            asm volatile("s_waitcnt vmcnt(8)" ::: "memory");
            bf16x8 qf[8];
#pragma unroll
            for (int s = 0; s < 8; ++s) qf[s] = *(const LAS bf16x8*)(qimg + tk * 256 + 16 * ((8 * (s >> 2) + 4 * hh + (s & 3)) ^ (tk & 15)));
            unsigned ky[64];
#pragma unroll
            for (int kb = 0; kb < 4; ++kb) {
                asm volatile("s_waitcnt vmcnt(0)" ::: "memory");
                bf16x8 kf[8];
#pragma unroll
                for (int s = 0; s < 8; ++s) kf[s] = *(const LAS bf16x8*)(kimg + tk * 256 + 16 * ((8 * (s >> 2) + 4 * hh + (s & 3)) ^ (tk & 15)));
                asm volatile("s_waitcnt lgkmcnt(0)" ::: "memory");
                if (kb < 3) PS_KDMA(kb + 1);
                f32x16 sa;
#pragma unroll
                for (int i = 0; i < 16; ++i) sa[i] = 0.f;
#pragma unroll
                for (int s = 0; s < 8; ++s) sa = __builtin_amdgcn_mfma_f32_32x32x16_bf16(kf[s], qf[s], sa, 0, 0, 0);
#pragma unroll
                for (int i = 0; i < 16; ++i) { const unsigned ck = (unsigned)(127 - (kb * 32 + (i & 3) + 8 * (i >> 2))) & ~4u;
                    ky[kb * 16 + i] = ((f2key(sa[i]) & ~127u) | nh4) | ck; }
                asm volatile("" ::: "memory");
            }
#undef PS_KDMA
            top16_of_64(ky);
#pragma unroll
            for (int i = 0; i < 16; ++i) ky[16 + i] = (unsigned)__shfl_xor((int)ky[i], 32);
            merge_top16<0, 16>(ky);
#pragma unroll
            for (int i = 0; i < 16; ++i) best[p][i] = ky[i];
        }
        float s1[16], s2[16];
#pragma unroll
        for (int i = 0; i < 16; ++i) { s1[i] = key2f(best[0][i] & ~127u); s2[i] = key2f(best[1][i] & ~127u);
            ixs[i * 64 + lane] = 127 - (int)(best[0][i] & 127u); ixs[(16 + i) * 64 + lane] = 127 - (int)(best[1][i] & 127u); }
        unsigned cd[64]; { int n = 0;
#pragma unroll
            for (int i = 0; i < 16; ++i)
#pragma unroll
                for (int j = 0; j < 16; ++j) if ((i + 1) * (j + 1) <= 16) { cd[n] = (f2key(s1[i] + s2[j]) & ~255u) | (unsigned)(255 - (16 * i + j)); ++n; }
#pragma unroll
            for (int i = 50; i < 64; ++i) cd[i] = 0u; }
        top16_of_64(cd);
        unsigned win[16];
#pragma unroll
        for (int i = 0; i < 16; ++i) win[i] = cd[i];
        LDS_WAIT();
        const float vmax = key2f(win[0] & ~255u);
        float ev[16], es = 0.f;
#pragma unroll
        for (int rnd = 0; rnd < 16; ++rnd) { ev[rnd] = __expf(key2f(win[rnd] & ~255u) - vmax); es += ev[rnd]; }
        const float ies = 1.f / es;
        if (hh == 0) {
            int* ip = AP_SELI + (size_t)token * 128 + h * 16; float* gp = AP_SELG + (size_t)token * 128 + h * 16;
#pragma unroll
            for (int rnd = 0; rnd < 16; ++rnd) { const int pos = 255 - (int)(win[rnd] & 255u); const int i1 = ixs[(pos >> 4) * 64 + lane], i2 = ixs[(16 + (pos & 15)) * 64 + lane];
                ip[rnd] = i1 * NKEYS + i2; gp[rnd] = ev[rnd] * ies; }
        }
        LDS_WAIT();
    }
}

typedef int v4i __attribute__((ext_vector_type(4)));
__device__ __forceinline__ float gelu_as(const float v) {
    const float av = fabsf(v), t = __builtin_amdgcn_rcpf(av * 0.2316418882f + 1.0f);
    float q = t * 0.5307027145f + (-0.7265760135f); q = q * t + 0.7107068705f; q = q * t + (-0.142248368f); q = q * t + 0.127414796f; q = q * t;
    const float e = __builtin_amdgcn_exp2f((v * v) * (-0.72134752044f));
    const float m = v * (q * e);
    return v < 0.f ? m : v - m;
}
constexpr int PL_WAVE = 16384, PL_EL = 8192, PL_PACC = 10240, PL_AQ = 14336, PL_SA = 15360;
__device__ __forceinline__ float wave_maxf(float v) {
#pragma unroll
    for (int o = 1; o < 64; o <<= 1) v = fmaxf(v, __shfl_xor(v, o));
    return v;
}
__device__ __forceinline__ void peer_u_phase(const Frame& F, const Args& A, float (&sa)[8]) {
    const int lane = lane_id(), p = lane >> 2, sub = lane & 3;
    LAS unsigned short* elist = (LAS unsigned short*)(F.lds + F.wave * PL_WAVE + PL_EL);
    LAS int* pacc = (LAS int*)(F.lds + F.wave * PL_WAVE + PL_PACC);
    LAS signed char* aq = (LAS signed char*)(F.lds + F.wave * PL_WAVE + PL_AQ);
    const int tok0 = F.vcu * 64 + F.wave * 8;
    for (int it = 0; it < 16; ++it) { elist[it * 64 + lane] = (unsigned short)AP_SELI[(size_t)tok0 * 128 + it * 64 + lane]; pacc[it * 64 + lane] = 0; }
    LDS_WAIT();
    v4u G0[4], G1[4], G2[4], G3[4], hreg[2];
    const unsigned char* ub = AP_U8 + 16 * sub;
    LAS unsigned char* hst = F.lds + F.wave * PL_WAVE;
#define PU_LOAD(G_, K_) do { const int kg_ = (K_), tp_ = kg_ & 31; const unsigned ea_ = elist[(2 * tp_) * 16 + p], eb_ = elist[(2 * tp_ + 1) * 16 + p]; \
            const unsigned char* ua_ = ub + (size_t)ea_ * D + 128 * (kg_ >> 5); const unsigned char* ubb_ = ub + (size_t)eb_ * D + 128 * (kg_ >> 5); \
            G_[0] = *(const v4u*)(ua_); G_[1] = *(const v4u*)(ua_ + 64); G_[2] = *(const v4u*)(ubb_); G_[3] = *(const v4u*)(ubb_ + 64); } while (0)
#define PU_DOT8(A0_, A1_) ([&]() { int d0_ = 0, d1_ = 0, d2_ = 0, d3_ = 0; \
            d0_ = __builtin_amdgcn_sdot4((int)(A0_).x, (int)hreg[0].x, d0_, false); d1_ = __builtin_amdgcn_sdot4((int)(A0_).y, (int)hreg[0].y, d1_, false); \
            d2_ = __builtin_amdgcn_sdot4((int)(A0_).z, (int)hreg[0].z, d2_, false); d3_ = __builtin_amdgcn_sdot4((int)(A0_).w, (int)hreg[0].w, d3_, false); \
            d0_ = __builtin_amdgcn_sdot4((int)(A1_).x, (int)hreg[1].x, d0_, false); d1_ = __builtin_amdgcn_sdot4((int)(A1_).y, (int)hreg[1].y, d1_, false); \
            d2_ = __builtin_amdgcn_sdot4((int)(A1_).z, (int)hreg[1].z, d2_, false); d3_ = __builtin_amdgcn_sdot4((int)(A1_).w, (int)hreg[1].w, d3_, false); \
            int v_ = (d0_ + d1_) + (d2_ + d3_); \
            v_ += __builtin_amdgcn_update_dpp(0, v_, 0xB1, 0xf, 0xf, true); v_ += __builtin_amdgcn_update_dpp(0, v_, 0x4E, 0xf, 0xf, true); return v_; }())
#define PU_COMPUTE(G_, TP_) do { const int va_ = PU_DOT8(G_[0], G_[1]), vb_ = PU_DOT8(G_[2], G_[3]); \
            if (sub == 0) { (void)__hip_atomic_fetch_add(pacc + (2 * (TP_)) * 16 + p, va_, __ATOMIC_RELAXED, __HIP_MEMORY_SCOPE_WORKGROUP); \
                            (void)__hip_atomic_fetch_add(pacc + (2 * (TP_) + 1) * 16 + p, vb_, __ATOMIC_RELAXED, __HIP_MEMORY_SCOPE_WORKGROUP); } } while (0)
    PU_LOAD(G0, 0); PU_LOAD(G1, 1); PU_LOAD(G2, 2); PU_LOAD(G3, 3);
    for (int slice = 0; slice < 16; ++slice) {
        { const int tk_ = lane >> 3, pc_ = lane & 7;
          *(LAS v4u*)(hst + tk_ * 128 + 16 * pc_) = *(const v4u*)(AP_H2Q + (size_t)(tok0 + tk_) * D + 128 * slice + 16 * pc_); }
        for (int tk = 0; tk < 8; ++tk) {
            hreg[0] = *(const LAS v4u*)(hst + tk * 128 + 16 * sub); hreg[1] = *(const LAS v4u*)(hst + tk * 128 + 64 + 16 * sub);
            { const int tp = tk * 4, k = slice * 32 + tp;
                PU_COMPUTE(G0, tp);     PU_LOAD(G0, (k + 4) & 511);
                PU_COMPUTE(G1, tp + 1); PU_LOAD(G1, (k + 5) & 511);
                PU_COMPUTE(G2, tp + 2); PU_LOAD(G2, (k + 6) & 511);
                PU_COMPUTE(G3, tp + 3); PU_LOAD(G3, (k + 7) & 511);
            }
        }
        if ((slice & 3) == 3) __builtin_amdgcn_s_barrier();
    }
#undef PU_LOAD
#undef PU_COMPUTE
#undef PU_DOT8
    LDS_WAIT();
#pragma unroll
    for (int t = 0; t < 8; ++t) { const int token = tok0 + t; const float hs = AP_H2S[token]; float av[2];
#pragma unroll
        for (int hf = 0; hf < 2; ++hf) { const int p = t * 128 + hf * 64 + lane; const unsigned e = elist[p];
            av[hf] = gelu_as((float)pacc[p] * AP_SU[e] * hs) * AP_SELG[(size_t)tok0 * 128 + p] * AP_SV[e]; }
        const float mx = fmaxf(wave_maxf(fmaxf(fabsf(av[0]), fabsf(av[1]))), 1e-30f), inv = 127.f / mx;
        aq[t * 128 + lane] = (signed char)(int)__builtin_rintf(av[0] * inv); aq[t * 128 + 64 + lane] = (signed char)(int)__builtin_rintf(av[1] * inv);
        sa[t] = mx * (1.f / 127.f); }
    LDS_WAIT();
}
__device__ __forceinline__ void peer_v_phase(const Frame& F, const Args& A, const float (&sa)[8]) {
    const int lane = lane_id(), n = lane & 15, kq = lane >> 4, rr = n >> 2, cc = n & 3;
    LAS unsigned char* buf = F.lds + F.wave * PL_WAVE;
    const LAS unsigned short* elist = (const LAS unsigned short*)(F.lds + F.wave * PL_WAVE + PL_EL);
    const LAS signed char* aq = (const LAS signed char*)(F.lds + F.wave * PL_WAVE + PL_AQ);
    const int tok0 = F.vcu * 64 + F.wave * 8;
    const int fsw = (rr >> 1) | ((kq & 1) << 1);
    const unsigned trbase = (unsigned)(size_t)buf + (unsigned)((8 * kq + rr) * 128 + 8 * cc);
    const int r0 = lane >> 3, c8 = lane & 7;
    v4u G0[4], G1[4], G2[4], G3[4];
    v4i accE[4], accO[4];
#pragma unroll
    for (int q = 0; q < 4; ++q) { accE[q] = (v4i){0, 0, 0, 0}; accO[q] = (v4i){0, 0, 0, 0}; }
#define PV_EREAD(K_) do { const int ke_ = (K_); _Pragma("unroll") for (int i_ = 0; i_ < 4; ++i_) en[i_] = elist[(ke_ & 31) * 32 + 8 * i_ + r0]; } while (0)
#define PV_LOAD(G_, K_) do { const int kg_ = (K_); _Pragma("unroll") for (int i_ = 0; i_ < 4; ++i_) { const unsigned e_ = en[i_]; \
            const int f_ = ((r0 >> 1) & 1) | ((i_ & 1) << 1); \
            G_[i_] = *(const v4u*)(AP_V8 + (size_t)e_ * D + 128 * (kg_ >> 5) + 32 * ((c8 >> 1) ^ f_) + 16 * (c8 & 1)); } } while (0)
#define PV_STORE(G_, B_) do { _Pragma("unroll") for (int i_ = 0; i_ < 4; ++i_) *(LAS v4u*)(buf + (B_) * 4096 + i_ * 1024 + lane * 16) = G_[i_]; } while (0)
#define PV_TR(B_) do { const unsigned tb_ = trbase + (unsigned)((B_) * 4096); \
            const unsigned t0_ = tb_ + 32u * (unsigned)(0 ^ fsw), t1_ = tb_ + 32u * (unsigned)(1 ^ fsw), t2_ = tb_ + 32u * (unsigned)(2 ^ fsw), t3_ = tb_ + 32u * (unsigned)(3 ^ fsw); \
            asm volatile("s_waitcnt lgkmcnt(0)\n\t" \
                         "ds_read_b64_tr_b16 %0, %8\n\tds_read_b64_tr_b16 %1, %8 offset:512\n\tds_read_b64_tr_b16 %2, %9\n\tds_read_b64_tr_b16 %3, %9 offset:512\n\t" \
                         "ds_read_b64_tr_b16 %4, %10\n\tds_read_b64_tr_b16 %5, %10 offset:512\n\tds_read_b64_tr_b16 %6, %11\n\tds_read_b64_tr_b16 %7, %11 offset:512" \
                         : "=&v"(RR[0][0]), "=&v"(RR[0][1]), "=&v"(RR[1][0]), "=&v"(RR[1][1]), "=&v"(RR[2][0]), "=&v"(RR[2][1]), "=&v"(RR[3][0]), "=&v"(RR[3][1]) : "v"(t0_), "v"(t1_), "v"(t2_), "v"(t3_) : "memory"); } while (0)
#define PV_MMA(K_) do { const int kc_ = (K_), b_ = kc_ & 31; \
            v2u a8_ = *(const LAS v2u*)(aq + b_ * 32 + 8 * kq);                        \
            if (n != (b_ >> 2)) a8_ = (v2u){0u, 0u};                                  \
            v4i AE_, AO_; \
            AE_.x = (int)__builtin_amdgcn_perm(0u, a8_.x, 0x0c010c00u); AE_.y = (int)__builtin_amdgcn_perm(0u, a8_.x, 0x0c030c02u); AE_.z = (int)__builtin_amdgcn_perm(0u, a8_.y, 0x0c010c00u); AE_.w = (int)__builtin_amdgcn_perm(0u, a8_.y, 0x0c030c02u); \
            AO_.x = (int)__builtin_amdgcn_perm(0u, a8_.x, 0x010c000cu); AO_.y = (int)__builtin_amdgcn_perm(0u, a8_.x, 0x030c020cu); AO_.z = (int)__builtin_amdgcn_perm(0u, a8_.y, 0x010c000cu); AO_.w = (int)__builtin_amdgcn_perm(0u, a8_.y, 0x030c020cu); \
            asm volatile("s_waitcnt lgkmcnt(0)" : "+v"(RR[0][0]), "+v"(RR[0][1]), "+v"(RR[1][0]), "+v"(RR[1][1]), "+v"(RR[2][0]), "+v"(RR[2][1]), "+v"(RR[3][0]), "+v"(RR[3][1]) : : "memory"); \
            _Pragma("unroll") for (int q_ = 0; q_ < 4; ++q_) { const v4i Bq_ = {(int)RR[q_][0].x, (int)RR[q_][0].y, (int)RR[q_][1].x, (int)RR[q_][1].y}; \
                accE[q_] = __builtin_amdgcn_mfma_i32_16x16x64_i8(AE_, Bq_, accE[q_], 0, 0, 0); \
                accO[q_] = __builtin_amdgcn_mfma_i32_16x16x64_i8(AO_, Bq_, accO[q_], 0, 0, 0); } } while (0)
    v2u RR[4][2]; unsigned en[4];
    PV_EREAD(0); PV_LOAD(G0, 0); PV_EREAD(1); PV_LOAD(G1, 1); PV_EREAD(2); PV_LOAD(G2, 2); PV_EREAD(3); PV_LOAD(G3, 3); PV_EREAD(4); PV_STORE(G0, 0);
    for (int slice = 0; slice < 16; ++slice) {
        for (int k = slice * 32; k < slice * 32 + 32; k += 4) {
            PV_TR(0); PV_STORE(G1, 1); PV_LOAD(G0, (k + 4) & 511); PV_EREAD((k + 5) & 511); PV_MMA(k);
            PV_TR(1); PV_STORE(G2, 0); PV_LOAD(G1, (k + 5) & 511); PV_EREAD((k + 6) & 511); PV_MMA(k + 1);
            PV_TR(0); PV_STORE(G3, 1); PV_LOAD(G2, (k + 6) & 511); PV_EREAD((k + 7) & 511); PV_MMA(k + 2);
            PV_TR(1); PV_STORE(G0, 0); PV_LOAD(G3, (k + 7) & 511); PV_EREAD((k + 8) & 511); PV_MMA(k + 3);
        }
        if (kq < 2) {
#pragma unroll
            for (int i = 0; i < 4; ++i) { const int token = tok0 + 4 * kq + i; const float sat = kq ? sa[4 + i] : sa[i];
                const float* gtp = AP_MOD + (size_t)(token >> 11) * 6 * D + 5 * D + 128 * slice + 2 * n; float* op = AP_out + (size_t)token * D + 128 * slice + 2 * n;
                const bf16* xp = AP_X1B + (size_t)token * D + 128 * slice + 2 * n;
#pragma unroll
                for (int q = 0; q < 4; ++q) { typedef float f32x2t __attribute__((ext_vector_type(2)));
                    const unsigned xw = *(const unsigned*)(xp + 32 * q); const f32x2t g0 = *(const f32x2t*)(gtp + 32 * q);
                    f32x2t rv; rv.x = bflo(xw) + g0.x * (sat * (float)accE[q][i]); rv.y = bfhi(xw) + g0.y * (sat * (float)accO[q][i]);
                    *(f32x2t*)(op + 32 * q) = rv; } }
        }
#pragma unroll
        for (int q = 0; q < 4; ++q) { accE[q] = (v4i){0, 0, 0, 0}; accO[q] = (v4i){0, 0, 0, 0}; }
        if ((slice & 1) == 1) __builtin_amdgcn_s_barrier();
    }
#undef PV_TR
#undef PV_MMA
#undef PV_LOAD
#undef PV_EREAD
#undef PV_STORE

}
__device__ __forceinline__ void peer_eval_phase(const Frame& F, const Args& A) { float sa[8]; peer_u_phase(F, A, sa); peer_v_phase(F, A, sa); }

template <bool FUSED, int ONLY>
__global__ void __launch_bounds__(NWAVES * 64, 2) mk_fwd(Args args) {
    extern __shared__ __attribute__((aligned(16))) unsigned char lds[];
    Frame F;
    F.lds = (LAS unsigned char*)lds;
    F.wave = __builtin_amdgcn_readfirstlane((int)threadIdx.x >> 6);
    F.G = gridDim.x; { const int bx = blockIdx.x; F.vcu = (F.G % 8 == 0) ? (bx % 8) * (F.G / 8) + bx / 8 : bx; }
    const Args& A = args;
    const int lo = (ONLY >= 0) ? ONLY : args.ph_lo, hi = (ONLY >= 0) ? ONLY + 1 : args.ph_hi;
#define IN(k) ((ONLY < 0 || ONLY == (k)) && lo <= (k) && (k) < hi)
    XcdBarrier bar; bar.bar = (unsigned*)(args.ws + WS_CTL); bar.x = 0; bar.st = (volatile LAS unsigned*)(F.lds + MISC_OFF);
    if constexpr (FUSED) {
        if (MK_CG_SYNC) cg::this_grid().sync();
        bar.x = xb_xcc_id();
        if (F.wave == 0 && lane_id() == 0) { bar.st[0] = 0u; bar.st[1] = 0u; (void)xb_add(&bar.bar[XB_XCNT(bar.x)], 1u); }
        __syncthreads();
    }
#define SEAM(k) do { if (FUSED && IN(k) && IN((k) + 1)) { xcd_barrier(bar, F.wave, (unsigned)F.G); } } while (0)

    if (IN(0)) { p0_prologue(F, A); } SEAM(0);
    if (IN(1)) { p1_norm1(F, A); } SEAM(1);
    if (IN(2)) {
        { pg8::Gemm g{(const bf16*)AP_H8, (const bf16*)AP_WIN8, M, NPROJ, D / 2}; pg8::StaticOrder S; S.init(M, NPROJ, F.G, (int)blockIdx.x);
          EpiProj E{AP_Q, AP_K, AP_VTR, AP_BG, AP_CG, AP_U, AP_qn, AP_kn, (LAS float*)(F.lds + XCH_OFF), 0, 11, 0.08838834764831845f * LOG2E, AP_HS, AP_WINS};
          pg8::gemm_phase<EpiProj, pg8::StaticOrder, true, true, true>(F.lds, g, S, E, F.wave); }
        { pg8::Gemm g{(const bf16*)AP_HC8, (const bf16*)(AP_WIN8 + (size_t)DA * D), MC, 2 * DA, D / 2}; pg8::StaticOrder S; S.init(MC, 2 * DA, F.G, (int)blockIdx.x);
          EpiProj E{nullptr, AP_KC, AP_VCT, nullptr, nullptr, nullptr, AP_qn, AP_kn, (LAS float*)(F.lds + XCH_OFF), 1, 8, 1.f, AP_HCS, AP_WINS + DA};
          pg8::gemm_phase<EpiProj, pg8::StaticOrder, true, true, true>(F.lds, g, S, E, F.wave); }
    } SEAM(2);
    if (IN(3)) { attn_phase(F, A); conv_phase(F, A); } SEAM(3);
    if (IN(4)) { pg8::Gemm g{(const bf16*)AP_A28, (const bf16*)AP_WOUT8, M, D, D / 2}; pg8::StaticOrder S; S.init(M, D, F.G, (int)blockIdx.x);
        EpiRes E{AP_x, AP_X1B, AP_MOD, 2 * D, AP_WOUTS, A2_SCALE};
        pg8::gemm_phase<EpiRes, pg8::StaticOrder, true, true, true>(F.lds, g, S, E, F.wave); } SEAM(4);
    if (IN(5)) { p5_norm2(F, A); } SEAM(5);
    if (IN(6)) { pg8::Gemm g{AP_ACT, AP_WPQ, M, D, D}; pg8::StaticOrder S; S.init(M, D, F.G, (int)blockIdx.x);
        EpiBf16 E{AP_QP, D};
        pg8::gemm_phase<EpiBf16, pg8::StaticOrder, true, true>(F.lds, g, S, E, F.wave); } SEAM(6);
    if (IN(7)) { peer_select_phase(F, A); } SEAM(7);
    if (IN(8)) { peer_eval_phase(F, A); }
#undef IN
#undef SEAM
}

template <int PHS> static bool set_lds() { return hipFuncSetAttribute((const void*)mk_fwd<false, PHS>, hipFuncAttributeMaxDynamicSharedMemorySize, LDS_BYTES) == hipSuccess; }
template <int PHS> static void launch_one(int grid, hipStream_t stream, const Args& a) {
    hipLaunchKernelGGL((mk_fwd<false, PHS>), dim3(grid), dim3(NWAVES * 64), LDS_BYTES, stream, a);
    const hipError_t le = hipPeekAtLastError();
    if (le != hipSuccess) fprintf(stderr, "kernel_launch: launch %d failed: %s\n", PHS, hipGetErrorName(le));
}
extern "C" void kernel_launch(void* const* d_in, const int* in_sizes, int n_in, void* d_out, int out_size, void* d_ws, size_t ws_size, hipStream_t stream) {
    constexpr bool FUSED = (MK_N_LAUNCHES == 1);
    static int grid = 0;
    if (grid == 0) {
        if (n_in != 20 || in_sizes[0] != M * D || out_size != M * D || ws_size < WS_END) { fprintf(stderr, "kernel_launch: unexpected shapes (n_in %d, in0 %d, out %d, ws %zu < %zu); nothing launched\n", n_in, n_in > 0 ? in_sizes[0] : -1, out_size, ws_size, (size_t)WS_END); grid = -1; return; }
        int dev = 0, cus = 0, per_cu = 0;
        if (hipGetDevice(&dev) != hipSuccess || hipDeviceGetAttribute(&cus, hipDeviceAttributeMultiprocessorCount, dev) != hipSuccess) { grid = -1; return; }
        bool okattr = true;
        if constexpr (FUSED) okattr = hipFuncSetAttribute((const void*)mk_fwd<true, -1>, hipFuncAttributeMaxDynamicSharedMemorySize, LDS_BYTES) == hipSuccess;
        else { okattr &= set_lds<0>(); okattr &= set_lds<1>(); okattr &= set_lds<2>(); okattr &= set_lds<3>(); okattr &= set_lds<4>(); okattr &= set_lds<5>(); okattr &= set_lds<6>(); okattr &= set_lds<7>(); okattr &= set_lds<8>(); }
        if (!okattr) { fprintf(stderr, "kernel_launch: hipFuncSetAttribute failed\n"); grid = -1; return; }
        if (hipOccupancyMaxActiveBlocksPerMultiprocessor(&per_cu, (const void*)mk_fwd<FUSED, (FUSED ? -1 : 2)>, NWAVES * 64, LDS_BYTES) != hipSuccess || per_cu < 1) { fprintf(stderr, "kernel_launch: occupancy query says %d blocks per CU; nothing launched\n", per_cu); grid = -1; return; }
        (void)hipGetLastError();
        grid = cus;
        if (grid != 256) fprintf(stderr, "kernel_launch: note: %d CUs (built for 256)\n", grid);
    }
    if (grid < 0) return;
    Args a{};
    for (int i = 0; i < 20; ++i) a.in[i] = (const float*)d_in[i];
    a.out = (float*)d_out; a.ws = (unsigned char*)d_ws;
    if constexpr (FUSED) {
        a.ph_lo = 0; a.ph_hi = NPHASE;
        if (hipMemsetAsync((char*)d_ws + WS_CTL, 0, 128 * 1024, stream) != hipSuccess) { fprintf(stderr, "kernel_launch: memset of the barrier words failed\n"); return; }
        void* kargs[] = {&a};
        hipError_t e;
        if (MK_CG_SYNC) e = hipLaunchCooperativeKernel((const void*)mk_fwd<true, -1>, dim3(grid), dim3(NWAVES * 64), kargs, LDS_BYTES, stream);
        else { hipLaunchKernelGGL((mk_fwd<true, -1>), dim3(grid), dim3(NWAVES * 64), LDS_BYTES, stream, a); e = hipPeekAtLastError(); }
        if (e != hipSuccess) fprintf(stderr, "kernel_launch: launch failed: %s (grid %d)\n", hipGetErrorString(e), grid);
    } else {
        a.ph_lo = 0; a.ph_hi = NPHASE;
        launch_one<0>(grid, stream, a); launch_one<1>(grid, stream, a); launch_one<2>(grid, stream, a); launch_one<3>(grid, stream, a); launch_one<4>(grid, stream, a);
        launch_one<5>(grid, stream, a); launch_one<6>(grid, stream, a); launch_one<7>(grid, stream, a); launch_one<8>(grid, stream, a);
    }
}
```

```cpp
#include <hip/hip_runtime.h>
#include <hip/hip_cooperative_groups.h>
#include <cstdio>
#include <cstdint>
namespace cg = cooperative_groups;
#define MK_N_LAUNCHES 1
namespace pg8 {
#define PG8_LAS __attribute__((address_space(3)))
typedef unsigned short bf16_t;
typedef short bf16x8 __attribute__((ext_vector_type(8)));
typedef float f32x4 __attribute__((ext_vector_type(4)));
typedef unsigned u32x4 __attribute__((ext_vector_type(4)));
constexpr int BM = 256, BK = 64, HALF = 128, HTB = HALF * BK * 2  , STAGE_BYTES = 8 * HTB, NXCD = 8, WGM = 8;

__host__ __device__ __forceinline__ int lds_byte(int r, int c) { const int st = (r >> 4) * 2 + (c >> 5), rr = r & 15, cc = c & 31, ob = rr * 64 + cc * 2; return st * 1024 + (ob ^ (((ob >> 9) & 1) << 5)); }
__host__ __device__ __forceinline__ void stage_rc(int b, int& R, int& C) { const int st = b / 1024, sb = b % 1024, swz = sb ^ (((sb >> 9) & 1) << 5); R = (st >> 1) * 16 + swz / 64; C = (st & 1) * 32 + (swz % 64) / 2; }
__host__ __device__ __forceinline__ int perm32(int rho) { const int n = rho >> 4, i = rho & 15; return 8 * (i >> 2) + 4 * n + (i & 3); }

struct Unit { int pm, pn; };
struct Gemm { const bf16_t* A; const bf16_t* Bt; int M, N, K; };

struct StaticOrder {
    int nM, nN, nwg, G, c;
    __host__ __device__ void init(int M, int N, int G_, int c_) { nM = M / BM; nN = N / BM; nwg = nM * nN; G = G_; c = c_; }
    __host__ __device__ bool next(int i, Unit& u) const {
        const long L = (long)i * G + c; if (L >= nwg) return false;
        int wgid = (int)L; { const int q = nwg / NXCD, r = nwg % NXCD, xcd = wgid % NXCD, off = wgid / NXCD; wgid = (xcd < r ? xcd * (q + 1) : r * (q + 1) + (xcd - r) * q) + off; }
        const int nig = WGM * nN, gid = wgid / nig, fm = gid * WGM, gsz = (nM - fm) < WGM ? (nM - fm) : WGM;
        u.pm = fm + ((wgid % nig) % gsz); u.pn = (wgid % nig) / gsz; return true;
    }
    __device__ __forceinline__ void a_ready(const Unit&) const {}
    __device__ __forceinline__ void done(const Unit&) const {}
};

__device__ __forceinline__ unsigned cvt_pk_bf16(float lo, float hi) { unsigned r; asm volatile("v_cvt_pk_bf16_f32 %0, %1, %2" : "=v"(r) : "v"(lo), "v"(hi)); return r; }
typedef float f32x2 __attribute__((ext_vector_type(2)));
template <class Epi, class Sched, bool ALIGN_EPI = false, bool SP2 = false, bool I8 = false>
__device__ __forceinline__ void gemm_phase(PG8_LAS unsigned char* lds, const Gemm g, const Sched& S, const Epi& E, const int wid) {
    int lane; asm volatile("v_mbcnt_lo_u32_b32 %0, -1, 0\n\tv_mbcnt_hi_u32_b32 %0, -1, %0" : "=v"(lane)); const int tid = wid * 64 + lane, wr = wid >> 2, wc = wid & 3, fr = lane & 15, fq = lane >> 4;
    const int K = g.K, nt = K / BK;
    unsigned voffA[2], voffB[2];
#pragma unroll
    for (int i = 0; i < 2; ++i) { int R, C; stage_rc(tid * 16 + i * 8192, R, C); const int Rb = Epi::PERM ? ((R & ~31) + perm32(R & 31)) : R;
        voffA[i] = (unsigned)(R * K + C) * 2u; voffB[i] = (unsigned)(Rb * K + C) * 2u; }
    const size_t kstep = (size_t)(BK * 2);
    const size_t hstep = (size_t)HALF * K * 2;
    const size_t tstep = 2 * hstep;
    const unsigned ldsw = (unsigned)wid * 1024u;
    const int aoff = lds_byte(wr * 64 + fr, fq * 8), boff = lds_byte(wc * 32 + fr, fq * 8);
#define PG8_SA(b, h) (((b) * 2 + (h)) * HTB)
#define PG8_SB(b, h) ((4 + (b) * 2 + (h)) * HTB)
#define PG8_STAGE(bufoff, gbase, voff) do { _Pragma("unroll") for (int _i = 0; _i < 2; ++_i) \
        __builtin_amdgcn_global_load_lds((const unsigned*)((const char*)(gbase) + (voff)[_i]), (PG8_LAS unsigned*)(lds + (bufoff) + ldsw + _i * 8192), 16, 0, 0); } while (0)
#define PG8_LDA(dst, b, h) do { _Pragma("unroll") for (int m = 0; m < 4; ++m) _Pragma("unroll") for (int k = 0; k < 2; ++k) dst[m][k] = *(const PG8_LAS bf16x8*)(lds + PG8_SA(b, h) + aoff + m * 2048 + k * 1024); } while (0)
#define PG8_LDB(dst, b, h) do { _Pragma("unroll") for (int n = 0; n < 2; ++n) _Pragma("unroll") for (int k = 0; k < 2; ++k) dst[n][k] = *(const PG8_LAS bf16x8*)(lds + PG8_SB(b, h) + boff + n * 2048 + k * 1024); } while (0)
#define PG8_MMA(ai, bj, At, Bt) do { __builtin_amdgcn_s_setprio(1); _Pragma("unroll") for (int m = 0; m < 4; ++m) _Pragma("unroll") for (int n = 0; n < 2; ++n) _Pragma("unroll") for (int k = 0; k < 2; ++k) \
        { if constexpr (I8) { typedef int v4i_ __attribute__((ext_vector_type(4))); acc[ai][bj][m][n] = __builtin_bit_cast(f32x4, __builtin_amdgcn_mfma_i32_16x16x64_i8(__builtin_bit_cast(v4i_, Bt[n][k]), __builtin_bit_cast(v4i_, At[m][k]), __builtin_bit_cast(v4i_, acc[ai][bj][m][n]), 0, 0, 0)); } \
          else acc[ai][bj][m][n] = __builtin_amdgcn_mfma_f32_16x16x32_bf16(Bt[n][k], At[m][k], acc[ai][bj][m][n], 0, 0, 0); } __builtin_amdgcn_s_setprio(0); } while (0)
#define PG8_WAIT_V(n) asm volatile("s_waitcnt vmcnt(" #n ")" ::: "memory")
#define PG8_WAIT_L(n) asm volatile("s_waitcnt lgkmcnt(" #n ")" ::: "memory")
#define PG8_BAR __builtin_amdgcn_s_barrier()
#define PG8_SCHED __builtin_amdgcn_sched_barrier(0)
    Unit cur, nxt; int ui = 0;
    if (!S.next(0, cur)) return;
    f32x4 acc[2][2][4][2];
#pragma unroll
    for (int a = 0; a < 2; ++a)
#pragma unroll
        for (int b = 0; b < 2; ++b)
#pragma unroll
            for (int m = 0; m < 4; ++m)
#pragma unroll
                for (int n = 0; n < 2; ++n) acc[a][b][m][n] = (f32x4){0.f, 0.f, 0.f, 0.f};
    bf16x8 At[4][2], B0[2][2], B1[2][2];
    const char* cA = (const char*)g.A + (size_t)cur.pm * tstep; const char* cB = (const char*)g.Bt + (size_t)cur.pn * tstep;
    S.a_ready(cur);
    if constexpr (SP2) {
        PG8_STAGE(PG8_SB(0, 0), cB, voffB); PG8_STAGE(PG8_SB(0, 1), cB + hstep, voffB); PG8_STAGE(PG8_SA(0, 0), cA, voffA); PG8_STAGE(PG8_SA(0, 1), cA + hstep, voffA);
        if (wr == 1) PG8_BAR;
        PG8_WAIT_V(2); PG8_BAR;
        PG8_STAGE(PG8_SB(1, 0), cB + kstep, voffB); PG8_STAGE(PG8_SA(1, 0), cA + kstep, voffA); PG8_STAGE(PG8_SB(1, 1), cB + hstep + kstep, voffB);
        PG8_WAIT_V(6); PG8_BAR;
    } else {
        PG8_STAGE(PG8_SB(0, 0), cB, voffB); PG8_STAGE(PG8_SA(0, 0), cA, voffA); PG8_STAGE(PG8_SB(0, 1), cB + hstep, voffB); PG8_STAGE(PG8_SA(0, 1), cA + hstep, voffA);
        if (wr == 1) PG8_BAR;
        PG8_WAIT_V(4); PG8_BAR;
        PG8_STAGE(PG8_SB(1, 0), cB + kstep, voffB); PG8_STAGE(PG8_SA(1, 0), cA + kstep, voffA); PG8_STAGE(PG8_SB(1, 1), cB + hstep + kstep, voffB);
        PG8_WAIT_V(6); PG8_BAR;
    }
    for (;;) {
        const bool has_next = S.next(ui + 1, nxt);
        const char* nA = has_next ? (const char*)g.A + (size_t)nxt.pm * tstep : cA; const char* nB = has_next ? (const char*)g.Bt + (size_t)nxt.pn * tstep : cB;
        for (int t = 0; t < nt; t += 2) {
            const bool last = (t == nt - 2);
            const char* a1 = cA + (size_t)(t + 1) * kstep;
            const char* a2 = last ? nA : cA + (size_t)(t + 2) * kstep; const char* b2 = last ? nB : cB + (size_t)(t + 2) * kstep;
            const char* a3 = a2 + kstep; const char* b3 = b2 + kstep;
            if (last && has_next) S.a_ready(nxt);
            if constexpr (SP2) {
            PG8_LDB(B0, 0, 0); PG8_LDB(B1, 0, 1); PG8_SCHED; PG8_LDA(At, 0, 0); PG8_STAGE(PG8_SA(1, 1), a1 + hstep, voffA);
            PG8_WAIT_V(8); PG8_WAIT_L(0); PG8_BAR; PG8_MMA(0, 0, At, B0); PG8_MMA(0, 1, At, B1); PG8_BAR; PG8_SCHED;
            PG8_LDA(At, 0, 1); PG8_STAGE(PG8_SB(0, 0), b2, voffB); PG8_STAGE(PG8_SB(0, 1), b2 + hstep, voffB); PG8_STAGE(PG8_SA(0, 0), a2, voffA);
            PG8_WAIT_V(8); PG8_WAIT_L(0); PG8_BAR; PG8_MMA(1, 0, At, B0); PG8_MMA(1, 1, At, B1); PG8_BAR; PG8_SCHED;
            PG8_LDB(B0, 1, 0); PG8_LDB(B1, 1, 1); PG8_SCHED; PG8_LDA(At, 1, 0); PG8_STAGE(PG8_SA(0, 1), a2 + hstep, voffA);
            PG8_WAIT_V(8); PG8_WAIT_L(0); PG8_BAR; PG8_MMA(0, 0, At, B0); PG8_MMA(0, 1, At, B1); PG8_BAR; PG8_SCHED;
            PG8_LDA(At, 1, 1); PG8_STAGE(PG8_SB(1, 0), b3, voffB); PG8_STAGE(PG8_SB(1, 1), b3 + hstep, voffB); PG8_STAGE(PG8_SA(1, 0), a3, voffA);
            PG8_WAIT_V(8); PG8_WAIT_L(0); PG8_BAR; PG8_MMA(1, 0, At, B0); PG8_MMA(1, 1, At, B1); PG8_BAR; PG8_SCHED;
            } else {
            PG8_LDB(B0, 0, 0); PG8_SCHED; PG8_LDA(At, 0, 0); PG8_STAGE(PG8_SA(1, 1), a1 + hstep, voffA);
            PG8_WAIT_L(8); PG8_BAR; PG8_WAIT_L(0); PG8_MMA(0, 0, At, B0); PG8_BAR; PG8_SCHED;
            PG8_LDB(B1, 0, 1); PG8_STAGE(PG8_SB(0, 0), b2, voffB);
            PG8_BAR; PG8_WAIT_L(0); PG8_MMA(0, 1, At, B1); PG8_BAR;
            PG8_LDA(At, 0, 1); PG8_STAGE(PG8_SA(0, 0), a2, voffA);
            PG8_BAR; PG8_WAIT_L(0); PG8_MMA(1, 0, At, B0); PG8_BAR; PG8_SCHED;
            PG8_STAGE(PG8_SB(0, 1), b2 + hstep, voffB);
            PG8_WAIT_V(6); PG8_BAR; PG8_MMA(1, 1, At, B1); PG8_BAR;
            PG8_LDB(B0, 1, 0); PG8_SCHED; PG8_LDA(At, 1, 0); PG8_STAGE(PG8_SA(0, 1), a2 + hstep, voffA);
            PG8_WAIT_L(8); PG8_BAR; PG8_WAIT_L(0); PG8_MMA(0, 0, At, B0); PG8_BAR; PG8_SCHED;
            PG8_LDB(B1, 1, 1); PG8_STAGE(PG8_SB(1, 0), b3, voffB);
            PG8_BAR; PG8_WAIT_L(0); PG8_MMA(0, 1, At, B1); PG8_BAR;
            PG8_LDA(At, 1, 1); PG8_STAGE(PG8_SA(1, 0), a3, voffA);
            PG8_BAR; PG8_WAIT_L(0); PG8_MMA(1, 0, At, B0); PG8_BAR; PG8_SCHED;
            PG8_STAGE(PG8_SB(1, 1), b3 + hstep, voffB);
            PG8_WAIT_V(6); PG8_BAR; PG8_MMA(1, 1, At, B1); PG8_BAR;
            }
        }
        if constexpr (ALIGN_EPI) { if (wr == 0) PG8_BAR; }
        if constexpr (!Epi::AFTER_DRAIN) { E(acc, cur, wr, wc, fr, fq); S.done(cur); }
        if (!has_next) break;
#pragma unroll
        for (int a = 0; a < 2; ++a)
#pragma unroll
            for (int b = 0; b < 2; ++b)
#pragma unroll
                for (int m = 0; m < 4; ++m)
#pragma unroll
                    for (int n = 0; n < 2; ++n) acc[a][b][m][n] = (f32x4){0.f, 0.f, 0.f, 0.f};
        cur = nxt; cA = nA; cB = nB; ++ui;
        if constexpr (ALIGN_EPI) { if (wr == 1) PG8_BAR; }
    }
    PG8_WAIT_V(0);
    if constexpr (!ALIGN_EPI) { if (wr == 0) PG8_BAR; }
    PG8_BAR;
    if constexpr (Epi::AFTER_DRAIN) { E.fused(acc, cur, wr, wc, fr, fq, lds, wid, lane); S.done(cur); }
#undef PG8_SA
#undef PG8_SB
#undef PG8_STAGE
#undef PG8_LDA
#undef PG8_LDB
#undef PG8_MMA
#undef PG8_WAIT_V
#undef PG8_WAIT_L
#undef PG8_BAR
#undef PG8_SCHED
}
}

#ifndef MK_N_LAUNCHES
#define MK_N_LAUNCHES 1
#endif
constexpr int NPHASE = 9;

constexpr int D = 2048, NB = 8, SEQ = 2048, M = NB * SEQ, CTXL = 256, MC = NB * CTXL;
constexpr int NH = 8, HD = 128, DA = 1024, NPROJ = 6144, GW = 64;
constexpr int NEXP = 16384, PH = 8, PK = 16, NKEYS = 128;
constexpr float EPS = 1e-6f, LOG2E = 1.4426950408889634f;
constexpr int NWAVES = 8;
constexpr float A2_SCALE = 10.0f / 127.0f, A2_INV = 127.0f / 10.0f;

constexpr size_t MiB = 1u << 20;
constexpr size_t WS_CTL = 0, WS_MOD = 1 * MiB, WS_SK = 2 * MiB, WS_WIN = 4 * MiB, WS_WOUT = 28 * MiB, WS_WPQ = 36 * MiB;
constexpr size_t WS_UT = 44 * MiB, WS_VT = 108 * MiB, WS_ACT = 172 * MiB, WS_HC = 236 * MiB;
constexpr size_t WS_Q = 244 * MiB, WS_K = 276 * MiB, WS_VTR = 308 * MiB, WS_BG = 340 * MiB, WS_CG = 372 * MiB, WS_U = 404 * MiB;
constexpr size_t WS_KC = 436 * MiB, WS_VCT = 440 * MiB, WS_QP = 244 * MiB  ;
constexpr size_t WS_SELI = 444 * MiB, WS_SELG = 452 * MiB, WS_AVW = 460 * MiB, WS_END = 468 * MiB;
constexpr size_t WS_U8 = WS_UT, WS_V8 = WS_UT + 32 * MiB, WS_SU = WS_VT, WS_SV = WS_VT + 64 * 1024, WS_H2S = WS_VT + 128 * 1024, WS_H2Q = WS_VT + 1 * MiB;

constexpr int LDS_BYTES = 147456;
constexpr int XCH_OFF = 131072;
constexpr int MISC_OFF = 131072 + 8192;
#ifndef MK_CG_SYNC
#define MK_CG_SYNC 1
#endif

#define GAS __attribute__((address_space(1)))
#define LAS __attribute__((address_space(3)))
typedef unsigned short bf16;
typedef unsigned v4u __attribute__((ext_vector_type(4)));
typedef unsigned v2u __attribute__((ext_vector_type(2)));
typedef float f32x4 __attribute__((ext_vector_type(4)));
typedef float f32x16 __attribute__((ext_vector_type(16)));
typedef short bf16x8 __attribute__((ext_vector_type(8)));
typedef __bf16 bf16x2 __attribute__((ext_vector_type(2)));
#define LDS_WAIT() asm volatile("s_waitcnt lgkmcnt(0)" ::: "memory")

__device__ __forceinline__ unsigned f2bf(float f) { unsigned u = __builtin_bit_cast(unsigned, f); return (u + 0x7fffu + ((u >> 16) & 1u)) >> 16; }
__device__ __forceinline__ unsigned pk2(float lo, float hi) { return pg8::cvt_pk_bf16(lo, hi); }
__device__ __forceinline__ float bflo(unsigned w) { return __builtin_bit_cast(float, w << 16); }
__device__ __forceinline__ float bfhi(unsigned w) { return __builtin_bit_cast(float, w & 0xffff0000u); }
__device__ __forceinline__ float dot2_bf16(unsigned w, unsigned x, float acc) { return __builtin_amdgcn_fdot2_f32_bf16(__builtin_bit_cast(bf16x2, w), __builtin_bit_cast(bf16x2, x), acc, false); }
__device__ __forceinline__ float wave_sum(float v) {
#pragma unroll
    for (int o = 1; o < 64; o <<= 1) v += __shfl_xor(v, o);
    return v;
}

struct Args { const float* in[20]; float* out; unsigned char* ws; int ph_lo, ph_hi; };
struct Frame {
    LAS unsigned char* lds;
    int wave, vcu, G;
};
__device__ __forceinline__ int lane_id() { int l; asm volatile("v_mbcnt_lo_u32_b32 %0, -1, 0\n\tv_mbcnt_hi_u32_b32 %0, -1, %0" : "=v"(l)); return l; }
#define F_LANE lane_id()
#define F_TID (F.wave * 64 + lane_id())
#define AP_x (A.in[0])
#define AP_c (A.in[1])
#define AP_ctx (A.in[2])
#define AP_c_ctx (A.in[3])
#define AP_w_ada (A.in[4])
#define AP_b_ada (A.in[5])
#define AP_g1 (A.in[6])
#define AP_w_in (A.in[7])
#define AP_qn (A.in[8])
#define AP_kn (A.in[9])
#define AP_rpb (A.in[10])
#define AP_w_conv (A.in[11])
#define AP_gao (A.in[12])
#define AP_gco (A.in[13])
#define AP_w_out (A.in[14])
#define AP_g2 (A.in[15])
#define AP_w_pq (A.in[16])
#define AP_subk (A.in[17])
#define AP_uex (A.in[18])
#define AP_vex (A.in[19])
#define AP_SK ((bf16*)(A.ws + WS_SK))
#define AP_WIN ((bf16*)(A.ws + WS_WIN))
#define AP_WOUT ((bf16*)(A.ws + WS_WOUT))
#define AP_WPQ ((bf16*)(A.ws + WS_WPQ))
#define AP_UT ((bf16*)(A.ws + WS_UT))
#define AP_VT ((bf16*)(A.ws + WS_VT))
#define AP_ACT ((bf16*)(A.ws + WS_ACT))
#define AP_HC ((bf16*)(A.ws + WS_HC))
#define AP_Q ((bf16*)(A.ws + WS_Q))
#define AP_K ((bf16*)(A.ws + WS_K))
#define AP_VTR ((bf16*)(A.ws + WS_VTR))
#define AP_BG ((bf16*)(A.ws + WS_BG))
#define AP_CG ((bf16*)(A.ws + WS_CG))
#define AP_U ((bf16*)(A.ws + WS_U))
#define AP_KC ((bf16*)(A.ws + WS_KC))
#define AP_VCT ((bf16*)(A.ws + WS_VCT))
#define AP_QP ((bf16*)(A.ws + WS_QP))
#define AP_MOD ((float*)(A.ws + WS_MOD))
#define AP_SELI ((int*)(A.ws + WS_SELI))
#define AP_SELG ((float*)(A.ws + WS_SELG))
#define AP_AVW ((float*)(A.ws + WS_AVW))
#define AP_WIN8 ((unsigned char*)(A.ws + WS_WIN))
#define AP_WINS ((float*)(A.ws + WS_WIN + 16 * MiB))
#define AP_WOUT8 ((unsigned char*)(A.ws + WS_WOUT))
#define AP_WOUTS ((float*)(A.ws + WS_WOUT + 5 * MiB))
#define AP_CPARTO ((float*)(A.ws + WS_WOUT + 6 * MiB))
#define AP_A28 ((unsigned char*)(A.ws + WS_ACT))
#define AP_WPQ8 ((unsigned char*)(A.ws + WS_WPQ))
#define AP_WPQS ((float*)(A.ws + WS_WPQ + 5 * MiB))
#define AP_CPARTQ ((float*)(A.ws + WS_WPQ + 6 * MiB))
#define AP_CPART ((float*)(A.ws + WS_WIN + 17 * MiB))
#define AP_H8 ((unsigned char*)(A.ws + WS_ACT))
#define AP_HC8 ((unsigned char*)(A.ws + WS_HC))
#define AP_HS ((float*)(A.ws + WS_HC + 4 * MiB))
#define AP_HCS ((float*)(A.ws + WS_HC + 4 * MiB + 65536))
#define AP_X1B ((bf16*)(A.ws + WS_BG))
#define AP_out (A.out)
#define AP_U8 ((const unsigned char*)(A.ws + WS_U8))
#define AP_V8 ((const unsigned char*)(A.ws + WS_V8))
#define AP_SU ((float*)(A.ws + WS_SU))
#define AP_SV ((float*)(A.ws + WS_SV))
#define AP_H2S ((float*)(A.ws + WS_H2S))
#define AP_H2Q ((unsigned char*)(A.ws + WS_H2Q))


#define XB_TMO      128
#define XB_XCNT(j)  (256  + 64 * (j))
#define XB_XSUB(j)  (1280 + 64 * (j))
#define XB_XGEN(j)  (2304 + 64 * (j))
#define XB_TOP      3328
#define XB_TOPGEN   3392
#define XCD_BAR_WORDS 3456
#define XB_SPIN_CAP (1u << 22)
__device__ __forceinline__ unsigned xb_ld(unsigned* p)              { return __hip_atomic_load(p, __ATOMIC_RELAXED, __HIP_MEMORY_SCOPE_AGENT); }
__device__ __forceinline__ unsigned xb_add(unsigned* p, unsigned v) { return __hip_atomic_fetch_add(p, v, __ATOMIC_RELAXED, __HIP_MEMORY_SCOPE_AGENT); }
__device__ __forceinline__ unsigned xb_xcc_id() { return (unsigned)__builtin_amdgcn_s_getreg((3 << 11) | 20) & 0xFu; }
#define XB_SPIN(cond, bar) do { unsigned _sp = 0; while (cond) { __builtin_amdgcn_s_sleep(1); \
    if ((++_sp & 255u) == 0u) { if (xb_ld(&(bar)[XB_TMO])) break; if (_sp > XB_SPIN_CAP) { atomicAdd(&(bar)[XB_TMO], 1u); break; } } } } while (0)
struct XcdBarrier { unsigned* bar; unsigned x; volatile LAS unsigned* st; };
__device__ __forceinline__ void xcd_barrier_complete(unsigned* bar, unsigned x, unsigned G, unsigned& nloc, unsigned& nx) {
    unsigned sum, cnt, mine, sp = 0u;
    for (;;) {
        sum = 0u; cnt = 0u; mine = 0u;
#pragma unroll
        for (unsigned j = 0; j < 16; ++j) { const unsigned c = xb_ld(&bar[XB_XCNT(j)]); sum += c; cnt += (c > 0u) ? 1u : 0u; mine = (j == x) ? c : mine; }
        if (sum == G) break;
        __builtin_amdgcn_s_sleep(1);
        if ((++sp & 255u) == 0u) { if (xb_ld(&bar[XB_TMO])) break; if (sp > XB_SPIN_CAP) { atomicAdd(&bar[XB_TMO], 1u); break; } }
    }
    nloc = mine > 0u ? mine : 1u; nx = cnt > 0u ? cnt : 1u;
}
__device__ __forceinline__ void xcd_barrier(const XcdBarrier& b, const int wave, const unsigned G) {
    asm volatile("s_waitcnt vmcnt(0)" ::: "memory");
    __syncthreads();
    if (wave == 0 && lane_id() == 0) {
        unsigned* bar = b.bar;
        __builtin_amdgcn_s_waitcnt(0);
        unsigned nloc = b.st[0], nx = b.st[1];
        if (nloc == 0u) { xcd_barrier_complete(bar, b.x, G, nloc, nx); b.st[0] = nloc; b.st[1] = nx; }
        const unsigned old = xb_add(&bar[XB_XSUB(b.x)], 1u);
        const unsigned gen = old / nloc;
        if (old + 1u == (gen + 1u) * nloc) {
            __builtin_amdgcn_fence(__ATOMIC_RELEASE, "agent");
            asm volatile("s_waitcnt vmcnt(0)" ::: "memory");
            const unsigned og = xb_add(&bar[XB_TOP], 1u);
            const unsigned tg = og / nx;
            if (og + 1u == (tg + 1u) * nx) xb_add(&bar[XB_TOPGEN], 1u);
            else XB_SPIN(xb_ld(&bar[XB_TOPGEN]) == tg, bar);
            __builtin_amdgcn_fence(__ATOMIC_ACQUIRE, "agent");
            xb_add(&bar[XB_XGEN(b.x)], 1u);
            asm volatile("s_waitcnt vmcnt(0)" ::: "memory");
        } else {
            XB_SPIN(xb_ld(&bar[XB_XGEN(b.x)]) == gen, bar);
            __builtin_amdgcn_fence(__ATOMIC_ACQUIRE, "agent");
            asm volatile("s_waitcnt vmcnt(0)" ::: "memory");
        }
    }
    __syncthreads();
}

__device__ __forceinline__ void p0_mod(const Frame& F, const Args& A) {
    const int lane = lane_id(), tid = F.wave * 64 + lane; (void)tid;
    LAS float* sc = (LAS float*)F.lds;
    LAS float* red = (LAS float*)(F.lds + 9 * 2048 * 4);
    for (int i = tid; i < 9 * D; i += NWAVES * 64) { const int r = i >> 11, k = i & (D - 1); const float cv = (r < 8) ? AP_c[r * D + k] : AP_c_ctx[k]; sc[i] = cv / (1.f + __expf(-cv)); }
    __syncthreads();
    const int sr = lane >> 4, cq = lane & 15;
    for (int item = F.vcu; item < (6 * D) / 64; item += F.G) {
        const int n0 = item * 64;
        float acc[9][4];
#pragma unroll
        for (int r = 0; r < 9; ++r)
#pragma unroll
            for (int j = 0; j < 4; ++j) acc[r][j] = 0.f;
        const float* wp = AP_w_ada + (size_t)(F.wave * 4 + sr) * (6 * D) + n0 + 4 * cq;
#pragma unroll 8
        for (int step = 0; step < 64; ++step) {
            const int k = step * 32 + F.wave * 4 + sr;
            const f32x4 w = *(const f32x4*)(wp + (size_t)step * 32 * (6 * D));
#pragma unroll
            for (int r = 0; r < 9; ++r) { const float s = sc[r * D + k]; acc[r][0] += s * w.x; acc[r][1] += s * w.y; acc[r][2] += s * w.z; acc[r][3] += s * w.w; }
        }
#pragma unroll
        for (int r = 0; r < 9; ++r)
#pragma unroll
            for (int j = 0; j < 4; ++j) { float v = acc[r][j]; v += __shfl_xor(v, 16); v += __shfl_xor(v, 32); if (sr == 0) red[(F.wave * 9 + r) * 64 + 4 * cq + j] = v; }
        __syncthreads();
        for (int i = tid; i < 9 * 64; i += NWAVES * 64) { const int r = i >> 6, cc = i & 63; float s = 0.f;
#pragma unroll
            for (int w = 0; w < 8; ++w) s += red[(w * 9 + r) * 64 + cc];
            AP_MOD[r * (6 * D) + n0 + cc] = s + AP_b_ada[n0 + cc]; }
        __syncthreads();
    }
    __syncthreads();
}
__device__ __forceinline__ void p0_transpose_item(const float* W, int K, int N, bf16* WT, LAS float* scr, int item, int lane) {
    const int nblk = N / 32, kb = item / nblk, nb = item % nblk, k0 = 64 * kb, n0 = 32 * nb;
#pragma unroll 8
    for (int i = 0; i < 32; ++i) { const int kk = 2 * i + (lane >> 5); scr[kk * 33 + (lane & 31)] = W[(size_t)(k0 + kk) * N + n0 + (lane & 31)]; }
    LDS_WAIT(); asm volatile("" ::: "memory");
    const int c = lane & 7;
#pragma unroll
    for (int j = 0; j < 4; ++j) { const int n = (lane >> 3) + 8 * j; const LAS float* s = scr + (8 * c) * 33 + n;
        v4u o; o.x = pk2(s[0 * 33], s[1 * 33]); o.y = pk2(s[2 * 33], s[3 * 33]); o.z = pk2(s[4 * 33], s[5 * 33]); o.w = pk2(s[6 * 33], s[7 * 33]);
        *(v4u*)(WT + (size_t)(n0 + n) * K + k0 + 8 * c) = o; }
    LDS_WAIT(); asm volatile("" ::: "memory");
}
__device__ __forceinline__ void cvt_f32_bf16(const float* src, bf16* dst, size_t n, size_t gtid, size_t gthreads) {
    for (size_t i = gtid * 8; i < n; i += gthreads * 8) { const f32x4 a = *(const f32x4*)(src + i), b = *(const f32x4*)(src + i + 4);
        v4u o; o.x = pk2(a.x, a.y); o.y = pk2(a.z, a.w); o.z = pk2(b.x, b.y); o.w = pk2(b.z, b.w); *(v4u*)(dst + i) = o; }
}
__device__ __forceinline__ float wave_max(float v) {
#pragma unroll
    for (int o = 1; o < 64; o <<= 1) v = fmaxf(v, __shfl_xor(v, o));
    return v;
}
__device__ __forceinline__ unsigned q4(const f32x4 v, const float inv, const int off = 0) {
    const int a = (int)fminf(fmaxf(__builtin_rintf(v.x * inv), -127.f), 127.f) + off, b = (int)fminf(fmaxf(__builtin_rintf(v.y * inv), -127.f), 127.f) + off, c = (int)fminf(fmaxf(__builtin_rintf(v.z * inv), -127.f), 127.f) + off, d = (int)fminf(fmaxf(__builtin_rintf(v.w * inv), -127.f), 127.f) + off;
    return (unsigned)(a & 255) | ((unsigned)(b & 255) << 8) | ((unsigned)(c & 255) << 16) | ((unsigned)(d & 255) << 24);
}
__device__ __forceinline__ void quant_row(const float* src, unsigned char* dst, float* scale, int lane, const int off) {
    const f32x4* xr = (const f32x4*)src + lane; f32x4 v[8]; float mx = 0.f;
#pragma unroll
    for (int j = 0; j < 8; ++j) { v[j] = xr[64 * j]; mx = fmaxf(mx, fmaxf(fmaxf(fabsf(v[j].x), fabsf(v[j].y)), fmaxf(fabsf(v[j].z), fabsf(v[j].w)))); }
    mx = fmaxf(wave_max(mx), 1e-30f);
    const float inv = 127.f / mx;
    unsigned* o = (unsigned*)dst + lane;
#pragma unroll
    for (int j = 0; j < 8; ++j) o[64 * j] = q4(v[j], inv, off);
    if (lane == 0) *scale = mx * (1.f / 127.f);
}
__device__ __forceinline__ void p1_transpose_item_i8(const float* W, int K, int N, unsigned char* WT, const float* cpart, float* wscale, LAS float* scr, int item, int lane) {
    const int nblk = N / 32, kb = item / nblk, nb = item % nblk, k0 = 64 * kb, n0 = 32 * nb;
    { float cm = 0.f;
#pragma unroll
      for (int p = 0; p < 16; ++p) cm = fmaxf(cm, cpart[(size_t)(16 * (lane >> 5) + p) * N + n0 + (lane & 31)]);
      cm = fmaxf(cm, __shfl_xor(cm, 32));
      scr[64 * 33 + (lane & 31)] = cm; }
#pragma unroll 8
    for (int i = 0; i < 32; ++i) { const int kk = 2 * i + (lane >> 5); scr[kk * 33 + (lane & 31)] = W[(size_t)(k0 + kk) * N + n0 + (lane & 31)]; }
    LDS_WAIT(); asm volatile("" ::: "memory");
    const int c = lane & 7;
#pragma unroll
    for (int j = 0; j < 4; ++j) { const int n = (lane >> 3) + 8 * j; const LAS float* sp = scr + (8 * c) * 33 + n;
        const float mx = fmaxf(scr[64 * 33 + n], 1e-30f), inv = 127.f / mx;
        f32x4 a = {sp[0 * 33], sp[1 * 33], sp[2 * 33], sp[3 * 33]}, b = {sp[4 * 33], sp[5 * 33], sp[6 * 33], sp[7 * 33]};
        v2u o; o.x = q4(a, inv); o.y = q4(b, inv);
        *(v2u*)(WT + (size_t)(n0 + n) * K + k0 + 8 * c) = o;
        if (kb == 0 && c == 0) wscale[n0 + n] = mx * (1.f / 127.f); }
    LDS_WAIT(); asm volatile("" ::: "memory");
}
__device__ __forceinline__ void p0_prologue(const Frame& F, const Args& A) {
    const int lane = lane_id(), tid = F.wave * 64 + lane; (void)tid;
    p0_mod(F, A);
    LAS float* scr = (LAS float*)(F.lds + F.wave * 16384);
    const int gw = F.vcu * NWAVES + F.wave, NGW = F.G * NWAVES;
    constexpr int I_SQ = (D / 64) * (D / 32);
    (void)I_SQ; (void)scr;
    for (int it = gw; it < (D / 256) * (D / 64); it += NGW) { const int cb = it % (D / 256), kb = it / (D / 256);
        const f32x4* wp = (const f32x4*)(AP_w_pq + (size_t)(kb * 64) * D + cb * 256) + lane; f32x4 mx = {0.f, 0.f, 0.f, 0.f};
#pragma unroll 8
        for (int k = 0; k < 64; ++k) { const f32x4 w = wp[(size_t)k * (D / 4)]; mx.x = fmaxf(mx.x, fabsf(w.x)); mx.y = fmaxf(mx.y, fabsf(w.y)); mx.z = fmaxf(mx.z, fabsf(w.z)); mx.w = fmaxf(mx.w, fabsf(w.w)); }
        *((f32x4*)(AP_CPARTQ + (size_t)kb * D + cb * 256) + lane) = mx; }
    for (int it = gw; it < (D / 256) * (D / 64); it += NGW) { const int cb = it % (D / 256), kb = it / (D / 256);
        const f32x4* wp = (const f32x4*)(AP_w_out + (size_t)(kb * 64) * D + cb * 256) + lane; f32x4 mx = {0.f, 0.f, 0.f, 0.f};
#pragma unroll 8
        for (int k = 0; k < 64; ++k) { const f32x4 w = wp[(size_t)k * (D / 4)]; mx.x = fmaxf(mx.x, fabsf(w.x)); mx.y = fmaxf(mx.y, fabsf(w.y)); mx.z = fmaxf(mx.z, fabsf(w.z)); mx.w = fmaxf(mx.w, fabsf(w.w)); }
        *((f32x4*)(AP_CPARTO + (size_t)kb * D + cb * 256) + lane) = mx; }
    for (int it = gw; it < (NPROJ / 256) * (D / 64); it += NGW) { const int cb = it % (NPROJ / 256), kb = it / (NPROJ / 256);
        const f32x4* wp = (const f32x4*)(AP_w_in + (size_t)(kb * 64) * NPROJ + cb * 256) + lane; f32x4 mx = {0.f, 0.f, 0.f, 0.f};
#pragma unroll 8
        for (int k = 0; k < 64; ++k) { const f32x4 w = wp[(size_t)k * (NPROJ / 4)]; mx.x = fmaxf(mx.x, fabsf(w.x)); mx.y = fmaxf(mx.y, fabsf(w.y)); mx.z = fmaxf(mx.z, fabsf(w.z)); mx.w = fmaxf(mx.w, fabsf(w.w)); }
        *((f32x4*)(AP_CPART + (size_t)kb * NPROJ + cb * 256) + lane) = mx; }
    const size_t gtid = (size_t)F.vcu * (NWAVES * 64) + tid, gth = (size_t)F.G * NWAVES * 64;
    cvt_f32_bf16(AP_subk, AP_SK, (size_t)PH * 2 * NKEYS * 128, gtid, gth);
    for (int it = gw; it < 2 * NEXP; it += NGW) {
        const int e = it >> 1; const bool isv = it & 1;
        quant_row((isv ? AP_vex : AP_uex) + (size_t)e * D, (unsigned char*)(A.ws + (isv ? WS_V8 : WS_U8)) + (size_t)e * D, (isv ? AP_SV : AP_SU) + e, lane, 0);
    }
}

__device__ __forceinline__ void norm_rows(const float* X, size_t row0, int nrows, const float* g, const float* sh, const float* sc, bf16* out, int lane, unsigned char* q8 = nullptr, float* qs = nullptr) {
    f32x4 gs[8], shv[8];
#pragma unroll
    for (int j = 0; j < 8; ++j) { const int cI = j * 64 + lane; const f32x4 gg = ((const f32x4*)g)[cI], s1 = ((const f32x4*)sc)[cI]; gs[j] = gg * (1.f + s1); shv[j] = ((const f32x4*)sh)[cI]; }
    for (int r = 0; r < nrows; ++r) {
        const f32x4* xr = (const f32x4*)(X + (row0 + r) * D) + lane;
        f32x4 v[8]; float ss = 0.f;
#pragma unroll
        for (int j = 0; j < 8; ++j) { v[j] = xr[64 * j]; ss += (v[j].x * v[j].x + v[j].y * v[j].y) + (v[j].z * v[j].z + v[j].w * v[j].w); }
        const float rstd = __builtin_amdgcn_rsqf(wave_sum(ss) * (1.f / D) + EPS);
        v2u* o8 = (v2u*)(out + (row0 + r) * D) + lane; float mx = 0.f;
#pragma unroll
        for (int j = 0; j < 8; ++j) { const f32x4 y = v[j] * rstd * gs[j] + shv[j]; v[j] = y; if (out) { v2u w; w.x = pk2(y.x, y.y); w.y = pk2(y.z, y.w); o8[64 * j] = w; }
            mx = fmaxf(mx, fmaxf(fmaxf(fabsf(y.x), fabsf(y.y)), fmaxf(fabsf(y.z), fabsf(y.w)))); }
        if (q8) { mx = fmaxf(wave_max(mx), 1e-30f); const float inv = 127.f / mx; unsigned* oq = (unsigned*)(q8 + (row0 + r) * D) + lane;
#pragma unroll
            for (int j = 0; j < 8; ++j) oq[64 * j] = q4(v[j], inv);
            if (lane == 0) qs[row0 + r] = mx * (1.f / 127.f); }
    }
}
__device__ __forceinline__ void norm_rows_b(const bf16* X, size_t row0, int nrows, const float* g, const float* sh, const float* sc, bf16* out, int lane, unsigned char* q8, float* qs) {
    f32x4 gs[8], shv[8];
#pragma unroll
    for (int j = 0; j < 8; ++j) { const int cI = j * 64 + lane; const f32x4 gg = ((const f32x4*)g)[cI], s1 = ((const f32x4*)sc)[cI]; gs[j] = gg * (1.f + s1); shv[j] = ((const f32x4*)sh)[cI]; }
    for (int r = 0; r < nrows; ++r) {
        const v2u* xr = (const v2u*)(X + (row0 + r) * D) + lane;
        f32x4 v[8]; float ss = 0.f;
#pragma unroll
        for (int j = 0; j < 8; ++j) { const v2u w = xr[64 * j]; v[j].x = bflo(w.x); v[j].y = bfhi(w.x); v[j].z = bflo(w.y); v[j].w = bfhi(w.y); ss += (v[j].x * v[j].x + v[j].y * v[j].y) + (v[j].z * v[j].z + v[j].w * v[j].w); }
        const float rstd = __builtin_amdgcn_rsqf(wave_sum(ss) * (1.f / D) + EPS);
        v2u* o8 = (v2u*)(out + (row0 + r) * D) + lane; float mx = 0.f;
#pragma unroll
        for (int j = 0; j < 8; ++j) { const f32x4 y = v[j] * rstd * gs[j] + shv[j]; v[j] = y; if (out) { v2u w; w.x = pk2(y.x, y.y); w.y = pk2(y.z, y.w); o8[64 * j] = w; }
            mx = fmaxf(mx, fmaxf(fmaxf(fabsf(y.x), fabsf(y.y)), fmaxf(fabsf(y.z), fabsf(y.w)))); }
        mx = fmaxf(wave_max(mx), 1e-30f); const float inv = 127.f / mx; unsigned* oq = (unsigned*)(q8 + (row0 + r) * D) + lane;
#pragma unroll
        for (int j = 0; j < 8; ++j) oq[64 * j] = q4(v[j], inv);
        if (lane == 0) qs[row0 + r] = mx * (1.f / 127.f);
    }
}
__device__ __forceinline__ void p1_norm1(const Frame& F, const Args& A) {
    const int lane = lane_id(), tid = F.wave * 64 + lane; (void)tid;
    const int gw = F.vcu * NWAVES + F.wave, NGW = F.G * NWAVES;
    { LAS float* scr = (LAS float*)(F.lds + F.wave * 16384);
      for (int it = gw; it < (D / 64) * (NPROJ / 32); it += NGW) p1_transpose_item_i8(AP_w_in, D, NPROJ, AP_WIN8, AP_CPART, AP_WINS, scr, it, lane);
      for (int it = gw; it < (D / 64) * (D / 32); it += NGW) p1_transpose_item_i8(AP_w_out, D, D, AP_WOUT8, AP_CPARTO, AP_WOUTS, scr, it, lane);
      for (int it = gw; it < (D / 64) * (D / 32); it += NGW) p1_transpose_item_i8(AP_w_pq, D, D, AP_WPQ8, AP_CPARTQ, AP_WPQS, scr, it, lane); }
    for (int it = gw; it < M / 8; it += NGW) { const size_t row0 = (size_t)it * 8; const int b = (int)(row0 >> 11);
        norm_rows(AP_x, row0, 8, AP_g1, AP_MOD + b * 6 * D + 0 * D, AP_MOD + b * 6 * D + 1 * D, nullptr, lane, AP_H8, AP_HS); }
    for (int it = gw; it < MC; it += NGW) norm_rows(AP_ctx, (size_t)it, 1, AP_g1, AP_MOD + 8 * 6 * D + 0 * D, AP_MOD + 8 * 6 * D + 1 * D, nullptr, lane, AP_HC8, AP_HCS);
}
__device__ __forceinline__ void p5_norm2(const Frame& F, const Args& A) {
    const int lane = lane_id(), tid = F.wave * 64 + lane; (void)tid;
    const int gw = F.vcu * NWAVES + F.wave, NGW = F.G * NWAVES;
    for (int it = gw; it < M / 8; it += NGW) { const size_t row0 = (size_t)it * 8; const int b = (int)(row0 >> 11);
        norm_rows_b(AP_X1B, row0, 8, AP_g2, AP_MOD + b * 6 * D + 3 * D, AP_MOD + b * 6 * D + 4 * D, nullptr, lane, AP_H2Q, AP_H2S); }
}

__device__ __forceinline__ f32x4 dq4(const f32x4 a, const f32x4 cs, const float rs) {
    typedef int v4i_ __attribute__((ext_vector_type(4))); const v4i_ iv = __builtin_bit_cast(v4i_, a);
    f32x4 r; r.x = (float)iv.x; r.y = (float)iv.y; r.z = (float)iv.z; r.w = (float)iv.w; return r * cs * rs;
}
struct EpiProj {
    static constexpr bool PERM = true, AFTER_DRAIN = false;
    bf16 *Q, *Kp, *VTp, *BG, *CG, *U; const float *qn, *kn; LAS float* xch; int region0, tshift; float qscale; const float *rs, *csb;
    __device__ __forceinline__ void operator()(const f32x4 (&acc)[2][2][4][2], const pg8::Unit& u, int wr, int wc, int fr, int fq) const {
        const int region = (u.pn >> 2) + region0, pnl = u.pn & 3;
        const int rowt = wr * 64 + fr;
        f32x4 cs_[2][2]; float rsc_[2][4];
#pragma unroll
        for (int bj = 0; bj < 2; ++bj)
#pragma unroll
            for (int n = 0; n < 2; ++n) cs_[bj][n] = *(const f32x4*)(csb + u.pn * 256 + bj * 128 + 32 * wc + 8 * fq + 4 * n);
#pragma unroll
        for (int ai = 0; ai < 2; ++ai)
#pragma unroll
            for (int m = 0; m < 4; ++m) rsc_[ai][m] = rs[u.pm * 256 + ai * 128 + rowt + m * 16];
#define DQ(ai_, bj_, m_, n_) dq4(acc[ai_][bj_][m_][n_], cs_[bj_][n_], rsc_[ai_][m_])
        if (region <= 1) {
#pragma unroll
            for (int ai = 0; ai < 2; ++ai)
#pragma unroll
                for (int m = 0; m < 4; ++m)
#pragma unroll
                    for (int bj = 0; bj < 2; ++bj) { const f32x4 a = DQ(ai, bj, m, 0), b = DQ(ai, bj, m, 1);
                        float s = (a.x * a.x + a.y * a.y) + (a.z * a.z + a.w * a.w) + (b.x * b.x + b.y * b.y) + (b.z * b.z + b.w * b.w);
                        s += __shfl_xor(s, 16); s += __shfl_xor(s, 32);
                        if (fq == 0) xch[((ai * 128 + rowt + m * 16) * 2 + bj) * 4 + wc] = s; }
            asm volatile("s_waitcnt lgkmcnt(0)" ::: "memory"); __builtin_amdgcn_s_barrier(); asm volatile("" ::: "memory");
            const float* gain = (region == 0) ? qn : kn; const float mul = (region == 0) ? qscale : 1.f; bf16* O = (region == 0) ? Q : Kp;
            const f32x4 g0 = *(const f32x4*)(gain + 32 * wc + 8 * fq), g1 = *(const f32x4*)(gain + 32 * wc + 8 * fq + 4);
#pragma unroll
            for (int ai = 0; ai < 2; ++ai)
#pragma unroll
                for (int m = 0; m < 4; ++m) { const int rt = ai * 128 + rowt + m * 16; bf16* rowp = O + (size_t)(u.pm * 256 + rt) * DA + (2 * pnl) * HD + 32 * wc + 8 * fq;
#pragma unroll
                    for (int bj = 0; bj < 2; ++bj) { const f32x4 p = *(const LAS f32x4*)(xch + (rt * 2 + bj) * 4);
                        const float rstd = __builtin_amdgcn_rsqf(((p.x + p.y) + (p.z + p.w)) * (1.f / HD) + EPS) * mul;
                        const f32x4 v0 = DQ(ai, bj, m, 0) * rstd * g0, v1 = DQ(ai, bj, m, 1) * rstd * g1;
                        v4u w; w.x = pk2(v0.x, v0.y); w.y = pk2(v0.z, v0.w); w.z = pk2(v1.x, v1.y); w.w = pk2(v1.z, v1.w);
                        *(v4u*)(rowp + bj * HD) = w; } }
        } else if (region == 2) {
            const int tmask = (1 << tshift) - 1;
#pragma unroll
            for (int ai = 0; ai < 2; ++ai)
#pragma unroll
                for (int m = 0; m < 4; ++m) { const int row = u.pm * 256 + ai * 128 + rowt + m * 16; const int b = row >> tshift, t = row & tmask;
#pragma unroll
                    for (int bj = 0; bj < 2; ++bj) { const int head = 2 * pnl + bj; bf16* base = VTp + (((size_t)(b * NH + head) * HD + 32 * wc + 8 * fq) << tshift) + t;
#pragma unroll
                        for (int n = 0; n < 2; ++n) { const f32x4 a = DQ(ai, bj, m, n); const unsigned w0 = pk2(a.x, a.y), w1 = pk2(a.z, a.w);
                            base[(size_t)(4 * n + 0) << tshift] = (bf16)(w0 & 0xffffu); base[(size_t)(4 * n + 1) << tshift] = (bf16)(w0 >> 16);
                            base[(size_t)(4 * n + 2) << tshift] = (bf16)(w1 & 0xffffu); base[(size_t)(4 * n + 3) << tshift] = (bf16)(w1 >> 16); } } }
        } else {
            bf16* O = (region == 3) ? BG : (region == 4) ? CG : U;
#pragma unroll
            for (int ai = 0; ai < 2; ++ai)
#pragma unroll
                for (int m = 0; m < 4; ++m) { bf16* rowp = O + (size_t)(u.pm * 256 + ai * 128 + rowt + m * 16) * DA + pnl * 256 + 32 * wc + 8 * fq;
#pragma unroll
                    for (int bj = 0; bj < 2; ++bj) { const f32x4 v0 = DQ(ai, bj, m, 0), v1 = DQ(ai, bj, m, 1);
                        v4u w; w.x = pk2(v0.x, v0.y); w.y = pk2(v0.z, v0.w); w.z = pk2(v1.x, v1.y); w.w = pk2(v1.z, v1.w);
                        *(v4u*)(rowp + bj * HD) = w; } }
        }
#undef DQ
    }
};
struct EpiBf16 {
    static constexpr bool PERM = true, AFTER_DRAIN = false;
    bf16* O; int ldc; const float *rs, *csb;
    __device__ __forceinline__ void operator()(const f32x4 (&acc)[2][2][4][2], const pg8::Unit& u, int wr, int wc, int fr, int fq) const {
        const int row0 = u.pm * 256 + wr * 64 + fr, col0 = u.pn * 256 + wc * 32 + 8 * fq;
#pragma unroll
        for (int ai = 0; ai < 2; ++ai)
#pragma unroll
            for (int m = 0; m < 4; ++m) { bf16* rowp = O + (size_t)(row0 + ai * 128 + m * 16) * ldc + col0;
#pragma unroll
                for (int bj = 0; bj < 2; ++bj) { const float rsv = rs[row0 + ai * 128 + m * 16]; const f32x4 v0 = dq4(acc[ai][bj][m][0], *(const f32x4*)(csb + col0 + bj * 128), rsv), v1 = dq4(acc[ai][bj][m][1], *(const f32x4*)(csb + col0 + bj * 128 + 4), rsv);
                    v4u w; w.x = pk2(v0.x, v0.y); w.y = pk2(v0.z, v0.w); w.z = pk2(v1.x, v1.y); w.w = pk2(v1.z, v1.w);
                    *(v4u*)(rowp + bj * 128) = w; } }
    }
};
struct EpiRes {
    static constexpr bool PERM = true, AFTER_DRAIN = false;
    const float* base; bf16* out; const float* mod; int gofs; const float* csb; float sa;
    __device__ __forceinline__ void operator()(const f32x4 (&acc)[2][2][4][2], const pg8::Unit& u, int wr, int wc, int fr, int fq) const {
        const int row0 = u.pm * 256 + wr * 64 + fr, col0 = u.pn * 256 + wc * 32 + 8 * fq;
        const float* gp = mod + (size_t)(u.pm >> 3) * 6 * D + gofs + col0;
        f32x4 gv[2][2];
#pragma unroll
        for (int bj = 0; bj < 2; ++bj)
#pragma unroll
            for (int n = 0; n < 2; ++n) gv[bj][n] = *(const f32x4*)(gp + bj * 128 + 4 * n);
        f32x4 cs_[2][2];
#pragma unroll
        for (int bj = 0; bj < 2; ++bj)
#pragma unroll
            for (int n = 0; n < 2; ++n) cs_[bj][n] = *(const f32x4*)(csb + col0 + bj * 128 + 4 * n);
#pragma unroll
        for (int ai = 0; ai < 2; ++ai)
#pragma unroll
            for (int m = 0; m < 4; ++m) { const size_t off = (size_t)(row0 + ai * 128 + m * 16) * D + col0;
#pragma unroll
                for (int bj = 0; bj < 2; ++bj) { const f32x4 b0 = *(const f32x4*)(base + off + bj * 128), b1 = *(const f32x4*)(base + off + bj * 128 + 4);
                    const f32x4 v0 = b0 + gv[bj][0] * dq4(acc[ai][bj][m][0], cs_[bj][0], sa), v1 = b1 + gv[bj][1] * dq4(acc[ai][bj][m][1], cs_[bj][1], sa);
                    v4u w; w.x = pk2(v0.x, v0.y); w.y = pk2(v0.z, v0.w); w.z = pk2(v1.x, v1.y); w.w = pk2(v1.z, v1.w);
                    *(v4u*)(out + off + bj * 128) = w; }
                asm volatile("" ::: "memory"); }
    }
};

__device__ __forceinline__ void attn_phase(const Frame& F, const Args& A) {
    const int lane = lane_id(), tid = F.wave * 64 + lane; (void)tid;
    LAS float* bias = (LAS float*)(F.lds + XCH_OFF);
    LAS unsigned char* kl = F.lds + F.wave * 16384;
    LAS unsigned char* vl = kl + 8192;
    const int bh = F.vcu >> 2, b = bh >> 3, h = bh & 7;
    for (int i = tid; i < 15 * 31; i += NWAVES * 64) bias[i] = AP_rpb[h * 465 + i] * LOG2E;
    __syncthreads();
    const int r = 8 * (F.vcu & 3) + F.wave;
    const int rs = min(max(r - 4, 0), 24);
    const int q = lane & 31, hh = lane >> 5;
    const int l4 = lane >> 4, c16 = lane & 15, l2 = lane >> 2, g4 = lane & 3;
    const unsigned char* Kb = (const unsigned char*)(AP_K + (size_t)b * SEQ * DA + h * HD);
    const unsigned char* VTb = (const unsigned char*)(AP_VTR + (size_t)(b * NH + h) * HD * SEQ);
    const unsigned char* KCb = (const unsigned char*)(AP_KC + (size_t)b * CTXL * DA + h * HD);
    const unsigned char* VCb = (const unsigned char*)(AP_VCT + (size_t)(b * NH + h) * HD * CTXL);
    for (int qh = 0; qh < 2; ++qh) {
        const int c0 = qh ? 24 : 0, qcol = qh * 32 + q, cs = min(max(qcol - 8, 0), 48);
        const bf16* qp = AP_Q + (size_t)(b * SEQ + r * GW + qcol) * DA + h * HD + 32 * hh;
        bf16x8 qf[8];
#pragma unroll
        for (int s = 0; s < 8; ++s) qf[s] = *(const bf16x8*)(qp + 64 * (s >> 2) + 8 * (s & 3));
        f32x16 o[4];
#pragma unroll
        for (int db = 0; db < 4; ++db)
#pragma unroll
            for (int i = 0; i < 16; ++i) o[db][i] = 0.f;
        float mrun = -1e30f, lrun = 0.f;
        const int gsw = g4 ^ ((l2 >> 2) & 3);
#define ATT_KDMA(KB_) do { const int kb_ = (KB_); \
            if (kb_ < 10) { \
                _Pragma("unroll") for (int i_ = 0; i_ < 8; ++i_) { const int rho_ = 4 * i_ + l4; const int kk_ = kb_ * 32 + (4 * ((i_ >> 1) & 1) + 8 * (i_ & 1) + 16 * (i_ >> 2)) + l4, krow_ = (kk_ * 205) >> 13, kc_ = c0 + kk_ - krow_ * 40; \
                    __builtin_amdgcn_global_load_lds((const unsigned*)(Kb + (unsigned)(((rs + krow_) * GW + kc_) * (DA * 2) + 16 * (c16 ^ (rho_ & 15)))), (LAS unsigned*)(kl + i_ * 1024), 16, 0, 0); } \
            } else { \
                _Pragma("unroll") for (int i_ = 0; i_ < 8; ++i_) { const int rho_ = 4 * i_ + l4; const int l_ = (kb_ - 10) * 32 + (4 * ((i_ >> 1) & 1) + 8 * (i_ & 1) + 16 * (i_ >> 2)) + l4; \
                    __builtin_amdgcn_global_load_lds((const unsigned*)(KCb + (unsigned)(l_ * (DA * 2) + 16 * (c16 ^ (rho_ & 15)))), (LAS unsigned*)(kl + i_ * 1024), 16, 0, 0); } \
            } } while (0)
#define ATT_VDMA(KB_) do { const int kb_ = (KB_); \
            if (kb_ < 10) { \
                const int k0_ = kb_ * 32 + 8 * gsw, vr_ = (k0_ * 205) >> 13, vc_ = c0 + k0_ - vr_ * 40; const unsigned vo_ = (unsigned)((l2 * SEQ + (rs + vr_) * GW + vc_) * 2); \
                _Pragma("unroll") for (int i_ = 0; i_ < 8; ++i_) __builtin_amdgcn_global_load_lds((const unsigned*)(VTb + vo_ + (unsigned)(i_ * 16 * SEQ * 2)), (LAS unsigned*)(vl + i_ * 1024), 16, 0, 0); \
            } else { \
                const unsigned vo_ = (unsigned)((l2 * CTXL + (kb_ - 10) * 32 + 8 * gsw) * 2); \
                _Pragma("unroll") for (int i_ = 0; i_ < 8; ++i_) __builtin_amdgcn_global_load_lds((const unsigned*)(VCb + vo_ + (unsigned)(i_ * 16 * CTXL * 2)), (LAS unsigned*)(vl + i_ * 1024), 16, 0, 0); \
            } } while (0)
        asm volatile("s_waitcnt vmcnt(0) lgkmcnt(0)" ::: "memory");
        ATT_KDMA(0); ATT_VDMA(0);
        for (int kb = 0; kb < 18; ++kb) {
            const bool win = kb < 10;
            asm volatile("s_waitcnt vmcnt(8)" ::: "memory");
            bf16x8 kf[8];
#pragma unroll
            for (int s = 0; s < 8; ++s) kf[s] = *(const LAS bf16x8*)(kl + q * 256 + 16 * ((8 * (s >> 2) + 4 * hh + (s & 3)) ^ (q & 15)));
            asm volatile("s_waitcnt lgkmcnt(0)" ::: "memory");
            if (kb + 1 < 18) ATT_KDMA(kb + 1);
            f32x16 sa;
#pragma unroll
            for (int i = 0; i < 16; ++i) sa[i] = 0.f;
#pragma unroll
            for (int s = 0; s < 8; ++s) sa = __builtin_amdgcn_mfma_f32_32x32x16_bf16(kf[s], qf[s], sa, 0, 0, 0);
            if (win) {
#pragma unroll
                for (int i = 0; i < 16; ++i) {
                    const int g = kb * 4 + 2 * (i >> 3) + hh, w = (i & 3) + 4 * ((i >> 2) & 1);
                    const int krow = (g * 205) >> 10, kcol = c0 + 8 * (g - 5 * krow) + w;
                    const int dr = rs + krow - r + 7;
                    const int dc = min(max(kcol - qcol, -15), 15) + 15;
                    const bool inw = (unsigned)(kcol - cs) < 16u;
                    sa[i] = inw ? sa[i] + bias[dr * 31 + dc] : -1e30f;
                }
            }
            float bm = sa[0];
#pragma unroll
            for (int i = 1; i < 16; ++i) bm = fmaxf(bm, sa[i]);
            bm = fmaxf(bm, __shfl_xor(bm, 32));
            if (!__all(bm - mrun <= 6.0f)) {
                const float mnew = fmaxf(mrun, bm), alpha = __builtin_amdgcn_exp2f(mrun - mnew);
                mrun = mnew; lrun *= alpha;
#pragma unroll
                for (int db = 0; db < 4; ++db)
#pragma unroll
                    for (int i = 0; i < 16; ++i) o[db][i] *= alpha;
            }
            float ps = 0.f;
#pragma unroll
            for (int i = 0; i < 16; ++i) { sa[i] = __builtin_amdgcn_exp2f(sa[i] - mrun); ps += sa[i]; }
            lrun += ps;
            bf16x8 pf[2];
#pragma unroll
            for (int s2 = 0; s2 < 2; ++s2) { v4u w; w.x = pk2(sa[8 * s2 + 0], sa[8 * s2 + 1]); w.y = pk2(sa[8 * s2 + 2], sa[8 * s2 + 3]); w.z = pk2(sa[8 * s2 + 4], sa[8 * s2 + 5]); w.w = pk2(sa[8 * s2 + 6], sa[8 * s2 + 7]); pf[s2] = __builtin_bit_cast(bf16x8, w); }
            if (kb + 1 < 18) asm volatile("s_waitcnt vmcnt(8)" ::: "memory"); else asm volatile("s_waitcnt vmcnt(0)" ::: "memory");
            bf16x8 vf[4][2];
#pragma unroll
            for (int db = 0; db < 4; ++db) { const int dd = db * 32 + q;
                vf[db][0] = *(const LAS bf16x8*)(vl + dd * 64 + 16 * ((0 + hh) ^ ((dd >> 2) & 3))); vf[db][1] = *(const LAS bf16x8*)(vl + dd * 64 + 16 * ((2 + hh) ^ ((dd >> 2) & 3))); }
            asm volatile("s_waitcnt lgkmcnt(0)" ::: "memory");
            if (kb + 1 < 18) ATT_VDMA(kb + 1);
#pragma unroll
            for (int db = 0; db < 4; ++db) { o[db] = __builtin_amdgcn_mfma_f32_32x32x16_bf16(vf[db][0], pf[0], o[db], 0, 0, 0); o[db] = __builtin_amdgcn_mfma_f32_32x32x16_bf16(vf[db][1], pf[1], o[db], 0, 0, 0); }
        }
#undef ATT_KDMA
#undef ATT_VDMA
        const float ltot = lrun + __shfl_xor(lrun, 32), inv = 1.f / ltot;
        float ss = 0.f;
#pragma unroll
        for (int db = 0; db < 4; ++db)
#pragma unroll
            for (int i = 0; i < 16; ++i) { o[db][i] *= inv; ss += o[db][i] * o[db][i]; }
        ss += __shfl_xor(ss, 32);
        const float rstd = __builtin_amdgcn_rsqf(ss * (1.f / HD) + EPS);
        unsigned char* op = AP_A28 + (size_t)(b * SEQ + r * GW + qcol) * D + h * HD + 4 * hh;
        const float* gp = AP_gao + h * HD + 4 * hh; const float rq = rstd * A2_INV;
#pragma unroll
        for (int db = 0; db < 4; ++db)
#pragma unroll
            for (int i4 = 0; i4 < 4; ++i4) { const f32x4 g = *(const f32x4*)(gp + db * 32 + 8 * i4);
                f32x4 y; y.x = o[db][4 * i4 + 0] * g.x; y.y = o[db][4 * i4 + 1] * g.y; y.z = o[db][4 * i4 + 2] * g.z; y.w = o[db][4 * i4 + 3] * g.w;
                *(unsigned*)(op + db * 32 + 8 * i4) = q4(y, rq); }
    }
    __syncthreads();
}

__device__ __forceinline__ void unpack16(const v4u a, const v4u b, float (&f)[16]) {
    f[0] = bflo(a.x); f[1] = bfhi(a.x); f[2] = bflo(a.y); f[3] = bfhi(a.y); f[4] = bflo(a.z); f[5] = bfhi(a.z); f[6] = bflo(a.w); f[7] = bfhi(a.w);
    f[8] = bflo(b.x); f[9] = bfhi(b.x); f[10] = bflo(b.y); f[11] = bfhi(b.y); f[12] = bflo(b.z); f[13] = bfhi(b.z); f[14] = bflo(b.w); f[15] = bfhi(b.w);
}
__device__ __forceinline__ void load_z(const bf16* CGp, const bf16* Up, size_t m, int lane, float (&z)[16]) {
    const v4u* cp = (const v4u*)(CGp + m * DA + 16 * lane); const v4u* up = (const v4u*)(Up + m * DA + 16 * lane);
    const v4u c0 = cp[0], c1 = cp[1], u0 = up[0], u1 = up[1];
    float cf[16], uf[16]; unpack16(c0, c1, cf); unpack16(u0, u1, uf);
#pragma unroll
    for (int i = 0; i < 16; ++i) z[i] = cf[i] * uf[i];
}
__device__ __forceinline__ void conv_phase(const Frame& F, const Args& A) {
    const int lane = lane_id(), tid = F.wave * 64 + lane; (void)tid;
    const int gw = F.vcu * NWAVES + F.wave, NGW = F.G * NWAVES;
    float w0[16], w1[16], w2[16], gg[16];
#pragma unroll
    for (int i = 0; i < 16; ++i) { w0[i] = AP_w_conv[0 * DA + 16 * lane + i]; w1[i] = AP_w_conv[1 * DA + 16 * lane + i]; w2[i] = AP_w_conv[2 * DA + 16 * lane + i]; gg[i] = AP_gco[16 * lane + i]; }
    for (int it = gw; it < M / 8; it += NGW) {
        const size_t m0 = (size_t)it * 8;
        float zp[16], zc[16], zn[16];
        if ((m0 & (SEQ - 1)) == 0) {
#pragma unroll
            for (int i = 0; i < 16; ++i) zp[i] = 0.f;
        } else load_z(AP_CG, AP_U, m0 - 1, lane, zp);
        load_z(AP_CG, AP_U, m0, lane, zc);
        for (int j = 0; j < 8; ++j) {
            const size_t m = m0 + j;
            if ((m & (SEQ - 1)) == SEQ - 1) {
#pragma unroll
                for (int i = 0; i < 16; ++i) zn[i] = 0.f;
            } else load_z(AP_CG, AP_U, m + 1, lane, zn);
            const v4u* bp = (const v4u*)(AP_BG + m * DA + 16 * lane); const v4u b0 = bp[0], b1 = bp[1];
            float bf[16]; unpack16(b0, b1, bf);
            float y[16], ss = 0.f;
#pragma unroll
            for (int i = 0; i < 16; ++i) { y[i] = bf[i] * (w0[i] * zp[i] + w1[i] * zc[i] + w2[i] * zn[i]); ss += y[i] * y[i]; }
            ss += __shfl_xor(ss, 1); ss += __shfl_xor(ss, 2); ss += __shfl_xor(ss, 4);
            const float rstd = __builtin_amdgcn_rsqf(ss * (1.f / 128.f) + EPS);
            const float rq = rstd * A2_INV; v4u o0;
            { f32x4 t0 = {y[0] * gg[0], y[1] * gg[1], y[2] * gg[2], y[3] * gg[3]}, t1 = {y[4] * gg[4], y[5] * gg[5], y[6] * gg[6], y[7] * gg[7]};
              f32x4 t2 = {y[8] * gg[8], y[9] * gg[9], y[10] * gg[10], y[11] * gg[11]}, t3 = {y[12] * gg[12], y[13] * gg[13], y[14] * gg[14], y[15] * gg[15]};
              o0.x = q4(t0, rq); o0.y = q4(t1, rq); o0.z = q4(t2, rq); o0.w = q4(t3, rq); }
            *(v4u*)(AP_A28 + m * D + DA + 16 * lane) = o0;
#pragma unroll
            for (int i = 0; i < 16; ++i) { zp[i] = zc[i]; zc[i] = zn[i]; }
        }
    }
}

__device__ __forceinline__ unsigned f2key(float f) { const unsigned u = __builtin_bit_cast(unsigned, f); return (u & 0x80000000u) ? ~u : (u | 0x80000000u); }
__device__ __forceinline__ float key2f(unsigned k) { const unsigned u = (k & 0x80000000u) ? (k & 0x7fffffffu) : ~k; return __builtin_bit_cast(float, u); }
__device__ __forceinline__ void ce_desc(unsigned& a, unsigned& b) { const unsigned hi = max(a, b), lo = min(a, b); a = hi; b = lo; }
template <int BASE> __device__ __forceinline__ void sort16_desc(unsigned (&v)[64]) {
#pragma unroll
    for (int k = 2; k <= 16; k <<= 1)
#pragma unroll
        for (int j = k >> 1; j >= 1; j >>= 1)
#pragma unroll
            for (int i = 0; i < 16; ++i) { const int l = i ^ j; if (l > i) { if ((i & k) == 0) ce_desc(v[BASE + i], v[BASE + l]); else ce_desc(v[BASE + l], v[BASE + i]); } }
}
template <int A_, int B_> __device__ __forceinline__ void merge_top16(unsigned (&v)[64]) {
#pragma unroll
    for (int i = 0; i < 16; ++i) v[A_ + i] = max(v[A_ + i], v[B_ + 15 - i]);
#pragma unroll
    for (int j = 8; j >= 1; j >>= 1)
#pragma unroll
        for (int i = 0; i < 16; ++i) { const int l = i ^ j; if (l > i) ce_desc(v[A_ + i], v[A_ + l]); }
}
__device__ __forceinline__ void top16_of_64(unsigned (&v)[64]) {
    sort16_desc<0>(v); sort16_desc<16>(v); sort16_desc<32>(v); sort16_desc<48>(v);
    merge_top16<0, 16>(v); merge_top16<32, 48>(v); merge_top16<0, 32>(v);
}
__device__ __forceinline__ void peer_select_phase(const Frame& F, const Args& A) {
    const int lane = lane_id(), tid = F.wave * 64 + lane; (void)tid;
    const int gw = F.vcu * NWAVES + F.wave, NGW = F.G * NWAVES, tk = lane & 31, hh = lane >> 5;
    LAS unsigned char* qimg = F.lds + F.wave * 16384;
    LAS unsigned char* kimg = qimg + 8192;
    LAS int* ixs = (LAS int*)qimg;
    const int l4 = lane >> 4, c16 = lane & 15;
    unsigned nh4 = (unsigned)(1 - hh) << 2; asm volatile("" : "+v"(nh4));
    for (int task = gw; task < (M / 32) * PH; task += NGW) {
        const int h = task & 7, tb = task >> 3; const int token = tb * 32 + tk;
        unsigned best[2][16];
#pragma unroll
        for (int p = 0; p < 2; ++p) {
            const unsigned char* qsrc = (const unsigned char*)(AP_QP + (size_t)(tb * 32) * D + h * 256 + p * 128);
            const unsigned char* ksrc = (const unsigned char*)(AP_SK + (size_t)((h * 2 + p) * NKEYS) * 128);
            unsigned bq = (unsigned)(l4 * (D * 2) + 16 * (c16 ^ l4)), bk = (unsigned)(l4 * 256 + 16 * (c16 ^ l4));
            asm volatile("s_waitcnt vmcnt(0) lgkmcnt(0)" : "+v"(bq), "+v"(bk) : : "memory");
#pragma unroll
            for (int i = 0; i < 8; ++i) __builtin_amdgcn_global_load_lds((const unsigned*)(qsrc + ((bq ^ (unsigned)(64 * (i & 3))) + (unsigned)(i * 4 * D * 2))), (LAS unsigned*)(qimg + i * 1024), 16, 0, 0);
#define PS_KDMA(KB_) do { _Pragma("unroll") for (int i_ = 0; i_ < 8; ++i_) \
                __builtin_amdgcn_global_load_lds((const unsigned*)(ksrc + ((bk ^ (unsigned)(64 * (i_ & 3))) + (unsigned)((KB_) * 8192 + i_ * 1024))), (LAS unsigned*)(kimg + i_ * 1024), 16, 0, 0); } while (0)
            PS_KDMA(0);
            asm volatile("s_waitcnt vmcnt(8)" ::: "memory");
            bf16x8 qf[8];
#pragma unroll
            for (int s = 0; s < 8; ++s) qf[s] = *(const LAS bf16x8*)(qimg + tk * 256 + 16 * ((8 * (s >> 2) + 4 * hh + (s & 3)) ^ (tk & 15)));
            unsigned ky[64];
#pragma unroll
            for (int kb = 0; kb < 4; ++kb) {
                asm volatile("s_waitcnt vmcnt(0)" ::: "memory");
                bf16x8 kf[8];
#pragma unroll
                for (int s = 0; s < 8; ++s) kf[s] = *(const LAS bf16x8*)(kimg + tk * 256 + 16 * ((8 * (s >> 2) + 4 * hh + (s & 3)) ^ (tk & 15)));
                asm volatile("s_waitcnt lgkmcnt(0)" ::: "memory");
                if (kb < 3) PS_KDMA(kb + 1);
                f32x16 sa;
#pragma unroll
                for (int i = 0; i < 16; ++i) sa[i] = 0.f;
#pragma unroll
                for (int s = 0; s < 8; ++s) sa = __builtin_amdgcn_mfma_f32_32x32x16_bf16(kf[s], qf[s], sa, 0, 0, 0);
#pragma unroll
                for (int i = 0; i < 16; ++i) { const unsigned ck = (unsigned)(127 - (kb * 32 + (i & 3) + 8 * (i >> 2))) & ~4u;
                    ky[kb * 16 + i] = ((f2key(sa[i]) & ~127u) | nh4) | ck; }
                asm volatile("" ::: "memory");
            }
#undef PS_KDMA
            top16_of_64(ky);
#pragma unroll
            for (int i = 0; i < 16; ++i) ky[16 + i] = (unsigned)__shfl_xor((int)ky[i], 32);
            merge_top16<0, 16>(ky);
#pragma unroll
            for (int i = 0; i < 16; ++i) best[p][i] = ky[i];
        }
        float s1[16], s2[16];
#pragma unroll
        for (int i = 0; i < 16; ++i) { s1[i] = key2f(best[0][i] & ~127u); s2[i] = key2f(best[1][i] & ~127u);
            ixs[i * 64 + lane] = 127 - (int)(best[0][i] & 127u); ixs[(16 + i) * 64 + lane] = 127 - (int)(best[1][i] & 127u); }
        unsigned cd[64]; { int n = 0;
#pragma unroll
            for (int i = 0; i < 16; ++i)
#pragma unroll
                for (int j = 0; j < 16; ++j) if ((i + 1) * (j + 1) <= 16) { cd[n] = (f2key(s1[i] + s2[j]) & ~255u) | (unsigned)(255 - (16 * i + j)); ++n; }
#pragma unroll
            for (int i = 50; i < 64; ++i) cd[i] = 0u; }
        top16_of_64(cd);
        unsigned win[16];
#pragma unroll
        for (int i = 0; i < 16; ++i) win[i] = cd[i];
        LDS_WAIT();
        const float vmax = key2f(win[0] & ~255u);
        float ev[16], es = 0.f;
#pragma unroll
        for (int rnd = 0; rnd < 16; ++rnd) { ev[rnd] = __expf(key2f(win[rnd] & ~255u) - vmax); es += ev[rnd]; }
        const float ies = 1.f / es;
        if (hh == 0) {
            int* ip = AP_SELI + (size_t)token * 128 + h * 16; float* gp = AP_SELG + (size_t)token * 128 + h * 16;
#pragma unroll
            for (int rnd = 0; rnd < 16; ++rnd) { const int pos = 255 - (int)(win[rnd] & 255u); const int i1 = ixs[(pos >> 4) * 64 + lane], i2 = ixs[(16 + (pos & 15)) * 64 + lane];
                ip[rnd] = i1 * NKEYS + i2; gp[rnd] = ev[rnd] * ies; }
        }
        LDS_WAIT();
    }
}

typedef int v4i __attribute__((ext_vector_type(4)));
__device__ __forceinline__ float gelu_as(const float v) {
    const float av = fabsf(v), t = __builtin_amdgcn_rcpf(av * 0.2316418882f + 1.0f);
    float q = t * 0.5307027145f + (-0.7265760135f); q = q * t + 0.7107068705f; q = q * t + (-0.142248368f); q = q * t + 0.127414796f; q = q * t;
    const float e = __builtin_amdgcn_exp2f((v * v) * (-0.72134752044f));
    const float m = v * (q * e);
    return v < 0.f ? m : v - m;
}
constexpr int PL_WAVE = 16384, PL_EL = 8192, PL_PACC = 10240, PL_AQ = 14336, PL_SA = 15360;
__device__ __forceinline__ float wave_maxf(float v) {
#pragma unroll
    for (int o = 1; o < 64; o <<= 1) v = fmaxf(v, __shfl_xor(v, o));
    return v;
}
__device__ __forceinline__ void peer_u_phase(const Frame& F, const Args& A, float (&sa)[8]) {
    const int lane = lane_id(), p = lane >> 2, sub = lane & 3;
    LAS unsigned short* elist = (LAS unsigned short*)(F.lds + F.wave * PL_WAVE + PL_EL);
    LAS int* pacc = (LAS int*)(F.lds + F.wave * PL_WAVE + PL_PACC);
    LAS signed char* aq = (LAS signed char*)(F.lds + F.wave * PL_WAVE + PL_AQ);
    const int tok0 = F.vcu * 64 + F.wave * 8;
    for (int it = 0; it < 16; ++it) { elist[it * 64 + lane] = (unsigned short)AP_SELI[(size_t)tok0 * 128 + it * 64 + lane]; pacc[it * 64 + lane] = 0; }
    LDS_WAIT();
    v4u G0[4], G1[4], G2[4], G3[4], hreg[2];
    const unsigned char* ub = AP_U8 + 16 * sub;
    LAS unsigned char* hst = F.lds + F.wave * PL_WAVE;
#define PU_LOAD(G_, K_) do { const int kg_ = (K_), tp_ = kg_ & 31; const unsigned ea_ = elist[(2 * tp_) * 16 + p], eb_ = elist[(2 * tp_ + 1) * 16 + p]; \
            const unsigned char* ua_ = ub + (size_t)ea_ * D + 128 * (kg_ >> 5); const unsigned char* ubb_ = ub + (size_t)eb_ * D + 128 * (kg_ >> 5); \
            G_[0] = *(const v4u*)(ua_); G_[1] = *(const v4u*)(ua_ + 64); G_[2] = *(const v4u*)(ubb_); G_[3] = *(const v4u*)(ubb_ + 64); } while (0)
#define PU_DOT8(A0_, A1_) ([&]() { int d0_ = 0, d1_ = 0, d2_ = 0, d3_ = 0; \
            d0_ = __builtin_amdgcn_sdot4((int)(A0_).x, (int)hreg[0].x, d0_, false); d1_ = __builtin_amdgcn_sdot4((int)(A0_).y, (int)hreg[0].y, d1_, false); \
            d2_ = __builtin_amdgcn_sdot4((int)(A0_).z, (int)hreg[0].z, d2_, false); d3_ = __builtin_amdgcn_sdot4((int)(A0_).w, (int)hreg[0].w, d3_, false); \
            d0_ = __builtin_amdgcn_sdot4((int)(A1_).x, (int)hreg[1].x, d0_, false); d1_ = __builtin_amdgcn_sdot4((int)(A1_).y, (int)hreg[1].y, d1_, false); \
            d2_ = __builtin_amdgcn_sdot4((int)(A1_).z, (int)hreg[1].z, d2_, false); d3_ = __builtin_amdgcn_sdot4((int)(A1_).w, (int)hreg[1].w, d3_, false); \
            int v_ = (d0_ + d1_) + (d2_ + d3_); \
            v_ += __builtin_amdgcn_update_dpp(0, v_, 0xB1, 0xf, 0xf, true); v_ += __builtin_amdgcn_update_dpp(0, v_, 0x4E, 0xf, 0xf, true); return v_; }())
#define PU_COMPUTE(G_, TP_) do { const int va_ = PU_DOT8(G_[0], G_[1]), vb_ = PU_DOT8(G_[2], G_[3]); \
            if (sub == 0) { (void)__hip_atomic_fetch_add(pacc + (2 * (TP_)) * 16 + p, va_, __ATOMIC_RELAXED, __HIP_MEMORY_SCOPE_WORKGROUP); \
                            (void)__hip_atomic_fetch_add(pacc + (2 * (TP_) + 1) * 16 + p, vb_, __ATOMIC_RELAXED, __HIP_MEMORY_SCOPE_WORKGROUP); } } while (0)
    PU_LOAD(G0, 0); PU_LOAD(G1, 1); PU_LOAD(G2, 2); PU_LOAD(G3, 3);
    for (int slice = 0; slice < 16; ++slice) {
        { const int tk_ = lane >> 3, pc_ = lane & 7;
          *(LAS v4u*)(hst + tk_ * 128 + 16 * pc_) = *(const v4u*)(AP_H2Q + (size_t)(tok0 + tk_) * D + 128 * slice + 16 * pc_); }
        for (int tk = 0; tk < 8; ++tk) {
            hreg[0] = *(const LAS v4u*)(hst + tk * 128 + 16 * sub); hreg[1] = *(const LAS v4u*)(hst + tk * 128 + 64 + 16 * sub);
            { const int tp = tk * 4, k = slice * 32 + tp;
                PU_COMPUTE(G0, tp);     PU_LOAD(G0, (k + 4) & 511);
                PU_COMPUTE(G1, tp + 1); PU_LOAD(G1, (k + 5) & 511);
                PU_COMPUTE(G2, tp + 2); PU_LOAD(G2, (k + 6) & 511);
                PU_COMPUTE(G3, tp + 3); PU_LOAD(G3, (k + 7) & 511);
            }
        }
        if ((slice & 3) == 3) __builtin_amdgcn_s_barrier();
    }
#undef PU_LOAD
#undef PU_COMPUTE
#undef PU_DOT8
    LDS_WAIT();
#pragma unroll
    for (int t = 0; t < 8; ++t) { const int token = tok0 + t; const float hs = AP_H2S[token]; float av[2];
#pragma unroll
        for (int hf = 0; hf < 2; ++hf) { const int p = t * 128 + hf * 64 + lane; const unsigned e = elist[p];
            av[hf] = gelu_as((float)pacc[p] * AP_SU[e] * hs) * AP_SELG[(size_t)tok0 * 128 + p] * AP_SV[e]; }
        const float mx = fmaxf(wave_maxf(fmaxf(fabsf(av[0]), fabsf(av[1]))), 1e-30f), inv = 127.f / mx;
        aq[t * 128 + lane] = (signed char)(int)__builtin_rintf(av[0] * inv); aq[t * 128 + 64 + lane] = (signed char)(int)__builtin_rintf(av[1] * inv);
        sa[t] = mx * (1.f / 127.f); }
    LDS_WAIT();
}
__device__ __forceinline__ void peer_v_phase(const Frame& F, const Args& A, const float (&sa)[8]) {
    const int lane = lane_id(), n = lane & 15, kq = lane >> 4, rr = n >> 2, cc = n & 3;
    LAS unsigned char* buf = F.lds + F.wave * PL_WAVE;
    const LAS unsigned short* elist = (const LAS unsigned short*)(F.lds + F.wave * PL_WAVE + PL_EL);
    const LAS signed char* aq = (const LAS signed char*)(F.lds + F.wave * PL_WAVE + PL_AQ);
    const int tok0 = F.vcu * 64 + F.wave * 8;
    const int fsw = (rr >> 1) | ((kq & 1) << 1);
    const unsigned trbase = (unsigned)(size_t)buf + (unsigned)((8 * kq + rr) * 128 + 8 * cc);
    const int r0 = lane >> 3, c8 = lane & 7;
    v4u G0[4], G1[4], G2[4], G3[4];
    v4i accE[4], accO[4];
#pragma unroll
    for (int q = 0; q < 4; ++q) { accE[q] = (v4i){0, 0, 0, 0}; accO[q] = (v4i){0, 0, 0, 0}; }
#define PV_EREAD(K_) do { const int ke_ = (K_); _Pragma("unroll") for (int i_ = 0; i_ < 4; ++i_) en[i_] = elist[(ke_ & 31) * 32 + 8 * i_ + r0]; } while (0)
#define PV_LOAD(G_, K_) do { const int kg_ = (K_); _Pragma("unroll") for (int i_ = 0; i_ < 4; ++i_) { const unsigned e_ = en[i_]; \
            const int f_ = ((r0 >> 1) & 1) | ((i_ & 1) << 1); \
            G_[i_] = *(const v4u*)(AP_V8 + (size_t)e_ * D + 128 * (kg_ >> 5) + 32 * ((c8 >> 1) ^ f_) + 16 * (c8 & 1)); } } while (0)
#define PV_STORE(G_, B_) do { _Pragma("unroll") for (int i_ = 0; i_ < 4; ++i_) *(LAS v4u*)(buf + (B_) * 4096 + i_ * 1024 + lane * 16) = G_[i_]; } while (0)
#define PV_TR(B_) do { const unsigned tb_ = trbase + (unsigned)((B_) * 4096); \
            const unsigned t0_ = tb_ + 32u * (unsigned)(0 ^ fsw), t1_ = tb_ + 32u * (unsigned)(1 ^ fsw), t2_ = tb_ + 32u * (unsigned)(2 ^ fsw), t3_ = tb_ + 32u * (unsigned)(3 ^ fsw); \
            asm volatile("s_waitcnt lgkmcnt(0)\n\t" \
                         "ds_read_b64_tr_b16 %0, %8\n\tds_read_b64_tr_b16 %1, %8 offset:512\n\tds_read_b64_tr_b16 %2, %9\n\tds_read_b64_tr_b16 %3, %9 offset:512\n\t" \
                         "ds_read_b64_tr_b16 %4, %10\n\tds_read_b64_tr_b16 %5, %10 offset:512\n\tds_read_b64_tr_b16 %6, %11\n\tds_read_b64_tr_b16 %7, %11 offset:512" \
                         : "=&v"(RR[0][0]), "=&v"(RR[0][1]), "=&v"(RR[1][0]), "=&v"(RR[1][1]), "=&v"(RR[2][0]), "=&v"(RR[2][1]), "=&v"(RR[3][0]), "=&v"(RR[3][1]) : "v"(t0_), "v"(t1_), "v"(t2_), "v"(t3_) : "memory"); } while (0)
#define PV_MMA(K_) do { const int kc_ = (K_), b_ = kc_ & 31; \
            v2u a8_ = *(const LAS v2u*)(aq + b_ * 32 + 8 * kq);                        \
            if (n != (b_ >> 2)) a8_ = (v2u){0u, 0u};                                  \
            v4i AE_, AO_; \
            AE_.x = (int)__builtin_amdgcn_perm(0u, a8_.x, 0x0c010c00u); AE_.y = (int)__builtin_amdgcn_perm(0u, a8_.x, 0x0c030c02u); AE_.z = (int)__builtin_amdgcn_perm(0u, a8_.y, 0x0c010c00u); AE_.w = (int)__builtin_amdgcn_perm(0u, a8_.y, 0x0c030c02u); \
            AO_.x = (int)__builtin_amdgcn_perm(0u, a8_.x, 0x010c000cu); AO_.y = (int)__builtin_amdgcn_perm(0u, a8_.x, 0x030c020cu); AO_.z = (int)__builtin_amdgcn_perm(0u, a8_.y, 0x010c000cu); AO_.w = (int)__builtin_amdgcn_perm(0u, a8_.y, 0x030c020cu); \
            asm volatile("s_waitcnt lgkmcnt(0)" : "+v"(RR[0][0]), "+v"(RR[0][1]), "+v"(RR[1][0]), "+v"(RR[1][1]), "+v"(RR[2][0]), "+v"(RR[2][1]), "+v"(RR[3][0]), "+v"(RR[3][1]) : : "memory"); \
            _Pragma("unroll") for (int q_ = 0; q_ < 4; ++q_) { const v4i Bq_ = {(int)RR[q_][0].x, (int)RR[q_][0].y, (int)RR[q_][1].x, (int)RR[q_][1].y}; \
                accE[q_] = __builtin_amdgcn_mfma_i32_16x16x64_i8(AE_, Bq_, accE[q_], 0, 0, 0); \
                accO[q_] = __builtin_amdgcn_mfma_i32_16x16x64_i8(AO_, Bq_, accO[q_], 0, 0, 0); } } while (0)
    v2u RR[4][2]; unsigned en[4];
    PV_EREAD(0); PV_LOAD(G0, 0); PV_EREAD(1); PV_LOAD(G1, 1); PV_EREAD(2); PV_LOAD(G2, 2); PV_EREAD(3); PV_LOAD(G3, 3); PV_EREAD(4); PV_STORE(G0, 0);
    for (int slice = 0; slice < 16; ++slice) {
        for (int k = slice * 32; k < slice * 32 + 32; k += 4) {
            PV_TR(0); PV_STORE(G1, 1); PV_LOAD(G0, (k + 4) & 511); PV_EREAD((k + 5) & 511); PV_MMA(k);
            PV_TR(1); PV_STORE(G2, 0); PV_LOAD(G1, (k + 5) & 511); PV_EREAD((k + 6) & 511); PV_MMA(k + 1);
            PV_TR(0); PV_STORE(G3, 1); PV_LOAD(G2, (k + 6) & 511); PV_EREAD((k + 7) & 511); PV_MMA(k + 2);
            PV_TR(1); PV_STORE(G0, 0); PV_LOAD(G3, (k + 7) & 511); PV_EREAD((k + 8) & 511); PV_MMA(k + 3);
        }
        if (kq < 2) {
#pragma unroll
            for (int i = 0; i < 4; ++i) { const int token = tok0 + 4 * kq + i; const float sat = kq ? sa[4 + i] : sa[i];
                const float* gtp = AP_MOD + (size_t)(token >> 11) * 6 * D + 5 * D + 128 * slice + 2 * n; float* op = AP_out + (size_t)token * D + 128 * slice + 2 * n;
                const bf16* xp = AP_X1B + (size_t)token * D + 128 * slice + 2 * n;
#pragma unroll
                for (int q = 0; q < 4; ++q) { typedef float f32x2t __attribute__((ext_vector_type(2)));
                    const unsigned xw = *(const unsigned*)(xp + 32 * q); const f32x2t g0 = *(const f32x2t*)(gtp + 32 * q);
                    f32x2t rv; rv.x = bflo(xw) + g0.x * (sat * (float)accE[q][i]); rv.y = bfhi(xw) + g0.y * (sat * (float)accO[q][i]);
                    *(f32x2t*)(op + 32 * q) = rv; } }
        }
#pragma unroll
        for (int q = 0; q < 4; ++q) { accE[q] = (v4i){0, 0, 0, 0}; accO[q] = (v4i){0, 0, 0, 0}; }
        if ((slice & 1) == 1) __builtin_amdgcn_s_barrier();
    }
#undef PV_TR
#undef PV_MMA
#undef PV_LOAD
#undef PV_EREAD
#undef PV_STORE

}
__device__ __forceinline__ void peer_eval_phase(const Frame& F, const Args& A) { float sa[8]; peer_u_phase(F, A, sa); peer_v_phase(F, A, sa); }

template <bool FUSED, int ONLY>
__global__ void __launch_bounds__(NWAVES * 64, 2) mk_fwd(Args args) {
    extern __shared__ __attribute__((aligned(16))) unsigned char lds[];
    Frame F;
    F.lds = (LAS unsigned char*)lds;
    F.wave = __builtin_amdgcn_readfirstlane((int)threadIdx.x >> 6);
    F.G = gridDim.x; { const int bx = blockIdx.x; F.vcu = (F.G % 8 == 0) ? (bx % 8) * (F.G / 8) + bx / 8 : bx; }
    const Args& A = args;
    const int lo = (ONLY >= 0) ? ONLY : args.ph_lo, hi = (ONLY >= 0) ? ONLY + 1 : args.ph_hi;
#define IN(k) ((ONLY < 0 || ONLY == (k)) && lo <= (k) && (k) < hi)
    XcdBarrier bar; bar.bar = (unsigned*)(args.ws + WS_CTL); bar.x = 0; bar.st = (volatile LAS unsigned*)(F.lds + MISC_OFF);
    if constexpr (FUSED) {
        if (MK_CG_SYNC) cg::this_grid().sync();
        bar.x = xb_xcc_id();
        if (F.wave == 0 && lane_id() == 0) { bar.st[0] = 0u; bar.st[1] = 0u; (void)xb_add(&bar.bar[XB_XCNT(bar.x)], 1u); }
        __syncthreads();
    }
#define SEAM(k) do { if (FUSED && IN(k) && IN((k) + 1)) { xcd_barrier(bar, F.wave, (unsigned)F.G); } } while (0)

    if (IN(0)) { p0_prologue(F, A); } SEAM(0);
    if (IN(1)) { p1_norm1(F, A); } SEAM(1);
    if (IN(2)) {
        { pg8::Gemm g{(const bf16*)AP_H8, (const bf16*)AP_WIN8, M, NPROJ, D / 2}; pg8::StaticOrder S; S.init(M, NPROJ, F.G, (int)blockIdx.x);
          EpiProj E{AP_Q, AP_K, AP_VTR, AP_BG, AP_CG, AP_U, AP_qn, AP_kn, (LAS float*)(F.lds + XCH_OFF), 0, 11, 0.08838834764831845f * LOG2E, AP_HS, AP_WINS};
          pg8::gemm_phase<EpiProj, pg8::StaticOrder, true, true, true>(F.lds, g, S, E, F.wave); }
        { pg8::Gemm g{(const bf16*)AP_HC8, (const bf16*)(AP_WIN8 + (size_t)DA * D), MC, 2 * DA, D / 2}; pg8::StaticOrder S; S.init(MC, 2 * DA, F.G, (int)blockIdx.x);
          EpiProj E{nullptr, AP_KC, AP_VCT, nullptr, nullptr, nullptr, AP_qn, AP_kn, (LAS float*)(F.lds + XCH_OFF), 1, 8, 1.f, AP_HCS, AP_WINS + DA};
          pg8::gemm_phase<EpiProj, pg8::StaticOrder, true, true, true>(F.lds, g, S, E, F.wave); }
    } SEAM(2);
    if (IN(3)) { attn_phase(F, A); conv_phase(F, A); } SEAM(3);
    if (IN(4)) { pg8::Gemm g{(const bf16*)AP_A28, (const bf16*)AP_WOUT8, M, D, D / 2}; pg8::StaticOrder S; S.init(M, D, F.G, (int)blockIdx.x);
        EpiRes E{AP_x, AP_X1B, AP_MOD, 2 * D, AP_WOUTS, A2_SCALE};
        pg8::gemm_phase<EpiRes, pg8::StaticOrder, true, true, true>(F.lds, g, S, E, F.wave); } SEAM(4);
    if (IN(5)) { p5_norm2(F, A); } SEAM(5);
    if (IN(6)) { pg8::Gemm g{(const bf16*)AP_H2Q, (const bf16*)AP_WPQ8, M, D, D / 2}; pg8::StaticOrder S; S.init(M, D, F.G, (int)blockIdx.x);
        EpiBf16 E{AP_QP, D, AP_H2S, AP_WPQS};
        pg8::gemm_phase<EpiBf16, pg8::StaticOrder, true, true, true>(F.lds, g, S, E, F.wave); } SEAM(6);
    if (IN(7)) { peer_select_phase(F, A); } SEAM(7);
    if (IN(8)) { peer_eval_phase(F, A); }
#undef IN
#undef SEAM
}

template <int PHS> static bool set_lds() { return hipFuncSetAttribute((const void*)mk_fwd<false, PHS>, hipFuncAttributeMaxDynamicSharedMemorySize, LDS_BYTES) == hipSuccess; }
template <int PHS> static void launch_one(int grid, hipStream_t stream, const Args& a) {
    hipLaunchKernelGGL((mk_fwd<false, PHS>), dim3(grid), dim3(NWAVES * 64), LDS_BYTES, stream, a);
    const hipError_t le = hipPeekAtLastError();
    if (le != hipSuccess) fprintf(stderr, "kernel_launch: launch %d failed: %s\n", PHS, hipGetErrorName(le));
}
extern "C" void kernel_launch(void* const* d_in, const int* in_sizes, int n_in, void* d_out, int out_size, void* d_ws, size_t ws_size, hipStream_t stream) {
    constexpr bool FUSED = (MK_N_LAUNCHES == 1);
    static int grid = 0;
    if (grid == 0) {
        if (n_in != 20 || in_sizes[0] != M * D || out_size != M * D || ws_size < WS_END) { fprintf(stderr, "kernel_launch: unexpected shapes (n_in %d, in0 %d, out %d, ws %zu < %zu); nothing launched\n", n_in, n_in > 0 ? in_sizes[0] : -1, out_size, ws_size, (size_t)WS_END); grid = -1; return; }
        int dev = 0, cus = 0, per_cu = 0;
        if (hipGetDevice(&dev) != hipSuccess || hipDeviceGetAttribute(&cus, hipDeviceAttributeMultiprocessorCount, dev) != hipSuccess) { grid = -1; return; }
        bool okattr = true;
        if constexpr (FUSED) okattr = hipFuncSetAttribute((const void*)mk_fwd<true, -1>, hipFuncAttributeMaxDynamicSharedMemorySize, LDS_BYTES) == hipSuccess;
        else { okattr &= set_lds<0>(); okattr &= set_lds<1>(); okattr &= set_lds<2>(); okattr &= set_lds<3>(); okattr &= set_lds<4>(); okattr &= set_lds<5>(); okattr &= set_lds<6>(); okattr &= set_lds<7>(); okattr &= set_lds<8>(); }
        if (!okattr) { fprintf(stderr, "kernel_launch: hipFuncSetAttribute failed\n"); grid = -1; return; }
        if (hipOccupancyMaxActiveBlocksPerMultiprocessor(&per_cu, (const void*)mk_fwd<FUSED, (FUSED ? -1 : 2)>, NWAVES * 64, LDS_BYTES) != hipSuccess || per_cu < 1) { fprintf(stderr, "kernel_launch: occupancy query says %d blocks per CU; nothing launched\n", per_cu); grid = -1; return; }
        (void)hipGetLastError();
        grid = cus;
        if (grid != 256) fprintf(stderr, "kernel_launch: note: %d CUs (built for 256)\n", grid);
    }
    if (grid < 0) return;
    Args a{};
    for (int i = 0; i < 20; ++i) a.in[i] = (const float*)d_in[i];
    a.out = (float*)d_out; a.ws = (unsigned char*)d_ws;
    if constexpr (FUSED) {
        a.ph_lo = 0; a.ph_hi = NPHASE;
        if (hipMemsetAsync((char*)d_ws + WS_CTL, 0, 128 * 1024, stream) != hipSuccess) { fprintf(stderr, "kernel_launch: memset of the barrier words failed\n"); return; }
        void* kargs[] = {&a};
        hipError_t e;
        if (MK_CG_SYNC) e = hipLaunchCooperativeKernel((const void*)mk_fwd<true, -1>, dim3(grid), dim3(NWAVES * 64), kargs, LDS_BYTES, stream);
        else { hipLaunchKernelGGL((mk_fwd<true, -1>), dim3(grid), dim3(NWAVES * 64), LDS_BYTES, stream, a); e = hipPeekAtLastError(); }
        if (e != hipSuccess) fprintf(stderr, "kernel_launch: launch failed: %s (grid %d)\n", hipGetErrorString(e), grid);
    } else {
        a.ph_lo = 0; a.ph_hi = NPHASE;
        launch_one<0>(grid, stream, a); launch_one<1>(grid, stream, a); launch_one<2>(grid, stream, a); launch_one<3>(grid, stream, a); launch_one<4>(grid, stream, a);
        launch_one<5>(grid, stream, a); launch_one<6>(grid, stream, a); launch_one<7>(grid, stream, a); launch_one<8>(grid, stream, a);
    }
}
```

```cpp
#include <hip/hip_runtime.h>
#include <hip/hip_cooperative_groups.h>
#include <cstdio>
#include <cstdint>
namespace cg = cooperative_groups;
#define MK_N_LAUNCHES 1
namespace pg8 {
#define PG8_LAS __attribute__((address_space(3)))
typedef unsigned short bf16_t;
typedef short bf16x8 __attribute__((ext_vector_type(8)));
typedef float f32x4 __attribute__((ext_vector_type(4)));
typedef unsigned u32x4 __attribute__((ext_vector_type(4)));
constexpr int BM = 256, BK = 64, HALF = 128, HTB = HALF * BK * 2  , STAGE_BYTES = 8 * HTB, NXCD = 8, WGM = 8;

__host__ __device__ __forceinline__ int lds_byte(int r, int c) { const int st = (r >> 4) * 2 + (c >> 5), rr = r & 15, cc = c & 31, ob = rr * 64 + cc * 2; return st * 1024 + (ob ^ (((ob >> 9) & 1) << 5)); }
__host__ __device__ __forceinline__ void stage_rc(int b, int& R, int& C) { const int st = b / 1024, sb = b % 1024, swz = sb ^ (((sb >> 9) & 1) << 5); R = (st >> 1) * 16 + swz / 64; C = (st & 1) * 32 + (swz % 64) / 2; }
__host__ __device__ __forceinline__ int perm32(int rho) { const int n = rho >> 4, i = rho & 15; return 8 * (i >> 2) + 4 * n + (i & 3); }

struct Unit { int pm, pn; };
struct Gemm { const bf16_t* A; const bf16_t* Bt; int M, N, K; };

struct StaticOrder {
    int nM, nN, nwg, G, c;
    __host__ __device__ void init(int M, int N, int G_, int c_) { nM = M / BM; nN = N / BM; nwg = nM * nN; G = G_; c = c_; }
    __host__ __device__ bool next(int i, Unit& u) const {
        const long L = (long)i * G + c; if (L >= nwg) return false;
        int wgid = (int)L; { const int q = nwg / NXCD, r = nwg % NXCD, xcd = wgid % NXCD, off = wgid / NXCD; wgid = (xcd < r ? xcd * (q + 1) : r * (q + 1) + (xcd - r) * q) + off; }
        const int nig = WGM * nN, gid = wgid / nig, fm = gid * WGM, gsz = (nM - fm) < WGM ? (nM - fm) : WGM;
        u.pm = fm + ((wgid % nig) % gsz); u.pn = (wgid % nig) / gsz; return true;
    }
    __device__ __forceinline__ void a_ready(const Unit&) const {}
    __device__ __forceinline__ void done(const Unit&) const {}
};

__device__ __forceinline__ unsigned cvt_pk_bf16(float lo, float hi) { unsigned r; asm volatile("v_cvt_pk_bf16_f32 %0, %1, %2" : "=v"(r) : "v"(lo), "v"(hi)); return r; }
typedef float f32x2 __attribute__((ext_vector_type(2)));
template <class Epi, class Sched, bool ALIGN_EPI = false, bool SP2 = false, bool I8 = false>
__device__ __forceinline__ void gemm_phase(PG8_LAS unsigned char* lds, const Gemm g, const Sched& S, const Epi& E, const int wid) {
    int lane; asm volatile("v_mbcnt_lo_u32_b32 %0, -1, 0\n\tv_mbcnt_hi_u32_b32 %0, -1, %0" : "=v"(lane)); const int tid = wid * 64 + lane, wr = wid >> 2, wc = wid & 3, fr = lane & 15, fq = lane >> 4;
    const int K = g.K, nt = K / BK;
    unsigned voffA[2], voffB[2];
#pragma unroll
    for (int i = 0; i < 2; ++i) { int R, C; stage_rc(tid * 16 + i * 8192, R, C); const int Rb = Epi::PERM ? ((R & ~31) + perm32(R & 31)) : R;
        voffA[i] = (unsigned)(R * K + C) * 2u; voffB[i] = (unsigned)(Rb * K + C) * 2u; }
    const size_t kstep = (size_t)(BK * 2);
    const size_t hstep = (size_t)HALF * K * 2;
    const size_t tstep = 2 * hstep;
    const unsigned ldsw = (unsigned)wid * 1024u;
    const int aoff = lds_byte(wr * 64 + fr, fq * 8), boff = lds_byte(wc * 32 + fr, fq * 8);
#define PG8_SA(b, h) (((b) * 2 + (h)) * HTB)
#define PG8_SB(b, h) ((4 + (b) * 2 + (h)) * HTB)
#define PG8_STAGE(bufoff, gbase, voff) do { _Pragma("unroll") for (int _i = 0; _i < 2; ++_i) \
        __builtin_amdgcn_global_load_lds((const unsigned*)((const char*)(gbase) + (voff)[_i]), (PG8_LAS unsigned*)(lds + (bufoff) + ldsw + _i * 8192), 16, 0, 0); } while (0)
#define PG8_LDA(dst, b, h) do { _Pragma("unroll") for (int m = 0; m < 4; ++m) _Pragma("unroll") for (int k = 0; k < 2; ++k) dst[m][k] = *(const PG8_LAS bf16x8*)(lds + PG8_SA(b, h) + aoff + m * 2048 + k * 1024); } while (0)
#define PG8_LDB(dst, b, h) do { _Pragma("unroll") for (int n = 0; n < 2; ++n) _Pragma("unroll") for (int k = 0; k < 2; ++k) dst[n][k] = *(const PG8_LAS bf16x8*)(lds + PG8_SB(b, h) + boff + n * 2048 + k * 1024); } while (0)
#define PG8_MMA(ai, bj, At, Bt) do { __builtin_amdgcn_s_setprio(1); _Pragma("unroll") for (int m = 0; m < 4; ++m) _Pragma("unroll") for (int n = 0; n < 2; ++n) _Pragma("unroll") for (int k = 0; k < 2; ++k) \
        { if constexpr (I8) { typedef int v4i_ __attribute__((ext_vector_type(4))); acc[ai][bj][m][n] = __builtin_bit_cast(f32x4, __builtin_amdgcn_mfma_i32_16x16x64_i8(__builtin_bit_cast(v4i_, Bt[n][k]), __builtin_bit_cast(v4i_, At[m][k]), __builtin_bit_cast(v4i_, acc[ai][bj][m][n]), 0, 0, 0)); } \
          else acc[ai][bj][m][n] = __builtin_amdgcn_mfma_f32_16x16x32_bf16(Bt[n][k], At[m][k], acc[ai][bj][m][n], 0, 0, 0); } __builtin_amdgcn_s_setprio(0); } while (0)
#define PG8_WAIT_V(n) asm volatile("s_waitcnt vmcnt(" #n ")" ::: "memory")
#define PG8_WAIT_L(n) asm volatile("s_waitcnt lgkmcnt(" #n ")" ::: "memory")
#define PG8_BAR __builtin_amdgcn_s_barrier()
#define PG8_SCHED __builtin_amdgcn_sched_barrier(0)
    Unit cur, nxt; int ui = 0;
    if (!S.next(0, cur)) return;
    f32x4 acc[2][2][4][2];
#pragma unroll
    for (int a = 0; a < 2; ++a)
#pragma unroll
        for (int b = 0; b < 2; ++b)
#pragma unroll
            for (int m = 0; m < 4; ++m)
#pragma unroll
                for (int n = 0; n < 2; ++n) acc[a][b][m][n] = (f32x4){0.f, 0.f, 0.f, 0.f};
    bf16x8 At[4][2], B0[2][2], B1[2][2];
    const char* cA = (const char*)g.A + (size_t)cur.pm * tstep; const char* cB = (const char*)g.Bt + (size_t)cur.pn * tstep;
    S.a_ready(cur);
    if constexpr (SP2) {
        PG8_STAGE(PG8_SB(0, 0), cB, voffB); PG8_STAGE(PG8_SB(0, 1), cB + hstep, voffB); PG8_STAGE(PG8_SA(0, 0), cA, voffA); PG8_STAGE(PG8_SA(0, 1), cA + hstep, voffA);
        if (wr == 1) PG8_BAR;
        PG8_WAIT_V(2); PG8_BAR;
        PG8_STAGE(PG8_SB(1, 0), cB + kstep, voffB); PG8_STAGE(PG8_SA(1, 0), cA + kstep, voffA); PG8_STAGE(PG8_SB(1, 1), cB + hstep + kstep, voffB);
        PG8_WAIT_V(6); PG8_BAR;
    } else {
        PG8_STAGE(PG8_SB(0, 0), cB, voffB); PG8_STAGE(PG8_SA(0, 0), cA, voffA); PG8_STAGE(PG8_SB(0, 1), cB + hstep, voffB); PG8_STAGE(PG8_SA(0, 1), cA + hstep, voffA);
        if (wr == 1) PG8_BAR;
        PG8_WAIT_V(4); PG8_BAR;
        PG8_STAGE(PG8_SB(1, 0), cB + kstep, voffB); PG8_STAGE(PG8_SA(1, 0), cA + kstep, voffA); PG8_STAGE(PG8_SB(1, 1), cB + hstep + kstep, voffB);
        PG8_WAIT_V(6); PG8_BAR;
    }
    for (;;) {
        const bool has_next = S.next(ui + 1, nxt);
        const char* nA = has_next ? (const char*)g.A + (size_t)nxt.pm * tstep : cA; const char* nB = has_next ? (const char*)g.Bt + (size_t)nxt.pn * tstep : cB;
        for (int t = 0; t < nt; t += 2) {
            const bool last = (t == nt - 2);
            const char* a1 = cA + (size_t)(t + 1) * kstep;
            const char* a2 = last ? nA : cA + (size_t)(t + 2) * kstep; const char* b2 = last ? nB : cB + (size_t)(t + 2) * kstep;
            const char* a3 = a2 + kstep; const char* b3 = b2 + kstep;
            if (last && has_next) S.a_ready(nxt);
            if constexpr (SP2) {
            PG8_LDB(B0, 0, 0); PG8_LDB(B1, 0, 1); PG8_SCHED; PG8_LDA(At, 0, 0); PG8_STAGE(PG8_SA(1, 1), a1 + hstep, voffA);
            PG8_WAIT_V(8); PG8_WAIT_L(0); PG8_BAR; PG8_MMA(0, 0, At, B0); PG8_MMA(0, 1, At, B1); PG8_BAR; PG8_SCHED;
            PG8_LDA(At, 0, 1); PG8_STAGE(PG8_SB(0, 0), b2, voffB); PG8_STAGE(PG8_SB(0, 1), b2 + hstep, voffB); PG8_STAGE(PG8_SA(0, 0), a2, voffA);
            PG8_WAIT_V(8); PG8_WAIT_L(0); PG8_BAR; PG8_MMA(1, 0, At, B0); PG8_MMA(1, 1, At, B1); PG8_BAR; PG8_SCHED;
            PG8_LDB(B0, 1, 0); PG8_LDB(B1, 1, 1); PG8_SCHED; PG8_LDA(At, 1, 0); PG8_STAGE(PG8_SA(0, 1), a2 + hstep, voffA);
            PG8_WAIT_V(8); PG8_WAIT_L(0); PG8_BAR; PG8_MMA(0, 0, At, B0); PG8_MMA(0, 1, At, B1); PG8_BAR; PG8_SCHED;
            PG8_LDA(At, 1, 1); PG8_STAGE(PG8_SB(1, 0), b3, voffB); PG8_STAGE(PG8_SB(1, 1), b3 + hstep, voffB); PG8_STAGE(PG8_SA(1, 0), a3, voffA);
            PG8_WAIT_V(8); PG8_WAIT_L(0); PG8_BAR; PG8_MMA(1, 0, At, B0); PG8_MMA(1, 1, At, B1); PG8_BAR; PG8_SCHED;
            } else {
            PG8_LDB(B0, 0, 0); PG8_SCHED; PG8_LDA(At, 0, 0); PG8_STAGE(PG8_SA(1, 1), a1 + hstep, voffA);
            PG8_WAIT_L(8); PG8_BAR; PG8_WAIT_L(0); PG8_MMA(0, 0, At, B0); PG8_BAR; PG8_SCHED;
            PG8_LDB(B1, 0, 1); PG8_STAGE(PG8_SB(0, 0), b2, voffB);
            PG8_BAR; PG8_WAIT_L(0); PG8_MMA(0, 1, At, B1); PG8_BAR;
            PG8_LDA(At, 0, 1); PG8_STAGE(PG8_SA(0, 0), a2, voffA);
            PG8_BAR; PG8_WAIT_L(0); PG8_MMA(1, 0, At, B0); PG8_BAR; PG8_SCHED;
            PG8_STAGE(PG8_SB(0, 1), b2 + hstep, voffB);
            PG8_WAIT_V(6); PG8_BAR; PG8_MMA(1, 1, At, B1); PG8_BAR;
            PG8_LDB(B0, 1, 0); PG8_SCHED; PG8_LDA(At, 1, 0); PG8_STAGE(PG8_SA(0, 1), a2 + hstep, voffA);
            PG8_WAIT_L(8); PG8_BAR; PG8_WAIT_L(0); PG8_MMA(0, 0, At, B0); PG8_BAR; PG8_SCHED;
            PG8_LDB(B1, 1, 1); PG8_STAGE(PG8_SB(1, 0), b3, voffB);
            PG8_BAR; PG8_WAIT_L(0); PG8_MMA(0, 1, At, B1); PG8_BAR;
            PG8_LDA(At, 1, 1); PG8_STAGE(PG8_SA(1, 0), a3, voffA);
            PG8_BAR; PG8_WAIT_L(0); PG8_MMA(1, 0, At, B0); PG8_BAR; PG8_SCHED;
            PG8_STAGE(PG8_SB(1, 1), b3 + hstep, voffB);
            PG8_WAIT_V(6); PG8_BAR; PG8_MMA(1, 1, At, B1); PG8_BAR;
            }
        }
        if constexpr (ALIGN_EPI) { if (wr == 0) PG8_BAR; }
        if constexpr (!Epi::AFTER_DRAIN) { E(acc, cur, wr, wc, fr, fq); S.done(cur); }
        if (!has_next) break;
#pragma unroll
        for (int a = 0; a < 2; ++a)
#pragma unroll
            for (int b = 0; b < 2; ++b)
#pragma unroll
                for (int m = 0; m < 4; ++m)
#pragma unroll
                    for (int n = 0; n < 2; ++n) acc[a][b][m][n] = (f32x4){0.f, 0.f, 0.f, 0.f};
        cur = nxt; cA = nA; cB = nB; ++ui;
        if constexpr (ALIGN_EPI) { if (wr == 1) PG8_BAR; }
    }
    PG8_WAIT_V(0);
    if constexpr (!ALIGN_EPI) { if (wr == 0) PG8_BAR; }
    PG8_BAR;
    if constexpr (Epi::AFTER_DRAIN) { E.fused(acc, cur, wr, wc, fr, fq, lds, wid, lane); S.done(cur); }
#undef PG8_SA
#undef PG8_SB
#undef PG8_STAGE
#undef PG8_LDA
#undef PG8_LDB
#undef PG8_MMA
#undef PG8_WAIT_V
#undef PG8_WAIT_L
#undef PG8_BAR
#undef PG8_SCHED
}
}

#ifndef MK_N_LAUNCHES
#define MK_N_LAUNCHES 1
#endif
constexpr int NPHASE = 9;

constexpr int D = 2048, NB = 8, SEQ = 2048, M = NB * SEQ, CTXL = 256, MC = NB * CTXL;
constexpr int NH = 8, HD = 128, DA = 1024, NPROJ = 6144, GW = 64;
constexpr int NEXP = 16384, PH = 8, PK = 16, NKEYS = 128;
constexpr float EPS = 1e-6f, LOG2E = 1.4426950408889634f;
constexpr int NWAVES = 8;
constexpr float A2_SCALE = 10.0f / 127.0f, A2_INV = 127.0f / 10.0f;

constexpr size_t MiB = 1u << 20;
constexpr size_t WS_CTL = 0, WS_MOD = 1 * MiB, WS_SK = 2 * MiB, WS_WIN = 4 * MiB, WS_WOUT = 28 * MiB, WS_WPQ = 36 * MiB;
constexpr size_t WS_UT = 44 * MiB, WS_VT = 108 * MiB, WS_ACT = 172 * MiB, WS_HC = 236 * MiB;
constexpr size_t WS_Q = 244 * MiB, WS_K = 276 * MiB, WS_VTR = 308 * MiB, WS_BG = 340 * MiB, WS_CG = 372 * MiB, WS_U = 404 * MiB;
constexpr size_t WS_KC = 436 * MiB, WS_VCT = 440 * MiB, WS_QP = 244 * MiB  ;
constexpr size_t WS_SELI = 444 * MiB, WS_SELG = 452 * MiB, WS_AVW = 460 * MiB, WS_END = 468 * MiB;
constexpr size_t WS_U8 = WS_UT, WS_V8 = WS_UT + 32 * MiB, WS_SU = WS_VT, WS_SV = WS_VT + 64 * 1024, WS_H2S = WS_VT + 128 * 1024, WS_H2Q = WS_VT + 1 * MiB;

constexpr int LDS_BYTES = 147456;
constexpr int XCH_OFF = 131072;
constexpr int MISC_OFF = 131072 + 8192;
#ifndef MK_CG_SYNC
#define MK_CG_SYNC 1
#endif

#define GAS __attribute__((address_space(1)))
#define LAS __attribute__((address_space(3)))
typedef unsigned short bf16;
typedef unsigned v4u __attribute__((ext_vector_type(4)));
typedef unsigned v2u __attribute__((ext_vector_type(2)));
typedef float f32x4 __attribute__((ext_vector_type(4)));
typedef float f32x16 __attribute__((ext_vector_type(16)));
typedef short bf16x8 __attribute__((ext_vector_type(8)));
typedef __bf16 bf16x2 __attribute__((ext_vector_type(2)));
#define LDS_WAIT() asm volatile("s_waitcnt lgkmcnt(0)" ::: "memory")

__device__ __forceinline__ unsigned f2bf(float f) { unsigned u = __builtin_bit_cast(unsigned, f); return (u + 0x7fffu + ((u >> 16) & 1u)) >> 16; }
__device__ __forceinline__ unsigned pk2(float lo, float hi) { return pg8::cvt_pk_bf16(lo, hi); }
__device__ __forceinline__ float bflo(unsigned w) { return __builtin_bit_cast(float, w << 16); }
__device__ __forceinline__ float bfhi(unsigned w) { return __builtin_bit_cast(float, w & 0xffff0000u); }
__device__ __forceinline__ float dot2_bf16(unsigned w, unsigned x, float acc) { return __builtin_amdgcn_fdot2_f32_bf16(__builtin_bit_cast(bf16x2, w), __builtin_bit_cast(bf16x2, x), acc, false); }
__device__ __forceinline__ float wave_sum(float v) {
#pragma unroll
    for (int o = 1; o < 64; o <<= 1) v += __shfl_xor(v, o);
    return v;
}

struct Args { const float* in[20]; float* out; unsigned char* ws; int ph_lo, ph_hi; };
struct Frame {
    LAS unsigned char* lds;
    int wave, vcu, G;
};
__device__ __forceinline__ int lane_id() { int l; asm volatile("v_mbcnt_lo_u32_b32 %0, -1, 0\n\tv_mbcnt_hi_u32_b32 %0, -1, %0" : "=v"(l)); return l; }
#define F_LANE lane_id()
#define F_TID (F.wave * 64 + lane_id())
#define AP_x (A.in[0])
#define AP_c (A.in[1])
#define AP_ctx (A.in[2])
#define AP_c_ctx (A.in[3])
#define AP_w_ada (A.in[4])
#define AP_b_ada (A.in[5])
#define AP_g1 (A.in[6])
#define AP_w_in (A.in[7])
#define AP_qn (A.in[8])
#define AP_kn (A.in[9])
#define AP_rpb (A.in[10])
#define AP_w_conv (A.in[11])
#define AP_gao (A.in[12])
#define AP_gco (A.in[13])
#define AP_w_out (A.in[14])
#define AP_g2 (A.in[15])
#define AP_w_pq (A.in[16])
#define AP_subk (A.in[17])
#define AP_uex (A.in[18])
#define AP_vex (A.in[19])
#define AP_SK ((bf16*)(A.ws + WS_SK))
#define AP_WIN ((bf16*)(A.ws + WS_WIN))
#define AP_WOUT ((bf16*)(A.ws + WS_WOUT))
#define AP_WPQ ((bf16*)(A.ws + WS_WPQ))
#define AP_UT ((bf16*)(A.ws + WS_UT))
#define AP_VT ((bf16*)(A.ws + WS_VT))
#define AP_ACT ((bf16*)(A.ws + WS_ACT))
#define AP_HC ((bf16*)(A.ws + WS_HC))
#define AP_Q ((bf16*)(A.ws + WS_Q))
#define AP_K ((bf16*)(A.ws + WS_K))
#define AP_VTR ((bf16*)(A.ws + WS_VTR))
#define AP_BG ((bf16*)(A.ws + WS_BG))
#define AP_CG ((bf16*)(A.ws + WS_CG))
#define AP_U ((bf16*)(A.ws + WS_U))
#define AP_KC ((bf16*)(A.ws + WS_KC))
#define AP_VCT ((bf16*)(A.ws + WS_VCT))
#define AP_QP ((bf16*)(A.ws + WS_QP))
#define AP_MOD ((float*)(A.ws + WS_MOD))
#define AP_SELI ((int*)(A.ws + WS_SELI))
#define AP_SELG ((float*)(A.ws + WS_SELG))
#define AP_AVW ((float*)(A.ws + WS_AVW))
#define AP_WIN8 ((unsigned char*)(A.ws + WS_WIN))
#define AP_WINS ((float*)(A.ws + WS_WIN + 16 * MiB))
#define AP_WOUT8 ((unsigned char*)(A.ws + WS_WOUT))
#define AP_WOUTS ((float*)(A.ws + WS_WOUT + 5 * MiB))
#define AP_CPARTO ((float*)(A.ws + WS_WOUT + 6 * MiB))
#define AP_A28 ((unsigned char*)(A.ws + WS_ACT))
#define AP_WPQ8 ((unsigned char*)(A.ws + WS_WPQ))
#define AP_WPQS ((float*)(A.ws + WS_WPQ + 5 * MiB))
#define AP_CPARTQ ((float*)(A.ws + WS_WPQ + 6 * MiB))
#define AP_CPART ((float*)(A.ws + WS_WIN + 17 * MiB))
#define AP_H8 ((unsigned char*)(A.ws + WS_ACT))
#define AP_HC8 ((unsigned char*)(A.ws + WS_HC))
#define AP_HS ((float*)(A.ws + WS_HC + 4 * MiB))
#define AP_HCS ((float*)(A.ws + WS_HC + 4 * MiB + 65536))
#define AP_X1B ((bf16*)(A.ws + WS_BG))
#define AP_out (A.out)
#define AP_U8 ((const unsigned char*)(A.ws + WS_U8))
#define AP_V8 ((const unsigned char*)(A.ws + WS_V8))
#define AP_SU ((float*)(A.ws + WS_SU))
#define AP_SV ((float*)(A.ws + WS_SV))
#define AP_H2S ((float*)(A.ws + WS_H2S))
#define AP_H2Q ((unsigned char*)(A.ws + WS_H2Q))


#define XB_TMO      128
#define XB_XCNT(j)  (256  + 64 * (j))
#define XB_XSUB(j)  (1280 + 64 * (j))
#define XB_XGEN(j)  (2304 + 64 * (j))
#define XB_TOP      3328
#define XB_TOPGEN   3392
#define XCD_BAR_WORDS 3456
#define XB_SPIN_CAP (1u << 22)
__device__ __forceinline__ unsigned xb_ld(unsigned* p)              { return __hip_atomic_load(p, __ATOMIC_RELAXED, __HIP_MEMORY_SCOPE_AGENT); }
__device__ __forceinline__ unsigned xb_add(unsigned* p, unsigned v) { return __hip_atomic_fetch_add(p, v, __ATOMIC_RELAXED, __HIP_MEMORY_SCOPE_AGENT); }
__device__ __forceinline__ unsigned xb_xcc_id() { return (unsigned)__builtin_amdgcn_s_getreg((3 << 11) | 20) & 0xFu; }
#define XB_SPIN(cond, bar) do { unsigned _sp = 0; while (cond) { __builtin_amdgcn_s_sleep(1); \
    if ((++_sp & 255u) == 0u) { if (xb_ld(&(bar)[XB_TMO])) break; if (_sp > XB_SPIN_CAP) { atomicAdd(&(bar)[XB_TMO], 1u); break; } } } } while (0)
struct XcdBarrier { unsigned* bar; unsigned x; volatile LAS unsigned* st; };
__device__ __forceinline__ void xcd_barrier_complete(unsigned* bar, unsigned x, unsigned G, unsigned& nloc, unsigned& nx) {
    unsigned sum, cnt, mine, sp = 0u;
    for (;;) {
        sum = 0u; cnt = 0u; mine = 0u;
#pragma unroll
        for (unsigned j = 0; j < 16; ++j) { const unsigned c = xb_ld(&bar[XB_XCNT(j)]); sum += c; cnt += (c > 0u) ? 1u : 0u; mine = (j == x) ? c : mine; }
        if (sum == G) break;
        __builtin_amdgcn_s_sleep(1);
        if ((++sp & 255u) == 0u) { if (xb_ld(&bar[XB_TMO])) break; if (sp > XB_SPIN_CAP) { atomicAdd(&bar[XB_TMO], 1u); break; } }
    }
    nloc = mine > 0u ? mine : 1u; nx = cnt > 0u ? cnt : 1u;
}
__device__ __forceinline__ void xcd_barrier(const XcdBarrier& b, const int wave, const unsigned G) {
    asm volatile("s_waitcnt vmcnt(0)" ::: "memory");
    __syncthreads();
    if (wave == 0 && lane_id() == 0) {
        unsigned* bar = b.bar;
        __builtin_amdgcn_s_waitcnt(0);
        unsigned nloc = b.st[0], nx = b.st[1];
        if (nloc == 0u) { xcd_barrier_complete(bar, b.x, G, nloc, nx); b.st[0] = nloc; b.st[1] = nx; }
        const unsigned old = xb_add(&bar[XB_XSUB(b.x)], 1u);
        const unsigned gen = old / nloc;
        if (old + 1u == (gen + 1u) * nloc) {
            __builtin_amdgcn_fence(__ATOMIC_RELEASE, "agent");
            asm volatile("s_waitcnt vmcnt(0)" ::: "memory");
            const unsigned og = xb_add(&bar[XB_TOP], 1u);
            const unsigned tg = og / nx;
            if (og + 1u == (tg + 1u) * nx) xb_add(&bar[XB_TOPGEN], 1u);
            else XB_SPIN(xb_ld(&bar[XB_TOPGEN]) == tg, bar);
            __builtin_amdgcn_fence(__ATOMIC_ACQUIRE, "agent");
            xb_add(&bar[XB_XGEN(b.x)], 1u);
            asm volatile("s_waitcnt vmcnt(0)" ::: "memory");
        } else {
            XB_SPIN(xb_ld(&bar[XB_XGEN(b.x)]) == gen, bar);
            __builtin_amdgcn_fence(__ATOMIC_ACQUIRE, "agent");
            asm volatile("s_waitcnt vmcnt(0)" ::: "memory");
        }
    }
    __syncthreads();
}

__device__ __forceinline__ void p0_mod(const Frame& F, const Args& A) {
    const int lane = lane_id(), tid = F.wave * 64 + lane; (void)tid;
    LAS float* sc = (LAS float*)F.lds;
    LAS float* red = (LAS float*)(F.lds + 9 * 2048 * 4);
    for (int i = tid; i < 9 * D; i += NWAVES * 64) { const int r = i >> 11, k = i & (D - 1); const float cv = (r < 8) ? AP_c[r * D + k] : AP_c_ctx[k]; sc[i] = cv / (1.f + __expf(-cv)); }
    __syncthreads();
    const int sr = lane >> 4, cq = lane & 15;
    for (int item = F.vcu; item < (6 * D) / 64; item += F.G) {
        const int n0 = item * 64;
        float acc[9][4];
#pragma unroll
        for (int r = 0; r < 9; ++r)
#pragma unroll
            for (int j = 0; j < 4; ++j) acc[r][j] = 0.f;
        const float* wp = AP_w_ada + (size_t)(F.wave * 4 + sr) * (6 * D) + n0 + 4 * cq;
#pragma unroll 8
        for (int step = 0; step < 64; ++step) {
            const int k = step * 32 + F.wave * 4 + sr;
            const f32x4 w = *(const f32x4*)(wp + (size_t)step * 32 * (6 * D));
#pragma unroll
            for (int r = 0; r < 9; ++r) { const float s = sc[r * D + k]; acc[r][0] += s * w.x; acc[r][1] += s * w.y; acc[r][2] += s * w.z; acc[r][3] += s * w.w; }
        }
#pragma unroll
        for (int r = 0; r < 9; ++r)
#pragma unroll
            for (int j = 0; j < 4; ++j) { float v = acc[r][j]; v += __shfl_xor(v, 16); v += __shfl_xor(v, 32); if (sr == 0) red[(F.wave * 9 + r) * 64 + 4 * cq + j] = v; }
        __syncthreads();
        for (int i = tid; i < 9 * 64; i += NWAVES * 64) { const int r = i >> 6, cc = i & 63; float s = 0.f;
#pragma unroll
            for (int w = 0; w < 8; ++w) s += red[(w * 9 + r) * 64 + cc];
            AP_MOD[r * (6 * D) + n0 + cc] = s + AP_b_ada[n0 + cc]; }
        __syncthreads();
    }
    __syncthreads();
}
__device__ __forceinline__ void p0_transpose_item(const float* W, int K, int N, bf16* WT, LAS float* scr, int item, int lane) {
    const int nblk = N / 32, kb = item / nblk, nb = item % nblk, k0 = 64 * kb, n0 = 32 * nb;
#pragma unroll 8
    for (int i = 0; i < 32; ++i) { const int kk = 2 * i + (lane >> 5); scr[kk * 33 + (lane & 31)] = W[(size_t)(k0 + kk) * N + n0 + (lane & 31)]; }
    LDS_WAIT(); asm volatile("" ::: "memory");
    const int c = lane & 7;
#pragma unroll
    for (int j = 0; j < 4; ++j) { const int n = (lane >> 3) + 8 * j; const LAS float* s = scr + (8 * c) * 33 + n;
        v4u o; o.x = pk2(s[0 * 33], s[1 * 33]); o.y = pk2(s[2 * 33], s[3 * 33]); o.z = pk2(s[4 * 33], s[5 * 33]); o.w = pk2(s[6 * 33], s[7 * 33]);
        *(v4u*)(WT + (size_t)(n0 + n) * K + k0 + 8 * c) = o; }
    LDS_WAIT(); asm volatile("" ::: "memory");
}
__device__ __forceinline__ void cvt_f32_bf16(const float* src, bf16* dst, size_t n, size_t gtid, size_t gthreads) {
    for (size_t i = gtid * 8; i < n; i += gthreads * 8) { const f32x4 a = *(const f32x4*)(src + i), b = *(const f32x4*)(src + i + 4);
        v4u o; o.x = pk2(a.x, a.y); o.y = pk2(a.z, a.w); o.z = pk2(b.x, b.y); o.w = pk2(b.z, b.w); *(v4u*)(dst + i) = o; }
}
__device__ __forceinline__ float wave_max(float v) {
#pragma unroll
    for (int o = 1; o < 64; o <<= 1) v = fmaxf(v, __shfl_xor(v, o));
    return v;
}
__device__ __forceinline__ unsigned q4(const f32x4 v, const float inv, const int off = 0) {
    const int a = (int)fminf(fmaxf(__builtin_rintf(v.x * inv), -127.f), 127.f) + off, b = (int)fminf(fmaxf(__builtin_rintf(v.y * inv), -127.f), 127.f) + off, c = (int)fminf(fmaxf(__builtin_rintf(v.z * inv), -127.f), 127.f) + off, d = (int)fminf(fmaxf(__builtin_rintf(v.w * inv), -127.f), 127.f) + off;
    return (unsigned)(a & 255) | ((unsigned)(b & 255) << 8) | ((unsigned)(c & 255) << 16) | ((unsigned)(d & 255) << 24);
}
__device__ __forceinline__ void quant_row(const float* src, unsigned char* dst, float* scale, int lane, const int off) {
    const f32x4* xr = (const f32x4*)src + lane; f32x4 v[8]; float mx = 0.f;
#pragma unroll
    for (int j = 0; j < 8; ++j) { v[j] = xr[64 * j]; mx = fmaxf(mx, fmaxf(fmaxf(fabsf(v[j].x), fabsf(v[j].y)), fmaxf(fabsf(v[j].z), fabsf(v[j].w)))); }
    mx = fmaxf(wave_max(mx), 1e-30f);
    const float inv = 127.f / mx;
    unsigned* o = (unsigned*)dst + lane;
#pragma unroll
    for (int j = 0; j < 8; ++j) o[64 * j] = q4(v[j], inv, off);
    if (lane == 0) *scale = mx * (1.f / 127.f);
}
__device__ __forceinline__ void p1_transpose_item_i8(const float* W, int K, int N, unsigned char* WT, const float* cpart, float* wscale, LAS float* scr, int item, int lane) {
    const int nblk = N / 32, kb = item / nblk, nb = item % nblk, k0 = 64 * kb, n0 = 32 * nb;
    { float cm = 0.f;
#pragma unroll
      for (int p = 0; p < 16; ++p) cm = fmaxf(cm, cpart[(size_t)(16 * (lane >> 5) + p) * N + n0 + (lane & 31)]);
      cm = fmaxf(cm, __shfl_xor(cm, 32));
      scr[64 * 33 + (lane & 31)] = cm; }
#pragma unroll 8
    for (int i = 0; i < 32; ++i) { const int kk = 2 * i + (lane >> 5); scr[kk * 33 + (lane & 31)] = W[(size_t)(k0 + kk) * N + n0 + (lane & 31)]; }
    LDS_WAIT(); asm volatile("" ::: "memory");
    const int c = lane & 7;
#pragma unroll
    for (int j = 0; j < 4; ++j) { const int n = (lane >> 3) + 8 * j; const LAS float* sp = scr + (8 * c) * 33 + n;
        const float mx = fmaxf(scr[64 * 33 + n], 1e-30f), inv = 127.f / mx;
        f32x4 a = {sp[0 * 33], sp[1 * 33], sp[2 * 33], sp[3 * 33]}, b = {sp[4 * 33], sp[5 * 33], sp[6 * 33], sp[7 * 33]};
        v2u o; o.x = q4(a, inv); o.y = q4(b, inv);
        *(v2u*)(WT + (size_t)(n0 + n) * K + k0 + 8 * c) = o;
        if (kb == 0 && c == 0) wscale[n0 + n] = mx * (1.f / 127.f); }
    LDS_WAIT(); asm volatile("" ::: "memory");
}
__device__ __forceinline__ void p0_prologue(const Frame& F, const Args& A) {
    const int lane = lane_id(), tid = F.wave * 64 + lane; (void)tid;
    p0_mod(F, A);
    LAS float* scr = (LAS float*)(F.lds + F.wave * 16384);
    const int gw = F.vcu * NWAVES + F.wave, NGW = F.G * NWAVES;
    constexpr int I_SQ = (D / 64) * (D / 32);
    (void)I_SQ; (void)scr;
    for (int it = gw; it < (D / 256) * (D / 64); it += NGW) { const int cb = it % (D / 256), kb = it / (D / 256);
        const f32x4* wp = (const f32x4*)(AP_w_pq + (size_t)(kb * 64) * D + cb * 256) + lane; f32x4 mx = {0.f, 0.f, 0.f, 0.f};
#pragma unroll 8
        for (int k = 0; k < 64; ++k) { const f32x4 w = wp[(size_t)k * (D / 4)]; mx.x = fmaxf(mx.x, fabsf(w.x)); mx.y = fmaxf(mx.y, fabsf(w.y)); mx.z = fmaxf(mx.z, fabsf(w.z)); mx.w = fmaxf(mx.w, fabsf(w.w)); }
        *((f32x4*)(AP_CPARTQ + (size_t)kb * D + cb * 256) + lane) = mx; }
    for (int it = gw; it < (D / 256) * (D / 64); it += NGW) { const int cb = it % (D / 256), kb = it / (D / 256);
        const f32x4* wp = (const f32x4*)(AP_w_out + (size_t)(kb * 64) * D + cb * 256) + lane; f32x4 mx = {0.f, 0.f, 0.f, 0.f};
#pragma unroll 8
        for (int k = 0; k < 64; ++k) { const f32x4 w = wp[(size_t)k * (D / 4)]; mx.x = fmaxf(mx.x, fabsf(w.x)); mx.y = fmaxf(mx.y, fabsf(w.y)); mx.z = fmaxf(mx.z, fabsf(w.z)); mx.w = fmaxf(mx.w, fabsf(w.w)); }
        *((f32x4*)(AP_CPARTO + (size_t)kb * D + cb * 256) + lane) = mx; }
    for (int it = gw; it < (NPROJ / 256) * (D / 64); it += NGW) { const int cb = it % (NPROJ / 256), kb = it / (NPROJ / 256);
        const f32x4* wp = (const f32x4*)(AP_w_in + (size_t)(kb * 64) * NPROJ + cb * 256) + lane; f32x4 mx = {0.f, 0.f, 0.f, 0.f};
#pragma unroll 8
        for (int k = 0; k < 64; ++k) { const f32x4 w = wp[(size_t)k * (NPROJ / 4)]; mx.x = fmaxf(mx.x, fabsf(w.x)); mx.y = fmaxf(mx.y, fabsf(w.y)); mx.z = fmaxf(mx.z, fabsf(w.z)); mx.w = fmaxf(mx.w, fabsf(w.w)); }
        *((f32x4*)(AP_CPART + (size_t)kb * NPROJ + cb * 256) + lane) = mx; }
    const size_t gtid = (size_t)F.vcu * (NWAVES * 64) + tid, gth = (size_t)F.G * NWAVES * 64;
    cvt_f32_bf16(AP_subk, AP_SK, (size_t)PH * 2 * NKEYS * 128, gtid, gth);
    for (int e = gw; e < NEXP; e += NGW) {
        const f32x4* ur = (const f32x4*)(AP_uex + (size_t)e * D) + lane; const f32x4* vr = (const f32x4*)(AP_vex + (size_t)e * D) + lane;
        f32x4 uv[8], vv[8]; float mu = 0.f, mv = 0.f;
#pragma unroll
        for (int j = 0; j < 8; ++j) { uv[j] = ur[64 * j]; vv[j] = vr[64 * j]; }
#pragma unroll
        for (int j = 0; j < 8; ++j) { mu = fmaxf(mu, fmaxf(fmaxf(fabsf(uv[j].x), fabsf(uv[j].y)), fmaxf(fabsf(uv[j].z), fabsf(uv[j].w)))); mv = fmaxf(mv, fmaxf(fmaxf(fabsf(vv[j].x), fabsf(vv[j].y)), fmaxf(fabsf(vv[j].z), fabsf(vv[j].w)))); }
        mu = fmaxf(wave_max(mu), 1e-30f); mv = fmaxf(wave_max(mv), 1e-30f);
        const float iu = 127.f / mu, iv = 127.f / mv;
        unsigned* ou = (unsigned*)(A.ws + WS_U8 + (size_t)e * D) + lane; unsigned* ov = (unsigned*)(A.ws + WS_V8 + (size_t)e * D) + lane;
#pragma unroll
        for (int j = 0; j < 8; ++j) { ou[64 * j] = q4(uv[j], iu); ov[64 * j] = q4(vv[j], iv); }
        if (lane == 0) { AP_SU[e] = mu * (1.f / 127.f); AP_SV[e] = mv * (1.f / 127.f); }
    }
}

__device__ __forceinline__ void norm_rows(const float* X, size_t row0, int nrows, const float* g, const float* sh, const float* sc, bf16* out, int lane, unsigned char* q8 = nullptr, float* qs = nullptr) {
    f32x4 gs[8], shv[8];
#pragma unroll
    for (int j = 0; j < 8; ++j) { const int cI = j * 64 + lane; const f32x4 gg = ((const f32x4*)g)[cI], s1 = ((const f32x4*)sc)[cI]; gs[j] = gg * (1.f + s1); shv[j] = ((const f32x4*)sh)[cI]; }
    f32x4 vn[8];
    { const f32x4* xr = (const f32x4*)(X + row0 * D) + lane;
#pragma unroll
      for (int j = 0; j < 8; ++j) vn[j] = xr[64 * j]; }
    for (int r = 0; r < nrows; ++r) {
        f32x4 v[8]; float ss = 0.f;
#pragma unroll
        for (int j = 0; j < 8; ++j) { v[j] = vn[j]; ss += (v[j].x * v[j].x + v[j].y * v[j].y) + (v[j].z * v[j].z + v[j].w * v[j].w); }
        { const f32x4* xr = (const f32x4*)(X + (row0 + ((r + 1 < nrows) ? r + 1 : r)) * D) + lane;
#pragma unroll
          for (int j = 0; j < 8; ++j) vn[j] = xr[64 * j]; }
        const float rstd = __builtin_amdgcn_rsqf(wave_sum(ss) * (1.f / D) + EPS);
        v2u* o8 = (v2u*)(out + (row0 + r) * D) + lane; float mx = 0.f;
#pragma unroll
        for (int j = 0; j < 8; ++j) { const f32x4 y = v[j] * rstd * gs[j] + shv[j]; v[j] = y; if (out) { v2u w; w.x = pk2(y.x, y.y); w.y = pk2(y.z, y.w); o8[64 * j] = w; }
            mx = fmaxf(mx, fmaxf(fmaxf(fabsf(y.x), fabsf(y.y)), fmaxf(fabsf(y.z), fabsf(y.w)))); }
        if (q8) { mx = fmaxf(wave_max(mx), 1e-30f); const float inv = 127.f / mx; unsigned* oq = (unsigned*)(q8 + (row0 + r) * D) + lane;
#pragma unroll
            for (int j = 0; j < 8; ++j) oq[64 * j] = q4(v[j], inv);
            if (lane == 0) qs[row0 + r] = mx * (1.f / 127.f); }
    }
}
__device__ __forceinline__ void norm_rows_b(const bf16* X, size_t row0, int nrows, const float* g, const float* sh, const float* sc, bf16* out, int lane, unsigned char* q8, float* qs) {
    f32x4 gs[8], shv[8];
#pragma unroll
    for (int j = 0; j < 8; ++j) { const int cI = j * 64 + lane; const f32x4 gg = ((const f32x4*)g)[cI], s1 = ((const f32x4*)sc)[cI]; gs[j] = gg * (1.f + s1); shv[j] = ((const f32x4*)sh)[cI]; }
    for (int r = 0; r < nrows; ++r) {
        const v2u* xr = (const v2u*)(X + (row0 + r) * D) + lane;
        f32x4 v[8]; float ss = 0.f;
#pragma unroll
        for (int j = 0; j < 8; ++j) { const v2u w = xr[64 * j]; v[j].x = bflo(w.x); v[j].y = bfhi(w.x); v[j].z = bflo(w.y); v[j].w = bfhi(w.y); ss += (v[j].x * v[j].x + v[j].y * v[j].y) + (v[j].z * v[j].z + v[j].w * v[j].w); }
        const float rstd = __builtin_amdgcn_rsqf(wave_sum(ss) * (1.f / D) + EPS);
        v2u* o8 = (v2u*)(out + (row0 + r) * D) + lane; float mx = 0.f;
#pragma unroll
        for (int j = 0; j < 8; ++j) { const f32x4 y = v[j] * rstd * gs[j] + shv[j]; v[j] = y; if (out) { v2u w; w.x = pk2(y.x, y.y); w.y = pk2(y.z, y.w); o8[64 * j] = w; }
            mx = fmaxf(mx, fmaxf(fmaxf(fabsf(y.x), fabsf(y.y)), fmaxf(fabsf(y.z), fabsf(y.w)))); }
        mx = fmaxf(wave_max(mx), 1e-30f); const float inv = 127.f / mx; unsigned* oq = (unsigned*)(q8 + (row0 + r) * D) + lane;
#pragma unroll
        for (int j = 0; j < 8; ++j) oq[64 * j] = q4(v[j], inv);
        if (lane == 0) qs[row0 + r] = mx * (1.f / 127.f);
    }
}
__device__ __forceinline__ void p1_norm1(const Frame& F, const Args& A) {
    const int lane = lane_id(), tid = F.wave * 64 + lane; (void)tid;
    const int gw = F.vcu * NWAVES + F.wave, NGW = F.G * NWAVES;
    { LAS float* scr = (LAS float*)(F.lds + F.wave * 16384);
      for (int it = gw; it < (D / 64) * (NPROJ / 32); it += NGW) p1_transpose_item_i8(AP_w_in, D, NPROJ, AP_WIN8, AP_CPART, AP_WINS, scr, it, lane);
      for (int it = gw; it < (D / 64) * (D / 32); it += NGW) p1_transpose_item_i8(AP_w_out, D, D, AP_WOUT8, AP_CPARTO, AP_WOUTS, scr, it, lane);
      for (int it = gw; it < (D / 64) * (D / 32); it += NGW) p1_transpose_item_i8(AP_w_pq, D, D, AP_WPQ8, AP_CPARTQ, AP_WPQS, scr, it, lane); }
    for (int it = gw; it < M / 8; it += NGW) { const size_t row0 = (size_t)it * 8; const int b = (int)(row0 >> 11);
        norm_rows(AP_x, row0, 8, AP_g1, AP_MOD + b * 6 * D + 0 * D, AP_MOD + b * 6 * D + 1 * D, nullptr, lane, AP_H8, AP_HS); }
    for (int it = gw; it < MC; it += NGW) norm_rows(AP_ctx, (size_t)it, 1, AP_g1, AP_MOD + 8 * 6 * D + 0 * D, AP_MOD + 8 * 6 * D + 1 * D, nullptr, lane, AP_HC8, AP_HCS);
}
__device__ __forceinline__ void p5_norm2(const Frame& F, const Args& A) {
    const int lane = lane_id(), tid = F.wave * 64 + lane; (void)tid;
    const int gw = F.vcu * NWAVES + F.wave, NGW = F.G * NWAVES;
    for (int it = gw; it < M / 8; it += NGW) { const size_t row0 = (size_t)it * 8; const int b = (int)(row0 >> 11);
        norm_rows_b(AP_X1B, row0, 8, AP_g2, AP_MOD + b * 6 * D + 3 * D, AP_MOD + b * 6 * D + 4 * D, nullptr, lane, AP_H2Q, AP_H2S); }
}

__device__ __forceinline__ f32x4 dq4(const f32x4 a, const f32x4 cs, const float rs) {
    typedef int v4i_ __attribute__((ext_vector_type(4))); const v4i_ iv = __builtin_bit_cast(v4i_, a);
    f32x4 r; r.x = (float)iv.x; r.y = (float)iv.y; r.z = (float)iv.z; r.w = (float)iv.w; return r * cs * rs;
}
struct EpiProj {
    static constexpr bool PERM = true, AFTER_DRAIN = false;
    bf16 *Q, *Kp, *VTp, *BG, *CG, *U; const float *qn, *kn; LAS float* xch; int region0, tshift; float qscale; const float *rs, *csb;
    __device__ __forceinline__ void operator()(const f32x4 (&acc)[2][2][4][2], const pg8::Unit& u, int wr, int wc, int fr, int fq) const {
        const int region = (u.pn >> 2) + region0, pnl = u.pn & 3;
        const int rowt = wr * 64 + fr;
        f32x4 cs_[2][2]; float rsc_[2][4];
#pragma unroll
        for (int bj = 0; bj < 2; ++bj)
#pragma unroll
            for (int n = 0; n < 2; ++n) cs_[bj][n] = *(const f32x4*)(csb + u.pn * 256 + bj * 128 + 32 * wc + 8 * fq + 4 * n);
#pragma unroll
        for (int ai = 0; ai < 2; ++ai)
#pragma unroll
            for (int m = 0; m < 4; ++m) rsc_[ai][m] = rs[u.pm * 256 + ai * 128 + rowt + m * 16];
#define DQ(ai_, bj_, m_, n_) dq4(acc[ai_][bj_][m_][n_], cs_[bj_][n_], rsc_[ai_][m_])
        if (region <= 1) {
#pragma unroll
            for (int ai = 0; ai < 2; ++ai)
#pragma unroll
                for (int m = 0; m < 4; ++m)
#pragma unroll
                    for (int bj = 0; bj < 2; ++bj) { const f32x4 a = DQ(ai, bj, m, 0), b = DQ(ai, bj, m, 1);
                        float s = (a.x * a.x + a.y * a.y) + (a.z * a.z + a.w * a.w) + (b.x * b.x + b.y * b.y) + (b.z * b.z + b.w * b.w);
                        s += __shfl_xor(s, 16); s += __shfl_xor(s, 32);
                        if (fq == 0) xch[((ai * 128 + rowt + m * 16) * 2 + bj) * 4 + wc] = s; }
            asm volatile("s_waitcnt lgkmcnt(0)" ::: "memory"); __builtin_amdgcn_s_barrier(); asm volatile("" ::: "memory");
            const float* gain = (region == 0) ? qn : kn; const float mul = (region == 0) ? qscale : 1.f; bf16* O = (region == 0) ? Q : Kp;
            const f32x4 g0 = *(const f32x4*)(gain + 32 * wc + 8 * fq), g1 = *(const f32x4*)(gain + 32 * wc + 8 * fq + 4);
#pragma unroll
            for (int ai = 0; ai < 2; ++ai)
#pragma unroll
                for (int m = 0; m < 4; ++m) { const int rt = ai * 128 + rowt + m * 16; bf16* rowp = O + (size_t)(u.pm * 256 + rt) * DA + (2 * pnl) * HD + 32 * wc + 8 * fq;
#pragma unroll
                    for (int bj = 0; bj < 2; ++bj) { const f32x4 p = *(const LAS f32x4*)(xch + (rt * 2 + bj) * 4);
                        const float rstd = __builtin_amdgcn_rsqf(((p.x + p.y) + (p.z + p.w)) * (1.f / HD) + EPS) * mul;
                        const f32x4 v0 = DQ(ai, bj, m, 0) * rstd * g0, v1 = DQ(ai, bj, m, 1) * rstd * g1;
                        v4u w; w.x = pk2(v0.x, v0.y); w.y = pk2(v0.z, v0.w); w.z = pk2(v1.x, v1.y); w.w = pk2(v1.z, v1.w);
                        *(v4u*)(rowp + bj * HD) = w; } }
        } else if (region == 2) {
            const int tmask = (1 << tshift) - 1;
#pragma unroll
            for (int ai = 0; ai < 2; ++ai)
#pragma unroll
                for (int m = 0; m < 4; ++m) { const int row = u.pm * 256 + ai * 128 + rowt + m * 16; const int b = row >> tshift, t = row & tmask;
#pragma unroll
                    for (int bj = 0; bj < 2; ++bj) { const int head = 2 * pnl + bj; bf16* base = VTp + (((size_t)(b * NH + head) * HD + 32 * wc + 8 * fq) << tshift) + t;
#pragma unroll
                        for (int n = 0; n < 2; ++n) { const f32x4 a = DQ(ai, bj, m, n); const unsigned w0 = pk2(a.x, a.y), w1 = pk2(a.z, a.w);
                            base[(size_t)(4 * n + 0) << tshift] = (bf16)(w0 & 0xffffu); base[(size_t)(4 * n + 1) << tshift] = (bf16)(w0 >> 16);
                            base[(size_t)(4 * n + 2) << tshift] = (bf16)(w1 & 0xffffu); base[(size_t)(4 * n + 3) << tshift] = (bf16)(w1 >> 16); } } }
        } else {
            bf16* O = (region == 3) ? BG : (region == 4) ? CG : U;
#pragma unroll
            for (int ai = 0; ai < 2; ++ai)
#pragma unroll
                for (int m = 0; m < 4; ++m) { bf16* rowp = O + (size_t)(u.pm * 256 + ai * 128 + rowt + m * 16) * DA + pnl * 256 + 32 * wc + 8 * fq;
#pragma unroll
                    for (int bj = 0; bj < 2; ++bj) { const f32x4 v0 = DQ(ai, bj, m, 0), v1 = DQ(ai, bj, m, 1);
                        v4u w; w.x = pk2(v0.x, v0.y); w.y = pk2(v0.z, v0.w); w.z = pk2(v1.x, v1.y); w.w = pk2(v1.z, v1.w);
                        *(v4u*)(rowp + bj * HD) = w; } }
        }
#undef DQ
    }
};
struct EpiBf16 {
    static constexpr bool PERM = true, AFTER_DRAIN = false;
    bf16* O; int ldc; const float *rs, *csb;
    __device__ __forceinline__ void operator()(const f32x4 (&acc)[2][2][4][2], const pg8::Unit& u, int wr, int wc, int fr, int fq) const {
        const int row0 = u.pm * 256 + wr * 64 + fr, col0 = u.pn * 256 + wc * 32 + 8 * fq;
#pragma unroll
        for (int ai = 0; ai < 2; ++ai)
#pragma unroll
            for (int m = 0; m < 4; ++m) { bf16* rowp = O + (size_t)(row0 + ai * 128 + m * 16) * ldc + col0;
#pragma unroll
                for (int bj = 0; bj < 2; ++bj) { const float rsv = rs[row0 + ai * 128 + m * 16]; const f32x4 v0 = dq4(acc[ai][bj][m][0], *(const f32x4*)(csb + col0 + bj * 128), rsv), v1 = dq4(acc[ai][bj][m][1], *(const f32x4*)(csb + col0 + bj * 128 + 4), rsv);
                    v4u w; w.x = pk2(v0.x, v0.y); w.y = pk2(v0.z, v0.w); w.z = pk2(v1.x, v1.y); w.w = pk2(v1.z, v1.w);
                    *(v4u*)(rowp + bj * 128) = w; } }
    }
};
struct EpiRes {
    static constexpr bool PERM = true, AFTER_DRAIN = false;
    const float* base; bf16* out; const float* mod; int gofs; const float* csb; float sa;
    __device__ __forceinline__ void operator()(const f32x4 (&acc)[2][2][4][2], const pg8::Unit& u, int wr, int wc, int fr, int fq) const {
        const int row0 = u.pm * 256 + wr * 64 + fr, col0 = u.pn * 256 + wc * 32 + 8 * fq;
        const float* gp = mod + (size_t)(u.pm >> 3) * 6 * D + gofs + col0;
        f32x4 gv[2][2];
#pragma unroll
        for (int bj = 0; bj < 2; ++bj)
#pragma unroll
            for (int n = 0; n < 2; ++n) gv[bj][n] = *(const f32x4*)(gp + bj * 128 + 4 * n);
        f32x4 cs_[2][2];
#pragma unroll
        for (int bj = 0; bj < 2; ++bj)
#pragma unroll
            for (int n = 0; n < 2; ++n) cs_[bj][n] = *(const f32x4*)(csb + col0 + bj * 128 + 4 * n);
#pragma unroll
        for (int ai = 0; ai < 2; ++ai)
#pragma unroll
            for (int m = 0; m < 4; ++m) { const size_t off = (size_t)(row0 + ai * 128 + m * 16) * D + col0;
#pragma unroll
                for (int bj = 0; bj < 2; ++bj) { const f32x4 b0 = *(const f32x4*)(base + off + bj * 128), b1 = *(const f32x4*)(base + off + bj * 128 + 4);
                    const f32x4 v0 = b0 + gv[bj][0] * dq4(acc[ai][bj][m][0], cs_[bj][0], sa), v1 = b1 + gv[bj][1] * dq4(acc[ai][bj][m][1], cs_[bj][1], sa);
                    v4u w; w.x = pk2(v0.x, v0.y); w.y = pk2(v0.z, v0.w); w.z = pk2(v1.x, v1.y); w.w = pk2(v1.z, v1.w);
                    *(v4u*)(out + off + bj * 128) = w; }
                asm volatile("" ::: "memory"); }
    }
};

__device__ __forceinline__ void attn_phase(const Frame& F, const Args& A) {
    const int lane = lane_id(), tid = F.wave * 64 + lane; (void)tid;
    LAS float* bias = (LAS float*)(F.lds + XCH_OFF);
    LAS unsigned char* kl = F.lds + F.wave * 16384;
    LAS unsigned char* vl = kl + 8192;
    const int bh = F.vcu >> 2, b = bh >> 3, h = bh & 7;
    for (int i = tid; i < 15 * 31; i += NWAVES * 64) bias[i] = AP_rpb[h * 465 + i] * LOG2E;
    __syncthreads();
    const int r = 8 * (F.vcu & 3) + F.wave;
    const int rs = min(max(r - 4, 0), 24);
    const int q = lane & 31, hh = lane >> 5;
    const int l4 = lane >> 4, c16 = lane & 15, l2 = lane >> 2, g4 = lane & 3;
    const unsigned char* Kb = (const unsigned char*)(AP_K + (size_t)b * SEQ * DA + h * HD);
    const unsigned char* VTb = (const unsigned char*)(AP_VTR + (size_t)(b * NH + h) * HD * SEQ);
    const unsigned char* KCb = (const unsigned char*)(AP_KC + (size_t)b * CTXL * DA + h * HD);
    const unsigned char* VCb = (const unsigned char*)(AP_VCT + (size_t)(b * NH + h) * HD * CTXL);
    for (int qh = 0; qh < 2; ++qh) {
        const int c0 = qh ? 24 : 0, qcol = qh * 32 + q, cs = min(max(qcol - 8, 0), 48);
        const bf16* qp = AP_Q + (size_t)(b * SEQ + r * GW + qcol) * DA + h * HD + 32 * hh;
        bf16x8 qf[8];
#pragma unroll
        for (int s = 0; s < 8; ++s) qf[s] = *(const bf16x8*)(qp + 64 * (s >> 2) + 8 * (s & 3));
        f32x16 o[4];
#pragma unroll
        for (int db = 0; db < 4; ++db)
#pragma unroll
            for (int i = 0; i < 16; ++i) o[db][i] = 0.f;
        float mrun = -1e30f, lrun = 0.f;
        const int gsw = g4 ^ ((l2 >> 2) & 3);
#define ATT_KDMA(KB_) do { const int kb_ = (KB_); \
            if (kb_ < 10) { \
                _Pragma("unroll") for (int i_ = 0; i_ < 8; ++i_) { const int rho_ = 4 * i_ + l4; const int kk_ = kb_ * 32 + (4 * ((i_ >> 1) & 1) + 8 * (i_ & 1) + 16 * (i_ >> 2)) + l4, krow_ = (kk_ * 205) >> 13, kc_ = c0 + kk_ - krow_ * 40; \
                    __builtin_amdgcn_global_load_lds((const unsigned*)(Kb + (unsigned)(((rs + krow_) * GW + kc_) * (DA * 2) + 16 * (c16 ^ (rho_ & 15)))), (LAS unsigned*)(kl + i_ * 1024), 16, 0, 0); } \
            } else { \
                _Pragma("unroll") for (int i_ = 0; i_ < 8; ++i_) { const int rho_ = 4 * i_ + l4; const int l_ = (kb_ - 10) * 32 + (4 * ((i_ >> 1) & 1) + 8 * (i_ & 1) + 16 * (i_ >> 2)) + l4; \
                    __builtin_amdgcn_global_load_lds((const unsigned*)(KCb + (unsigned)(l_ * (DA * 2) + 16 * (c16 ^ (rho_ & 15)))), (LAS unsigned*)(kl + i_ * 1024), 16, 0, 0); } \
            } } while (0)
#define ATT_VDMA(KB_) do { const int kb_ = (KB_); \
            if (kb_ < 10) { \
                const int k0_ = kb_ * 32 + 8 * gsw, vr_ = (k0_ * 205) >> 13, vc_ = c0 + k0_ - vr_ * 40; const unsigned vo_ = (unsigned)((l2 * SEQ + (rs + vr_) * GW + vc_) * 2); \
                _Pragma("unroll") for (int i_ = 0; i_ < 8; ++i_) __builtin_amdgcn_global_load_lds((const unsigned*)(VTb + vo_ + (unsigned)(i_ * 16 * SEQ * 2)), (LAS unsigned*)(vl + i_ * 1024), 16, 0, 0); \
            } else { \
                const unsigned vo_ = (unsigned)((l2 * CTXL + (kb_ - 10) * 32 + 8 * gsw) * 2); \
                _Pragma("unroll") for (int i_ = 0; i_ < 8; ++i_) __builtin_amdgcn_global_load_lds((const unsigned*)(VCb + vo_ + (unsigned)(i_ * 16 * CTXL * 2)), (LAS unsigned*)(vl + i_ * 1024), 16, 0, 0); \
            } } while (0)
        asm volatile("s_waitcnt vmcnt(0) lgkmcnt(0)" ::: "memory");
        ATT_KDMA(0); ATT_VDMA(0);
        for (int kb = 0; kb < 18; ++kb) {
            const bool win = kb < 10;
            asm volatile("s_waitcnt vmcnt(8)" ::: "memory");
            bf16x8 kf[8];
#pragma unroll
            for (int s = 0; s < 8; ++s) kf[s] = *(const LAS bf16x8*)(kl + q * 256 + 16 * ((8 * (s >> 2) + 4 * hh + (s & 3)) ^ (q & 15)));
            asm volatile("s_waitcnt lgkmcnt(0)" ::: "memory");
            if (kb + 1 < 18) ATT_KDMA(kb + 1);
            f32x16 sa;
#pragma unroll
            for (int i = 0; i < 16; ++i) sa[i] = 0.f;
#pragma unroll
            for (int s = 0; s < 8; ++s) sa = __builtin_amdgcn_mfma_f32_32x32x16_bf16(kf[s], qf[s], sa, 0, 0, 0);
            if (win) {
#pragma unroll
                for (int i = 0; i < 16; ++i) {
                    const int g = kb * 4 + 2 * (i >> 3) + hh, w = (i & 3) + 4 * ((i >> 2) & 1);
                    const int krow = (g * 205) >> 10, kcol = c0 + 8 * (g - 5 * krow) + w;
                    const int dr = rs + krow - r + 7;
                    const int dc = min(max(kcol - qcol, -15), 15) + 15;
                    const bool inw = (unsigned)(kcol - cs) < 16u;
                    sa[i] = inw ? sa[i] + bias[dr * 31 + dc] : -1e30f;
                }
            }
            float bm = sa[0];
#pragma unroll
            for (int i = 1; i < 16; ++i) bm = fmaxf(bm, sa[i]);
            bm = fmaxf(bm, __shfl_xor(bm, 32));
            if (!__all(bm - mrun <= 6.0f)) {
                const float mnew = fmaxf(mrun, bm), alpha = __builtin_amdgcn_exp2f(mrun - mnew);
                mrun = mnew; lrun *= alpha;
#pragma unroll
                for (int db = 0; db < 4; ++db)
#pragma unroll
                    for (int i = 0; i < 16; ++i) o[db][i] *= alpha;
            }
            float ps = 0.f;
#pragma unroll
            for (int i = 0; i < 16; ++i) { sa[i] = __builtin_amdgcn_exp2f(sa[i] - mrun); ps += sa[i]; }
            lrun += ps;
            bf16x8 pf[2];
#pragma unroll
            for (int s2 = 0; s2 < 2; ++s2) { v4u w; w.x = pk2(sa[8 * s2 + 0], sa[8 * s2 + 1]); w.y = pk2(sa[8 * s2 + 2], sa[8 * s2 + 3]); w.z = pk2(sa[8 * s2 + 4], sa[8 * s2 + 5]); w.w = pk2(sa[8 * s2 + 6], sa[8 * s2 + 7]); pf[s2] = __builtin_bit_cast(bf16x8, w); }
            if (kb + 1 < 18) asm volatile("s_waitcnt vmcnt(8)" ::: "memory"); else asm volatile("s_waitcnt vmcnt(0)" ::: "memory");
            bf16x8 vf[4][2];
#pragma unroll
            for (int db = 0; db < 4; ++db) { const int dd = db * 32 + q;
                vf[db][0] = *(const LAS bf16x8*)(vl + dd * 64 + 16 * ((0 + hh) ^ ((dd >> 2) & 3))); vf[db][1] = *(const LAS bf16x8*)(vl + dd * 64 + 16 * ((2 + hh) ^ ((dd >> 2) & 3))); }
            asm volatile("s_waitcnt lgkmcnt(0)" ::: "memory");
            if (kb + 1 < 18) ATT_VDMA(kb + 1);
#pragma unroll
            for (int db = 0; db < 4; ++db) { o[db] = __builtin_amdgcn_mfma_f32_32x32x16_bf16(vf[db][0], pf[0], o[db], 0, 0, 0); o[db] = __builtin_amdgcn_mfma_f32_32x32x16_bf16(vf[db][1], pf[1], o[db], 0, 0, 0); }
        }
#undef ATT_KDMA
#undef ATT_VDMA
        const float ltot = lrun + __shfl_xor(lrun, 32), inv = 1.f / ltot;
        float ss = 0.f;
#pragma unroll
        for (int db = 0; db < 4; ++db)
#pragma unroll
            for (int i = 0; i < 16; ++i) { o[db][i] *= inv; ss += o[db][i] * o[db][i]; }
        ss += __shfl_xor(ss, 32);
        const float rstd = __builtin_amdgcn_rsqf(ss * (1.f / HD) + EPS);
        unsigned char* op = AP_A28 + (size_t)(b * SEQ + r * GW + qcol) * D + h * HD + 4 * hh;
        const float* gp = AP_gao + h * HD + 4 * hh; const float rq = rstd * A2_INV;
#pragma unroll
        for (int db = 0; db < 4; ++db)
#pragma unroll
            for (int i4 = 0; i4 < 4; ++i4) { const f32x4 g = *(const f32x4*)(gp + db * 32 + 8 * i4);
                f32x4 y; y.x = o[db][4 * i4 + 0] * g.x; y.y = o[db][4 * i4 + 1] * g.y; y.z = o[db][4 * i4 + 2] * g.z; y.w = o[db][4 * i4 + 3] * g.w;
                *(unsigned*)(op + db * 32 + 8 * i4) = q4(y, rq); }
    }
    __syncthreads();
}

__device__ __forceinline__ void unpack16(const v4u a, const v4u b, float (&f)[16]) {
    f[0] = bflo(a.x); f[1] = bfhi(a.x); f[2] = bflo(a.y); f[3] = bfhi(a.y); f[4] = bflo(a.z); f[5] = bfhi(a.z); f[6] = bflo(a.w); f[7] = bfhi(a.w);
    f[8] = bflo(b.x); f[9] = bfhi(b.x); f[10] = bflo(b.y); f[11] = bfhi(b.y); f[12] = bflo(b.z); f[13] = bfhi(b.z); f[14] = bflo(b.w); f[15] = bfhi(b.w);
}
__device__ __forceinline__ void load_z(const bf16* CGp, const bf16* Up, size_t m, int lane, float (&z)[16]) {
    const v4u* cp = (const v4u*)(CGp + m * DA + 16 * lane); const v4u* up = (const v4u*)(Up + m * DA + 16 * lane);
    const v4u c0 = cp[0], c1 = cp[1], u0 = up[0], u1 = up[1];
    float cf[16], uf[16]; unpack16(c0, c1, cf); unpack16(u0, u1, uf);
#pragma unroll
    for (int i = 0; i < 16; ++i) z[i] = cf[i] * uf[i];
}
__device__ __forceinline__ void conv_phase(const Frame& F, const Args& A) {
    const int lane = lane_id(), tid = F.wave * 64 + lane; (void)tid;
    const int gw = F.vcu * NWAVES + F.wave, NGW = F.G * NWAVES;
    float w0[16], w1[16], w2[16], gg[16];
#pragma unroll
    for (int i = 0; i < 16; ++i) { w0[i] = AP_w_conv[0 * DA + 16 * lane + i]; w1[i] = AP_w_conv[1 * DA + 16 * lane + i]; w2[i] = AP_w_conv[2 * DA + 16 * lane + i]; gg[i] = AP_gco[16 * lane + i]; }
    for (int it = gw; it < M / 8; it += NGW) {
        const size_t m0 = (size_t)it * 8;
        float zp[16], zc[16], zn[16];
        if ((m0 & (SEQ - 1)) == 0) {
#pragma unroll
            for (int i = 0; i < 16; ++i) zp[i] = 0.f;
        } else load_z(AP_CG, AP_U, m0 - 1, lane, zp);
        load_z(AP_CG, AP_U, m0, lane, zc);
        for (int j = 0; j < 8; ++j) {
            const size_t m = m0 + j;
            if ((m & (SEQ - 1)) == SEQ - 1) {
#pragma unroll
                for (int i = 0; i < 16; ++i) zn[i] = 0.f;
            } else load_z(AP_CG, AP_U, m + 1, lane, zn);
            const v4u* bp = (const v4u*)(AP_BG + m * DA + 16 * lane); const v4u b0 = bp[0], b1 = bp[1];
            float bf[16]; unpack16(b0, b1, bf);
            float y[16], ss = 0.f;
#pragma unroll
            for (int i = 0; i < 16; ++i) { y[i] = bf[i] * (w0[i] * zp[i] + w1[i] * zc[i] + w2[i] * zn[i]); ss += y[i] * y[i]; }
            ss += __shfl_xor(ss, 1); ss += __shfl_xor(ss, 2); ss += __shfl_xor(ss, 4);
            const float rstd = __builtin_amdgcn_rsqf(ss * (1.f / 128.f) + EPS);
            const float rq = rstd * A2_INV; v4u o0;
            { f32x4 t0 = {y[0] * gg[0], y[1] * gg[1], y[2] * gg[2], y[3] * gg[3]}, t1 = {y[4] * gg[4], y[5] * gg[5], y[6] * gg[6], y[7] * gg[7]};
              f32x4 t2 = {y[8] * gg[8], y[9] * gg[9], y[10] * gg[10], y[11] * gg[11]}, t3 = {y[12] * gg[12], y[13] * gg[13], y[14] * gg[14], y[15] * gg[15]};
              o0.x = q4(t0, rq); o0.y = q4(t1, rq); o0.z = q4(t2, rq); o0.w = q4(t3, rq); }
            *(v4u*)(AP_A28 + m * D + DA + 16 * lane) = o0;
#pragma unroll
            for (int i = 0; i < 16; ++i) { zp[i] = zc[i]; zc[i] = zn[i]; }
        }
    }
}

__device__ __forceinline__ unsigned f2key(float f) { const unsigned u = __builtin_bit_cast(unsigned, f); return (u & 0x80000000u) ? ~u : (u | 0x80000000u); }
__device__ __forceinline__ float key2f(unsigned k) { const unsigned u = (k & 0x80000000u) ? (k & 0x7fffffffu) : ~k; return __builtin_bit_cast(float, u); }
__device__ __forceinline__ void ce_desc(unsigned& a, unsigned& b) { const unsigned hi = max(a, b), lo = min(a, b); a = hi; b = lo; }
template <int BASE> __device__ __forceinline__ void sort16_desc(unsigned (&v)[64]) {
#pragma unroll
    for (int k = 2; k <= 16; k <<= 1)
#pragma unroll
        for (int j = k >> 1; j >= 1; j >>= 1)
#pragma unroll
            for (int i = 0; i < 16; ++i) { const int l = i ^ j; if (l > i) { if ((i & k) == 0) ce_desc(v[BASE + i], v[BASE + l]); else ce_desc(v[BASE + l], v[BASE + i]); } }
}
template <int A_, int B_> __device__ __forceinline__ void merge_top16(unsigned (&v)[64]) {
#pragma unroll
    for (int i = 0; i < 16; ++i) v[A_ + i] = max(v[A_ + i], v[B_ + 15 - i]);
#pragma unroll
    for (int j = 8; j >= 1; j >>= 1)
#pragma unroll
        for (int i = 0; i < 16; ++i) { const int l = i ^ j; if (l > i) ce_desc(v[A_ + i], v[A_ + l]); }
}
__device__ __forceinline__ void top16_of_64(unsigned (&v)[64]) {
    sort16_desc<0>(v); sort16_desc<16>(v); sort16_desc<32>(v); sort16_desc<48>(v);
    merge_top16<0, 16>(v); merge_top16<32, 48>(v); merge_top16<0, 32>(v);
}
__device__ __forceinline__ void peer_select_phase(const Frame& F, const Args& A) {
    const int lane = lane_id(), tid = F.wave * 64 + lane; (void)tid;
    const int gw = F.vcu * NWAVES + F.wave, NGW = F.G * NWAVES, tk = lane & 31, hh = lane >> 5;
    LAS unsigned char* qimg = F.lds + F.wave * 16384;
    LAS unsigned char* kimg = qimg + 8192;
    LAS int* ixs = (LAS int*)qimg;
    const int l4 = lane >> 4, c16 = lane & 15;
    unsigned nh4 = (unsigned)(1 - hh) << 2; asm volatile("" : "+v"(nh4));
    for (int task = gw; task < (M / 32) * PH; task += NGW) {
        const int h = task & 7, tb = task >> 3; const int token = tb * 32 + tk;
        unsigned best[2][16];
#pragma unroll
        for (int p = 0; p < 2; ++p) {
            const unsigned char* qsrc = (const unsigned char*)(AP_QP + (size_t)(tb * 32) * D + h * 256 + p * 128);
            const unsigned char* ksrc = (const unsigned char*)(AP_SK + (size_t)((h * 2 + p) * NKEYS) * 128);
            unsigned bq = (unsigned)(l4 * (D * 2) + 16 * (c16 ^ l4)), bk = (unsigned)(l4 * 256 + 16 * (c16 ^ l4));
            asm volatile("s_waitcnt vmcnt(0) lgkmcnt(0)" : "+v"(bq), "+v"(bk) : : "memory");
#pragma unroll
            for (int i = 0; i < 8; ++i) __builtin_amdgcn_global_load_lds((const unsigned*)(qsrc + ((bq ^ (unsigned)(64 * (i & 3))) + (unsigned)(i * 4 * D * 2))), (LAS unsigned*)(qimg + i * 1024), 16, 0, 0);
#define PS_KDMA(KB_) do { _Pragma("unroll") for (int i_ = 0; i_ < 8; ++i_) \
                __builtin_amdgcn_global_load_lds((const unsigned*)(ksrc + ((bk ^ (unsigned)(64 * (i_ & 3))) + (unsigned)((KB_) * 8192 + i_ * 1024))), (LAS unsigned*)(kimg + i_ * 1024), 16, 0, 0); } while (0)
            PS_KDMA(0);
            asm volatile("s_waitcnt vmcnt(8)" ::: "memory");
            bf16x8 qf[8];
#pragma unroll
            for (int s = 0; s < 8; ++s) qf[s] = *(const LAS bf16x8*)(qimg + tk * 256 + 16 * ((8 * (s >> 2) + 4 * hh + (s & 3)) ^ (tk & 15)));
            unsigned ky[64];
#pragma unroll
            for (int kb = 0; kb < 4; ++kb) {
                asm volatile("s_waitcnt vmcnt(0)" ::: "memory");
                bf16x8 kf[8];
#pragma unroll
                for (int s = 0; s < 8; ++s) kf[s] = *(const LAS bf16x8*)(kimg + tk * 256 + 16 * ((8 * (s >> 2) + 4 * hh + (s & 3)) ^ (tk & 15)));
                asm volatile("s_waitcnt lgkmcnt(0)" ::: "memory");
                if (kb < 3) PS_KDMA(kb + 1);
                f32x16 sa;
#pragma unroll
                for (int i = 0; i < 16; ++i) sa[i] = 0.f;
#pragma unroll
                for (int s = 0; s < 8; ++s) sa = __builtin_amdgcn_mfma_f32_32x32x16_bf16(kf[s], qf[s], sa, 0, 0, 0);
#pragma unroll
                for (int i = 0; i < 16; ++i) { const unsigned ck = (unsigned)(127 - (kb * 32 + (i & 3) + 8 * (i >> 2))) & ~4u;
                    ky[kb * 16 + i] = ((f2key(sa[i]) & ~127u) | nh4) | ck; }
                asm volatile("" ::: "memory");
            }
#undef PS_KDMA
            top16_of_64(ky);
#pragma unroll
            for (int i = 0; i < 16; ++i) ky[16 + i] = (unsigned)__shfl_xor((int)ky[i], 32);
            merge_top16<0, 16>(ky);
#pragma unroll
            for (int i = 0; i < 16; ++i) best[p][i] = ky[i];
        }
        float s1[16], s2[16];
#pragma unroll
        for (int i = 0; i < 16; ++i) { s1[i] = key2f(best[0][i] & ~127u); s2[i] = key2f(best[1][i] & ~127u);
            ixs[i * 64 + lane] = 127 - (int)(best[0][i] & 127u); ixs[(16 + i) * 64 + lane] = 127 - (int)(best[1][i] & 127u); }
        unsigned cd[64]; { int n = 0;
#pragma unroll
            for (int i = 0; i < 16; ++i)
#pragma unroll
                for (int j = 0; j < 16; ++j) if ((i + 1) * (j + 1) <= 16) { cd[n] = (f2key(s1[i] + s2[j]) & ~255u) | (unsigned)(255 - (16 * i + j)); ++n; }
#pragma unroll
            for (int i = 50; i < 64; ++i) cd[i] = 0u; }
        top16_of_64(cd);
        unsigned win[16];
#pragma unroll
        for (int i = 0; i < 16; ++i) win[i] = cd[i];
        LDS_WAIT();
        const float vmax = key2f(win[0] & ~255u);
        float ev[16], es = 0.f;
#pragma unroll
        for (int rnd = 0; rnd < 16; ++rnd) { ev[rnd] = __expf(key2f(win[rnd] & ~255u) - vmax); es += ev[rnd]; }
        const float ies = 1.f / es;
        if (hh == 0) {
            int* ip = AP_SELI + (size_t)token * 128 + h * 16; float* gp = AP_SELG + (size_t)token * 128 + h * 16;
#pragma unroll
            for (int rnd = 0; rnd < 16; ++rnd) { const int pos = 255 - (int)(win[rnd] & 255u); const int i1 = ixs[(pos >> 4) * 64 + lane], i2 = ixs[(16 + (pos & 15)) * 64 + lane];
                ip[rnd] = i1 * NKEYS + i2; gp[rnd] = ev[rnd] * ies; }
        }
        LDS_WAIT();
    }
}

typedef int v4i __attribute__((ext_vector_type(4)));
__device__ __forceinline__ float gelu_as(const float v) {
    const float av = fabsf(v), t = __builtin_amdgcn_rcpf(av * 0.2316418882f + 1.0f);
    float q = t * 0.5307027145f + (-0.7265760135f); q = q * t + 0.7107068705f; q = q * t + (-0.142248368f); q = q * t + 0.127414796f; q = q * t;
    const float e = __builtin_amdgcn_exp2f((v * v) * (-0.72134752044f));
    const float m = v * (q * e);
    return v < 0.f ? m : v - m;
}
constexpr int PL_WAVE = 16384, PL_EL = 8192, PL_PACC = 10240, PL_AQ = 14336, PL_SA = 15360;
__device__ __forceinline__ float wave_maxf(float v) {
#pragma unroll
    for (int o = 1; o < 64; o <<= 1) v = fmaxf(v, __shfl_xor(v, o));
    return v;
}
__device__ __forceinline__ void peer_u_phase(const Frame& F, const Args& A, float (&sa)[8]) {
    const int lane = lane_id(), p = lane >> 2, sub = lane & 3;
    LAS unsigned short* elist = (LAS unsigned short*)(F.lds + F.wave * PL_WAVE + PL_EL);
    LAS int* pacc = (LAS int*)(F.lds + F.wave * PL_WAVE + PL_PACC);
    LAS signed char* aq = (LAS signed char*)(F.lds + F.wave * PL_WAVE + PL_AQ);
    const int tok0 = F.vcu * 64 + F.wave * 8;
    for (int it = 0; it < 16; ++it) { elist[it * 64 + lane] = (unsigned short)AP_SELI[(size_t)tok0 * 128 + it * 64 + lane]; pacc[it * 64 + lane] = 0; }
    LDS_WAIT();
    v4u G0[4], G1[4], G2[4], G3[4], hreg[2];
    const unsigned char* ub = AP_U8 + 16 * sub;
    LAS unsigned char* hst = F.lds + F.wave * PL_WAVE;
#define PU_LOAD(G_, K_) do { const int kg_ = (K_), tp_ = kg_ & 31; const unsigned ea_ = elist[(2 * tp_) * 16 + p], eb_ = elist[(2 * tp_ + 1) * 16 + p]; \
            const unsigned char* ua_ = ub + (size_t)ea_ * D + 128 * (kg_ >> 5); const unsigned char* ubb_ = ub + (size_t)eb_ * D + 128 * (kg_ >> 5); \
            G_[0] = *(const v4u*)(ua_); G_[1] = *(const v4u*)(ua_ + 64); G_[2] = *(const v4u*)(ubb_); G_[3] = *(const v4u*)(ubb_ + 64); } while (0)
#define PU_DOT8(A0_, A1_) ([&]() { int d0_ = 0, d1_ = 0, d2_ = 0, d3_ = 0; \
            d0_ = __builtin_amdgcn_sdot4((int)(A0_).x, (int)hreg[0].x, d0_, false); d1_ = __builtin_amdgcn_sdot4((int)(A0_).y, (int)hreg[0].y, d1_, false); \
            d2_ = __builtin_amdgcn_sdot4((int)(A0_).z, (int)hreg[0].z, d2_, false); d3_ = __builtin_amdgcn_sdot4((int)(A0_).w, (int)hreg[0].w, d3_, false); \
            d0_ = __builtin_amdgcn_sdot4((int)(A1_).x, (int)hreg[1].x, d0_, false); d1_ = __builtin_amdgcn_sdot4((int)(A1_).y, (int)hreg[1].y, d1_, false); \
            d2_ = __builtin_amdgcn_sdot4((int)(A1_).z, (int)hreg[1].z, d2_, false); d3_ = __builtin_amdgcn_sdot4((int)(A1_).w, (int)hreg[1].w, d3_, false); \
            int v_ = (d0_ + d1_) + (d2_ + d3_); \
            v_ += __builtin_amdgcn_update_dpp(0, v_, 0xB1, 0xf, 0xf, true); v_ += __builtin_amdgcn_update_dpp(0, v_, 0x4E, 0xf, 0xf, true); return v_; }())
#define PU_COMPUTE(G_, TP_) do { const int va_ = PU_DOT8(G_[0], G_[1]), vb_ = PU_DOT8(G_[2], G_[3]); \
            if (sub == 0) { (void)__hip_atomic_fetch_add(pacc + (2 * (TP_)) * 16 + p, va_, __ATOMIC_RELAXED, __HIP_MEMORY_SCOPE_WORKGROUP); \
                            (void)__hip_atomic_fetch_add(pacc + (2 * (TP_) + 1) * 16 + p, vb_, __ATOMIC_RELAXED, __HIP_MEMORY_SCOPE_WORKGROUP); } } while (0)
    PU_LOAD(G0, 0); PU_LOAD(G1, 1); PU_LOAD(G2, 2); PU_LOAD(G3, 3);
    for (int slice = 0; slice < 16; ++slice) {
        { const int tk_ = lane >> 3, pc_ = lane & 7;
          *(LAS v4u*)(hst + tk_ * 128 + 16 * pc_) = *(const v4u*)(AP_H2Q + (size_t)(tok0 + tk_) * D + 128 * slice + 16 * pc_); }
        for (int tk = 0; tk < 8; ++tk) {
            hreg[0] = *(const LAS v4u*)(hst + tk * 128 + 16 * sub); hreg[1] = *(const LAS v4u*)(hst + tk * 128 + 64 + 16 * sub);
            { const int tp = tk * 4, k = slice * 32 + tp;
                PU_COMPUTE(G0, tp);     PU_LOAD(G0, (k + 4) & 511);
                PU_COMPUTE(G1, tp + 1); PU_LOAD(G1, (k + 5) & 511);
                PU_COMPUTE(G2, tp + 2); PU_LOAD(G2, (k + 6) & 511);
                PU_COMPUTE(G3, tp + 3); PU_LOAD(G3, (k + 7) & 511);
            }
        }
        if ((slice & 3) == 3) __builtin_amdgcn_s_barrier();
    }
#undef PU_LOAD
#undef PU_COMPUTE
#undef PU_DOT8
    LDS_WAIT();
#pragma unroll
    for (int t = 0; t < 8; ++t) { const int token = tok0 + t; const float hs = AP_H2S[token]; float av[2];
#pragma unroll
        for (int hf = 0; hf < 2; ++hf) { const int p = t * 128 + hf * 64 + lane; const unsigned e = elist[p];
            av[hf] = gelu_as((float)pacc[p] * AP_SU[e] * hs) * AP_SELG[(size_t)tok0 * 128 + p] * AP_SV[e]; }
        const float mx = fmaxf(wave_maxf(fmaxf(fabsf(av[0]), fabsf(av[1]))), 1e-30f), inv = 127.f / mx;
        aq[t * 128 + lane] = (signed char)(int)__builtin_rintf(av[0] * inv); aq[t * 128 + 64 + lane] = (signed char)(int)__builtin_rintf(av[1] * inv);
        sa[t] = mx * (1.f / 127.f); }
    LDS_WAIT();
}
__device__ __forceinline__ void peer_v_phase(const Frame& F, const Args& A, const float (&sa)[8]) {
    const int lane = lane_id(), n = lane & 15, kq = lane >> 4, rr = n >> 2, cc = n & 3;
    LAS unsigned char* buf = F.lds + F.wave * PL_WAVE;
    const LAS unsigned short* elist = (const LAS unsigned short*)(F.lds + F.wave * PL_WAVE + PL_EL);
    const LAS signed char* aq = (const LAS signed char*)(F.lds + F.wave * PL_WAVE + PL_AQ);
    const int tok0 = F.vcu * 64 + F.wave * 8;
    const int fsw = (rr >> 1) | ((kq & 1) << 1);
    const unsigned trbase = (unsigned)(size_t)buf + (unsigned)((8 * kq + rr) * 128 + 8 * cc);
    const int r0 = lane >> 3, c8 = lane & 7;
    v4u G0[4], G1[4], G2[4], G3[4];
    v4i accE[4], accO[4];
#pragma unroll
    for (int q = 0; q < 4; ++q) { accE[q] = (v4i){0, 0, 0, 0}; accO[q] = (v4i){0, 0, 0, 0}; }
#define PV_EREAD(K_) do { const int ke_ = (K_); _Pragma("unroll") for (int i_ = 0; i_ < 4; ++i_) en[i_] = elist[(ke_ & 31) * 32 + 8 * i_ + r0]; } while (0)
#define PV_LOAD(G_, K_) do { const int kg_ = (K_); _Pragma("unroll") for (int i_ = 0; i_ < 4; ++i_) { const unsigned e_ = en[i_]; \
            const int f_ = ((r0 >> 1) & 1) | ((i_ & 1) << 1); \
            G_[i_] = *(const v4u*)(AP_V8 + (size_t)e_ * D + 128 * (kg_ >> 5) + 32 * ((c8 >> 1) ^ f_) + 16 * (c8 & 1)); } } while (0)
#define PV_STORE(G_, B_) do { _Pragma("unroll") for (int i_ = 0; i_ < 4; ++i_) *(LAS v4u*)(buf + (B_) * 4096 + i_ * 1024 + lane * 16) = G_[i_]; } while (0)
#define PV_TR(B_) do { const unsigned tb_ = trbase + (unsigned)((B_) * 4096); \
            const unsigned t0_ = tb_ + 32u * (unsigned)(0 ^ fsw), t1_ = tb_ + 32u * (unsigned)(1 ^ fsw), t2_ = tb_ + 32u * (unsigned)(2 ^ fsw), t3_ = tb_ + 32u * (unsigned)(3 ^ fsw); \
            asm volatile("s_waitcnt lgkmcnt(0)\n\t" \
                         "ds_read_b64_tr_b16 %0, %8\n\tds_read_b64_tr_b16 %1, %8 offset:512\n\tds_read_b64_tr_b16 %2, %9\n\tds_read_b64_tr_b16 %3, %9 offset:512\n\t" \
                         "ds_read_b64_tr_b16 %4, %10\n\tds_read_b64_tr_b16 %5, %10 offset:512\n\tds_read_b64_tr_b16 %6, %11\n\tds_read_b64_tr_b16 %7, %11 offset:512" \
                         : "=&v"(RR[0][0]), "=&v"(RR[0][1]), "=&v"(RR[1][0]), "=&v"(RR[1][1]), "=&v"(RR[2][0]), "=&v"(RR[2][1]), "=&v"(RR[3][0]), "=&v"(RR[3][1]) : "v"(t0_), "v"(t1_), "v"(t2_), "v"(t3_) : "memory"); } while (0)
#define PV_MMA(K_) do { const int kc_ = (K_), b_ = kc_ & 31; \
            v2u a8_ = *(const LAS v2u*)(aq + b_ * 32 + 8 * kq);                        \
            if (n != (b_ >> 2)) a8_ = (v2u){0u, 0u};                                  \
            v4i AE_, AO_; \
            AE_.x = (int)__builtin_amdgcn_perm(0u, a8_.x, 0x0c010c00u); AE_.y = (int)__builtin_amdgcn_perm(0u, a8_.x, 0x0c030c02u); AE_.z = (int)__builtin_amdgcn_perm(0u, a8_.y, 0x0c010c00u); AE_.w = (int)__builtin_amdgcn_perm(0u, a8_.y, 0x0c030c02u); \
            AO_.x = (int)__builtin_amdgcn_perm(0u, a8_.x, 0x010c000cu); AO_.y = (int)__builtin_amdgcn_perm(0u, a8_.x, 0x030c020cu); AO_.z = (int)__builtin_amdgcn_perm(0u, a8_.y, 0x010c000cu); AO_.w = (int)__builtin_amdgcn_perm(0u, a8_.y, 0x030c020cu); \
            asm volatile("s_waitcnt lgkmcnt(0)" : "+v"(RR[0][0]), "+v"(RR[0][1]), "+v"(RR[1][0]), "+v"(RR[1][1]), "+v"(RR[2][0]), "+v"(RR[2][1]), "+v"(RR[3][0]), "+v"(RR[3][1]) : : "memory"); \
            _Pragma("unroll") for (int q_ = 0; q_ < 4; ++q_) { const v4i Bq_ = {(int)RR[q_][0].x, (int)RR[q_][0].y, (int)RR[q_][1].x, (int)RR[q_][1].y}; \
                accE[q_] = __builtin_amdgcn_mfma_i32_16x16x64_i8(AE_, Bq_, accE[q_], 0, 0, 0); \
                accO[q_] = __builtin_amdgcn_mfma_i32_16x16x64_i8(AO_, Bq_, accO[q_], 0, 0, 0); } } while (0)
    v2u RR[4][2]; unsigned en[4];
    PV_EREAD(0); PV_LOAD(G0, 0); PV_EREAD(1); PV_LOAD(G1, 1); PV_EREAD(2); PV_LOAD(G2, 2); PV_EREAD(3); PV_LOAD(G3, 3); PV_EREAD(4); PV_STORE(G0, 0);
    for (int slice = 0; slice < 16; ++slice) {
        for (int k = slice * 32; k < slice * 32 + 32; k += 4) {
            PV_TR(0); PV_STORE(G1, 1); PV_LOAD(G0, (k + 4) & 511); PV_EREAD((k + 5) & 511); PV_MMA(k);
            PV_TR(1); PV_STORE(G2, 0); PV_LOAD(G1, (k + 5) & 511); PV_EREAD((k + 6) & 511); PV_MMA(k + 1);
            PV_TR(0); PV_STORE(G3, 1); PV_LOAD(G2, (k + 6) & 511); PV_EREAD((k + 7) & 511); PV_MMA(k + 2);
            PV_TR(1); PV_STORE(G0, 0); PV_LOAD(G3, (k + 7) & 511); PV_EREAD((k + 8) & 511); PV_MMA(k + 3);
        }
        if (kq < 2) {
#pragma unroll
            for (int i = 0; i < 4; ++i) { const int token = tok0 + 4 * kq + i; const float sat = kq ? sa[4 + i] : sa[i];
                const float* gtp = AP_MOD + (size_t)(token >> 11) * 6 * D + 5 * D + 128 * slice + 2 * n; float* op = AP_out + (size_t)token * D + 128 * slice + 2 * n;
                const bf16* xp = AP_X1B + (size_t)token * D + 128 * slice + 2 * n;
#pragma unroll
                for (int q = 0; q < 4; ++q) { typedef float f32x2t __attribute__((ext_vector_type(2)));
                    const unsigned xw = *(const unsigned*)(xp + 32 * q); const f32x2t g0 = *(const f32x2t*)(gtp + 32 * q);
                    f32x2t rv; rv.x = bflo(xw) + g0.x * (sat * (float)accE[q][i]); rv.y = bfhi(xw) + g0.y * (sat * (float)accO[q][i]);
                    *(f32x2t*)(op + 32 * q) = rv; } }
        }
#pragma unroll
        for (int q = 0; q < 4; ++q) { accE[q] = (v4i){0, 0, 0, 0}; accO[q] = (v4i){0, 0, 0, 0}; }
        if ((slice & 3) == 3) __builtin_amdgcn_s_barrier();
    }
#undef PV_TR
#undef PV_MMA
#undef PV_LOAD
#undef PV_EREAD
#undef PV_STORE

}
__device__ __forceinline__ void peer_eval_phase(const Frame& F, const Args& A) { float sa[8]; peer_u_phase(F, A, sa); peer_v_phase(F, A, sa); }

template <bool FUSED, int ONLY>
__global__ void __launch_bounds__(NWAVES * 64, 2) mk_fwd(Args args) {
    extern __shared__ __attribute__((aligned(16))) unsigned char lds[];
    Frame F;
    F.lds = (LAS unsigned char*)lds;
    F.wave = __builtin_amdgcn_readfirstlane((int)threadIdx.x >> 6);
    F.G = gridDim.x; { const int bx = blockIdx.x; F.vcu = (F.G % 8 == 0) ? (bx % 8) * (F.G / 8) + bx / 8 : bx; }
    const Args& A = args;
    const int lo = (ONLY >= 0) ? ONLY : args.ph_lo, hi = (ONLY >= 0) ? ONLY + 1 : args.ph_hi;
#define IN(k) ((ONLY < 0 || ONLY == (k)) && lo <= (k) && (k) < hi)
    XcdBarrier bar; bar.bar = (unsigned*)(args.ws + WS_CTL); bar.x = 0; bar.st = (volatile LAS unsigned*)(F.lds + MISC_OFF);
    if constexpr (FUSED) {
        if (MK_CG_SYNC) cg::this_grid().sync();
        bar.x = xb_xcc_id();
        if (F.wave == 0 && lane_id() == 0) { bar.st[0] = 0u; bar.st[1] = 0u; (void)xb_add(&bar.bar[XB_XCNT(bar.x)], 1u); }
        __syncthreads();
    }
#define SEAM(k) do { if (FUSED && IN(k) && IN((k) + 1)) { xcd_barrier(bar, F.wave, (unsigned)F.G); } } while (0)

    if (IN(0)) { p0_prologue(F, A); } SEAM(0);
    if (IN(1)) { p1_norm1(F, A); } SEAM(1);
    if (IN(2)) {
        { pg8::Gemm g{(const bf16*)AP_H8, (const bf16*)AP_WIN8, M, NPROJ, D / 2}; pg8::StaticOrder S; S.init(M, NPROJ, F.G, (int)blockIdx.x);
          EpiProj E{AP_Q, AP_K, AP_VTR, AP_BG, AP_CG, AP_U, AP_qn, AP_kn, (LAS float*)(F.lds + XCH_OFF), 0, 11, 0.08838834764831845f * LOG2E, AP_HS, AP_WINS};
          pg8::gemm_phase<EpiProj, pg8::StaticOrder, true, true, true>(F.lds, g, S, E, F.wave); }
        { pg8::Gemm g{(const bf16*)AP_HC8, (const bf16*)(AP_WIN8 + (size_t)DA * D), MC, 2 * DA, D / 2}; pg8::StaticOrder S; S.init(MC, 2 * DA, F.G, (int)blockIdx.x);
          EpiProj E{nullptr, AP_KC, AP_VCT, nullptr, nullptr, nullptr, AP_qn, AP_kn, (LAS float*)(F.lds + XCH_OFF), 1, 8, 1.f, AP_HCS, AP_WINS + DA};
          pg8::gemm_phase<EpiProj, pg8::StaticOrder, true, true, true>(F.lds, g, S, E, F.wave); }
    } SEAM(2);
    if (IN(3)) { attn_phase(F, A); conv_phase(F, A); } SEAM(3);
    if (IN(4)) { pg8::Gemm g{(const bf16*)AP_A28, (const bf16*)AP_WOUT8, M, D, D / 2}; pg8::StaticOrder S; S.init(M, D, F.G, (int)blockIdx.x);
        EpiRes E{AP_x, AP_X1B, AP_MOD, 2 * D, AP_WOUTS, A2_SCALE};
        pg8::gemm_phase<EpiRes, pg8::StaticOrder, true, true, true>(F.lds, g, S, E, F.wave); } SEAM(4);
    if (IN(5)) { p5_norm2(F, A); } SEAM(5);
    if (IN(6)) { pg8::Gemm g{(const bf16*)AP_H2Q, (const bf16*)AP_WPQ8, M, D, D / 2}; pg8::StaticOrder S; S.init(M, D, F.G, (int)blockIdx.x);
        EpiBf16 E{AP_QP, D, AP_H2S, AP_WPQS};
        pg8::gemm_phase<EpiBf16, pg8::StaticOrder, true, true, true>(F.lds, g, S, E, F.wave); } SEAM(6);
    if (IN(7)) { peer_select_phase(F, A); } SEAM(7);
    if (IN(8)) { peer_eval_phase(F, A); }
#undef IN
#undef SEAM
}

template <int PHS> static bool set_lds() { return hipFuncSetAttribute((const void*)mk_fwd<false, PHS>, hipFuncAttributeMaxDynamicSharedMemorySize, LDS_BYTES) == hipSuccess; }
template <int PHS> static void launch_one(int grid, hipStream_t stream, const Args& a) {
    hipLaunchKernelGGL((mk_fwd<false, PHS>), dim3(grid), dim3(NWAVES * 64), LDS_BYTES, stream, a);
    const hipError_t le = hipPeekAtLastError();
    if (le != hipSuccess) fprintf(stderr, "kernel_launch: launch %d failed: %s\n", PHS, hipGetErrorName(le));
}
extern "C" void kernel_launch(void* const* d_in, const int* in_sizes, int n_in, void* d_out, int out_size, void* d_ws, size_t ws_size, hipStream_t stream) {
    constexpr bool FUSED = (MK_N_LAUNCHES == 1);
    static int grid = 0;
    if (grid == 0) {
        if (n_in != 20 || in_sizes[0] != M * D || out_size != M * D || ws_size < WS_END) { fprintf(stderr, "kernel_launch: unexpected shapes (n_in %d, in0 %d, out %d, ws %zu < %zu); nothing launched\n", n_in, n_in > 0 ? in_sizes[0] : -1, out_size, ws_size, (size_t)WS_END); grid = -1; return; }
        int dev = 0, cus = 0, per_cu = 0;
        if (hipGetDevice(&dev) != hipSuccess || hipDeviceGetAttribute(&cus, hipDeviceAttributeMultiprocessorCount, dev) != hipSuccess) { grid = -1; return; }
        bool okattr = true;
        if constexpr (FUSED) okattr = hipFuncSetAttribute((const void*)mk_fwd<true, -1>, hipFuncAttributeMaxDynamicSharedMemorySize, LDS_BYTES) == hipSuccess;
        else { okattr &= set_lds<0>(); okattr &= set_lds<1>(); okattr &= set_lds<2>(); okattr &= set_lds<3>(); okattr &= set_lds<4>(); okattr &= set_lds<5>(); okattr &= set_lds<6>(); okattr &= set_lds<7>(); okattr &= set_lds<8>(); }
        if (!okattr) { fprintf(stderr, "kernel_launch: hipFuncSetAttribute failed\n"); grid = -1; return; }
        if (hipOccupancyMaxActiveBlocksPerMultiprocessor(&per_cu, (const void*)mk_fwd<FUSED, (FUSED ? -1 : 2)>, NWAVES * 64, LDS_BYTES) != hipSuccess || per_cu < 1) { fprintf(stderr, "kernel_launch: occupancy query says %d blocks per CU; nothing launched\n", per_cu); grid = -1; return; }
        (void)hipGetLastError();
        grid = cus;
        if (grid != 256) fprintf(stderr, "kernel_launch: note: %d CUs (built for 256)\n", grid);
    }
    if (grid < 0) return;
    Args a{};
    for (int i = 0; i < 20; ++i) a.in[i] = (const float*)d_in[i];
    a.out = (float*)d_out; a.ws = (unsigned char*)d_ws;
    if constexpr (FUSED) {
        a.ph_lo = 0; a.ph_hi = NPHASE;
        if (hipMemsetAsync((char*)d_ws + WS_CTL, 0, 128 * 1024, stream) != hipSuccess) { fprintf(stderr, "kernel_launch: memset of the barrier words failed\n"); return; }
        void* kargs[] = {&a};
        hipError_t e;
        if (MK_CG_SYNC) e = hipLaunchCooperativeKernel((const void*)mk_fwd<true, -1>, dim3(grid), dim3(NWAVES * 64), kargs, LDS_BYTES, stream);
        else { hipLaunchKernelGGL((mk_fwd<true, -1>), dim3(grid), dim3(NWAVES * 64), LDS_BYTES, stream, a); e = hipPeekAtLastError(); }
        if (e != hipSuccess) fprintf(stderr, "kernel_launch: launch failed: %s (grid %d)\n", hipGetErrorString(e), grid);
    } else {
        a.ph_lo = 0; a.ph_hi = NPHASE;
        launch_one<0>(grid, stream, a); launch_one<1>(grid, stream, a); launch_one<2>(grid, stream, a); launch_one<3>(grid, stream, a); launch_one<4>(grid, stream, a);
        launch_one<5>(grid, stream, a); launch_one<6>(grid, stream, a); launch_one<7>(grid, stream, a); launch_one<8>(grid, stream, a);
    }
}
```

```cpp
#include <hip/hip_runtime.h>
#include <hip/hip_cooperative_groups.h>
#include <cstdio>
#include <cstdint>
namespace cg = cooperative_groups;
#define MK_N_LAUNCHES 1
namespace pg8 {
#define PG8_LAS __attribute__((address_space(3)))
typedef unsigned short bf16_t;
typedef short bf16x8 __attribute__((ext_vector_type(8)));
typedef float f32x4 __attribute__((ext_vector_type(4)));
typedef unsigned u32x4 __attribute__((ext_vector_type(4)));
constexpr int BM = 256, BK = 64, HALF = 128, HTB = HALF * BK * 2  , STAGE_BYTES = 8 * HTB, NXCD = 8, WGM = 8;

__host__ __device__ __forceinline__ int lds_byte(int r, int c) { const int st = (r >> 4) * 2 + (c >> 5), rr = r & 15, cc = c & 31, ob = rr * 64 + cc * 2; return st * 1024 + (ob ^ (((ob >> 9) & 1) << 5)); }
__host__ __device__ __forceinline__ void stage_rc(int b, int& R, int& C) { const int st = b / 1024, sb = b % 1024, swz = sb ^ (((sb >> 9) & 1) << 5); R = (st >> 1) * 16 + swz / 64; C = (st & 1) * 32 + (swz % 64) / 2; }
__host__ __device__ __forceinline__ int perm32(int rho) { const int n = rho >> 4, i = rho & 15; return 8 * (i >> 2) + 4 * n + (i & 3); }

struct Unit { int pm, pn; };
struct Gemm { const bf16_t* A; const bf16_t* Bt; int M, N, K; };

struct StaticOrder {
    int nM, nN, nwg, G, c;
    __host__ __device__ void init(int M, int N, int G_, int c_) { nM = M / BM; nN = N / BM; nwg = nM * nN; G = G_; c = c_; }
    __host__ __device__ bool next(int i, Unit& u) const {
        const long L = (long)i * G + c; if (L >= nwg) return false;
        int wgid = (int)L; { const int q = nwg / NXCD, r = nwg % NXCD, xcd = wgid % NXCD, off = wgid / NXCD; wgid = (xcd < r ? xcd * (q + 1) : r * (q + 1) + (xcd - r) * q) + off; }
        const int nig = WGM * nN, gid = wgid / nig, fm = gid * WGM, gsz = (nM - fm) < WGM ? (nM - fm) : WGM;
        u.pm = fm + ((wgid % nig) % gsz); u.pn = (wgid % nig) / gsz; return true;
    }
    __device__ __forceinline__ void a_ready(const Unit&) const {}
    __device__ __forceinline__ void done(const Unit&) const {}
};

__device__ __forceinline__ unsigned cvt_pk_bf16(float lo, float hi) { unsigned r; asm volatile("v_cvt_pk_bf16_f32 %0, %1, %2" : "=v"(r) : "v"(lo), "v"(hi)); return r; }
typedef float f32x2 __attribute__((ext_vector_type(2)));
template <class Epi, class Sched, bool ALIGN_EPI = false, bool SP2 = false, bool I8 = false>
__device__ __forceinline__ void gemm_phase(PG8_LAS unsigned char* lds, const Gemm g, const Sched& S, const Epi& E, const int wid) {
    int lane; asm volatile("v_mbcnt_lo_u32_b32 %0, -1, 0\n\tv_mbcnt_hi_u32_b32 %0, -1, %0" : "=v"(lane)); const int tid = wid * 64 + lane, wr = wid >> 2, wc = wid & 3, fr = lane & 15, fq = lane >> 4;
    const int K = g.K, nt = K / BK;
    unsigned voffA[2], voffB[2];
#pragma unroll
    for (int i = 0; i < 2; ++i) { int R, C; stage_rc(tid * 16 + i * 8192, R, C); const int Rb = Epi::PERM ? ((R & ~31) + perm32(R & 31)) : R;
        voffA[i] = (unsigned)(R * K + C) * 2u; voffB[i] = (unsigned)(Rb * K + C) * 2u; }
    const size_t kstep = (size_t)(BK * 2);
    const size_t hstep = (size_t)HALF * K * 2;
    const size_t tstep = 2 * hstep;
    const unsigned ldsw = (unsigned)wid * 1024u;
    const int aoff = lds_byte(wr * 64 + fr, fq * 8), boff = lds_byte(wc * 32 + fr, fq * 8);
#define PG8_SA(b, h) (((b) * 2 + (h)) * HTB)
#define PG8_SB(b, h) ((4 + (b) * 2 + (h)) * HTB)
#define PG8_STAGE(bufoff, gbase, voff) do { _Pragma("unroll") for (int _i = 0; _i < 2; ++_i) \
        __builtin_amdgcn_global_load_lds((const unsigned*)((const char*)(gbase) + (voff)[_i]), (PG8_LAS unsigned*)(lds + (bufoff) + ldsw + _i * 8192), 16, 0, 0); } while (0)
#define PG8_LDA(dst, b, h) do { _Pragma("unroll") for (int m = 0; m < 4; ++m) _Pragma("unroll") for (int k = 0; k < 2; ++k) dst[m][k] = *(const PG8_LAS bf16x8*)(lds + PG8_SA(b, h) + aoff + m * 2048 + k * 1024); } while (0)
#define PG8_LDB(dst, b, h) do { _Pragma("unroll") for (int n = 0; n < 2; ++n) _Pragma("unroll") for (int k = 0; k < 2; ++k) dst[n][k] = *(const PG8_LAS bf16x8*)(lds + PG8_SB(b, h) + boff + n * 2048 + k * 1024); } while (0)
#define PG8_MMA(ai, bj, At, Bt) do { __builtin_amdgcn_s_setprio(1); _Pragma("unroll") for (int m = 0; m < 4; ++m) _Pragma("unroll") for (int n = 0; n < 2; ++n) _Pragma("unroll") for (int k = 0; k < 2; ++k) \
        { if constexpr (I8) { typedef int v4i_ __attribute__((ext_vector_type(4))); acc[ai][bj][m][n] = __builtin_bit_cast(f32x4, __builtin_amdgcn_mfma_i32_16x16x64_i8(__builtin_bit_cast(v4i_, Bt[n][k]), __builtin_bit_cast(v4i_, At[m][k]), __builtin_bit_cast(v4i_, acc[ai][bj][m][n]), 0, 0, 0)); } \
          else acc[ai][bj][m][n] = __builtin_amdgcn_mfma_f32_16x16x32_bf16(Bt[n][k], At[m][k], acc[ai][bj][m][n], 0, 0, 0); } __builtin_amdgcn_s_setprio(0); } while (0)
#define PG8_WAIT_V(n) asm volatile("s_waitcnt vmcnt(" #n ")" ::: "memory")
#define PG8_WAIT_L(n) asm volatile("s_waitcnt lgkmcnt(" #n ")" ::: "memory")
#define PG8_BAR __builtin_amdgcn_s_barrier()
#define PG8_SCHED __builtin_amdgcn_sched_barrier(0)
    Unit cur, nxt; int ui = 0;
    if (!S.next(0, cur)) return;
    f32x4 acc[2][2][4][2];
#pragma unroll
    for (int a = 0; a < 2; ++a)
#pragma unroll
        for (int b = 0; b < 2; ++b)
#pragma unroll
            for (int m = 0; m < 4; ++m)
#pragma unroll
                for (int n = 0; n < 2; ++n) acc[a][b][m][n] = (f32x4){0.f, 0.f, 0.f, 0.f};
    bf16x8 At[4][2], B0[2][2], B1[2][2];
    const char* cA = (const char*)g.A + (size_t)cur.pm * tstep; const char* cB = (const char*)g.Bt + (size_t)cur.pn * tstep;
    S.a_ready(cur);
    if constexpr (SP2) {
        PG8_STAGE(PG8_SB(0, 0), cB, voffB); PG8_STAGE(PG8_SB(0, 1), cB + hstep, voffB); PG8_STAGE(PG8_SA(0, 0), cA, voffA); PG8_STAGE(PG8_SA(0, 1), cA + hstep, voffA);
        if (wr == 1) PG8_BAR;
        PG8_WAIT_V(2); PG8_BAR;
        PG8_STAGE(PG8_SB(1, 0), cB + kstep, voffB); PG8_STAGE(PG8_SA(1, 0), cA + kstep, voffA); PG8_STAGE(PG8_SB(1, 1), cB + hstep + kstep, voffB);
        PG8_WAIT_V(6); PG8_BAR;
    } else {
        PG8_STAGE(PG8_SB(0, 0), cB, voffB); PG8_STAGE(PG8_SA(0, 0), cA, voffA); PG8_STAGE(PG8_SB(0, 1), cB + hstep, voffB); PG8_STAGE(PG8_SA(0, 1), cA + hstep, voffA);
        if (wr == 1) PG8_BAR;
        PG8_WAIT_V(4); PG8_BAR;
        PG8_STAGE(PG8_SB(1, 0), cB + kstep, voffB); PG8_STAGE(PG8_SA(1, 0), cA + kstep, voffA); PG8_STAGE(PG8_SB(1, 1), cB + hstep + kstep, voffB);
        PG8_WAIT_V(6); PG8_BAR;
    }
    for (;;) {
        const bool has_next = S.next(ui + 1, nxt);
        const char* nA = has_next ? (const char*)g.A + (size_t)nxt.pm * tstep : cA; const char* nB = has_next ? (const char*)g.Bt + (size_t)nxt.pn * tstep : cB;
        for (int t = 0; t < nt; t += 2) {
            const bool last = (t == nt - 2);
            const char* a1 = cA + (size_t)(t + 1) * kstep;
            const char* a2 = last ? nA : cA + (size_t)(t + 2) * kstep; const char* b2 = last ? nB : cB + (size_t)(t + 2) * kstep;
            const char* a3 = a2 + kstep; const char* b3 = b2 + kstep;
            if (last && has_next) S.a_ready(nxt);
            if constexpr (SP2) {
            PG8_LDB(B0, 0, 0); PG8_LDB(B1, 0, 1); PG8_SCHED; PG8_LDA(At, 0, 0); PG8_STAGE(PG8_SA(1, 1), a1 + hstep, voffA);
            PG8_WAIT_V(8); PG8_WAIT_L(0); PG8_BAR; PG8_MMA(0, 0, At, B0); PG8_MMA(0, 1, At, B1); PG8_BAR; PG8_SCHED;
            PG8_LDA(At, 0, 1); PG8_STAGE(PG8_SB(0, 0), b2, voffB); PG8_STAGE(PG8_SB(0, 1), b2 + hstep, voffB); PG8_STAGE(PG8_SA(0, 0), a2, voffA);
            PG8_WAIT_V(8); PG8_WAIT_L(0); PG8_BAR; PG8_MMA(1, 0, At, B0); PG8_MMA(1, 1, At, B1); PG8_BAR; PG8_SCHED;
            PG8_LDB(B0, 1, 0); PG8_LDB(B1, 1, 1); PG8_SCHED; PG8_LDA(At, 1, 0); PG8_STAGE(PG8_SA(0, 1), a2 + hstep, voffA);
            PG8_WAIT_V(8); PG8_WAIT_L(0); PG8_BAR; PG8_MMA(0, 0, At, B0); PG8_MMA(0, 1, At, B1); PG8_BAR; PG8_SCHED;
            PG8_LDA(At, 1, 1); PG8_STAGE(PG8_SB(1, 0), b3, voffB); PG8_STAGE(PG8_SB(1, 1), b3 + hstep, voffB); PG8_STAGE(PG8_SA(1, 0), a3, voffA);
            PG8_WAIT_V(8); PG8_WAIT_L(0); PG8_BAR; PG8_MMA(1, 0, At, B0); PG8_MMA(1, 1, At, B1); PG8_BAR; PG8_SCHED;
            } else {
            PG8_LDB(B0, 0, 0); PG8_SCHED; PG8_LDA(At, 0, 0); PG8_STAGE(PG8_SA(1, 1), a1 + hstep, voffA);
            PG8_WAIT_L(8); PG8_BAR; PG8_WAIT_L(0); PG8_MMA(0, 0, At, B0); PG8_BAR; PG8_SCHED;
            PG8_LDB(B1, 0, 1); PG8_STAGE(PG8_SB(0, 0), b2, voffB);
            PG8_BAR; PG8_WAIT_L(0); PG8_MMA(0, 1, At, B1); PG8_BAR;
            PG8_LDA(At, 0, 1); PG8_STAGE(PG8_SA(0, 0), a2, voffA);
            PG8_BAR; PG8_WAIT_L(0); PG8_MMA(1, 0, At, B0); PG8_BAR; PG8_SCHED;
            PG8_STAGE(PG8_SB(0, 1), b2 + hstep, voffB);
            PG8_WAIT_V(6); PG8_BAR; PG8_MMA(1, 1, At, B1); PG8_BAR;
            PG8_LDB(B0, 1, 0); PG8_SCHED; PG8_LDA(At, 1, 0); PG8_STAGE(PG8_SA(0, 1), a2 + hstep, voffA);
            PG8_WAIT_L(8); PG8_BAR; PG8_WAIT_L(0); PG8_MMA(0, 0, At, B0); PG8_BAR; PG8_SCHED;
            PG8_LDB(B1, 1, 1); PG8_STAGE(PG8_SB(1, 0), b3, voffB);
            PG8_BAR; PG8_WAIT_L(0); PG8_MMA(0, 1, At, B1); PG8_BAR;
            PG8_LDA(At, 1, 1); PG8_STAGE(PG8_SA(1, 0), a3, voffA);
            PG8_BAR; PG8_WAIT_L(0); PG8_MMA(1, 0, At, B0); PG8_BAR; PG8_SCHED;
            PG8_STAGE(PG8_SB(1, 1), b3 + hstep, voffB);
            PG8_WAIT_V(6); PG8_BAR; PG8_MMA(1, 1, At, B1); PG8_BAR;
            }
        }
        if constexpr (ALIGN_EPI) { if (wr == 0) PG8_BAR; }
        if constexpr (!Epi::AFTER_DRAIN) { E(acc, cur, wr, wc, fr, fq); S.done(cur); }
        if (!has_next) break;
#pragma unroll
        for (int a = 0; a < 2; ++a)
#pragma unroll
            for (int b = 0; b < 2; ++b)
#pragma unroll
                for (int m = 0; m < 4; ++m)
#pragma unroll
                    for (int n = 0; n < 2; ++n) acc[a][b][m][n] = (f32x4){0.f, 0.f, 0.f, 0.f};
        cur = nxt; cA = nA; cB = nB; ++ui;
        if constexpr (ALIGN_EPI) { if (wr == 1) PG8_BAR; }
    }
    PG8_WAIT_V(0);
    if constexpr (!ALIGN_EPI) { if (wr == 0) PG8_BAR; }
    PG8_BAR;
    if constexpr (Epi::AFTER_DRAIN) { E.fused(acc, cur, wr, wc, fr, fq, lds, wid, lane); S.done(cur); }
#undef PG8_SA
#undef PG8_SB
#undef PG8_STAGE
#undef PG8_LDA
#undef PG8_LDB
#undef PG8_MMA
#undef PG8_WAIT_V
#undef PG8_WAIT_L
#undef PG8_BAR
#undef PG8_SCHED
}
}

#ifndef MK_N_LAUNCHES
#define MK_N_LAUNCHES 1
#endif
constexpr int NPHASE = 9;

constexpr int D = 2048, NB = 8, SEQ = 2048, M = NB * SEQ, CTXL = 256, MC = NB * CTXL;
constexpr int NH = 8, HD = 128, DA = 1024, NPROJ = 6144, GW = 64;
constexpr int NEXP = 16384, PH = 8, PK = 16, NKEYS = 128;
constexpr float EPS = 1e-6f, LOG2E = 1.4426950408889634f;
constexpr int NWAVES = 8;
constexpr float A2_SCALE = 10.0f / 127.0f, A2_INV = 127.0f / 10.0f;

constexpr size_t MiB = 1u << 20;
constexpr size_t WS_CTL = 0, WS_MOD = 1 * MiB, WS_SK = 2 * MiB, WS_WIN = 4 * MiB, WS_WOUT = 28 * MiB, WS_WPQ = 36 * MiB;
constexpr size_t WS_UT = 44 * MiB, WS_VT = 108 * MiB, WS_ACT = 172 * MiB, WS_HC = 236 * MiB;
constexpr size_t WS_Q = 244 * MiB, WS_K = 276 * MiB, WS_VTR = 308 * MiB, WS_BG = 340 * MiB, WS_CG = 372 * MiB, WS_U = 404 * MiB;
constexpr size_t WS_KC = 436 * MiB, WS_VCT = 440 * MiB, WS_QP = 244 * MiB  ;
constexpr size_t WS_SELI = 444 * MiB, WS_SELG = 452 * MiB, WS_AVW = 460 * MiB, WS_END = 468 * MiB;
constexpr size_t WS_U8 = WS_UT, WS_V8 = WS_UT + 32 * MiB, WS_SU = WS_VT, WS_SV = WS_VT + 64 * 1024, WS_H2S = WS_VT + 128 * 1024, WS_H2Q = WS_VT + 1 * MiB;

constexpr int LDS_BYTES = 147456;
constexpr int XCH_OFF = 131072;
constexpr int MISC_OFF = 131072 + 8192;
#ifndef MK_CG_SYNC
#define MK_CG_SYNC 1
#endif

#define GAS __attribute__((address_space(1)))
#define LAS __attribute__((address_space(3)))
typedef unsigned short bf16;
typedef unsigned v4u __attribute__((ext_vector_type(4)));
typedef unsigned v2u __attribute__((ext_vector_type(2)));
typedef float f32x4 __attribute__((ext_vector_type(4)));
typedef float f32x16 __attribute__((ext_vector_type(16)));
typedef short bf16x8 __attribute__((ext_vector_type(8)));
typedef __bf16 bf16x2 __attribute__((ext_vector_type(2)));
#define LDS_WAIT() asm volatile("s_waitcnt lgkmcnt(0)" ::: "memory")

__device__ __forceinline__ unsigned f2bf(float f) { unsigned u = __builtin_bit_cast(unsigned, f); return (u + 0x7fffu + ((u >> 16) & 1u)) >> 16; }
__device__ __forceinline__ unsigned pk2(float lo, float hi) { return pg8::cvt_pk_bf16(lo, hi); }
__device__ __forceinline__ float bflo(unsigned w) { return __builtin_bit_cast(float, w << 16); }
__device__ __forceinline__ float bfhi(unsigned w) { return __builtin_bit_cast(float, w & 0xffff0000u); }
__device__ __forceinline__ float dot2_bf16(unsigned w, unsigned x, float acc) { return __builtin_amdgcn_fdot2_f32_bf16(__builtin_bit_cast(bf16x2, w), __builtin_bit_cast(bf16x2, x), acc, false); }
__device__ __forceinline__ float wave_sum(float v) {
#pragma unroll
    for (int o = 1; o < 64; o <<= 1) v += __shfl_xor(v, o);
    return v;
}

struct Args { const float* in[20]; float* out; unsigned char* ws; int ph_lo, ph_hi; };
struct Frame {
    LAS unsigned char* lds;
    int wave, vcu, G;
};
__device__ __forceinline__ int lane_id() { int l; asm volatile("v_mbcnt_lo_u32_b32 %0, -1, 0\n\tv_mbcnt_hi_u32_b32 %0, -1, %0" : "=v"(l)); return l; }
#define F_LANE lane_id()
#define F_TID (F.wave * 64 + lane_id())
#define AP_x (A.in[0])
#define AP_c (A.in[1])
#define AP_ctx (A.in[2])
#define AP_c_ctx (A.in[3])
#define AP_w_ada (A.in[4])
#define AP_b_ada (A.in[5])
#define AP_g1 (A.in[6])
#define AP_w_in (A.in[7])
#define AP_qn (A.in[8])
#define AP_kn (A.in[9])
#define AP_rpb (A.in[10])
#define AP_w_conv (A.in[11])
#define AP_gao (A.in[12])
#define AP_gco (A.in[13])
#define AP_w_out (A.in[14])
#define AP_g2 (A.in[15])
#define AP_w_pq (A.in[16])
#define AP_subk (A.in[17])
#define AP_uex (A.in[18])
#define AP_vex (A.in[19])
#define AP_SK ((bf16*)(A.ws + WS_SK))
#define AP_WIN ((bf16*)(A.ws + WS_WIN))
#define AP_WOUT ((bf16*)(A.ws + WS_WOUT))
#define AP_WPQ ((bf16*)(A.ws + WS_WPQ))
#define AP_UT ((bf16*)(A.ws + WS_UT))
#define AP_VT ((bf16*)(A.ws + WS_VT))
#define AP_ACT ((bf16*)(A.ws + WS_ACT))
#define AP_HC ((bf16*)(A.ws + WS_HC))
#define AP_Q ((bf16*)(A.ws + WS_Q))
#define AP_K ((bf16*)(A.ws + WS_K))
#define AP_VTR ((bf16*)(A.ws + WS_VTR))
#define AP_BG ((bf16*)(A.ws + WS_BG))
#define AP_CG ((bf16*)(A.ws + WS_CG))
#define AP_U ((bf16*)(A.ws + WS_U))
#define AP_KC ((bf16*)(A.ws + WS_KC))
#define AP_VCT ((bf16*)(A.ws + WS_VCT))
#define AP_QP ((bf16*)(A.ws + WS_QP))
#define AP_MOD ((float*)(A.ws + WS_MOD))
#define AP_SELI ((int*)(A.ws + WS_SELI))
#define AP_SELG ((float*)(A.ws + WS_SELG))
#define AP_AVW ((float*)(A.ws + WS_AVW))
#define AP_WIN8 ((unsigned char*)(A.ws + WS_WIN))
#define AP_WINS ((float*)(A.ws + WS_WIN + 16 * MiB))
#define AP_WOUT8 ((unsigned char*)(A.ws + WS_WOUT))
#define AP_WOUTS ((float*)(A.ws + WS_WOUT + 5 * MiB))
#define AP_CPARTO ((float*)(A.ws + WS_WOUT + 6 * MiB))
#define AP_A28 ((unsigned char*)(A.ws + WS_ACT))
#define AP_WPQ8 ((unsigned char*)(A.ws + WS_WPQ))
#define AP_WPQS ((float*)(A.ws + WS_WPQ + 5 * MiB))
#define AP_CPARTQ ((float*)(A.ws + WS_WPQ + 6 * MiB))
#define AP_CPART ((float*)(A.ws + WS_WIN + 17 * MiB))
#define AP_H8 ((unsigned char*)(A.ws + WS_ACT))
#define AP_HC8 ((unsigned char*)(A.ws + WS_HC))
#define AP_HS ((float*)(A.ws + WS_HC + 4 * MiB))
#define AP_HCS ((float*)(A.ws + WS_HC + 4 * MiB + 65536))
#define AP_X1B ((bf16*)(A.ws + WS_BG))
#define AP_out (A.out)
#define AP_U8 ((const unsigned char*)(A.ws + WS_U8))
#define AP_V8 ((const unsigned char*)(A.ws + WS_V8))
#define AP_SU ((float*)(A.ws + WS_SU))
#define AP_SV ((float*)(A.ws + WS_SV))
#define AP_H2S ((float*)(A.ws + WS_H2S))
#define AP_H2Q ((unsigned char*)(A.ws + WS_H2Q))


#define XB_TMO      128
#define XB_XCNT(j)  (256  + 64 * (j))
#define XB_XSUB(j)  (1280 + 64 * (j))
#define XB_XGEN(j)  (2304 + 64 * (j))
#define XB_TOP      3328
#define XB_TOPGEN   3392
#define XCD_BAR_WORDS 3456
#define XB_SPIN_CAP (1u << 22)
__device__ __forceinline__ unsigned xb_ld(unsigned* p)              { return __hip_atomic_load(p, __ATOMIC_RELAXED, __HIP_MEMORY_SCOPE_AGENT); }
__device__ __forceinline__ unsigned xb_add(unsigned* p, unsigned v) { return __hip_atomic_fetch_add(p, v, __ATOMIC_RELAXED, __HIP_MEMORY_SCOPE_AGENT); }
__device__ __forceinline__ unsigned xb_xcc_id() { return (unsigned)__builtin_amdgcn_s_getreg((3 << 11) | 20) & 0xFu; }
#define XB_SPIN(cond, bar) do { unsigned _sp = 0; while (cond) { __builtin_amdgcn_s_sleep(1); \
    if ((++_sp & 255u) == 0u) { if (xb_ld(&(bar)[XB_TMO])) break; if (_sp > XB_SPIN_CAP) { atomicAdd(&(bar)[XB_TMO], 1u); break; } } } } while (0)
struct XcdBarrier { unsigned* bar; unsigned x; volatile LAS unsigned* st; };
__device__ __forceinline__ void xcd_barrier_complete(unsigned* bar, unsigned x, unsigned G, unsigned& nloc, unsigned& nx) {
    unsigned sum, cnt, mine, sp = 0u;
    for (;;) {
        sum = 0u; cnt = 0u; mine = 0u;
#pragma unroll
        for (unsigned j = 0; j < 16; ++j) { const unsigned c = xb_ld(&bar[XB_XCNT(j)]); sum += c; cnt += (c > 0u) ? 1u : 0u; mine = (j == x) ? c : mine; }
        if (sum == G) break;
        __builtin_amdgcn_s_sleep(1);
        if ((++sp & 255u) == 0u) { if (xb_ld(&bar[XB_TMO])) break; if (sp > XB_SPIN_CAP) { atomicAdd(&bar[XB_TMO], 1u); break; } }
    }
    nloc = mine > 0u ? mine : 1u; nx = cnt > 0u ? cnt : 1u;
}
__device__ __forceinline__ void xcd_barrier(const XcdBarrier& b, const int wave, const unsigned G) {
    asm volatile("s_waitcnt vmcnt(0)" ::: "memory");
    __syncthreads();
    if (wave == 0 && lane_id() == 0) {
        unsigned* bar = b.bar;
        __builtin_amdgcn_s_waitcnt(0);
        unsigned nloc = b.st[0], nx = b.st[1];
        if (nloc == 0u) { xcd_barrier_complete(bar, b.x, G, nloc, nx); b.st[0] = nloc; b.st[1] = nx; }
        const unsigned old = xb_add(&bar[XB_XSUB(b.x)], 1u);
        const unsigned gen = old / nloc;
        if (old + 1u == (gen + 1u) * nloc) {
            __builtin_amdgcn_fence(__ATOMIC_RELEASE, "agent");
            asm volatile("s_waitcnt vmcnt(0)" ::: "memory");
            const unsigned og = xb_add(&bar[XB_TOP], 1u);
            const unsigned tg = og / nx;
            if (og + 1u == (tg + 1u) * nx) xb_add(&bar[XB_TOPGEN], 1u);
            else XB_SPIN(xb_ld(&bar[XB_TOPGEN]) == tg, bar);
            __builtin_amdgcn_fence(__ATOMIC_ACQUIRE, "agent");
            xb_add(&bar[XB_XGEN(b.x)], 1u);
            asm volatile("s_waitcnt vmcnt(0)" ::: "memory");
        } else {
            XB_SPIN(xb_ld(&bar[XB_XGEN(b.x)]) == gen, bar);
            __builtin_amdgcn_fence(__ATOMIC_ACQUIRE, "agent");
            asm volatile("s_waitcnt vmcnt(0)" ::: "memory");
        }
    }
    __syncthreads();
}

__device__ __forceinline__ void p0_mod(const Frame& F, const Args& A) {
    const int lane = lane_id(), tid = F.wave * 64 + lane; (void)tid;
    LAS float* sc = (LAS float*)F.lds;
    LAS float* red = (LAS float*)(F.lds + 9 * 2048 * 4);
    for (int i = tid; i < 9 * D; i += NWAVES * 64) { const int r = i >> 11, k = i & (D - 1); const float cv = (r < 8) ? AP_c[r * D + k] : AP_c_ctx[k]; sc[i] = cv / (1.f + __expf(-cv)); }
    __syncthreads();
    const int sr = lane >> 4, cq = lane & 15;
    for (int item = F.vcu; item < (6 * D) / 64; item += F.G) {
        const int n0 = item * 64;
        float acc[9][4];
#pragma unroll
        for (int r = 0; r < 9; ++r)
#pragma unroll
            for (int j = 0; j < 4; ++j) acc[r][j] = 0.f;
        const float* wp = AP_w_ada + (size_t)(F.wave * 4 + sr) * (6 * D) + n0 + 4 * cq;
#pragma unroll 8
        for (int step = 0; step < 64; ++step) {
            const int k = step * 32 + F.wave * 4 + sr;
            const f32x4 w = *(const f32x4*)(wp + (size_t)step * 32 * (6 * D));
#pragma unroll
            for (int r = 0; r < 9; ++r) { const float s = sc[r * D + k]; acc[r][0] += s * w.x; acc[r][1] += s * w.y; acc[r][2] += s * w.z; acc[r][3] += s * w.w; }
        }
#pragma unroll
        for (int r = 0; r < 9; ++r)
#pragma unroll
            for (int j = 0; j < 4; ++j) { float v = acc[r][j]; v += __shfl_xor(v, 16); v += __shfl_xor(v, 32); if (sr == 0) red[(F.wave * 9 + r) * 64 + 4 * cq + j] = v; }
        __syncthreads();
        for (int i = tid; i < 9 * 64; i += NWAVES * 64) { const int r = i >> 6, cc = i & 63; float s = 0.f;
#pragma unroll
            for (int w = 0; w < 8; ++w) s += red[(w * 9 + r) * 64 + cc];
            AP_MOD[r * (6 * D) + n0 + cc] = s + AP_b_ada[n0 + cc]; }
        __syncthreads();
    }
    __syncthreads();
}
__device__ __forceinline__ void p0_transpose_item(const float* W, int K, int N, bf16* WT, LAS float* scr, int item, int lane) {
    const int nblk = N / 32, kb = item / nblk, nb = item % nblk, k0 = 64 * kb, n0 = 32 * nb;
#pragma unroll 8
    for (int i = 0; i < 32; ++i) { const int kk = 2 * i + (lane >> 5); scr[kk * 33 + (lane & 31)] = W[(size_t)(k0 + kk) * N + n0 + (lane & 31)]; }
    LDS_WAIT(); asm volatile("" ::: "memory");
    const int c = lane & 7;
#pragma unroll
    for (int j = 0; j < 4; ++j) { const int n = (lane >> 3) + 8 * j; const LAS float* s = scr + (8 * c) * 33 + n;
        v4u o; o.x = pk2(s[0 * 33], s[1 * 33]); o.y = pk2(s[2 * 33], s[3 * 33]); o.z = pk2(s[4 * 33], s[5 * 33]); o.w = pk2(s[6 * 33], s[7 * 33]);
        *(v4u*)(WT + (size_t)(n0 + n) * K + k0 + 8 * c) = o; }
    LDS_WAIT(); asm volatile("" ::: "memory");
}
__device__ __forceinline__ void cvt_f32_bf16(const float* src, bf16* dst, size_t n, size_t gtid, size_t gthreads) {
    for (size_t i = gtid * 8; i < n; i += gthreads * 8) { const f32x4 a = *(const f32x4*)(src + i), b = *(const f32x4*)(src + i + 4);
        v4u o; o.x = pk2(a.x, a.y); o.y = pk2(a.z, a.w); o.z = pk2(b.x, b.y); o.w = pk2(b.z, b.w); *(v4u*)(dst + i) = o; }
}
__device__ __forceinline__ float wave_max(float v) {
#pragma unroll
    for (int o = 1; o < 64; o <<= 1) v = fmaxf(v, __shfl_xor(v, o));
    return v;
}
__device__ __forceinline__ unsigned q4(const f32x4 v, const float inv, const int off = 0) {
    const int a = (int)fminf(fmaxf(__builtin_rintf(v.x * inv), -127.f), 127.f) + off, b = (int)fminf(fmaxf(__builtin_rintf(v.y * inv), -127.f), 127.f) + off, c = (int)fminf(fmaxf(__builtin_rintf(v.z * inv), -127.f), 127.f) + off, d = (int)fminf(fmaxf(__builtin_rintf(v.w * inv), -127.f), 127.f) + off;
    return (unsigned)(a & 255) | ((unsigned)(b & 255) << 8) | ((unsigned)(c & 255) << 16) | ((unsigned)(d & 255) << 24);
}
__device__ __forceinline__ void quant_row(const float* src, unsigned char* dst, float* scale, int lane, const int off) {
    const f32x4* xr = (const f32x4*)src + lane; f32x4 v[8]; float mx = 0.f;
#pragma unroll
    for (int j = 0; j < 8; ++j) { v[j] = xr[64 * j]; mx = fmaxf(mx, fmaxf(fmaxf(fabsf(v[j].x), fabsf(v[j].y)), fmaxf(fabsf(v[j].z), fabsf(v[j].w)))); }
    mx = fmaxf(wave_max(mx), 1e-30f);
    const float inv = 127.f / mx;
    unsigned* o = (unsigned*)dst + lane;
#pragma unroll
    for (int j = 0; j < 8; ++j) o[64 * j] = q4(v[j], inv, off);
    if (lane == 0) *scale = mx * (1.f / 127.f);
}
__device__ __forceinline__ void p1_transpose_item_i8(const float* W, int K, int N, unsigned char* WT, const float* cpart, float* wscale, LAS float* scr, int item, int lane) {
    const int nblk = N / 32, kb = item / nblk, nb = item % nblk, k0 = 64 * kb, n0 = 32 * nb;
    { float cm = 0.f;
#pragma unroll
      for (int p = 0; p < 16; ++p) cm = fmaxf(cm, cpart[(size_t)(16 * (lane >> 5) + p) * N + n0 + (lane & 31)]);
      cm = fmaxf(cm, __shfl_xor(cm, 32));
      scr[64 * 33 + (lane & 31)] = cm; }
#pragma unroll 8
    for (int i = 0; i < 32; ++i) { const int kk = 2 * i + (lane >> 5); scr[kk * 33 + (lane & 31)] = W[(size_t)(k0 + kk) * N + n0 + (lane & 31)]; }
    LDS_WAIT(); asm volatile("" ::: "memory");
    const int c = lane & 7;
#pragma unroll
    for (int j = 0; j < 4; ++j) { const int n = (lane >> 3) + 8 * j; const LAS float* sp = scr + (8 * c) * 33 + n;
        const float mx = fmaxf(scr[64 * 33 + n], 1e-30f), inv = 127.f / mx;
        f32x4 a = {sp[0 * 33], sp[1 * 33], sp[2 * 33], sp[3 * 33]}, b = {sp[4 * 33], sp[5 * 33], sp[6 * 33], sp[7 * 33]};
        v2u o; o.x = q4(a, inv); o.y = q4(b, inv);
        *(v2u*)(WT + (size_t)(n0 + n) * K + k0 + 8 * c) = o;
        if (kb == 0 && c == 0) wscale[n0 + n] = mx * (1.f / 127.f); }
    LDS_WAIT(); asm volatile("" ::: "memory");
}
__device__ __forceinline__ void p0_prologue(const Frame& F, const Args& A) {
    const int lane = lane_id(), tid = F.wave * 64 + lane; (void)tid;
    p0_mod(F, A);
    LAS float* scr = (LAS float*)(F.lds + F.wave * 16384);
    const int gw = F.vcu * NWAVES + F.wave, NGW = F.G * NWAVES;
    constexpr int I_SQ = (D / 64) * (D / 32);
    (void)I_SQ; (void)scr;
    for (int it = gw; it < (D / 256) * (D / 64); it += NGW) { const int cb = it % (D / 256), kb = it / (D / 256);
        const f32x4* wp = (const f32x4*)(AP_w_pq + (size_t)(kb * 64) * D + cb * 256) + lane; f32x4 mx = {0.f, 0.f, 0.f, 0.f};
#pragma unroll 8
        for (int k = 0; k < 64; ++k) { const f32x4 w = wp[(size_t)k * (D / 4)]; mx.x = fmaxf(mx.x, fabsf(w.x)); mx.y = fmaxf(mx.y, fabsf(w.y)); mx.z = fmaxf(mx.z, fabsf(w.z)); mx.w = fmaxf(mx.w, fabsf(w.w)); }
        *((f32x4*)(AP_CPARTQ + (size_t)kb * D + cb * 256) + lane) = mx; }
    for (int it = gw; it < (D / 256) * (D / 64); it += NGW) { const int cb = it % (D / 256), kb = it / (D / 256);
        const f32x4* wp = (const f32x4*)(AP_w_out + (size_t)(kb * 64) * D + cb * 256) + lane; f32x4 mx = {0.f, 0.f, 0.f, 0.f};
#pragma unroll 8
        for (int k = 0; k < 64; ++k) { const f32x4 w = wp[(size_t)k * (D / 4)]; mx.x = fmaxf(mx.x, fabsf(w.x)); mx.y = fmaxf(mx.y, fabsf(w.y)); mx.z = fmaxf(mx.z, fabsf(w.z)); mx.w = fmaxf(mx.w, fabsf(w.w)); }
        *((f32x4*)(AP_CPARTO + (size_t)kb * D + cb * 256) + lane) = mx; }
    for (int it = gw; it < (NPROJ / 256) * (D / 64); it += NGW) { const int cb = it % (NPROJ / 256), kb = it / (NPROJ / 256);
        const f32x4* wp = (const f32x4*)(AP_w_in + (size_t)(kb * 64) * NPROJ + cb * 256) + lane; f32x4 mx = {0.f, 0.f, 0.f, 0.f};
#pragma unroll 8
        for (int k = 0; k < 64; ++k) { const f32x4 w = wp[(size_t)k * (NPROJ / 4)]; mx.x = fmaxf(mx.x, fabsf(w.x)); mx.y = fmaxf(mx.y, fabsf(w.y)); mx.z = fmaxf(mx.z, fabsf(w.z)); mx.w = fmaxf(mx.w, fabsf(w.w)); }
        *((f32x4*)(AP_CPART + (size_t)kb * NPROJ + cb * 256) + lane) = mx; }
    const size_t gtid = (size_t)F.vcu * (NWAVES * 64) + tid, gth = (size_t)F.G * NWAVES * 64;
    cvt_f32_bf16(AP_subk, AP_SK, (size_t)PH * 2 * NKEYS * 128, gtid, gth);
    for (int e = gw; e < NEXP; e += NGW) {
        const f32x4* ur = (const f32x4*)(AP_uex + (size_t)e * D) + lane; const f32x4* vr = (const f32x4*)(AP_vex + (size_t)e * D) + lane;
        f32x4 uv[8], vv[8]; float mu = 0.f, mv = 0.f;
#pragma unroll
        for (int j = 0; j < 8; ++j) { uv[j] = ur[64 * j]; vv[j] = vr[64 * j]; }
#pragma unroll
        for (int j = 0; j < 8; ++j) { mu = fmaxf(mu, fmaxf(fmaxf(fabsf(uv[j].x), fabsf(uv[j].y)), fmaxf(fabsf(uv[j].z), fabsf(uv[j].w)))); mv = fmaxf(mv, fmaxf(fmaxf(fabsf(vv[j].x), fabsf(vv[j].y)), fmaxf(fabsf(vv[j].z), fabsf(vv[j].w)))); }
        mu = fmaxf(wave_max(mu), 1e-30f); mv = fmaxf(wave_max(mv), 1e-30f);
        const float iu = 127.f / mu, iv = 127.f / mv;
        unsigned* ou = (unsigned*)(A.ws + WS_U8 + (size_t)e * D) + lane; unsigned* ov = (unsigned*)(A.ws + WS_V8 + (size_t)e * D) + lane;
#pragma unroll
        for (int j = 0; j < 8; ++j) { ou[64 * j] = q4(uv[j], iu); ov[64 * j] = q4(vv[j], iv); }
        if (lane == 0) { AP_SU[e] = mu * (1.f / 127.f); AP_SV[e] = mv * (1.f / 127.f); }
    }
}

__device__ __forceinline__ void norm_rows(const float* X, size_t row0, int nrows, const float* g, const float* sh, const float* sc, bf16* out, int lane, unsigned char* q8 = nullptr, float* qs = nullptr) {
    f32x4 gs[8], shv[8];
#pragma unroll
    for (int j = 0; j < 8; ++j) { const int cI = j * 64 + lane; const f32x4 gg = ((const f32x4*)g)[cI], s1 = ((const f32x4*)sc)[cI]; gs[j] = gg * (1.f + s1); shv[j] = ((const f32x4*)sh)[cI]; }
    f32x4 vn[8];
    { const f32x4* xr = (const f32x4*)(X + row0 * D) + lane;
#pragma unroll
      for (int j = 0; j < 8; ++j) vn[j] = xr[64 * j]; }
    for (int r = 0; r < nrows; ++r) {
        f32x4 v[8]; float ss = 0.f;
#pragma unroll
        for (int j = 0; j < 8; ++j) { v[j] = vn[j]; ss += (v[j].x * v[j].x + v[j].y * v[j].y) + (v[j].z * v[j].z + v[j].w * v[j].w); }
        { const f32x4* xr = (const f32x4*)(X + (row0 + ((r + 1 < nrows) ? r + 1 : r)) * D) + lane;
#pragma unroll
          for (int j = 0; j < 8; ++j) vn[j] = xr[64 * j]; }
        const float rstd = __builtin_amdgcn_rsqf(wave_sum(ss) * (1.f / D) + EPS);
        v2u* o8 = (v2u*)(out + (row0 + r) * D) + lane; float mx = 0.f;
#pragma unroll
        for (int j = 0; j < 8; ++j) { const f32x4 y = v[j] * rstd * gs[j] + shv[j]; v[j] = y; if (out) { v2u w; w.x = pk2(y.x, y.y); w.y = pk2(y.z, y.w); o8[64 * j] = w; }
            mx = fmaxf(mx, fmaxf(fmaxf(fabsf(y.x), fabsf(y.y)), fmaxf(fabsf(y.z), fabsf(y.w)))); }
        if (q8) { mx = fmaxf(wave_max(mx), 1e-30f); const float inv = 127.f / mx; unsigned* oq = (unsigned*)(q8 + (row0 + r) * D) + lane;
#pragma unroll
            for (int j = 0; j < 8; ++j) oq[64 * j] = q4(v[j], inv);
            if (lane == 0) qs[row0 + r] = mx * (1.f / 127.f); }
    }
}
__device__ __forceinline__ void norm_rows_b(const bf16* X, size_t row0, int nrows, const float* g, const float* sh, const float* sc, bf16* out, int lane, unsigned char* q8, float* qs) {
    f32x4 gs[8], shv[8];
#pragma unroll
    for (int j = 0; j < 8; ++j) { const int cI = j * 64 + lane; const f32x4 gg = ((const f32x4*)g)[cI], s1 = ((const f32x4*)sc)[cI]; gs[j] = gg * (1.f + s1); shv[j] = ((const f32x4*)sh)[cI]; }
    for (int r = 0; r < nrows; ++r) {
        const v2u* xr = (const v2u*)(X + (row0 + r) * D) + lane;
        f32x4 v[8]; float ss = 0.f;
#pragma unroll
        for (int j = 0; j < 8; ++j) { const v2u w = xr[64 * j]; v[j].x = bflo(w.x); v[j].y = bfhi(w.x); v[j].z = bflo(w.y); v[j].w = bfhi(w.y); ss += (v[j].x * v[j].x + v[j].y * v[j].y) + (v[j].z * v[j].z + v[j].w * v[j].w); }
        const float rstd = __builtin_amdgcn_rsqf(wave_sum(ss) * (1.f / D) + EPS);
        v2u* o8 = (v2u*)(out + (row0 + r) * D) + lane; float mx = 0.f;
#pragma unroll
        for (int j = 0; j < 8; ++j) { const f32x4 y = v[j] * rstd * gs[j] + shv[j]; v[j] = y; if (out) { v2u w; w.x = pk2(y.x, y.y); w.y = pk2(y.z, y.w); o8[64 * j] = w; }
            mx = fmaxf(mx, fmaxf(fmaxf(fabsf(y.x), fabsf(y.y)), fmaxf(fabsf(y.z), fabsf(y.w)))); }
        mx = fmaxf(wave_max(mx), 1e-30f); const float inv = 127.f / mx; unsigned* oq = (unsigned*)(q8 + (row0 + r) * D) + lane;
#pragma unroll
        for (int j = 0; j < 8; ++j) oq[64 * j] = q4(v[j], inv);
        if (lane == 0) qs[row0 + r] = mx * (1.f / 127.f);
    }
}
__device__ __forceinline__ void p1_norm1(const Frame& F, const Args& A) {
    const int lane = lane_id(), tid = F.wave * 64 + lane; (void)tid;
    const int gw = F.vcu * NWAVES + F.wave, NGW = F.G * NWAVES;
    { LAS float* scr = (LAS float*)(F.lds + F.wave * 16384);
      for (int it = gw; it < (D / 64) * (NPROJ / 32); it += NGW) p1_transpose_item_i8(AP_w_in, D, NPROJ, AP_WIN8, AP_CPART, AP_WINS, scr, it, lane);
      for (int it = gw; it < (D / 64) * (D / 32); it += NGW) p1_transpose_item_i8(AP_w_out, D, D, AP_WOUT8, AP_CPARTO, AP_WOUTS, scr, it, lane);
      for (int it = gw; it < (D / 64) * (D / 32); it += NGW) p1_transpose_item_i8(AP_w_pq, D, D, AP_WPQ8, AP_CPARTQ, AP_WPQS, scr, it, lane); }
    for (int it = gw; it < M / 8; it += NGW) { const size_t row0 = (size_t)it * 8; const int b = (int)(row0 >> 11);
        norm_rows(AP_x, row0, 8, AP_g1, AP_MOD + b * 6 * D + 0 * D, AP_MOD + b * 6 * D + 1 * D, nullptr, lane, AP_H8, AP_HS); }
    for (int it = gw; it < MC; it += NGW) norm_rows(AP_ctx, (size_t)it, 1, AP_g1, AP_MOD + 8 * 6 * D + 0 * D, AP_MOD + 8 * 6 * D + 1 * D, nullptr, lane, AP_HC8, AP_HCS);
}
__device__ __forceinline__ void p5_norm2(const Frame& F, const Args& A) {
    const int lane = lane_id(), tid = F.wave * 64 + lane; (void)tid;
    const int gw = F.vcu * NWAVES + F.wave, NGW = F.G * NWAVES;
    for (int it = gw; it < M / 8; it += NGW) { const size_t row0 = (size_t)it * 8; const int b = (int)(row0 >> 11);
        norm_rows_b(AP_X1B, row0, 8, AP_g2, AP_MOD + b * 6 * D + 3 * D, AP_MOD + b * 6 * D + 4 * D, nullptr, lane, AP_H2Q, AP_H2S); }
}

__device__ __forceinline__ f32x4 dq4(const f32x4 a, const f32x4 cs, const float rs) {
    typedef int v4i_ __attribute__((ext_vector_type(4))); const v4i_ iv = __builtin_bit_cast(v4i_, a);
    f32x4 r; r.x = (float)iv.x; r.y = (float)iv.y; r.z = (float)iv.z; r.w = (float)iv.w; return r * cs * rs;
}
struct EpiProj {
    static constexpr bool PERM = true, AFTER_DRAIN = false;
    bf16 *Q, *Kp, *VTp, *BG, *CG, *U; const float *qn, *kn; LAS float* xch; int region0, tshift; float qscale; const float *rs, *csb;
    __device__ __forceinline__ void operator()(const f32x4 (&acc)[2][2][4][2], const pg8::Unit& u, int wr, int wc, int fr, int fq) const {
        const int region = (u.pn >> 2) + region0, pnl = u.pn & 3;
        const int rowt = wr * 64 + fr;
        f32x4 cs_[2][2]; float rsc_[2][4];
#pragma unroll
        for (int bj = 0; bj < 2; ++bj)
#pragma unroll
            for (int n = 0; n < 2; ++n) cs_[bj][n] = *(const f32x4*)(csb + u.pn * 256 + bj * 128 + 32 * wc + 8 * fq + 4 * n);
#pragma unroll
        for (int ai = 0; ai < 2; ++ai)
#pragma unroll
            for (int m = 0; m < 4; ++m) rsc_[ai][m] = rs[u.pm * 256 + ai * 128 + rowt + m * 16];
#define DQ(ai_, bj_, m_, n_) dq4(acc[ai_][bj_][m_][n_], cs_[bj_][n_], rsc_[ai_][m_])
        if (region <= 1) {
#pragma unroll
            for (int ai = 0; ai < 2; ++ai)
#pragma unroll
                for (int m = 0; m < 4; ++m)
#pragma unroll
                    for (int bj = 0; bj < 2; ++bj) { const f32x4 a = DQ(ai, bj, m, 0), b = DQ(ai, bj, m, 1);
                        float s = (a.x * a.x + a.y * a.y) + (a.z * a.z + a.w * a.w) + (b.x * b.x + b.y * b.y) + (b.z * b.z + b.w * b.w);
                        s += __shfl_xor(s, 16); s += __shfl_xor(s, 32);
                        if (fq == 0) xch[((ai * 128 + rowt + m * 16) * 2 + bj) * 4 + wc] = s; }
            asm volatile("s_waitcnt lgkmcnt(0)" ::: "memory"); __builtin_amdgcn_s_barrier(); asm volatile("" ::: "memory");
            const float* gain = (region == 0) ? qn : kn; const float mul = (region == 0) ? qscale : 1.f; bf16* O = (region == 0) ? Q : Kp;
            const f32x4 g0 = *(const f32x4*)(gain + 32 * wc + 8 * fq), g1 = *(const f32x4*)(gain + 32 * wc + 8 * fq + 4);
#pragma unroll
            for (int ai = 0; ai < 2; ++ai)
#pragma unroll
                for (int m = 0; m < 4; ++m) { const int rt = ai * 128 + rowt + m * 16; bf16* rowp = O + (size_t)(u.pm * 256 + rt) * DA + (2 * pnl) * HD + 32 * wc + 8 * fq;
#pragma unroll
                    for (int bj = 0; bj < 2; ++bj) { const f32x4 p = *(const LAS f32x4*)(xch + (rt * 2 + bj) * 4);
                        const float rstd = __builtin_amdgcn_rsqf(((p.x + p.y) + (p.z + p.w)) * (1.f / HD) + EPS) * mul;
                        const f32x4 v0 = DQ(ai, bj, m, 0) * rstd * g0, v1 = DQ(ai, bj, m, 1) * rstd * g1;
                        v4u w; w.x = pk2(v0.x, v0.y); w.y = pk2(v0.z, v0.w); w.z = pk2(v1.x, v1.y); w.w = pk2(v1.z, v1.w);
                        *(v4u*)(rowp + bj * HD) = w; } }
        } else if (region == 2) {
            const int tmask = (1 << tshift) - 1;
#pragma unroll
            for (int ai = 0; ai < 2; ++ai)
#pragma unroll
                for (int m = 0; m < 4; ++m) { const int row = u.pm * 256 + ai * 128 + rowt + m * 16; const int b = row >> tshift, t = row & tmask;
#pragma unroll
                    for (int bj = 0; bj < 2; ++bj) { const int head = 2 * pnl + bj; bf16* base = VTp + (((size_t)(b * NH + head) * HD + 32 * wc + 8 * fq) << tshift) + t;
#pragma unroll
                        for (int n = 0; n < 2; ++n) { const f32x4 a = DQ(ai, bj, m, n); const unsigned w0 = pk2(a.x, a.y), w1 = pk2(a.z, a.w);
                            base[(size_t)(4 * n + 0) << tshift] = (bf16)(w0 & 0xffffu); base[(size_t)(4 * n + 1) << tshift] = (bf16)(w0 >> 16);
                            base[(size_t)(4 * n + 2) << tshift] = (bf16)(w1 & 0xffffu); base[(size_t)(4 * n + 3) << tshift] = (bf16)(w1 >> 16); } } }
        } else {
            bf16* O = (region == 3) ? BG : (region == 4) ? CG : U;
#pragma unroll
            for (int ai = 0; ai < 2; ++ai)
#pragma unroll
                for (int m = 0; m < 4; ++m) { bf16* rowp = O + (size_t)(u.pm * 256 + ai * 128 + rowt + m * 16) * DA + pnl * 256 + 32 * wc + 8 * fq;
#pragma unroll
                    for (int bj = 0; bj < 2; ++bj) { const f32x4 v0 = DQ(ai, bj, m, 0), v1 = DQ(ai, bj, m, 1);
                        v4u w; w.x = pk2(v0.x, v0.y); w.y = pk2(v0.z, v0.w); w.z = pk2(v1.x, v1.y); w.w = pk2(v1.z, v1.w);
                        *(v4u*)(rowp + bj * HD) = w; } }
        }
#undef DQ
    }
};
struct EpiBf16 {
    static constexpr bool PERM = true, AFTER_DRAIN = false;
    bf16* O; int ldc; const float *rs, *csb;
    __device__ __forceinline__ void operator()(const f32x4 (&acc)[2][2][4][2], const pg8::Unit& u, int wr, int wc, int fr, int fq) const {
        const int row0 = u.pm * 256 + wr * 64 + fr, col0 = u.pn * 256 + wc * 32 + 8 * fq;
#pragma unroll
        for (int ai = 0; ai < 2; ++ai)
#pragma unroll
            for (int m = 0; m < 4; ++m) { bf16* rowp = O + (size_t)(row0 + ai * 128 + m * 16) * ldc + col0;
#pragma unroll
                for (int bj = 0; bj < 2; ++bj) { const float rsv = rs[row0 + ai * 128 + m * 16]; const f32x4 v0 = dq4(acc[ai][bj][m][0], *(const f32x4*)(csb + col0 + bj * 128), rsv), v1 = dq4(acc[ai][bj][m][1], *(const f32x4*)(csb + col0 + bj * 128 + 4), rsv);
                    v4u w; w.x = pk2(v0.x, v0.y); w.y = pk2(v0.z, v0.w); w.z = pk2(v1.x, v1.y); w.w = pk2(v1.z, v1.w);
                    *(v4u*)(rowp + bj * 128) = w; } }
    }
};
struct EpiRes {
    static constexpr bool PERM = true, AFTER_DRAIN = false;
    const float* base; bf16* out; const float* mod; int gofs; const float* csb; float sa;
    __device__ __forceinline__ void operator()(const f32x4 (&acc)[2][2][4][2], const pg8::Unit& u, int wr, int wc, int fr, int fq) const {
        const int row0 = u.pm * 256 + wr * 64 + fr, col0 = u.pn * 256 + wc * 32 + 8 * fq;
        const float* gp = mod + (size_t)(u.pm >> 3) * 6 * D + gofs + col0;
        f32x4 gv[2][2];
#pragma unroll
        for (int bj = 0; bj < 2; ++bj)
#pragma unroll
            for (int n = 0; n < 2; ++n) gv[bj][n] = *(const f32x4*)(gp + bj * 128 + 4 * n);
        f32x4 cs_[2][2];
#pragma unroll
        for (int bj = 0; bj < 2; ++bj)
#pragma unroll
            for (int n = 0; n < 2; ++n) cs_[bj][n] = *(const f32x4*)(csb + col0 + bj * 128 + 4 * n);
#pragma unroll
        for (int ai = 0; ai < 2; ++ai)
#pragma unroll
            for (int m = 0; m < 4; ++m) { const size_t off = (size_t)(row0 + ai * 128 + m * 16) * D + col0;
#pragma unroll
                for (int bj = 0; bj < 2; ++bj) { const f32x4 b0 = *(const f32x4*)(base + off + bj * 128), b1 = *(const f32x4*)(base + off + bj * 128 + 4);
                    const f32x4 v0 = b0 + gv[bj][0] * dq4(acc[ai][bj][m][0], cs_[bj][0], sa), v1 = b1 + gv[bj][1] * dq4(acc[ai][bj][m][1], cs_[bj][1], sa);
                    v4u w; w.x = pk2(v0.x, v0.y); w.y = pk2(v0.z, v0.w); w.z = pk2(v1.x, v1.y); w.w = pk2(v1.z, v1.w);
                    *(v4u*)(out + off + bj * 128) = w; }
                asm volatile("" ::: "memory"); }
    }
};

__device__ __forceinline__ void attn_phase(const Frame& F, const Args& A) {
    const int lane = lane_id(), tid = F.wave * 64 + lane; (void)tid;
    LAS float* bias = (LAS float*)(F.lds + XCH_OFF);
    LAS unsigned char* kl = F.lds + F.wave * 16384;
    LAS unsigned char* vl = kl + 8192;
    const int bh = F.vcu >> 2, b = bh >> 3, h = bh & 7;
    for (int i = tid; i < 15 * 31; i += NWAVES * 64) bias[i] = AP_rpb[h * 465 + i] * LOG2E;
    __syncthreads();
    const int r = 8 * (F.vcu & 3) + F.wave;
    const int rs = min(max(r - 4, 0), 24);
    const int q = lane & 31, hh = lane >> 5;
    const int l4 = lane >> 4, c16 = lane & 15, l2 = lane >> 2, g4 = lane & 3;
    const unsigned char* Kb = (const unsigned char*)(AP_K + (size_t)b * SEQ * DA + h * HD);
    const unsigned char* VTb = (const unsigned char*)(AP_VTR + (size_t)(b * NH + h) * HD * SEQ);
    const unsigned char* KCb = (const unsigned char*)(AP_KC + (size_t)b * CTXL * DA + h * HD);
    const unsigned char* VCb = (const unsigned char*)(AP_VCT + (size_t)(b * NH + h) * HD * CTXL);
    for (int qh = 0; qh < 2; ++qh) {
        const int c0 = qh ? 24 : 0, qcol = qh * 32 + q, cs = min(max(qcol - 8, 0), 48);
        const bf16* qp = AP_Q + (size_t)(b * SEQ + r * GW + qcol) * DA + h * HD + 32 * hh;
        bf16x8 qf[8];
#pragma unroll
        for (int s = 0; s < 8; ++s) qf[s] = *(const bf16x8*)(qp + 64 * (s >> 2) + 8 * (s & 3));
        f32x16 o[4];
#pragma unroll
        for (int db = 0; db < 4; ++db)
#pragma unroll
            for (int i = 0; i < 16; ++i) o[db][i] = 0.f;
        float mrun = -1e30f, lrun = 0.f;
        const int gsw = g4 ^ ((l2 >> 2) & 3);
#define ATT_KDMA(KB_) do { const int kb_ = (KB_); \
            if (kb_ < 10) { \
                _Pragma("unroll") for (int i_ = 0; i_ < 8; ++i_) { const int rho_ = 4 * i_ + l4; const int kk_ = kb_ * 32 + (4 * ((i_ >> 1) & 1) + 8 * (i_ & 1) + 16 * (i_ >> 2)) + l4, krow_ = (kk_ * 205) >> 13, kc_ = c0 + kk_ - krow_ * 40; \
                    __builtin_amdgcn_global_load_lds((const unsigned*)(Kb + (unsigned)(((rs + krow_) * GW + kc_) * (DA * 2) + 16 * (c16 ^ (rho_ & 15)))), (LAS unsigned*)(kl + i_ * 1024), 16, 0, 0); } \
            } else { \
                _Pragma("unroll") for (int i_ = 0; i_ < 8; ++i_) { const int rho_ = 4 * i_ + l4; const int l_ = (kb_ - 10) * 32 + (4 * ((i_ >> 1) & 1) + 8 * (i_ & 1) + 16 * (i_ >> 2)) + l4; \
                    __builtin_amdgcn_global_load_lds((const unsigned*)(KCb + (unsigned)(l_ * (DA * 2) + 16 * (c16 ^ (rho_ & 15)))), (LAS unsigned*)(kl + i_ * 1024), 16, 0, 0); } \
            } } while (0)
#define ATT_VDMA(KB_) do { const int kb_ = (KB_); \
            if (kb_ < 10) { \
                const int k0_ = kb_ * 32 + 8 * gsw, vr_ = (k0_ * 205) >> 13, vc_ = c0 + k0_ - vr_ * 40; const unsigned vo_ = (unsigned)((l2 * SEQ + (rs + vr_) * GW + vc_) * 2); \
                _Pragma("unroll") for (int i_ = 0; i_ < 8; ++i_) __builtin_amdgcn_global_load_lds((const unsigned*)(VTb + vo_ + (unsigned)(i_ * 16 * SEQ * 2)), (LAS unsigned*)(vl + i_ * 1024), 16, 0, 0); \
            } else { \
                const unsigned vo_ = (unsigned)((l2 * CTXL + (kb_ - 10) * 32 + 8 * gsw) * 2); \
                _Pragma("unroll") for (int i_ = 0; i_ < 8; ++i_) __builtin_amdgcn_global_load_lds((const unsigned*)(VCb + vo_ + (unsigned)(i_ * 16 * CTXL * 2)), (LAS unsigned*)(vl + i_ * 1024), 16, 0, 0); \
            } } while (0)
        asm volatile("s_waitcnt vmcnt(0) lgkmcnt(0)" ::: "memory");
        ATT_KDMA(0); ATT_VDMA(0);
        for (int kb = 0; kb < 18; ++kb) {
            const bool win = kb < 10;
            asm volatile("s_waitcnt vmcnt(8)" ::: "memory");
            bf16x8 kf[8];
#pragma unroll
            for (int s = 0; s < 8; ++s) kf[s] = *(const LAS bf16x8*)(kl + q * 256 + 16 * ((8 * (s >> 2) + 4 * hh + (s & 3)) ^ (q & 15)));
            asm volatile("s_waitcnt lgkmcnt(0)" ::: "memory");
            if (kb + 1 < 18) ATT_KDMA(kb + 1);
            f32x16 sa;
#pragma unroll
            for (int i = 0; i < 16; ++i) sa[i] = 0.f;
#pragma unroll
            for (int s = 0; s < 8; ++s) sa = __builtin_amdgcn_mfma_f32_32x32x16_bf16(kf[s], qf[s], sa, 0, 0, 0);
            if (win) {
#pragma unroll
                for (int i = 0; i < 16; ++i) {
                    const int g = kb * 4 + 2 * (i >> 3) + hh, w = (i & 3) + 4 * ((i >> 2) & 1);
                    const int krow = (g * 205) >> 10, kcol = c0 + 8 * (g - 5 * krow) + w;
                    const int dr = rs + krow - r + 7;
                    const int dc = min(max(kcol - qcol, -15), 15) + 15;
                    const bool inw = (unsigned)(kcol - cs) < 16u;
                    sa[i] = inw ? sa[i] + bias[dr * 31 + dc] : -1e30f;
                }
            }
            float bm = sa[0];
#pragma unroll
            for (int i = 1; i < 16; ++i) bm = fmaxf(bm, sa[i]);
            bm = fmaxf(bm, __shfl_xor(bm, 32));
            if (!__all(bm - mrun <= 6.0f)) {
                const float mnew = fmaxf(mrun, bm), alpha = __builtin_amdgcn_exp2f(mrun - mnew);
                mrun = mnew; lrun *= alpha;
#pragma unroll
                for (int db = 0; db < 4; ++db)
#pragma unroll
                    for (int i = 0; i < 16; ++i) o[db][i] *= alpha;
            }
            float ps = 0.f;
#pragma unroll
            for (int i = 0; i < 16; ++i) { sa[i] = __builtin_amdgcn_exp2f(sa[i] - mrun); ps += sa[i]; }
            lrun += ps;
            bf16x8 pf[2];
#pragma unroll
            for (int s2 = 0; s2 < 2; ++s2) { v4u w; w.x = pk2(sa[8 * s2 + 0], sa[8 * s2 + 1]); w.y = pk2(sa[8 * s2 + 2], sa[8 * s2 + 3]); w.z = pk2(sa[8 * s2 + 4], sa[8 * s2 + 5]); w.w = pk2(sa[8 * s2 + 6], sa[8 * s2 + 7]); pf[s2] = __builtin_bit_cast(bf16x8, w); }
            if (kb + 1 < 18) asm volatile("s_waitcnt vmcnt(8)" ::: "memory"); else asm volatile("s_waitcnt vmcnt(0)" ::: "memory");
            bf16x8 vf[4][2];
#pragma unroll
            for (int db = 0; db < 4; ++db) { const int dd = db * 32 + q;
                vf[db][0] = *(const LAS bf16x8*)(vl + dd * 64 + 16 * ((0 + hh) ^ ((dd >> 2) & 3))); vf[db][1] = *(const LAS bf16x8*)(vl + dd * 64 + 16 * ((2 + hh) ^ ((dd >> 2) & 3))); }
            asm volatile("s_waitcnt lgkmcnt(0)" ::: "memory");
            if (kb + 1 < 18) ATT_VDMA(kb + 1);
#pragma unroll
            for (int db = 0; db < 4; ++db) { o[db] = __builtin_amdgcn_mfma_f32_32x32x16_bf16(vf[db][0], pf[0], o[db], 0, 0, 0); o[db] = __builtin_amdgcn_mfma_f32_32x32x16_bf16(vf[db][1], pf[1], o[db], 0, 0, 0); }
        }
#undef ATT_KDMA
#undef ATT_VDMA
        const float ltot = lrun + __shfl_xor(lrun, 32), inv = 1.f / ltot;
        float ss = 0.f;
#pragma unroll
        for (int db = 0; db < 4; ++db)
#pragma unroll
            for (int i = 0; i < 16; ++i) { o[db][i] *= inv; ss += o[db][i] * o[db][i]; }
        ss += __shfl_xor(ss, 32);
        const float rstd = __builtin_amdgcn_rsqf(ss * (1.f / HD) + EPS);
        unsigned char* op = AP_A28 + (size_t)(b * SEQ + r * GW + qcol) * D + h * HD + 4 * hh;
        const float* gp = AP_gao + h * HD + 4 * hh; const float rq = rstd * A2_INV;
#pragma unroll
        for (int db = 0; db < 4; ++db)
#pragma unroll
            for (int i4 = 0; i4 < 4; ++i4) { const f32x4 g = *(const f32x4*)(gp + db * 32 + 8 * i4);
                f32x4 y; y.x = o[db][4 * i4 + 0] * g.x; y.y = o[db][4 * i4 + 1] * g.y; y.z = o[db][4 * i4 + 2] * g.z; y.w = o[db][4 * i4 + 3] * g.w;
                *(unsigned*)(op + db * 32 + 8 * i4) = q4(y, rq); }
    }
    __syncthreads();
}

__device__ __forceinline__ void unpack16(const v4u a, const v4u b, float (&f)[16]) {
    f[0] = bflo(a.x); f[1] = bfhi(a.x); f[2] = bflo(a.y); f[3] = bfhi(a.y); f[4] = bflo(a.z); f[5] = bfhi(a.z); f[6] = bflo(a.w); f[7] = bfhi(a.w);
    f[8] = bflo(b.x); f[9] = bfhi(b.x); f[10] = bflo(b.y); f[11] = bfhi(b.y); f[12] = bflo(b.z); f[13] = bfhi(b.z); f[14] = bflo(b.w); f[15] = bfhi(b.w);
}
__device__ __forceinline__ void load_z(const bf16* CGp, const bf16* Up, size_t m, int lane, float (&z)[16]) {
    const v4u* cp = (const v4u*)(CGp + m * DA + 16 * lane); const v4u* up = (const v4u*)(Up + m * DA + 16 * lane);
    const v4u c0 = cp[0], c1 = cp[1], u0 = up[0], u1 = up[1];
    float cf[16], uf[16]; unpack16(c0, c1, cf); unpack16(u0, u1, uf);
#pragma unroll
    for (int i = 0; i < 16; ++i) z[i] = cf[i] * uf[i];
}
__device__ __forceinline__ void conv_phase(const Frame& F, const Args& A) {
    const int lane = lane_id(), tid = F.wave * 64 + lane; (void)tid;
    const int gw = F.vcu * NWAVES + F.wave, NGW = F.G * NWAVES;
    float w0[16], w1[16], w2[16], gg[16];
#pragma unroll
    for (int i = 0; i < 16; ++i) { w0[i] = AP_w_conv[0 * DA + 16 * lane + i]; w1[i] = AP_w_conv[1 * DA + 16 * lane + i]; w2[i] = AP_w_conv[2 * DA + 16 * lane + i]; gg[i] = AP_gco[16 * lane + i]; }
    for (int it = gw; it < M / 8; it += NGW) {
        const size_t m0 = (size_t)it * 8;
        float zp[16], zc[16], zn[16];
        if ((m0 & (SEQ - 1)) == 0) {
#pragma unroll
            for (int i = 0; i < 16; ++i) zp[i] = 0.f;
        } else load_z(AP_CG, AP_U, m0 - 1, lane, zp);
        load_z(AP_CG, AP_U, m0, lane, zc);
        for (int j = 0; j < 8; ++j) {
            const size_t m = m0 + j;
            if ((m & (SEQ - 1)) == SEQ - 1) {
#pragma unroll
                for (int i = 0; i < 16; ++i) zn[i] = 0.f;
            } else load_z(AP_CG, AP_U, m + 1, lane, zn);
            const v4u* bp = (const v4u*)(AP_BG + m * DA + 16 * lane); const v4u b0 = bp[0], b1 = bp[1];
            float bf[16]; unpack16(b0, b1, bf);
            float y[16], ss = 0.f;
#pragma unroll
            for (int i = 0; i < 16; ++i) { y[i] = bf[i] * (w0[i] * zp[i] + w1[i] * zc[i] + w2[i] * zn[i]); ss += y[i] * y[i]; }
            ss += __shfl_xor(ss, 1); ss += __shfl_xor(ss, 2); ss += __shfl_xor(ss, 4);
            const float rstd = __builtin_amdgcn_rsqf(ss * (1.f / 128.f) + EPS);
            const float rq = rstd * A2_INV; v4u o0;
            { f32x4 t0 = {y[0] * gg[0], y[1] * gg[1], y[2] * gg[2], y[3] * gg[3]}, t1 = {y[4] * gg[4], y[5] * gg[5], y[6] * gg[6], y[7] * gg[7]};
              f32x4 t2 = {y[8] * gg[8], y[9] * gg[9], y[10] * gg[10], y[11] * gg[11]}, t3 = {y[12] * gg[12], y[13] * gg[13], y[14] * gg[14], y[15] * gg[15]};
              o0.x = q4(t0, rq); o0.y = q4(t1, rq); o0.z = q4(t2, rq); o0.w = q4(t3, rq); }
            *(v4u*)(AP_A28 + m * D + DA + 16 * lane) = o0;
#pragma unroll
            for (int i = 0; i < 16; ++i) { zp[i] = zc[i]; zc[i] = zn[i]; }
        }
    }
}

__device__ __forceinline__ unsigned f2key(float f) { const unsigned u = __builtin_bit_cast(unsigned, f); return (u & 0x80000000u) ? ~u : (u | 0x80000000u); }
__device__ __forceinline__ float key2f(unsigned k) { const unsigned u = (k & 0x80000000u) ? (k & 0x7fffffffu) : ~k; return __builtin_bit_cast(float, u); }
__device__ __forceinline__ void ce_desc(unsigned& a, unsigned& b) { const unsigned hi = max(a, b), lo = min(a, b); a = hi; b = lo; }
template <int BASE> __device__ __forceinline__ void sort16_desc(unsigned (&v)[64]) {
#pragma unroll
    for (int k = 2; k <= 16; k <<= 1)
#pragma unroll
        for (int j = k >> 1; j >= 1; j >>= 1)
#pragma unroll
            for (int i = 0; i < 16; ++i) { const int l = i ^ j; if (l > i) { if ((i & k) == 0) ce_desc(v[BASE + i], v[BASE + l]); else ce_desc(v[BASE + l], v[BASE + i]); } }
}
template <int A_, int B_> __device__ __forceinline__ void merge_top16(unsigned (&v)[64]) {
#pragma unroll
    for (int i = 0; i < 16; ++i) v[A_ + i] = max(v[A_ + i], v[B_ + 15 - i]);
#pragma unroll
    for (int j = 8; j >= 1; j >>= 1)
#pragma unroll
        for (int i = 0; i < 16; ++i) { const int l = i ^ j; if (l > i) ce_desc(v[A_ + i], v[A_ + l]); }
}
__device__ __forceinline__ void top16_of_64(unsigned (&v)[64]) {
    sort16_desc<0>(v); sort16_desc<16>(v); sort16_desc<32>(v); sort16_desc<48>(v);
    merge_top16<0, 16>(v); merge_top16<32, 48>(v); merge_top16<0, 32>(v);
}
__device__ __forceinline__ void peer_select_phase(const Frame& F, const Args& A) {
    const int lane = lane_id(), tid = F.wave * 64 + lane; (void)tid;
    const int gw = F.vcu * NWAVES + F.wave, NGW = F.G * NWAVES, tk = lane & 31, hh = lane >> 5;
    LAS unsigned char* qimg = F.lds + F.wave * 16384;
    LAS unsigned char* kimg = qimg + 8192;
    LAS int* ixs = (LAS int*)qimg;
    const int l4 = lane >> 4, c16 = lane & 15;
    unsigned nh4 = (unsigned)(1 - hh) << 2; asm volatile("" : "+v"(nh4));
    for (int task = gw; task < (M / 32) * PH; task += NGW) {
        const int h = task & 7, tb = task >> 3; const int token = tb * 32 + tk;
        unsigned best[2][16];
#pragma unroll
        for (int p = 0; p < 2; ++p) {
            const unsigned char* qsrc = (const unsigned char*)(AP_QP + (size_t)(tb * 32) * D + h * 256 + p * 128);
            const unsigned char* ksrc = (const unsigned char*)(AP_SK + (size_t)((h * 2 + p) * NKEYS) * 128);
            unsigned bq = (unsigned)(l4 * (D * 2) + 16 * (c16 ^ l4)), bk = (unsigned)(l4 * 256 + 16 * (c16 ^ l4));
            asm volatile("s_waitcnt vmcnt(0) lgkmcnt(0)" : "+v"(bq), "+v"(bk) : : "memory");
#pragma unroll
            for (int i = 0; i < 8; ++i) __builtin_amdgcn_global_load_lds((const unsigned*)(qsrc + ((bq ^ (unsigned)(64 * (i & 3))) + (unsigned)(i * 4 * D * 2))), (LAS unsigned*)(qimg + i * 1024), 16, 0, 0);
#define PS_KDMA(KB_) do { _Pragma("unroll") for (int i_ = 0; i_ < 8; ++i_) \
                __builtin_amdgcn_global_load_lds((const unsigned*)(ksrc + ((bk ^ (unsigned)(64 * (i_ & 3))) + (unsigned)((KB_) * 8192 + i_ * 1024))), (LAS unsigned*)(kimg + i_ * 1024), 16, 0, 0); } while (0)
            PS_KDMA(0);
            asm volatile("s_waitcnt vmcnt(8)" ::: "memory");
            bf16x8 qf[8];
#pragma unroll
            for (int s = 0; s < 8; ++s) qf[s] = *(const LAS bf16x8*)(qimg + tk * 256 + 16 * ((8 * (s >> 2) + 4 * hh + (s & 3)) ^ (tk & 15)));
            unsigned ky[64];
#pragma unroll
            for (int kb = 0; kb < 4; ++kb) {
                asm volatile("s_waitcnt vmcnt(0)" ::: "memory");
                bf16x8 kf[8];
#pragma unroll
                for (int s = 0; s < 8; ++s) kf[s] = *(const LAS bf16x8*)(kimg + tk * 256 + 16 * ((8 * (s >> 2) + 4 * hh + (s & 3)) ^ (tk & 15)));
                asm volatile("s_waitcnt lgkmcnt(0)" ::: "memory");
                if (kb < 3) PS_KDMA(kb + 1);
                f32x16 sa;
#pragma unroll
                for (int i = 0; i < 16; ++i) sa[i] = 0.f;
#pragma unroll
                for (int s = 0; s < 8; ++s) sa = __builtin_amdgcn_mfma_f32_32x32x16_bf16(kf[s], qf[s], sa, 0, 0, 0);
#pragma unroll
                for (int i = 0; i < 16; ++i) { const unsigned ck = (unsigned)(127 - (kb * 32 + (i & 3) + 8 * (i >> 2))) & ~4u;
                    ky[kb * 16 + i] = ((f2key(sa[i]) & ~127u) | nh4) | ck; }
                asm volatile("" ::: "memory");
            }
#undef PS_KDMA
            top16_of_64(ky);
#pragma unroll
            for (int i = 0; i < 16; ++i) ky[16 + i] = (unsigned)__shfl_xor((int)ky[i], 32);
            merge_top16<0, 16>(ky);
#pragma unroll
            for (int i = 0; i < 16; ++i) best[p][i] = ky[i];
        }
        float s1[16], s2[16];
#pragma unroll
        for (int i = 0; i < 16; ++i) { s1[i] = key2f(best[0][i] & ~127u); s2[i] = key2f(best[1][i] & ~127u);
            ixs[i * 64 + lane] = 127 - (int)(best[0][i] & 127u); ixs[(16 + i) * 64 + lane] = 127 - (int)(best[1][i] & 127u); }
        unsigned cd[64]; { int n = 0;
#pragma unroll
            for (int i = 0; i < 16; ++i)
#pragma unroll
                for (int j = 0; j < 16; ++j) if ((i + 1) * (j + 1) <= 16) { cd[n] = (f2key(s1[i] + s2[j]) & ~255u) | (unsigned)(255 - (16 * i + j)); ++n; }
#pragma unroll
            for (int i = 50; i < 64; ++i) cd[i] = 0u; }
        top16_of_64(cd);
        unsigned win[16];
#pragma unroll
        for (int i = 0; i < 16; ++i) win[i] = cd[i];
        LDS_WAIT();
        const float vmax = key2f(win[0] & ~255u);
        float ev[16], es = 0.f;
#pragma unroll
        for (int rnd = 0; rnd < 16; ++rnd) { ev[rnd] = __expf(key2f(win[rnd] & ~255u) - vmax); es += ev[rnd]; }
        const float ies = 1.f / es;
        if (hh == 0) {
            int* ip = AP_SELI + (size_t)token * 128 + h * 16; float* gp = AP_SELG + (size_t)token * 128 + h * 16;
#pragma unroll
            for (int rnd = 0; rnd < 16; ++rnd) { const int pos = 255 - (int)(win[rnd] & 255u); const int i1 = ixs[(pos >> 4) * 64 + lane], i2 = ixs[(16 + (pos & 15)) * 64 + lane];
                ip[rnd] = i1 * NKEYS + i2; gp[rnd] = ev[rnd] * ies; }
        }
        LDS_WAIT();
    }
}

typedef int v4i __attribute__((ext_vector_type(4)));
__device__ __forceinline__ float gelu_as(const float v) {
    const float av = fabsf(v), t = __builtin_amdgcn_rcpf(av * 0.2316418882f + 1.0f);
    float q = t * 0.5307027145f + (-0.7265760135f); q = q * t + 0.7107068705f; q = q * t + (-0.142248368f); q = q * t + 0.127414796f; q = q * t;
    const float e = __builtin_amdgcn_exp2f((v * v) * (-0.72134752044f));
    const float m = v * (q * e);
    return v < 0.f ? m : v - m;
}
constexpr int PL_WAVE = 16384, PL_EL = 8192, PL_PACC = 10240, PL_AQ = 14336, PL_SA = 15360;
__device__ __forceinline__ float wave_maxf(float v) {
#pragma unroll
    for (int o = 1; o < 64; o <<= 1) v = fmaxf(v, __shfl_xor(v, o));
    return v;
}
__device__ __forceinline__ void peer_u_phase(const Frame& F, const Args& A, float (&sa)[8]) {
    const int lane = lane_id(), p = lane >> 2, sub = lane & 3;
    LAS unsigned short* elist = (LAS unsigned short*)(F.lds + F.wave * PL_WAVE + PL_EL);
    LAS int* pacc = (LAS int*)(F.lds + F.wave * PL_WAVE + PL_PACC);
    LAS signed char* aq = (LAS signed char*)(F.lds + F.wave * PL_WAVE + PL_AQ);
    const int tok0 = F.vcu * 64 + F.wave * 8;
    for (int it = 0; it < 16; ++it) { elist[it * 64 + lane] = (unsigned short)AP_SELI[(size_t)tok0 * 128 + it * 64 + lane]; pacc[it * 64 + lane] = 0; }
    LDS_WAIT();
    v4u G0[4], G1[4], G2[4], G3[4], hreg[2];
    const unsigned char* ub = AP_U8 + 16 * sub;
    LAS unsigned char* hst = F.lds + F.wave * PL_WAVE;
#define PU_LOAD(G_, K_) do { const int kg_ = (K_), tp_ = kg_ & 31; const unsigned ea_ = elist[(2 * tp_) * 16 + p], eb_ = elist[(2 * tp_ + 1) * 16 + p]; \
            const unsigned char* ua_ = ub + (size_t)ea_ * D + 128 * (kg_ >> 5); const unsigned char* ubb_ = ub + (size_t)eb_ * D + 128 * (kg_ >> 5); \
            G_[0] = *(const v4u*)(ua_); G_[1] = *(const v4u*)(ua_ + 64); G_[2] = *(const v4u*)(ubb_); G_[3] = *(const v4u*)(ubb_ + 64); } while (0)
#define PU_DOT8(A0_, A1_) ([&]() { int d0_ = 0, d1_ = 0, d2_ = 0, d3_ = 0; \
            d0_ = __builtin_amdgcn_sdot4((int)(A0_).x, (int)hreg[0].x, d0_, false); d1_ = __builtin_amdgcn_sdot4((int)(A0_).y, (int)hreg[0].y, d1_, false); \
            d2_ = __builtin_amdgcn_sdot4((int)(A0_).z, (int)hreg[0].z, d2_, false); d3_ = __builtin_amdgcn_sdot4((int)(A0_).w, (int)hreg[0].w, d3_, false); \
            d0_ = __builtin_amdgcn_sdot4((int)(A1_).x, (int)hreg[1].x, d0_, false); d1_ = __builtin_amdgcn_sdot4((int)(A1_).y, (int)hreg[1].y, d1_, false); \
            d2_ = __builtin_amdgcn_sdot4((int)(A1_).z, (int)hreg[1].z, d2_, false); d3_ = __builtin_amdgcn_sdot4((int)(A1_).w, (int)hreg[1].w, d3_, false); \
            int v_ = (d0_ + d1_) + (d2_ + d3_); \
            v_ += __builtin_amdgcn_update_dpp(0, v_, 0xB1, 0xf, 0xf, true); v_ += __builtin_amdgcn_update_dpp(0, v_, 0x4E, 0xf, 0xf, true); return v_; }())
#define PU_COMPUTE(G_, TP_) do { const int va_ = PU_DOT8(G_[0], G_[1]), vb_ = PU_DOT8(G_[2], G_[3]); \
            if (sub == 0) { (void)__hip_atomic_fetch_add(pacc + (2 * (TP_)) * 16 + p, va_, __ATOMIC_RELAXED, __HIP_MEMORY_SCOPE_WORKGROUP); \
                            (void)__hip_atomic_fetch_add(pacc + (2 * (TP_) + 1) * 16 + p, vb_, __ATOMIC_RELAXED, __HIP_MEMORY_SCOPE_WORKGROUP); } } while (0)
    PU_LOAD(G0, 0); PU_LOAD(G1, 1); PU_LOAD(G2, 2); PU_LOAD(G3, 3);
    for (int slice = 0; slice < 16; ++slice) {
        { const int tk_ = lane >> 3, pc_ = lane & 7;
          *(LAS v4u*)(hst + tk_ * 128 + 16 * pc_) = *(const v4u*)(AP_H2Q + (size_t)(tok0 + tk_) * D + 128 * slice + 16 * pc_); }
        for (int tk = 0; tk < 8; ++tk) {
            hreg[0] = *(const LAS v4u*)(hst + tk * 128 + 16 * sub); hreg[1] = *(const LAS v4u*)(hst + tk * 128 + 64 + 16 * sub);
            { const int tp = tk * 4, k = slice * 32 + tp;
                PU_COMPUTE(G0, tp);     PU_LOAD(G0, (k + 4) & 511);
                PU_COMPUTE(G1, tp + 1); PU_LOAD(G1, (k + 5) & 511);
                PU_COMPUTE(G2, tp + 2); PU_LOAD(G2, (k + 6) & 511);
                PU_COMPUTE(G3, tp + 3); PU_LOAD(G3, (k + 7) & 511);
            }
        }
        if ((slice & 3) == 3) __builtin_amdgcn_s_barrier();
    }
#undef PU_LOAD
#undef PU_COMPUTE
#undef PU_DOT8
    LDS_WAIT();
#pragma unroll
    for (int t = 0; t < 8; ++t) { const int token = tok0 + t; const float hs = AP_H2S[token]; float av[2];
#pragma unroll
        for (int hf = 0; hf < 2; ++hf) { const int p = t * 128 + hf * 64 + lane; const unsigned e = elist[p];
            av[hf] = gelu_as((float)pacc[p] * AP_SU[e] * hs) * AP_SELG[(size_t)tok0 * 128 + p] * AP_SV[e]; }
        const float mx = fmaxf(wave_maxf(fmaxf(fabsf(av[0]), fabsf(av[1]))), 1e-30f), inv = 127.f / mx;
        aq[t * 128 + lane] = (signed char)(int)__builtin_rintf(av[0] * inv); aq[t * 128 + 64 + lane] = (signed char)(int)__builtin_rintf(av[1] * inv);
        sa[t] = mx * (1.f / 127.f); if (lane == 0) *(LAS float*)(F.lds + F.wave * PL_WAVE + PL_SA + 4 * t) = mx * (1.f / 127.f); }
    LDS_WAIT();
}
__device__ __forceinline__ void peer_v_phase(const Frame& F, const Args& A, const float (&sa)[8]) {
    const int lane = lane_id(), n = lane & 15, kq = lane >> 4, rr = n >> 2, cc = n & 3;
    LAS unsigned char* buf = F.lds + F.wave * PL_WAVE;
    const LAS unsigned short* elist = (const LAS unsigned short*)(F.lds + F.wave * PL_WAVE + PL_EL);
    const LAS signed char* aq = (const LAS signed char*)(F.lds + F.wave * PL_WAVE + PL_AQ);
    const int tok0 = F.vcu * 64 + F.wave * 8;
    const int fsw = (rr >> 1) | ((kq & 1) << 1);
    const unsigned trbase = (unsigned)(size_t)buf + (unsigned)((8 * kq + rr) * 128 + 8 * cc);
    const int r0 = lane >> 3, c8 = lane & 7;
    v4u G0[4], G1[4], G2[4], G3[4];
    v4i accE[4], accO[4];
#pragma unroll
    for (int q = 0; q < 4; ++q) { accE[q] = (v4i){0, 0, 0, 0}; accO[q] = (v4i){0, 0, 0, 0}; }
#define PV_EREAD(K_) do { const int ke_ = (K_); _Pragma("unroll") for (int i_ = 0; i_ < 4; ++i_) en[i_] = elist[(ke_ & 31) * 32 + 8 * i_ + r0]; } while (0)
#define PV_LOAD(G_, K_) do { const int kg_ = (K_); _Pragma("unroll") for (int i_ = 0; i_ < 4; ++i_) { const unsigned e_ = en[i_]; \
            const int f_ = ((r0 >> 1) & 1) | ((i_ & 1) << 1); \
            G_[i_] = *(const v4u*)(AP_V8 + (size_t)e_ * D + 128 * (kg_ >> 5) + 32 * ((c8 >> 1) ^ f_) + 16 * (c8 & 1)); } } while (0)
#define PV_STORE(G_, B_) do { _Pragma("unroll") for (int i_ = 0; i_ < 4; ++i_) *(LAS v4u*)(buf + (B_) * 4096 + i_ * 1024 + lane * 16) = G_[i_]; } while (0)
#define PV_TR(B_) do { const unsigned tb_ = trbase + (unsigned)((B_) * 4096); \
            const unsigned t0_ = tb_ + 32u * (unsigned)(0 ^ fsw), t1_ = tb_ + 32u * (unsigned)(1 ^ fsw), t2_ = tb_ + 32u * (unsigned)(2 ^ fsw), t3_ = tb_ + 32u * (unsigned)(3 ^ fsw); \
            asm volatile("s_waitcnt lgkmcnt(0)\n\t" \
                         "ds_read_b64_tr_b16 %0, %8\n\tds_read_b64_tr_b16 %1, %8 offset:512\n\tds_read_b64_tr_b16 %2, %9\n\tds_read_b64_tr_b16 %3, %9 offset:512\n\t" \
                         "ds_read_b64_tr_b16 %4, %10\n\tds_read_b64_tr_b16 %5, %10 offset:512\n\tds_read_b64_tr_b16 %6, %11\n\tds_read_b64_tr_b16 %7, %11 offset:512" \
                         : "=&v"(RR[0][0]), "=&v"(RR[0][1]), "=&v"(RR[1][0]), "=&v"(RR[1][1]), "=&v"(RR[2][0]), "=&v"(RR[2][1]), "=&v"(RR[3][0]), "=&v"(RR[3][1]) : "v"(t0_), "v"(t1_), "v"(t2_), "v"(t3_) : "memory"); } while (0)
#define PV_MMA(K_) do { const int kc_ = (K_), b_ = kc_ & 31; \
            v2u a8_ = *(const LAS v2u*)(aq + b_ * 32 + 8 * kq);                        \
            if (n != (b_ >> 2)) a8_ = (v2u){0u, 0u};                                  \
            v4i AE_, AO_; \
            AE_.x = (int)__builtin_amdgcn_perm(0u, a8_.x, 0x0c010c00u); AE_.y = (int)__builtin_amdgcn_perm(0u, a8_.x, 0x0c030c02u); AE_.z = (int)__builtin_amdgcn_perm(0u, a8_.y, 0x0c010c00u); AE_.w = (int)__builtin_amdgcn_perm(0u, a8_.y, 0x0c030c02u); \
            AO_.x = (int)__builtin_amdgcn_perm(0u, a8_.x, 0x010c000cu); AO_.y = (int)__builtin_amdgcn_perm(0u, a8_.x, 0x030c020cu); AO_.z = (int)__builtin_amdgcn_perm(0u, a8_.y, 0x010c000cu); AO_.w = (int)__builtin_amdgcn_perm(0u, a8_.y, 0x030c020cu); \
            asm volatile("s_waitcnt lgkmcnt(0)" : "+v"(RR[0][0]), "+v"(RR[0][1]), "+v"(RR[1][0]), "+v"(RR[1][1]), "+v"(RR[2][0]), "+v"(RR[2][1]), "+v"(RR[3][0]), "+v"(RR[3][1]) : : "memory"); \
            _Pragma("unroll") for (int q_ = 0; q_ < 4; ++q_) { const v4i Bq_ = {(int)RR[q_][0].x, (int)RR[q_][0].y, (int)RR[q_][1].x, (int)RR[q_][1].y}; \
                accE[q_] = __builtin_amdgcn_mfma_i32_16x16x64_i8(AE_, Bq_, accE[q_], 0, 0, 0); \
                accO[q_] = __builtin_amdgcn_mfma_i32_16x16x64_i8(AO_, Bq_, accO[q_], 0, 0, 0); } } while (0)
    v2u RR[4][2]; unsigned en[4];
    PV_EREAD(0); PV_LOAD(G0, 0); PV_EREAD(1); PV_LOAD(G1, 1); PV_EREAD(2); PV_LOAD(G2, 2); PV_EREAD(3); PV_LOAD(G3, 3); PV_EREAD(4); PV_STORE(G0, 0);
    for (int slice = 0; slice < 16; ++slice) {
        for (int k = slice * 32; k < slice * 32 + 32; k += 4) {
            PV_TR(0); PV_STORE(G1, 1); PV_LOAD(G0, (k + 4) & 511); PV_EREAD((k + 5) & 511); PV_MMA(k);
            PV_TR(1); PV_STORE(G2, 0); PV_LOAD(G1, (k + 5) & 511); PV_EREAD((k + 6) & 511); PV_MMA(k + 1);
            PV_TR(0); PV_STORE(G3, 1); PV_LOAD(G2, (k + 6) & 511); PV_EREAD((k + 7) & 511); PV_MMA(k + 2);
            PV_TR(1); PV_STORE(G0, 0); PV_LOAD(G3, (k + 7) & 511); PV_EREAD((k + 8) & 511); PV_MMA(k + 3);
        }
        if (kq < 2) {
#pragma unroll
            for (int i = 0; i < 4; ++i) { const int token = tok0 + 4 * kq + i; const float sat = kq ? sa[4 + i] : sa[i];
                const float* gtp = AP_MOD + (size_t)(token >> 11) * 6 * D + 5 * D + 128 * slice + 2 * n; float* op = AP_out + (size_t)token * D + 128 * slice + 2 * n;
                const bf16* xp = AP_X1B + (size_t)token * D + 128 * slice + 2 * n;
#pragma unroll
                for (int q = 0; q < 4; ++q) { typedef float f32x2t __attribute__((ext_vector_type(2)));
                    const unsigned xw = *(const unsigned*)(xp + 32 * q); const f32x2t g0 = *(const f32x2t*)(gtp + 32 * q);
                    f32x2t rv; rv.x = bflo(xw) + g0.x * (sat * (float)accE[q][i]); rv.y = bfhi(xw) + g0.y * (sat * (float)accO[q][i]);
                    *(f32x2t*)(op + 32 * q) = rv; } }
        }
#pragma unroll
        for (int q = 0; q < 4; ++q) { accE[q] = (v4i){0, 0, 0, 0}; accO[q] = (v4i){0, 0, 0, 0}; }
        if ((slice & 3) == 3) __builtin_amdgcn_s_barrier();
    }
#undef PV_TR
#undef PV_MMA
#undef PV_LOAD
#undef PV_EREAD
#undef PV_STORE

}

__device__ __forceinline__ void peer_v_phase_valu(const Frame& F, const Args& A) {
    typedef float f32x2v __attribute__((ext_vector_type(2)));
    const int lane = lane_id(), r = lane >> 3, c = lane & 7, jq = lane >> 4, hb = (lane >> 3) & 1;
    const LAS unsigned char* wb = F.lds + F.wave * PL_WAVE;
    const LAS unsigned short* elist = (const LAS unsigned short*)(wb + PL_EL) + 4 * r;
    const LAS unsigned char* aq = wb + PL_AQ + 4 * r;
    const LAS float* sal = (const LAS float*)(wb + PL_SA);
    const int tok0 = F.vcu * 64 + F.wave * 8;
    const unsigned char* vb = AP_V8 + 16 * c;
    v4u G0[4], G1[4], G2[4], G3[4];
    v2u EN[4]; unsigned AC[4], AN[4];
    int acc[16];
#define PW_META(T_) do { const int tm_ = (T_) & 7; _Pragma("unroll") for (int s_ = 0; s_ < 4; ++s_) { EN[s_] = *(const LAS v2u*)(elist + tm_ * 128 + s_ * 32); AN[s_] = *(const LAS unsigned*)(aq + tm_ * 128 + s_ * 32); } } while (0)
#define PW_LOAD(G_, S_, SL_) do { const unsigned char* vs_ = vb + 128 * ((SL_) & 15); const v2u en_ = EN[S_]; \
        G_[0] = *(const v4u*)(vs_ + (size_t)(en_.x & 0xffffu) * D); G_[1] = *(const v4u*)(vs_ + (size_t)(en_.x >> 16) * D); \
        G_[2] = *(const v4u*)(vs_ + (size_t)(en_.y & 0xffffu) * D); G_[3] = *(const v4u*)(vs_ + (size_t)(en_.y >> 16) * D); } while (0)
#define PW_COL(W0_, W1_, W2_, W3_, J_, AP_) do { \
        const unsigned tl0_ = __builtin_amdgcn_perm(W1_, W0_, 0x05010400u), th0_ = __builtin_amdgcn_perm(W1_, W0_, 0x07030602u); \
        const unsigned tl1_ = __builtin_amdgcn_perm(W3_, W2_, 0x05010400u), th1_ = __builtin_amdgcn_perm(W3_, W2_, 0x07030602u); \
        acc[4 * (J_) + 0] = __builtin_amdgcn_sdot4((int)__builtin_amdgcn_perm(tl1_, tl0_, 0x05040100u), (int)(AP_), acc[4 * (J_) + 0], false); \
        acc[4 * (J_) + 1] = __builtin_amdgcn_sdot4((int)__builtin_amdgcn_perm(tl1_, tl0_, 0x07060302u), (int)(AP_), acc[4 * (J_) + 1], false); \
        acc[4 * (J_) + 2] = __builtin_amdgcn_sdot4((int)__builtin_amdgcn_perm(th1_, th0_, 0x05040100u), (int)(AP_), acc[4 * (J_) + 2], false); \
        acc[4 * (J_) + 3] = __builtin_amdgcn_sdot4((int)__builtin_amdgcn_perm(th1_, th0_, 0x07060302u), (int)(AP_), acc[4 * (J_) + 3], false); } while (0)
#define PW_COMPUTE(G_, AP_) do { PW_COL(G_[0].x, G_[1].x, G_[2].x, G_[3].x, 0, AP_); PW_COL(G_[0].y, G_[1].y, G_[2].y, G_[3].y, 1, AP_); \
        PW_COL(G_[0].z, G_[1].z, G_[2].z, G_[3].z, 2, AP_); PW_COL(G_[0].w, G_[1].w, G_[2].w, G_[3].w, 3, AP_); } while (0)
    PW_META(0);
    LDS_WAIT();
    PW_LOAD(G0, 0, 0); PW_LOAD(G1, 1, 0); PW_LOAD(G2, 2, 0); PW_LOAD(G3, 3, 0);
#pragma unroll
    for (int s = 0; s < 4; ++s) AC[s] = AN[s];
    for (int slice = 0; slice < 16; ++slice) {
        for (int t = 0; t < 8; ++t) {
            const int token = tok0 + t, d0 = 128 * slice + 16 * c + 4 * jq + 2 * hb;
            const unsigned xw = *(const unsigned*)(AP_X1B + (size_t)token * D + d0);
            const f32x2v g2 = *(const f32x2v*)(AP_MOD + (size_t)(token >> 11) * 6 * D + 5 * D + d0);
            const float sat = sal[t];
            PW_META(t + 1);
            const int sn = slice + ((t + 1) >> 3);
#pragma unroll
            for (int q = 0; q < 16; ++q) acc[q] = 0;
            __builtin_amdgcn_sched_barrier(0);
            PW_COMPUTE(G0, AC[0]); __builtin_amdgcn_sched_barrier(0); PW_LOAD(G0, 0, sn); __builtin_amdgcn_sched_barrier(0);
            PW_COMPUTE(G1, AC[1]); __builtin_amdgcn_sched_barrier(0); PW_LOAD(G1, 1, sn); __builtin_amdgcn_sched_barrier(0);
            PW_COMPUTE(G2, AC[2]); __builtin_amdgcn_sched_barrier(0); PW_LOAD(G2, 2, sn); __builtin_amdgcn_sched_barrier(0);
            PW_COMPUTE(G3, AC[3]); __builtin_amdgcn_sched_barrier(0); PW_LOAD(G3, 3, sn); __builtin_amdgcn_sched_barrier(0);
#pragma unroll
            for (int s = 0; s < 4; ++s) AC[s] = AN[s];
            int s1[8], s2[4];
#pragma unroll
            for (int q = 0; q < 8; ++q) { const auto rr = __builtin_amdgcn_permlane32_swap((unsigned)acc[q], (unsigned)acc[8 + q], false, false); s1[q] = (int)rr[0] + (int)rr[1]; }
#pragma unroll
            for (int q = 0; q < 4; ++q) { const auto rr = __builtin_amdgcn_permlane16_swap((unsigned)s1[q], (unsigned)s1[4 + q], false, false); s2[q] = (int)rr[0] + (int)rr[1]; }
#pragma unroll
            for (int q = 0; q < 4; ++q) s2[q] += __builtin_amdgcn_update_dpp(0, s2[q], 0x128, 0xf, 0xf, true);
            f32x2v o;
            o.x = bflo(xw) + g2.x * (sat * (float)(hb ? s2[2] : s2[0])); o.y = bfhi(xw) + g2.y * (sat * (float)(hb ? s2[3] : s2[1]));
            *(f32x2v*)(AP_out + (size_t)token * D + d0) = o;
        }
        if ((slice & 3) == 3) __builtin_amdgcn_s_barrier();
    }
#undef PW_META
#undef PW_LOAD
#undef PW_COL
#undef PW_COMPUTE
}
__device__ __forceinline__ void peer_eval_phase(const Frame& F, const Args& A) { float sa[8]; peer_u_phase(F, A, sa); peer_v_phase_valu(F, A); }

template <bool FUSED, int ONLY>
__global__ void __launch_bounds__(NWAVES * 64, 2) mk_fwd(Args args) {
    extern __shared__ __attribute__((aligned(16))) unsigned char lds[];
    Frame F;
    F.lds = (LAS unsigned char*)lds;
    F.wave = __builtin_amdgcn_readfirstlane((int)threadIdx.x >> 6);
    F.G = gridDim.x; { const int bx = blockIdx.x; F.vcu = (F.G % 8 == 0) ? (bx % 8) * (F.G / 8) + bx / 8 : bx; }
    const Args& A = args;
    const int lo = (ONLY >= 0) ? ONLY : args.ph_lo, hi = (ONLY >= 0) ? ONLY + 1 : args.ph_hi;
#define IN(k) ((ONLY < 0 || ONLY == (k)) && lo <= (k) && (k) < hi)
    XcdBarrier bar; bar.bar = (unsigned*)(args.ws + WS_CTL); bar.x = 0; bar.st = (volatile LAS unsigned*)(F.lds + MISC_OFF);
    if constexpr (FUSED) {
        if (MK_CG_SYNC) cg::this_grid().sync();
        bar.x = xb_xcc_id();
        if (F.wave == 0 && lane_id() == 0) { bar.st[0] = 0u; bar.st[1] = 0u; (void)xb_add(&bar.bar[XB_XCNT(bar.x)], 1u); }
        __syncthreads();
    }
#define SEAM(k) do { if (FUSED && IN(k) && IN((k) + 1)) { xcd_barrier(bar, F.wave, (unsigned)F.G); } } while (0)

    if (IN(0)) { p0_prologue(F, A); } SEAM(0);
    if (IN(1)) { p1_norm1(F, A); } SEAM(1);
    if (IN(2)) {
        { pg8::Gemm g{(const bf16*)AP_H8, (const bf16*)AP_WIN8, M, NPROJ, D / 2}; pg8::StaticOrder S; S.init(M, NPROJ, F.G, (int)blockIdx.x);
          EpiProj E{AP_Q, AP_K, AP_VTR, AP_BG, AP_CG, AP_U, AP_qn, AP_kn, (LAS float*)(F.lds + XCH_OFF), 0, 11, 0.08838834764831845f * LOG2E, AP_HS, AP_WINS};
          pg8::gemm_phase<EpiProj, pg8::StaticOrder, true, true, true>(F.lds, g, S, E, F.wave); }
        { pg8::Gemm g{(const bf16*)AP_HC8, (const bf16*)(AP_WIN8 + (size_t)DA * D), MC, 2 * DA, D / 2}; pg8::StaticOrder S; S.init(MC, 2 * DA, F.G, (int)blockIdx.x);
          EpiProj E{nullptr, AP_KC, AP_VCT, nullptr, nullptr, nullptr, AP_qn, AP_kn, (LAS float*)(F.lds + XCH_OFF), 1, 8, 1.f, AP_HCS, AP_WINS + DA};
          pg8::gemm_phase<EpiProj, pg8::StaticOrder, true, true, true>(F.lds, g, S, E, F.wave); }
    } SEAM(2);
    if (IN(3)) { attn_phase(F, A); conv_phase(F, A); } SEAM(3);
    if (IN(4)) { pg8::Gemm g{(const bf16*)AP_A28, (const bf16*)AP_WOUT8, M, D, D / 2}; pg8::StaticOrder S; S.init(M, D, F.G, (int)blockIdx.x);
        EpiRes E{AP_x, AP_X1B, AP_MOD, 2 * D, AP_WOUTS, A2_SCALE};
        pg8::gemm_phase<EpiRes, pg8::StaticOrder, true, true, true>(F.lds, g, S, E, F.wave); } SEAM(4);
    if (IN(5)) { p5_norm2(F, A); } SEAM(5);
    if (IN(6)) { pg8::Gemm g{(const bf16*)AP_H2Q, (const bf16*)AP_WPQ8, M, D, D / 2}; pg8::StaticOrder S; S.init(M, D, F.G, (int)blockIdx.x);
        EpiBf16 E{AP_QP, D, AP_H2S, AP_WPQS};
        pg8::gemm_phase<EpiBf16, pg8::StaticOrder, true, true, true>(F.lds, g, S, E, F.wave); } SEAM(6);
    if (IN(7)) { peer_select_phase(F, A); } SEAM(7);
    if (IN(8)) { peer_eval_phase(F, A); }
#undef IN
#undef SEAM
}

template <int PHS> static bool set_lds() { return hipFuncSetAttribute((const void*)mk_fwd<false, PHS>, hipFuncAttributeMaxDynamicSharedMemorySize, LDS_BYTES) == hipSuccess; }
template <int PHS> static void launch_one(int grid, hipStream_t stream, const Args& a) {
    hipLaunchKernelGGL((mk_fwd<false, PHS>), dim3(grid), dim3(NWAVES * 64), LDS_BYTES, stream, a);
    const hipError_t le = hipPeekAtLastError();
    if (le != hipSuccess) fprintf(stderr, "kernel_launch: launch %d failed: %s\n", PHS, hipGetErrorName(le));
}
extern "C" void kernel_launch(void* const* d_in, const int* in_sizes, int n_in, void* d_out, int out_size, void* d_ws, size_t ws_size, hipStream_t stream) {
    constexpr bool FUSED = (MK_N_LAUNCHES == 1);
    static int grid = 0;
    if (grid == 0) {
        if (n_in != 20 || in_sizes[0] != M * D || out_size != M * D || ws_size < WS_END) { fprintf(stderr, "kernel_launch: unexpected shapes (n_in %d, in0 %d, out %d, ws %zu < %zu); nothing launched\n", n_in, n_in > 0 ? in_sizes[0] : -1, out_size, ws_size, (size_t)WS_END); grid = -1; return; }
        int dev = 0, cus = 0, per_cu = 0;
        if (hipGetDevice(&dev) != hipSuccess || hipDeviceGetAttribute(&cus, hipDeviceAttributeMultiprocessorCount, dev) != hipSuccess) { grid = -1; return; }
        bool okattr = true;
        if constexpr (FUSED) okattr = hipFuncSetAttribute((const void*)mk_fwd<true, -1>, hipFuncAttributeMaxDynamicSharedMemorySize, LDS_BYTES) == hipSuccess;
        else { okattr &= set_lds<0>(); okattr &= set_lds<1>(); okattr &= set_lds<2>(); okattr &= set_lds<3>(); okattr &= set_lds<4>(); okattr &= set_lds<5>(); okattr &= set_lds<6>(); okattr &= set_lds<7>(); okattr &= set_lds<8>(); }
        if (!okattr) { fprintf(stderr, "kernel_launch: hipFuncSetAttribute failed\n"); grid = -1; return; }
        if (hipOccupancyMaxActiveBlocksPerMultiprocessor(&per_cu, (const void*)mk_fwd<FUSED, (FUSED ? -1 : 2)>, NWAVES * 64, LDS_BYTES) != hipSuccess || per_cu < 1) { fprintf(stderr, "kernel_launch: occupancy query says %d blocks per CU; nothing launched\n", per_cu); grid = -1; return; }
        (void)hipGetLastError();
        grid = cus;
        if (grid != 256) fprintf(stderr, "kernel_launch: note: %d CUs (built for 256)\n", grid);
    }
    if (grid < 0) return;
    Args a{};
    for (int i = 0; i < 20; ++i) a.in[i] = (const float*)d_in[i];
    a.out = (float*)d_out; a.ws = (unsigned char*)d_ws;
    if constexpr (FUSED) {
        a.ph_lo = 0; a.ph_hi = NPHASE;
        if (hipMemsetAsync((char*)d_ws + WS_CTL, 0, 128 * 1024, stream) != hipSuccess) { fprintf(stderr, "kernel_launch: memset of the barrier words failed\n"); return; }
        void* kargs[] = {&a};
        hipError_t e;
        if (MK_CG_SYNC) e = hipLaunchCooperativeKernel((const void*)mk_fwd<true, -1>, dim3(grid), dim3(NWAVES * 64), kargs, LDS_BYTES, stream);
        else { hipLaunchKernelGGL((mk_fwd<true, -1>), dim3(grid), dim3(NWAVES * 64), LDS_BYTES, stream, a); e = hipPeekAtLastError(); }
        if (e != hipSuccess) fprintf(stderr, "kernel_launch: launch failed: %s (grid %d)\n", hipGetErrorString(e), grid);
    } else {
        a.ph_lo = 0; a.ph_hi = NPHASE;
        launch_one<0>(grid, stream, a); launch_one<1>(grid, stream, a); launch_one<2>(grid, stream, a); launch_one<3>(grid, stream, a); launch_one<4>(grid, stream, a);
        launch_one<5>(grid, stream, a); launch_one<6>(grid, stream, a); launch_one<7>(grid, stream, a); launch_one<8>(grid, stream, a);
    }
}
```

```cpp
#include <hip/hip_runtime.h>
#include <hip/hip_cooperative_groups.h>
#include <cstdio>
#include <cstdint>
namespace cg = cooperative_groups;
#define MK_N_LAUNCHES 1
namespace pg8 {
#define PG8_LAS __attribute__((address_space(3)))
typedef unsigned short bf16_t;
typedef short bf16x8 __attribute__((ext_vector_type(8)));
typedef float f32x4 __attribute__((ext_vector_type(4)));
typedef unsigned u32x4 __attribute__((ext_vector_type(4)));
constexpr int BM = 256, BK = 64, HALF = 128, HTB = HALF * BK * 2  , STAGE_BYTES = 8 * HTB, NXCD = 8, WGM = 8;

__host__ __device__ __forceinline__ int lds_byte(int r, int c) { const int st = (r >> 4) * 2 + (c >> 5), rr = r & 15, cc = c & 31, ob = rr * 64 + cc * 2; return st * 1024 + (ob ^ (((ob >> 9) & 1) << 5)); }
__host__ __device__ __forceinline__ void stage_rc(int b, int& R, int& C) { const int st = b / 1024, sb = b % 1024, swz = sb ^ (((sb >> 9) & 1) << 5); R = (st >> 1) * 16 + swz / 64; C = (st & 1) * 32 + (swz % 64) / 2; }
__host__ __device__ __forceinline__ int perm32(int rho) { const int n = rho >> 4, i = rho & 15; return 8 * (i >> 2) + 4 * n + (i & 3); }

struct Unit { int pm, pn; };
struct Gemm { const bf16_t* A; const bf16_t* Bt; int M, N, K; };

struct StaticOrder {
    int nM, nN, nwg, G, c;
    __host__ __device__ void init(int M, int N, int G_, int c_) { nM = M / BM; nN = N / BM; nwg = nM * nN; G = G_; c = c_; }
    __host__ __device__ bool next(int i, Unit& u) const {
        const long L = (long)i * G + c; if (L >= nwg) return false;
        int wgid = (int)L; { const int q = nwg / NXCD, r = nwg % NXCD, xcd = wgid % NXCD, off = wgid / NXCD; wgid = (xcd < r ? xcd * (q + 1) : r * (q + 1) + (xcd - r) * q) + off; }
        const int nig = WGM * nN, gid = wgid / nig, fm = gid * WGM, gsz = (nM - fm) < WGM ? (nM - fm) : WGM;
        u.pm = fm + ((wgid % nig) % gsz); u.pn = (wgid % nig) / gsz; return true;
    }
    __device__ __forceinline__ void a_ready(const Unit&) const {}
    __device__ __forceinline__ void done(const Unit&) const {}
};

__device__ __forceinline__ unsigned cvt_pk_bf16(float lo, float hi) { unsigned r; asm volatile("v_cvt_pk_bf16_f32 %0, %1, %2" : "=v"(r) : "v"(lo), "v"(hi)); return r; }
typedef float f32x2 __attribute__((ext_vector_type(2)));
template <class Epi, class Sched, bool ALIGN_EPI = false, bool SP2 = false, bool I8 = false>
__device__ __forceinline__ void gemm_phase(PG8_LAS unsigned char* lds, const Gemm g, const Sched& S, const Epi& E, const int wid) {
    int lane; asm volatile("v_mbcnt_lo_u32_b32 %0, -1, 0\n\tv_mbcnt_hi_u32_b32 %0, -1, %0" : "=v"(lane)); const int tid = wid * 64 + lane, wr = wid >> 2, wc = wid & 3, fr = lane & 15, fq = lane >> 4;
    const int K = g.K, nt = K / BK;
    unsigned voffA[2], voffB[2];
#pragma unroll
    for (int i = 0; i < 2; ++i) { int R, C; stage_rc(tid * 16 + i * 8192, R, C); const int Rb = Epi::PERM ? ((R & ~31) + perm32(R & 31)) : R;
        voffA[i] = (unsigned)(R * K + C) * 2u; voffB[i] = (unsigned)(Rb * K + C) * 2u; }
    const size_t kstep = (size_t)(BK * 2);
    const size_t hstep = (size_t)HALF * K * 2;
    const size_t tstep = 2 * hstep;
    const unsigned ldsw = (unsigned)wid * 1024u;
    const int aoff = lds_byte(wr * 64 + fr, fq * 8), boff = lds_byte(wc * 32 + fr, fq * 8);
#define PG8_SA(b, h) (((b) * 2 + (h)) * HTB)
#define PG8_SB(b, h) ((4 + (b) * 2 + (h)) * HTB)
#define PG8_STAGE(bufoff, gbase, voff) do { _Pragma("unroll") for (int _i = 0; _i < 2; ++_i) \
        __builtin_amdgcn_global_load_lds((const unsigned*)((const char*)(gbase) + (voff)[_i]), (PG8_LAS unsigned*)(lds + (bufoff) + ldsw + _i * 8192), 16, 0, 0); } while (0)
#define PG8_LDA(dst, b, h) do { _Pragma("unroll") for (int m = 0; m < 4; ++m) _Pragma("unroll") for (int k = 0; k < 2; ++k) dst[m][k] = *(const PG8_LAS bf16x8*)(lds + PG8_SA(b, h) + aoff + m * 2048 + k * 1024); } while (0)
#define PG8_LDB(dst, b, h) do { _Pragma("unroll") for (int n = 0; n < 2; ++n) _Pragma("unroll") for (int k = 0; k < 2; ++k) dst[n][k] = *(const PG8_LAS bf16x8*)(lds + PG8_SB(b, h) + boff + n * 2048 + k * 1024); } while (0)
#define PG8_MMA(ai, bj, At, Bt) do { __builtin_amdgcn_s_setprio(1); _Pragma("unroll") for (int m = 0; m < 4; ++m) _Pragma("unroll") for (int n = 0; n < 2; ++n) _Pragma("unroll") for (int k = 0; k < 2; ++k) \
        { if constexpr (I8) { typedef int v4i_ __attribute__((ext_vector_type(4))); acc[ai][bj][m][n] = __builtin_bit_cast(f32x4, __builtin_amdgcn_mfma_i32_16x16x64_i8(__builtin_bit_cast(v4i_, Bt[n][k]), __builtin_bit_cast(v4i_, At[m][k]), __builtin_bit_cast(v4i_, acc[ai][bj][m][n]), 0, 0, 0)); } \
          else acc[ai][bj][m][n] = __builtin_amdgcn_mfma_f32_16x16x32_bf16(Bt[n][k], At[m][k], acc[ai][bj][m][n], 0, 0, 0); } __builtin_amdgcn_s_setprio(0); } while (0)
#define PG8_WAIT_V(n) asm volatile("s_waitcnt vmcnt(" #n ")" ::: "memory")
#define PG8_WAIT_L(n) asm volatile("s_waitcnt lgkmcnt(" #n ")" ::: "memory")
#define PG8_BAR __builtin_amdgcn_s_barrier()
#define PG8_SCHED __builtin_amdgcn_sched_barrier(0)
    Unit cur, nxt; int ui = 0;
    if (!S.next(0, cur)) return;
    f32x4 acc[2][2][4][2];
#pragma unroll
    for (int a = 0; a < 2; ++a)
#pragma unroll
        for (int b = 0; b < 2; ++b)
#pragma unroll
            for (int m = 0; m < 4; ++m)
#pragma unroll
                for (int n = 0; n < 2; ++n) acc[a][b][m][n] = (f32x4){0.f, 0.f, 0.f, 0.f};
    bf16x8 At[4][2], B0[2][2], B1[2][2];
    const char* cA = (const char*)g.A + (size_t)cur.pm * tstep; const char* cB = (const char*)g.Bt + (size_t)cur.pn * tstep;
    S.a_ready(cur);
    if constexpr (SP2) {
        PG8_STAGE(PG8_SB(0, 0), cB, voffB); PG8_STAGE(PG8_SB(0, 1), cB + hstep, voffB); PG8_STAGE(PG8_SA(0, 0), cA, voffA); PG8_STAGE(PG8_SA(0, 1), cA + hstep, voffA);
        if (wr == 1) PG8_BAR;
        PG8_WAIT_V(2); PG8_BAR;
        PG8_STAGE(PG8_SB(1, 0), cB + kstep, voffB); PG8_STAGE(PG8_SA(1, 0), cA + kstep, voffA); PG8_STAGE(PG8_SB(1, 1), cB + hstep + kstep, voffB);
        PG8_WAIT_V(6); PG8_BAR;
    } else {
        PG8_STAGE(PG8_SB(0, 0), cB, voffB); PG8_STAGE(PG8_SA(0, 0), cA, voffA); PG8_STAGE(PG8_SB(0, 1), cB + hstep, voffB); PG8_STAGE(PG8_SA(0, 1), cA + hstep, voffA);
        if (wr == 1) PG8_BAR;
        PG8_WAIT_V(4); PG8_BAR;
        PG8_STAGE(PG8_SB(1, 0), cB + kstep, voffB); PG8_STAGE(PG8_SA(1, 0), cA + kstep, voffA); PG8_STAGE(PG8_SB(1, 1), cB + hstep + kstep, voffB);
        PG8_WAIT_V(6); PG8_BAR;
    }
    for (;;) {
        const bool has_next = S.next(ui + 1, nxt);
        const char* nA = has_next ? (const char*)g.A + (size_t)nxt.pm * tstep : cA; const char* nB = has_next ? (const char*)g.Bt + (size_t)nxt.pn * tstep : cB;
        for (int t = 0; t < nt; t += 2) {
            const bool last = (t == nt - 2);
            const char* a1 = cA + (size_t)(t + 1) * kstep;
            const char* a2 = last ? nA : cA + (size_t)(t + 2) * kstep; const char* b2 = last ? nB : cB + (size_t)(t + 2) * kstep;
            const char* a3 = a2 + kstep; const char* b3 = b2 + kstep;
            if (last && has_next) S.a_ready(nxt);
            if constexpr (SP2) {
            PG8_LDB(B0, 0, 0); PG8_LDB(B1, 0, 1); PG8_SCHED; PG8_LDA(At, 0, 0); PG8_STAGE(PG8_SA(1, 1), a1 + hstep, voffA);
            PG8_WAIT_V(8); PG8_WAIT_L(0); PG8_BAR; PG8_MMA(0, 0, At, B0); PG8_MMA(0, 1, At, B1); PG8_BAR; PG8_SCHED;
            PG8_LDA(At, 0, 1); PG8_STAGE(PG8_SB(0, 0), b2, voffB); PG8_STAGE(PG8_SB(0, 1), b2 + hstep, voffB); PG8_STAGE(PG8_SA(0, 0), a2, voffA);
            PG8_WAIT_V(8); PG8_WAIT_L(0); PG8_BAR; PG8_MMA(1, 0, At, B0); PG8_MMA(1, 1, At, B1); PG8_BAR; PG8_SCHED;
            PG8_LDB(B0, 1, 0); PG8_LDB(B1, 1, 1); PG8_SCHED; PG8_LDA(At, 1, 0); PG8_STAGE(PG8_SA(0, 1), a2 + hstep, voffA);
            PG8_WAIT_V(8); PG8_WAIT_L(0); PG8_BAR; PG8_MMA(0, 0, At, B0); PG8_MMA(0, 1, At, B1); PG8_BAR; PG8_SCHED;
            PG8_LDA(At, 1, 1); PG8_STAGE(PG8_SB(1, 0), b3, voffB); PG8_STAGE(PG8_SB(1, 1), b3 + hstep, voffB); PG8_STAGE(PG8_SA(1, 0), a3, voffA);
            PG8_WAIT_V(8); PG8_WAIT_L(0); PG8_BAR; PG8_MMA(1, 0, At, B0); PG8_MMA(1, 1, At, B1); PG8_BAR; PG8_SCHED;
            } else {
            PG8_LDB(B0, 0, 0); PG8_SCHED; PG8_LDA(At, 0, 0); PG8_STAGE(PG8_SA(1, 1), a1 + hstep, voffA);
            PG8_WAIT_L(8); PG8_BAR; PG8_WAIT_L(0); PG8_MMA(0, 0, At, B0); PG8_BAR; PG8_SCHED;
            PG8_LDB(B1, 0, 1); PG8_STAGE(PG8_SB(0, 0), b2, voffB);
            PG8_BAR; PG8_WAIT_L(0); PG8_MMA(0, 1, At, B1); PG8_BAR;
            PG8_LDA(At, 0, 1); PG8_STAGE(PG8_SA(0, 0), a2, voffA);
            PG8_BAR; PG8_WAIT_L(0); PG8_MMA(1, 0, At, B0); PG8_BAR; PG8_SCHED;
            PG8_STAGE(PG8_SB(0, 1), b2 + hstep, voffB);
            PG8_WAIT_V(6); PG8_BAR; PG8_MMA(1, 1, At, B1); PG8_BAR;
            PG8_LDB(B0, 1, 0); PG8_SCHED; PG8_LDA(At, 1, 0); PG8_STAGE(PG8_SA(0, 1), a2 + hstep, voffA);
            PG8_WAIT_L(8); PG8_BAR; PG8_WAIT_L(0); PG8_MMA(0, 0, At, B0); PG8_BAR; PG8_SCHED;
            PG8_LDB(B1, 1, 1); PG8_STAGE(PG8_SB(1, 0), b3, voffB);
            PG8_BAR; PG8_WAIT_L(0); PG8_MMA(0, 1, At, B1); PG8_BAR;
            PG8_LDA(At, 1, 1); PG8_STAGE(PG8_SA(1, 0), a3, voffA);
            PG8_BAR; PG8_WAIT_L(0); PG8_MMA(1, 0, At, B0); PG8_BAR; PG8_SCHED;
            PG8_STAGE(PG8_SB(1, 1), b3 + hstep, voffB);
            PG8_WAIT_V(6); PG8_BAR; PG8_MMA(1, 1, At, B1); PG8_BAR;
            }
        }
        if constexpr (ALIGN_EPI) { if (wr == 0) PG8_BAR; }
        if constexpr (!Epi::AFTER_DRAIN) { E(acc, cur, wr, wc, fr, fq); S.done(cur); }
        if (!has_next) break;
#pragma unroll
        for (int a = 0; a < 2; ++a)
#pragma unroll
            for (int b = 0; b < 2; ++b)
#pragma unroll
                for (int m = 0; m < 4; ++m)
#pragma unroll
                    for (int n = 0; n < 2; ++n) acc[a][b][m][n] = (f32x4){0.f, 0.f, 0.f, 0.f};
        cur = nxt; cA = nA; cB = nB; ++ui;
        if constexpr (ALIGN_EPI) { if (wr == 1) PG8_BAR; }
    }
    PG8_WAIT_V(0);
    if constexpr (!ALIGN_EPI) { if (wr == 0) PG8_BAR; }
    PG8_BAR;
    if constexpr (Epi::AFTER_DRAIN) { E.fused(acc, cur, wr, wc, fr, fq, lds, wid, lane); S.done(cur); }
#undef PG8_SA
#undef PG8_SB
#undef PG8_STAGE
#undef PG8_LDA
#undef PG8_LDB
#undef PG8_MMA
#undef PG8_WAIT_V
#undef PG8_WAIT_L
#undef PG8_BAR
#undef PG8_SCHED
}
}

#ifndef MK_N_LAUNCHES
#define MK_N_LAUNCHES 1
#endif
constexpr int NPHASE = 9;

constexpr int D = 2048, NB = 8, SEQ = 2048, M = NB * SEQ, CTXL = 256, MC = NB * CTXL;
constexpr int NH = 8, HD = 128, DA = 1024, NPROJ = 6144, GW = 64;
constexpr int NEXP = 16384, PH = 8, PK = 16, NKEYS = 128;
constexpr float EPS = 1e-6f, LOG2E = 1.4426950408889634f;
constexpr int NWAVES = 8;
constexpr float A2_SCALE = 10.0f / 127.0f, A2_INV = 127.0f / 10.0f;

constexpr size_t MiB = 1u << 20;
constexpr size_t WS_CTL = 0, WS_MOD = 1 * MiB, WS_SK = 2 * MiB, WS_WIN = 4 * MiB, WS_WOUT = 28 * MiB, WS_WPQ = 36 * MiB;
constexpr size_t WS_UT = 44 * MiB, WS_VT = 108 * MiB, WS_ACT = 172 * MiB, WS_HC = 236 * MiB;
constexpr size_t WS_Q = 244 * MiB, WS_K = 276 * MiB, WS_VTR = 308 * MiB, WS_BG = 340 * MiB, WS_CG = 372 * MiB, WS_U = 404 * MiB;
constexpr size_t WS_KC = 436 * MiB, WS_VCT = 440 * MiB, WS_QP = 244 * MiB  ;
constexpr size_t WS_SELI = 444 * MiB, WS_SELG = 452 * MiB, WS_AVW = 460 * MiB, WS_END = 468 * MiB;
constexpr size_t WS_U8 = WS_UT, WS_V8 = WS_UT + 32 * MiB, WS_SU = WS_VT, WS_SV = WS_VT + 64 * 1024, WS_H2S = WS_VT + 128 * 1024, WS_H2Q = WS_VT + 1 * MiB;

constexpr int LDS_BYTES = 147456;
constexpr int XCH_OFF = 131072;
constexpr int MISC_OFF = 131072 + 8192;
#ifndef MK_CG_SYNC
#define MK_CG_SYNC 1
#endif

#define GAS __attribute__((address_space(1)))
#define LAS __attribute__((address_space(3)))
typedef unsigned short bf16;
typedef unsigned v4u __attribute__((ext_vector_type(4)));
typedef unsigned v2u __attribute__((ext_vector_type(2)));
typedef float f32x4 __attribute__((ext_vector_type(4)));
typedef float f32x16 __attribute__((ext_vector_type(16)));
typedef short bf16x8 __attribute__((ext_vector_type(8)));
typedef __bf16 bf16x2 __attribute__((ext_vector_type(2)));
#define LDS_WAIT() asm volatile("s_waitcnt lgkmcnt(0)" ::: "memory")

__device__ __forceinline__ unsigned f2bf(float f) { unsigned u = __builtin_bit_cast(unsigned, f); return (u + 0x7fffu + ((u >> 16) & 1u)) >> 16; }
__device__ __forceinline__ unsigned pk2(float lo, float hi) { return pg8::cvt_pk_bf16(lo, hi); }
__device__ __forceinline__ float bflo(unsigned w) { return __builtin_bit_cast(float, w << 16); }
__device__ __forceinline__ float bfhi(unsigned w) { return __builtin_bit_cast(float, w & 0xffff0000u); }
__device__ __forceinline__ float dot2_bf16(unsigned w, unsigned x, float acc) { return __builtin_amdgcn_fdot2_f32_bf16(__builtin_bit_cast(bf16x2, w), __builtin_bit_cast(bf16x2, x), acc, false); }
__device__ __forceinline__ float wave_sum(float v) {
#pragma unroll
    for (int o = 1; o < 64; o <<= 1) v += __shfl_xor(v, o);
    return v;
}

struct Args { const float* in[20]; float* out; unsigned char* ws; int ph_lo, ph_hi; };
struct Frame {
    LAS unsigned char* lds;
    int wave, vcu, G;
};
__device__ __forceinline__ int lane_id() { int l; asm volatile("v_mbcnt_lo_u32_b32 %0, -1, 0\n\tv_mbcnt_hi_u32_b32 %0, -1, %0" : "=v"(l)); return l; }
#define F_LANE lane_id()
#define F_TID (F.wave * 64 + lane_id())
#define AP_x (A.in[0])
#define AP_c (A.in[1])
#define AP_ctx (A.in[2])
#define AP_c_ctx (A.in[3])
#define AP_w_ada (A.in[4])
#define AP_b_ada (A.in[5])
#define AP_g1 (A.in[6])
#define AP_w_in (A.in[7])
#define AP_qn (A.in[8])
#define AP_kn (A.in[9])
#define AP_rpb (A.in[10])
#define AP_w_conv (A.in[11])
#define AP_gao (A.in[12])
#define AP_gco (A.in[13])
#define AP_w_out (A.in[14])
#define AP_g2 (A.in[15])
#define AP_w_pq (A.in[16])
#define AP_subk (A.in[17])
#define AP_uex (A.in[18])
#define AP_vex (A.in[19])
#define AP_SK ((bf16*)(A.ws + WS_SK))
#define AP_WIN ((bf16*)(A.ws + WS_WIN))
#define AP_WOUT ((bf16*)(A.ws + WS_WOUT))
#define AP_WPQ ((bf16*)(A.ws + WS_WPQ))
#define AP_UT ((bf16*)(A.ws + WS_UT))
#define AP_VT ((bf16*)(A.ws + WS_VT))
#define AP_ACT ((bf16*)(A.ws + WS_ACT))
#define AP_HC ((bf16*)(A.ws + WS_HC))
#define AP_Q ((bf16*)(A.ws + WS_Q))
#define AP_K ((bf16*)(A.ws + WS_K))
#define AP_VTR ((bf16*)(A.ws + WS_VTR))
#define AP_BG ((bf16*)(A.ws + WS_BG))
#define AP_CG ((bf16*)(A.ws + WS_CG))
#define AP_U ((bf16*)(A.ws + WS_U))
#define AP_KC ((bf16*)(A.ws + WS_KC))
#define AP_VCT ((bf16*)(A.ws + WS_VCT))
#define AP_QP ((bf16*)(A.ws + WS_QP))
#define AP_MOD ((float*)(A.ws + WS_MOD))
#define AP_SELI ((int*)(A.ws + WS_SELI))
#define AP_SELG ((float*)(A.ws + WS_SELG))
#define AP_AVW ((float*)(A.ws + WS_AVW))
#define AP_WIN8 ((unsigned char*)(A.ws + WS_WIN))
#define AP_WINS ((float*)(A.ws + WS_WIN + 16 * MiB))
#define AP_WOUT8 ((unsigned char*)(A.ws + WS_WOUT))
#define AP_WOUTS ((float*)(A.ws + WS_WOUT + 5 * MiB))
#define AP_CPARTO ((float*)(A.ws + WS_WOUT + 6 * MiB))
#define AP_A28 ((unsigned char*)(A.ws + WS_ACT))
#define AP_WPQ8 ((unsigned char*)(A.ws + WS_WPQ))
#define AP_WPQS ((float*)(A.ws + WS_WPQ + 5 * MiB))
#define AP_CPARTQ ((float*)(A.ws + WS_WPQ + 6 * MiB))
#define AP_CPART ((float*)(A.ws + WS_WIN + 17 * MiB))
#define AP_H8 ((unsigned char*)(A.ws + WS_ACT))
#define AP_HC8 ((unsigned char*)(A.ws + WS_HC))
#define AP_HS ((float*)(A.ws + WS_HC + 4 * MiB))
#define AP_HCS ((float*)(A.ws + WS_HC + 4 * MiB + 65536))
#define AP_X1B ((bf16*)(A.ws + WS_BG))
#define AP_out (A.out)
#define AP_U8 ((const unsigned char*)(A.ws + WS_U8))
#define AP_V8 ((const unsigned char*)(A.ws + WS_V8))
#define AP_SU ((float*)(A.ws + WS_SU))
#define AP_SV ((float*)(A.ws + WS_SV))
#define AP_H2S ((float*)(A.ws + WS_H2S))
#define AP_H2Q ((unsigned char*)(A.ws + WS_H2Q))


#define XB_TMO      128
#define XB_XCNT(j)  (256  + 64 * (j))
#define XB_XSUB(j)  (1280 + 64 * (j))
#define XB_XGEN(j)  (2304 + 64 * (j))
#define XB_TOP      3328
#define XB_TOPGEN   3392
#define XCD_BAR_WORDS 3456
#define XB_SPIN_CAP (1u << 22)
__device__ __forceinline__ unsigned xb_ld(unsigned* p)              { return __hip_atomic_load(p, __ATOMIC_RELAXED, __HIP_MEMORY_SCOPE_AGENT); }
__device__ __forceinline__ unsigned xb_add(unsigned* p, unsigned v) { return __hip_atomic_fetch_add(p, v, __ATOMIC_RELAXED, __HIP_MEMORY_SCOPE_AGENT); }
__device__ __forceinline__ unsigned xb_xcc_id() { return (unsigned)__builtin_amdgcn_s_getreg((3 << 11) | 20) & 0xFu; }
#define XB_SPIN(cond, bar) do { unsigned _sp = 0; while (cond) { __builtin_amdgcn_s_sleep(1); \
    if ((++_sp & 255u) == 0u) { if (xb_ld(&(bar)[XB_TMO])) break; if (_sp > XB_SPIN_CAP) { atomicAdd(&(bar)[XB_TMO], 1u); break; } } } } while (0)
struct XcdBarrier { unsigned* bar; unsigned x; volatile LAS unsigned* st; };
__device__ __forceinline__ void xcd_barrier_complete(unsigned* bar, unsigned x, unsigned G, unsigned& nloc, unsigned& nx) {
    unsigned sum, cnt, mine, sp = 0u;
    for (;;) {
        sum = 0u; cnt = 0u; mine = 0u;
#pragma unroll
        for (unsigned j = 0; j < 16; ++j) { const unsigned c = xb_ld(&bar[XB_XCNT(j)]); sum += c; cnt += (c > 0u) ? 1u : 0u; mine = (j == x) ? c : mine; }
        if (sum == G) break;
        __builtin_amdgcn_s_sleep(1);
        if ((++sp & 255u) == 0u) { if (xb_ld(&bar[XB_TMO])) break; if (sp > XB_SPIN_CAP) { atomicAdd(&bar[XB_TMO], 1u); break; } }
    }
    nloc = mine > 0u ? mine : 1u; nx = cnt > 0u ? cnt : 1u;
}
__device__ __forceinline__ void xcd_barrier(const XcdBarrier& b, const int wave, const unsigned G) {
    asm volatile("s_waitcnt vmcnt(0)" ::: "memory");
    __syncthreads();
    if (wave == 0 && lane_id() == 0) {
        unsigned* bar = b.bar;
        __builtin_amdgcn_s_waitcnt(0);
        unsigned nloc = b.st[0], nx = b.st[1];
        if (nloc == 0u) { xcd_barrier_complete(bar, b.x, G, nloc, nx); b.st[0] = nloc; b.st[1] = nx; }
        const unsigned old = xb_add(&bar[XB_XSUB(b.x)], 1u);
        const unsigned gen = old / nloc;
        if (old + 1u == (gen + 1u) * nloc) {
            __builtin_amdgcn_fence(__ATOMIC_RELEASE, "agent");
            asm volatile("s_waitcnt vmcnt(0)" ::: "memory");
            const unsigned og = xb_add(&bar[XB_TOP], 1u);
            const unsigned tg = og / nx;
            if (og + 1u == (tg + 1u) * nx) xb_add(&bar[XB_TOPGEN], 1u);
            else XB_SPIN(xb_ld(&bar[XB_TOPGEN]) == tg, bar);
            __builtin_amdgcn_fence(__ATOMIC_ACQUIRE, "agent");
            xb_add(&bar[XB_XGEN(b.x)], 1u);
            asm volatile("s_waitcnt vmcnt(0)" ::: "memory");
        } else {
            XB_SPIN(xb_ld(&bar[XB_XGEN(b.x)]) == gen, bar);
            __builtin_amdgcn_fence(__ATOMIC_ACQUIRE, "agent");
            asm volatile("s_waitcnt vmcnt(0)" ::: "memory");
        }
    }
    __syncthreads();
}

__device__ __forceinline__ void p0_mod(const Frame& F, const Args& A) {
    const int lane = lane_id(), tid = F.wave * 64 + lane; (void)tid;
    LAS float* sc = (LAS float*)F.lds;
    LAS float* red = (LAS float*)(F.lds + 9 * 2048 * 4);
    for (int i = tid; i < 9 * D; i += NWAVES * 64) { const int r = i >> 11, k = i & (D - 1); const float cv = (r < 8) ? AP_c[r * D + k] : AP_c_ctx[k]; sc[i] = cv / (1.f + __expf(-cv)); }
    __syncthreads();
    const int sr = lane >> 4, cq = lane & 15;
    for (int item = F.vcu; item < (6 * D) / 64; item += F.G) {
        const int n0 = item * 64;
        float acc[9][4];
#pragma unroll
        for (int r = 0; r < 9; ++r)
#pragma unroll
            for (int j = 0; j < 4; ++j) acc[r][j] = 0.f;
        const float* wp = AP_w_ada + (size_t)(F.wave * 4 + sr) * (6 * D) + n0 + 4 * cq;
#pragma unroll 8
        for (int step = 0; step < 64; ++step) {
            const int k = step * 32 + F.wave * 4 + sr;
            const f32x4 w = *(const f32x4*)(wp + (size_t)step * 32 * (6 * D));
#pragma unroll
            for (int r = 0; r < 9; ++r) { const float s = sc[r * D + k]; acc[r][0] += s * w.x; acc[r][1] += s * w.y; acc[r][2] += s * w.z; acc[r][3] += s * w.w; }
        }
#pragma unroll
        for (int r = 0; r < 9; ++r)
#pragma unroll
            for (int j = 0; j < 4; ++j) { float v = acc[r][j]; v += __shfl_xor(v, 16); v += __shfl_xor(v, 32); if (sr == 0) red[(F.wave * 9 + r) * 64 + 4 * cq + j] = v; }
        __syncthreads();
        for (int i = tid; i < 9 * 64; i += NWAVES * 64) { const int r = i >> 6, cc = i & 63; float s = 0.f;
#pragma unroll
            for (int w = 0; w < 8; ++w) s += red[(w * 9 + r) * 64 + cc];
            AP_MOD[r * (6 * D) + n0 + cc] = s + AP_b_ada[n0 + cc]; }
        __syncthreads();
    }
    __syncthreads();
}
__device__ __forceinline__ void p0_transpose_item(const float* W, int K, int N, bf16* WT, LAS float* scr, int item, int lane) {
    const int nblk = N / 32, kb = item / nblk, nb = item % nblk, k0 = 64 * kb, n0 = 32 * nb;
#pragma unroll 8
    for (int i = 0; i < 32; ++i) { const int kk = 2 * i + (lane >> 5); scr[kk * 33 + (lane & 31)] = W[(size_t)(k0 + kk) * N + n0 + (lane & 31)]; }
    LDS_WAIT(); asm volatile("" ::: "memory");
    const int c = lane & 7;
#pragma unroll
    for (int j = 0; j < 4; ++j) { const int n = (lane >> 3) + 8 * j; const LAS float* s = scr + (8 * c) * 33 + n;
        v4u o; o.x = pk2(s[0 * 33], s[1 * 33]); o.y = pk2(s[2 * 33], s[3 * 33]); o.z = pk2(s[4 * 33], s[5 * 33]); o.w = pk2(s[6 * 33], s[7 * 33]);
        *(v4u*)(WT + (size_t)(n0 + n) * K + k0 + 8 * c) = o; }
    LDS_WAIT(); asm volatile("" ::: "memory");
}
__device__ __forceinline__ void cvt_f32_bf16(const float* src, bf16* dst, size_t n, size_t gtid, size_t gthreads) {
    for (size_t i = gtid * 8; i < n; i += gthreads * 8) { const f32x4 a = *(const f32x4*)(src + i), b = *(const f32x4*)(src + i + 4);
        v4u o; o.x = pk2(a.x, a.y); o.y = pk2(a.z, a.w); o.z = pk2(b.x, b.y); o.w = pk2(b.z, b.w); *(v4u*)(dst + i) = o; }
}
__device__ __forceinline__ float wave_max(float v) {
#pragma unroll
    for (int o = 1; o < 64; o <<= 1) v = fmaxf(v, __shfl_xor(v, o));
    return v;
}
__device__ __forceinline__ unsigned q4(const f32x4 v, const float inv, const int off = 0) {
    const int a = (int)fminf(fmaxf(__builtin_rintf(v.x * inv), -127.f), 127.f) + off, b = (int)fminf(fmaxf(__builtin_rintf(v.y * inv), -127.f), 127.f) + off, c = (int)fminf(fmaxf(__builtin_rintf(v.z * inv), -127.f), 127.f) + off, d = (int)fminf(fmaxf(__builtin_rintf(v.w * inv), -127.f), 127.f) + off;
    return (unsigned)(a & 255) | ((unsigned)(b & 255) << 8) | ((unsigned)(c & 255) << 16) | ((unsigned)(d & 255) << 24);
}
__device__ __forceinline__ void quant_row(const float* src, unsigned char* dst, float* scale, int lane, const int off) {
    const f32x4* xr = (const f32x4*)src + lane; f32x4 v[8]; float mx = 0.f;
#pragma unroll
    for (int j = 0; j < 8; ++j) { v[j] = xr[64 * j]; mx = fmaxf(mx, fmaxf(fmaxf(fabsf(v[j].x), fabsf(v[j].y)), fmaxf(fabsf(v[j].z), fabsf(v[j].w)))); }
    mx = fmaxf(wave_max(mx), 1e-30f);
    const float inv = 127.f / mx;
    unsigned* o = (unsigned*)dst + lane;
#pragma unroll
    for (int j = 0; j < 8; ++j) o[64 * j] = q4(v[j], inv, off);
    if (lane == 0) *scale = mx * (1.f / 127.f);
}
struct TrItem { const float* W; const float* cpart; unsigned char* WT; float* wscale; int N, li; };
struct TrRegs { f32x4 wv[8]; float cp[16]; };
__device__ __forceinline__ TrItem tr_item(const Args& A, int it) {
    TrItem t;
    if (it < 6144) { t.W = AP_w_in; t.cpart = AP_CPART; t.WT = AP_WIN8; t.wscale = AP_WINS; t.N = NPROJ; t.li = it; }
    else if (it < 8192) { t.W = AP_w_out; t.cpart = AP_CPARTO; t.WT = AP_WOUT8; t.wscale = AP_WOUTS; t.N = D; t.li = it - 6144; }
    else { t.W = AP_w_pq; t.cpart = AP_CPARTQ; t.WT = AP_WPQ8; t.wscale = AP_WPQS; t.N = D; t.li = it - 8192; }
    return t;
}
__device__ __forceinline__ void tr_load(const TrItem& t, TrRegs& R, int lane) {
    const int nblk = t.N / 32, kb = t.li / nblk, nb = t.li % nblk, k0 = 64 * kb, n0 = 32 * nb;
#pragma unroll
    for (int p = 0; p < 16; ++p) R.cp[p] = t.cpart[(size_t)(16 * (lane >> 5) + p) * t.N + n0 + (lane & 31)];
#pragma unroll
    for (int i = 0; i < 8; ++i) R.wv[i] = *(const f32x4*)(t.W + (size_t)(k0 + 8 * i + (lane >> 3)) * t.N + n0 + 4 * (lane & 7));
}
__device__ __forceinline__ void tr_process(const TrItem& t, const TrRegs& R, LAS float* scr, int lane) {
    constexpr int K = D;
    const int nblk = t.N / 32, kb = t.li / nblk, nb = t.li % nblk, k0 = 64 * kb, n0 = 32 * nb;
    { float cm = 0.f;
#pragma unroll
      for (int p = 0; p < 16; ++p) cm = fmaxf(cm, R.cp[p]);
      cm = fmaxf(cm, __shfl_xor(cm, 32));
      scr[64 * 33 + (lane & 31)] = cm; }
#pragma unroll
    for (int i = 0; i < 8; ++i) { LAS float* d = scr + (8 * i + (lane >> 3)) * 33 + 4 * (lane & 7); d[0] = R.wv[i].x; d[1] = R.wv[i].y; d[2] = R.wv[i].z; d[3] = R.wv[i].w; }
    LDS_WAIT(); asm volatile("" ::: "memory");
    const int c = lane & 7;
#pragma unroll
    for (int j = 0; j < 4; ++j) { const int n = (lane >> 3) + 8 * j; const LAS float* sp = scr + (8 * c) * 33 + n;
        const float mx = fmaxf(scr[64 * 33 + n], 1e-30f), inv = 127.f / mx;
        f32x4 a = {sp[0 * 33], sp[1 * 33], sp[2 * 33], sp[3 * 33]}, b = {sp[4 * 33], sp[5 * 33], sp[6 * 33], sp[7 * 33]};
        v2u o; o.x = q4(a, inv); o.y = q4(b, inv);
        *(v2u*)(t.WT + (size_t)(n0 + n) * K + k0 + 8 * c) = o;
        if (kb == 0 && c == 0) t.wscale[n0 + n] = mx * (1.f / 127.f); }
    LDS_WAIT(); asm volatile("" ::: "memory");
}
__device__ __forceinline__ void p0_prologue(const Frame& F, const Args& A) {
    const int lane = lane_id(), tid = F.wave * 64 + lane; (void)tid;
    LAS float* scr = (LAS float*)(F.lds + F.wave * 16384);
    const int gw = F.vcu * NWAVES + F.wave, NGW = F.G * NWAVES;
    constexpr int I_SQ = (D / 64) * (D / 32);
    (void)I_SQ; (void)scr;
    const size_t gtid = (size_t)F.vcu * (NWAVES * 64) + tid, gth = (size_t)F.G * NWAVES * 64;
    cvt_f32_bf16(AP_subk, AP_SK, (size_t)PH * 2 * NKEYS * 128, gtid, gth);
    for (int e = gw; e < NEXP; e += NGW) {
        const f32x4* ur = (const f32x4*)(AP_uex + (size_t)e * D) + lane; const f32x4* vr = (const f32x4*)(AP_vex + (size_t)e * D) + lane;
        f32x4 uv[8], vv[8]; float mu = 0.f, mv = 0.f;
#pragma unroll
        for (int j = 0; j < 8; ++j) { uv[j] = ur[64 * j]; vv[j] = vr[64 * j]; }
#pragma unroll
        for (int j = 0; j < 8; ++j) { mu = fmaxf(mu, fmaxf(fmaxf(fabsf(uv[j].x), fabsf(uv[j].y)), fmaxf(fabsf(uv[j].z), fabsf(uv[j].w)))); mv = fmaxf(mv, fmaxf(fmaxf(fabsf(vv[j].x), fabsf(vv[j].y)), fmaxf(fabsf(vv[j].z), fabsf(vv[j].w)))); }
        mu = fmaxf(wave_max(mu), 1e-30f); mv = fmaxf(wave_max(mv), 1e-30f);
        const float iu = 127.f / mu, iv = 127.f / mv;
        unsigned* ou = (unsigned*)(A.ws + WS_U8 + (size_t)e * D) + lane; unsigned* ov = (unsigned*)(A.ws + WS_V8 + (size_t)e * D) + lane;
#pragma unroll
        for (int j = 0; j < 8; ++j) { ou[64 * j] = q4(uv[j], iu); ov[64 * j] = q4(vv[j], iv); }
        if (lane == 0) { AP_SU[e] = mu * (1.f / 127.f); AP_SV[e] = mv * (1.f / 127.f); }
    }
    p0_mod(F, A);
    for (int it = gw; it < 5120; it += NGW) {
        const float* W; float* CP; int N, li;
        if (it < 3072) { W = AP_w_in; CP = AP_CPART; N = NPROJ; li = it; } else if (it < 4096) { W = AP_w_out; CP = AP_CPARTO; N = D; li = it - 3072; } else { W = AP_w_pq; CP = AP_CPARTQ; N = D; li = it - 4096; }
        const int ncb = N / 64, cb = li % ncb, kb = li / ncb, sr = lane >> 4, cq = lane & 15;
        const f32x4* wp = (const f32x4*)(W + (size_t)(kb * 64 + sr) * N + cb * 64) + cq; f32x4 mx = {0.f, 0.f, 0.f, 0.f};
#pragma unroll
        for (int k = 0; k < 16; ++k) { const f32x4 w = wp[(size_t)k * N]; mx.x = fmaxf(mx.x, fabsf(w.x)); mx.y = fmaxf(mx.y, fabsf(w.y)); mx.z = fmaxf(mx.z, fabsf(w.z)); mx.w = fmaxf(mx.w, fabsf(w.w)); }
        mx.x = fmaxf(mx.x, __shfl_xor(mx.x, 16)); mx.y = fmaxf(mx.y, __shfl_xor(mx.y, 16)); mx.z = fmaxf(mx.z, __shfl_xor(mx.z, 16)); mx.w = fmaxf(mx.w, __shfl_xor(mx.w, 16));
        mx.x = fmaxf(mx.x, __shfl_xor(mx.x, 32)); mx.y = fmaxf(mx.y, __shfl_xor(mx.y, 32)); mx.z = fmaxf(mx.z, __shfl_xor(mx.z, 32)); mx.w = fmaxf(mx.w, __shfl_xor(mx.w, 32));
        if (sr == 0) *((f32x4*)(CP + (size_t)kb * N + cb * 64) + cq) = mx;
    }
}

__device__ __forceinline__ void norm_rows(const float* X, size_t row0, int nrows, const float* g, const float* sh, const float* sc, bf16* out, int lane, unsigned char* q8 = nullptr, float* qs = nullptr) {
    f32x4 gs[8], shv[8];
#pragma unroll
    for (int j = 0; j < 8; ++j) { const int cI = j * 64 + lane; const f32x4 gg = ((const f32x4*)g)[cI], s1 = ((const f32x4*)sc)[cI]; gs[j] = gg * (1.f + s1); shv[j] = ((const f32x4*)sh)[cI]; }
    f32x4 vn[8];
    { const f32x4* xr = (const f32x4*)(X + row0 * D) + lane;
#pragma unroll
      for (int j = 0; j < 8; ++j) vn[j] = xr[64 * j]; }
    for (int r = 0; r < nrows; ++r) {
        f32x4 v[8]; float ss = 0.f;
#pragma unroll
        for (int j = 0; j < 8; ++j) { v[j] = vn[j]; ss += (v[j].x * v[j].x + v[j].y * v[j].y) + (v[j].z * v[j].z + v[j].w * v[j].w); }
        { const f32x4* xr = (const f32x4*)(X + (row0 + ((r + 1 < nrows) ? r + 1 : r)) * D) + lane;
#pragma unroll
          for (int j = 0; j < 8; ++j) vn[j] = xr[64 * j]; }
        const float rstd = __builtin_amdgcn_rsqf(wave_sum(ss) * (1.f / D) + EPS);
        v2u* o8 = (v2u*)(out + (row0 + r) * D) + lane; float mx = 0.f;
#pragma unroll
        for (int j = 0; j < 8; ++j) { const f32x4 y = v[j] * rstd * gs[j] + shv[j]; v[j] = y; if (out) { v2u w; w.x = pk2(y.x, y.y); w.y = pk2(y.z, y.w); o8[64 * j] = w; }
            mx = fmaxf(mx, fmaxf(fmaxf(fabsf(y.x), fabsf(y.y)), fmaxf(fabsf(y.z), fabsf(y.w)))); }
        if (q8) { mx = fmaxf(wave_max(mx), 1e-30f); const float inv = 127.f / mx; unsigned* oq = (unsigned*)(q8 + (row0 + r) * D) + lane;
#pragma unroll
            for (int j = 0; j < 8; ++j) oq[64 * j] = q4(v[j], inv);
            if (lane == 0) qs[row0 + r] = mx * (1.f / 127.f); }
    }
}
__device__ __forceinline__ void norm_rows_b(const bf16* X, size_t row0, int nrows, const float* g, const float* sh, const float* sc, bf16* out, int lane, unsigned char* q8, float* qs) {
    f32x4 gs[8], shv[8];
#pragma unroll
    for (int j = 0; j < 8; ++j) { const int cI = j * 64 + lane; const f32x4 gg = ((const f32x4*)g)[cI], s1 = ((const f32x4*)sc)[cI]; gs[j] = gg * (1.f + s1); shv[j] = ((const f32x4*)sh)[cI]; }
    for (int r = 0; r < nrows; ++r) {
        const v2u* xr = (const v2u*)(X + (row0 + r) * D) + lane;
        f32x4 v[8]; float ss = 0.f;
#pragma unroll
        for (int j = 0; j < 8; ++j) { const v2u w = xr[64 * j]; v[j].x = bflo(w.x); v[j].y = bfhi(w.x); v[j].z = bflo(w.y); v[j].w = bfhi(w.y); ss += (v[j].x * v[j].x + v[j].y * v[j].y) + (v[j].z * v[j].z + v[j].w * v[j].w); }
        const float rstd = __builtin_amdgcn_rsqf(wave_sum(ss) * (1.f / D) + EPS);
        v2u* o8 = (v2u*)(out + (row0 + r) * D) + lane; float mx = 0.f;
#pragma unroll
        for (int j = 0; j < 8; ++j) { const f32x4 y = v[j] * rstd * gs[j] + shv[j]; v[j] = y; if (out) { v2u w; w.x = pk2(y.x, y.y); w.y = pk2(y.z, y.w); o8[64 * j] = w; }
            mx = fmaxf(mx, fmaxf(fmaxf(fabsf(y.x), fabsf(y.y)), fmaxf(fabsf(y.z), fabsf(y.w)))); }
        mx = fmaxf(wave_max(mx), 1e-30f); const float inv = 127.f / mx; unsigned* oq = (unsigned*)(q8 + (row0 + r) * D) + lane;
#pragma unroll
        for (int j = 0; j < 8; ++j) oq[64 * j] = q4(v[j], inv);
        if (lane == 0) qs[row0 + r] = mx * (1.f / 127.f);
    }
}
__device__ __forceinline__ void p1_norm1(const Frame& F, const Args& A) {
    const int lane = lane_id(), tid = F.wave * 64 + lane; (void)tid;
    const int gw = F.vcu * NWAVES + F.wave, NGW = F.G * NWAVES;
    { LAS float* scr = (LAS float*)(F.lds + F.wave * 16384);
      TrRegs R0, R1; int it = gw;
      if (it < 10240) { TrItem t0 = tr_item(A, it); tr_load(t0, R0, lane);
        for (;;) {
            const int itn = it + NGW; const bool more = itn < 10240; TrItem t1 = t0;
            if (more) { t1 = tr_item(A, itn); tr_load(t1, R1, lane); }
            tr_process(t0, R0, scr, lane);
            if (!more) break;
            t0 = t1; R0 = R1; it = itn;
        } } }
    for (int it = gw; it < M / 8; it += NGW) { const size_t row0 = (size_t)it * 8; const int b = (int)(row0 >> 11);
        norm_rows(AP_x, row0, 8, AP_g1, AP_MOD + b * 6 * D + 0 * D, AP_MOD + b * 6 * D + 1 * D, nullptr, lane, AP_H8, AP_HS); }
    for (int it = gw; it < MC; it += NGW) norm_rows(AP_ctx, (size_t)it, 1, AP_g1, AP_MOD + 8 * 6 * D + 0 * D, AP_MOD + 8 * 6 * D + 1 * D, nullptr, lane, AP_HC8, AP_HCS);
}
__device__ __forceinline__ void p5_norm2(const Frame& F, const Args& A) {
    const int lane = lane_id(), tid = F.wave * 64 + lane; (void)tid;
    const int gw = F.vcu * NWAVES + F.wave, NGW = F.G * NWAVES;
    for (int it = gw; it < M / 8; it += NGW) { const size_t row0 = (size_t)it * 8; const int b = (int)(row0 >> 11);
        norm_rows_b(AP_X1B, row0, 8, AP_g2, AP_MOD + b * 6 * D + 3 * D, AP_MOD + b * 6 * D + 4 * D, nullptr, lane, AP_H2Q, AP_H2S); }
}

__device__ __forceinline__ f32x4 dq4(const f32x4 a, const f32x4 cs, const float rs) {
    typedef int v4i_ __attribute__((ext_vector_type(4))); const v4i_ iv = __builtin_bit_cast(v4i_, a);
    f32x4 r; r.x = (float)iv.x; r.y = (float)iv.y; r.z = (float)iv.z; r.w = (float)iv.w; return r * cs * rs;
}
struct EpiProj {
    static constexpr bool PERM = true, AFTER_DRAIN = false;
    bf16 *Q, *Kp, *VTp, *BG, *CG, *U; const float *qn, *kn; LAS float* xch; int region0, tshift; float qscale; const float *rs, *csb;
    __device__ __forceinline__ void operator()(const f32x4 (&acc)[2][2][4][2], const pg8::Unit& u, int wr, int wc, int fr, int fq) const {
        const int region = (u.pn >> 2) + region0, pnl = u.pn & 3;
        const int rowt = wr * 64 + fr;
        f32x4 cs_[2][2]; float rsc_[2][4];
#pragma unroll
        for (int bj = 0; bj < 2; ++bj)
#pragma unroll
            for (int n = 0; n < 2; ++n) cs_[bj][n] = *(const f32x4*)(csb + u.pn * 256 + bj * 128 + 32 * wc + 8 * fq + 4 * n);
#pragma unroll
        for (int ai = 0; ai < 2; ++ai)
#pragma unroll
            for (int m = 0; m < 4; ++m) rsc_[ai][m] = rs[u.pm * 256 + ai * 128 + rowt + m * 16];
#define DQ(ai_, bj_, m_, n_) dq4(acc[ai_][bj_][m_][n_], cs_[bj_][n_], rsc_[ai_][m_])
        if (region <= 1) {
#pragma unroll
            for (int ai = 0; ai < 2; ++ai)
#pragma unroll
                for (int m = 0; m < 4; ++m)
#pragma unroll
                    for (int bj = 0; bj < 2; ++bj) { const f32x4 a = DQ(ai, bj, m, 0), b = DQ(ai, bj, m, 1);
                        float s = (a.x * a.x + a.y * a.y) + (a.z * a.z + a.w * a.w) + (b.x * b.x + b.y * b.y) + (b.z * b.z + b.w * b.w);
                        s += __shfl_xor(s, 16); s += __shfl_xor(s, 32);
                        if (fq == 0) xch[((ai * 128 + rowt + m * 16) * 2 + bj) * 4 + wc] = s; }
            asm volatile("s_waitcnt lgkmcnt(0)" ::: "memory"); __builtin_amdgcn_s_barrier(); asm volatile("" ::: "memory");
            const float* gain = (region == 0) ? qn : kn; const float mul = (region == 0) ? qscale : 1.f; bf16* O = (region == 0) ? Q : Kp;
            const f32x4 g0 = *(const f32x4*)(gain + 32 * wc + 8 * fq), g1 = *(const f32x4*)(gain + 32 * wc + 8 * fq + 4);
#pragma unroll
            for (int ai = 0; ai < 2; ++ai)
#pragma unroll
                for (int m = 0; m < 4; ++m) { const int rt = ai * 128 + rowt + m * 16; bf16* rowp = O + (size_t)(u.pm * 256 + rt) * DA + (2 * pnl) * HD + 32 * wc + 8 * fq;
#pragma unroll
                    for (int bj = 0; bj < 2; ++bj) { const f32x4 p = *(const LAS f32x4*)(xch + (rt * 2 + bj) * 4);
                        const float rstd = __builtin_amdgcn_rsqf(((p.x + p.y) + (p.z + p.w)) * (1.f / HD) + EPS) * mul;
                        const f32x4 v0 = DQ(ai, bj, m, 0) * rstd * g0, v1 = DQ(ai, bj, m, 1) * rstd * g1;
                        v4u w; w.x = pk2(v0.x, v0.y); w.y = pk2(v0.z, v0.w); w.z = pk2(v1.x, v1.y); w.w = pk2(v1.z, v1.w);
                        *(v4u*)(rowp + bj * HD) = w; } }
        } else if (region == 2) {
            const int tmask = (1 << tshift) - 1;
#pragma unroll
            for (int ai = 0; ai < 2; ++ai)
#pragma unroll
                for (int m = 0; m < 4; ++m) { const int row = u.pm * 256 + ai * 128 + rowt + m * 16; const int b = row >> tshift, t = row & tmask;
#pragma unroll
                    for (int bj = 0; bj < 2; ++bj) { const int head = 2 * pnl + bj; bf16* base = VTp + (((size_t)(b * NH + head) * HD + 32 * wc + 8 * fq) << tshift) + t;
#pragma unroll
                        for (int n = 0; n < 2; ++n) { const f32x4 a = DQ(ai, bj, m, n); const unsigned w0 = pk2(a.x, a.y), w1 = pk2(a.z, a.w);
                            base[(size_t)(4 * n + 0) << tshift] = (bf16)(w0 & 0xffffu); base[(size_t)(4 * n + 1) << tshift] = (bf16)(w0 >> 16);
                            base[(size_t)(4 * n + 2) << tshift] = (bf16)(w1 & 0xffffu); base[(size_t)(4 * n + 3) << tshift] = (bf16)(w1 >> 16); } } }
        } else {
            bf16* O = (region == 3) ? BG : (region == 4) ? CG : U;
#pragma unroll
            for (int ai = 0; ai < 2; ++ai)
#pragma unroll
                for (int m = 0; m < 4; ++m) { bf16* rowp = O + (size_t)(u.pm * 256 + ai * 128 + rowt + m * 16) * DA + pnl * 256 + 32 * wc + 8 * fq;
#pragma unroll
                    for (int bj = 0; bj < 2; ++bj) { const f32x4 v0 = DQ(ai, bj, m, 0), v1 = DQ(ai, bj, m, 1);
                        v4u w; w.x = pk2(v0.x, v0.y); w.y = pk2(v0.z, v0.w); w.z = pk2(v1.x, v1.y); w.w = pk2(v1.z, v1.w);
                        *(v4u*)(rowp + bj * HD) = w; } }
        }
#undef DQ
    }
};
struct EpiBf16 {
    static constexpr bool PERM = true, AFTER_DRAIN = false;
    bf16* O; int ldc; const float *rs, *csb;
    __device__ __forceinline__ void operator()(const f32x4 (&acc)[2][2][4][2], const pg8::Unit& u, int wr, int wc, int fr, int fq) const {
        const int row0 = u.pm * 256 + wr * 64 + fr, col0 = u.pn * 256 + wc * 32 + 8 * fq;
#pragma unroll
        for (int ai = 0; ai < 2; ++ai)
#pragma unroll
            for (int m = 0; m < 4; ++m) { bf16* rowp = O + (size_t)(row0 + ai * 128 + m * 16) * ldc + col0;
#pragma unroll
                for (int bj = 0; bj < 2; ++bj) { const float rsv = rs[row0 + ai * 128 + m * 16]; const f32x4 v0 = dq4(acc[ai][bj][m][0], *(const f32x4*)(csb + col0 + bj * 128), rsv), v1 = dq4(acc[ai][bj][m][1], *(const f32x4*)(csb + col0 + bj * 128 + 4), rsv);
                    v4u w; w.x = pk2(v0.x, v0.y); w.y = pk2(v0.z, v0.w); w.z = pk2(v1.x, v1.y); w.w = pk2(v1.z, v1.w);
                    *(v4u*)(rowp + bj * 128) = w; } }
    }
};
struct EpiRes {
    static constexpr bool PERM = true, AFTER_DRAIN = false;
    const float* base; bf16* out; const float* mod; int gofs; const float* csb; float sa;
    __device__ __forceinline__ void operator()(const f32x4 (&acc)[2][2][4][2], const pg8::Unit& u, int wr, int wc, int fr, int fq) const {
        const int row0 = u.pm * 256 + wr * 64 + fr, col0 = u.pn * 256 + wc * 32 + 8 * fq;
        const float* gp = mod + (size_t)(u.pm >> 3) * 6 * D + gofs + col0;
        f32x4 gv[2][2];
#pragma unroll
        for (int bj = 0; bj < 2; ++bj)
#pragma unroll
            for (int n = 0; n < 2; ++n) gv[bj][n] = *(const f32x4*)(gp + bj * 128 + 4 * n);
        f32x4 cs_[2][2];
#pragma unroll
        for (int bj = 0; bj < 2; ++bj)
#pragma unroll
            for (int n = 0; n < 2; ++n) cs_[bj][n] = *(const f32x4*)(csb + col0 + bj * 128 + 4 * n);
        f32x4 xb[3][2][2];
#define ER_LOAD(I_) do { const size_t o_ = (size_t)(row0 + ((I_) >> 2) * 128 + ((I_) & 3) * 16) * D + col0; _Pragma("unroll") for (int bj_ = 0; bj_ < 2; ++bj_) { \
            xb[(I_) % 3][bj_][0] = *(const f32x4*)(base + o_ + bj_ * 128); xb[(I_) % 3][bj_][1] = *(const f32x4*)(base + o_ + bj_ * 128 + 4); } } while (0)
        ER_LOAD(0); ER_LOAD(1);
#pragma unroll
        for (int idx = 0; idx < 8; ++idx) { const int ai = idx >> 2, m = idx & 3; const size_t off = (size_t)(row0 + ai * 128 + m * 16) * D + col0;
            if (idx + 2 < 8) ER_LOAD(idx + 2);
#pragma unroll
            for (int bj = 0; bj < 2; ++bj) {
                const f32x4 v0 = xb[idx % 3][bj][0] + gv[bj][0] * dq4(acc[ai][bj][m][0], cs_[bj][0], sa), v1 = xb[idx % 3][bj][1] + gv[bj][1] * dq4(acc[ai][bj][m][1], cs_[bj][1], sa);
                v4u w; w.x = pk2(v0.x, v0.y); w.y = pk2(v0.z, v0.w); w.z = pk2(v1.x, v1.y); w.w = pk2(v1.z, v1.w);
                *(v4u*)(out + off + bj * 128) = w; }
            asm volatile("" ::: "memory"); }
#undef ER_LOAD
    }
};

__device__ __forceinline__ void attn_phase(const Frame& F, const Args& A) {
    const int lane = lane_id(), tid = F.wave * 64 + lane; (void)tid;
    LAS float* bias = (LAS float*)(F.lds + XCH_OFF);
    LAS unsigned char* kl = F.lds + F.wave * 16384;
    LAS unsigned char* vl = kl + 8192;
    const int q = lane & 31, hh = lane >> 5;
    const int l4 = lane >> 4, c16 = lane & 15, l2 = lane >> 2, g4 = lane & 3;
    for (int pass = 0; pass < 2; ++pass) {
        const int jx = F.vcu & 31, bh = (F.vcu >> 5) * 8 + 4 * pass + (jx >> 3), b = bh >> 3, h = bh & 7;
        const int tidq = (jx & 7) * 8 + F.wave, r = tidq >> 1, qh = tidq & 1;
        __syncthreads();
        for (int i = tid; i < 15 * 31; i += NWAVES * 64) bias[i] = AP_rpb[h * 465 + i] * LOG2E;
        __syncthreads();
        const int rs = min(max(r - 4, 0), 24);
        const unsigned char* Kb = (const unsigned char*)(AP_K + (size_t)b * SEQ * DA + h * HD);
        const unsigned char* VTb = (const unsigned char*)(AP_VTR + (size_t)(b * NH + h) * HD * SEQ);
        const unsigned char* KCb = (const unsigned char*)(AP_KC + (size_t)b * CTXL * DA + h * HD);
        const unsigned char* VCb = (const unsigned char*)(AP_VCT + (size_t)(b * NH + h) * HD * CTXL);
        const int c0 = qh ? 24 : 0, qcol = qh * 32 + q, cs = min(max(qcol - 8, 0), 48);
        const bf16* qp = AP_Q + (size_t)(b * SEQ + r * GW + qcol) * DA + h * HD + 32 * hh;
        bf16x8 qf[8];
#pragma unroll
        for (int s = 0; s < 8; ++s) qf[s] = *(const bf16x8*)(qp + 64 * (s >> 2) + 8 * (s & 3));
        f32x16 o[4];
#pragma unroll
        for (int db = 0; db < 4; ++db)
#pragma unroll
            for (int i = 0; i < 16; ++i) o[db][i] = 0.f;
        float mrun = -1e30f, lrun = 0.f;
        const int gsw = g4 ^ ((l2 >> 2) & 3);
#define ATT_KDMA(KB_) do { const int kb_ = (KB_); \
            if (kb_ < 10) { \
                _Pragma("unroll") for (int i_ = 0; i_ < 8; ++i_) { const int rho_ = 4 * i_ + l4; const int kk_ = kb_ * 32 + (4 * ((i_ >> 1) & 1) + 8 * (i_ & 1) + 16 * (i_ >> 2)) + l4, krow_ = (kk_ * 205) >> 13, kc_ = c0 + kk_ - krow_ * 40; \
                    __builtin_amdgcn_global_load_lds((const unsigned*)(Kb + (unsigned)(((rs + krow_) * GW + kc_) * (DA * 2) + 16 * (c16 ^ (rho_ & 15)))), (LAS unsigned*)(kl + i_ * 1024), 16, 0, 0); } \
            } else { \
                _Pragma("unroll") for (int i_ = 0; i_ < 8; ++i_) { const int rho_ = 4 * i_ + l4; const int l_ = (kb_ - 10) * 32 + (4 * ((i_ >> 1) & 1) + 8 * (i_ & 1) + 16 * (i_ >> 2)) + l4; \
                    __builtin_amdgcn_global_load_lds((const unsigned*)(KCb + (unsigned)(l_ * (DA * 2) + 16 * (c16 ^ (rho_ & 15)))), (LAS unsigned*)(kl + i_ * 1024), 16, 0, 0); } \
            } } while (0)
#define ATT_VDMA(KB_) do { const int kb_ = (KB_); \
            if (kb_ < 10) { \
                const int k0_ = kb_ * 32 + 8 * gsw, vr_ = (k0_ * 205) >> 13, vc_ = c0 + k0_ - vr_ * 40; const unsigned vo_ = (unsigned)((l2 * SEQ + (rs + vr_) * GW + vc_) * 2); \
                _Pragma("unroll") for (int i_ = 0; i_ < 8; ++i_) __builtin_amdgcn_global_load_lds((const unsigned*)(VTb + vo_ + (unsigned)(i_ * 16 * SEQ * 2)), (LAS unsigned*)(vl + i_ * 1024), 16, 0, 0); \
            } else { \
                const unsigned vo_ = (unsigned)((l2 * CTXL + (kb_ - 10) * 32 + 8 * gsw) * 2); \
                _Pragma("unroll") for (int i_ = 0; i_ < 8; ++i_) __builtin_amdgcn_global_load_lds((const unsigned*)(VCb + vo_ + (unsigned)(i_ * 16 * CTXL * 2)), (LAS unsigned*)(vl + i_ * 1024), 16, 0, 0); \
            } } while (0)
        asm volatile("s_waitcnt vmcnt(0) lgkmcnt(0)" ::: "memory");
        ATT_KDMA(0); ATT_VDMA(0);
        for (int kb = 0; kb < 18; ++kb) {
            const bool win = kb < 10;
            asm volatile("s_waitcnt vmcnt(8)" ::: "memory");
            bf16x8 kf[8];
#pragma unroll
            for (int s = 0; s < 8; ++s) kf[s] = *(const LAS bf16x8*)(kl + q * 256 + 16 * ((8 * (s >> 2) + 4 * hh + (s & 3)) ^ (q & 15)));
            asm volatile("s_waitcnt lgkmcnt(0)" ::: "memory");
            if (kb + 1 < 18) ATT_KDMA(kb + 1);
            f32x16 sa;
#pragma unroll
            for (int i = 0; i < 16; ++i) sa[i] = 0.f;
#pragma unroll
            for (int s = 0; s < 8; ++s) sa = __builtin_amdgcn_mfma_f32_32x32x16_bf16(kf[s], qf[s], sa, 0, 0, 0);
            if (win) {
#pragma unroll
                for (int i = 0; i < 16; ++i) {
                    const int g = kb * 4 + 2 * (i >> 3) + hh, w = (i & 3) + 4 * ((i >> 2) & 1);
                    const int krow = (g * 205) >> 10, kcol = c0 + 8 * (g - 5 * krow) + w;
                    const int dr = rs + krow - r + 7;
                    const int dc = min(max(kcol - qcol, -15), 15) + 15;
                    const bool inw = (unsigned)(kcol - cs) < 16u;
                    sa[i] = inw ? sa[i] + bias[dr * 31 + dc] : -1e30f;
                }
            }
            float bm = sa[0];
#pragma unroll
            for (int i = 1; i < 16; ++i) bm = fmaxf(bm, sa[i]);
            bm = fmaxf(bm, __shfl_xor(bm, 32));
            if (!__all(bm - mrun <= 6.0f)) {
                const float mnew = fmaxf(mrun, bm), alpha = __builtin_amdgcn_exp2f(mrun - mnew);
                mrun = mnew; lrun *= alpha;
#pragma unroll
                for (int db = 0; db < 4; ++db)
#pragma unroll
                    for (int i = 0; i < 16; ++i) o[db][i] *= alpha;
            }
            float ps = 0.f;
#pragma unroll
            for (int i = 0; i < 16; ++i) { sa[i] = __builtin_amdgcn_exp2f(sa[i] - mrun); ps += sa[i]; }
            lrun += ps;
            bf16x8 pf[2];
#pragma unroll
            for (int s2 = 0; s2 < 2; ++s2) { v4u w; w.x = pk2(sa[8 * s2 + 0], sa[8 * s2 + 1]); w.y = pk2(sa[8 * s2 + 2], sa[8 * s2 + 3]); w.z = pk2(sa[8 * s2 + 4], sa[8 * s2 + 5]); w.w = pk2(sa[8 * s2 + 6], sa[8 * s2 + 7]); pf[s2] = __builtin_bit_cast(bf16x8, w); }
            if (kb + 1 < 18) asm volatile("s_waitcnt vmcnt(8)" ::: "memory"); else asm volatile("s_waitcnt vmcnt(0)" ::: "memory");
            bf16x8 vf[4][2];
#pragma unroll
            for (int db = 0; db < 4; ++db) { const int dd = db * 32 + q;
                vf[db][0] = *(const LAS bf16x8*)(vl + dd * 64 + 16 * ((0 + hh) ^ ((dd >> 2) & 3))); vf[db][1] = *(const LAS bf16x8*)(vl + dd * 64 + 16 * ((2 + hh) ^ ((dd >> 2) & 3))); }
            asm volatile("s_waitcnt lgkmcnt(0)" ::: "memory");
            if (kb + 1 < 18) ATT_VDMA(kb + 1);
#pragma unroll
            for (int db = 0; db < 4; ++db) { o[db] = __builtin_amdgcn_mfma_f32_32x32x16_bf16(vf[db][0], pf[0], o[db], 0, 0, 0); o[db] = __builtin_amdgcn_mfma_f32_32x32x16_bf16(vf[db][1], pf[1], o[db], 0, 0, 0); }
        }
#undef ATT_KDMA
#undef ATT_VDMA
        const float ltot = lrun + __shfl_xor(lrun, 32), inv = 1.f / ltot;
        float ss = 0.f;
#pragma unroll
        for (int db = 0; db < 4; ++db)
#pragma unroll
            for (int i = 0; i < 16; ++i) { o[db][i] *= inv; ss += o[db][i] * o[db][i]; }
        ss += __shfl_xor(ss, 32);
        const float rstd = __builtin_amdgcn_rsqf(ss * (1.f / HD) + EPS);
        unsigned char* op = AP_A28 + (size_t)(b * SEQ + r * GW + qcol) * D + h * HD + 4 * hh;
        const float* gp = AP_gao + h * HD + 4 * hh; const float rq = rstd * A2_INV;
#pragma unroll
        for (int db = 0; db < 4; ++db)
#pragma unroll
            for (int i4 = 0; i4 < 4; ++i4) { const f32x4 g = *(const f32x4*)(gp + db * 32 + 8 * i4);
                f32x4 y; y.x = o[db][4 * i4 + 0] * g.x; y.y = o[db][4 * i4 + 1] * g.y; y.z = o[db][4 * i4 + 2] * g.z; y.w = o[db][4 * i4 + 3] * g.w;
                *(unsigned*)(op + db * 32 + 8 * i4) = q4(y, rq); }
    }
    __syncthreads();
}

__device__ __forceinline__ void unpack16(const v4u a, const v4u b, float (&f)[16]) {
    f[0] = bflo(a.x); f[1] = bfhi(a.x); f[2] = bflo(a.y); f[3] = bfhi(a.y); f[4] = bflo(a.z); f[5] = bfhi(a.z); f[6] = bflo(a.w); f[7] = bfhi(a.w);
    f[8] = bflo(b.x); f[9] = bfhi(b.x); f[10] = bflo(b.y); f[11] = bfhi(b.y); f[12] = bflo(b.z); f[13] = bfhi(b.z); f[14] = bflo(b.w); f[15] = bfhi(b.w);
}
__device__ __forceinline__ void load_z(const bf16* CGp, const bf16* Up, size_t m, int lane, float (&z)[16]) {
    const v4u* cp = (const v4u*)(CGp + m * DA + 16 * lane); const v4u* up = (const v4u*)(Up + m * DA + 16 * lane);
    const v4u c0 = cp[0], c1 = cp[1], u0 = up[0], u1 = up[1];
    float cf[16], uf[16]; unpack16(c0, c1, cf); unpack16(u0, u1, uf);
#pragma unroll
    for (int i = 0; i < 16; ++i) z[i] = cf[i] * uf[i];
}
__device__ __forceinline__ void conv_phase(const Frame& F, const Args& A) {
    const int lane = lane_id(), tid = F.wave * 64 + lane; (void)tid;
    const int gw = F.vcu * NWAVES + F.wave, NGW = F.G * NWAVES;
    float w0[16], w1[16], w2[16], gg[16];
#pragma unroll
    for (int i = 0; i < 16; ++i) { w0[i] = AP_w_conv[0 * DA + 16 * lane + i]; w1[i] = AP_w_conv[1 * DA + 16 * lane + i]; w2[i] = AP_w_conv[2 * DA + 16 * lane + i]; gg[i] = AP_gco[16 * lane + i]; }
    for (int it = gw; it < M / 8; it += NGW) {
        const size_t m0 = (size_t)it * 8;
        float zp[16], zc[16], zn[16];
        if ((m0 & (SEQ - 1)) == 0) {
#pragma unroll
            for (int i = 0; i < 16; ++i) zp[i] = 0.f;
        } else load_z(AP_CG, AP_U, m0 - 1, lane, zp);
        load_z(AP_CG, AP_U, m0, lane, zc);
        for (int j = 0; j < 8; ++j) {
            const size_t m = m0 + j;
            if ((m & (SEQ - 1)) == SEQ - 1) {
#pragma unroll
                for (int i = 0; i < 16; ++i) zn[i] = 0.f;
            } else load_z(AP_CG, AP_U, m + 1, lane, zn);
            const v4u* bp = (const v4u*)(AP_BG + m * DA + 16 * lane); const v4u b0 = bp[0], b1 = bp[1];
            float bf[16]; unpack16(b0, b1, bf);
            float y[16], ss = 0.f;
#pragma unroll
            for (int i = 0; i < 16; ++i) { y[i] = bf[i] * (w0[i] * zp[i] + w1[i] * zc[i] + w2[i] * zn[i]); ss += y[i] * y[i]; }
            ss += __shfl_xor(ss, 1); ss += __shfl_xor(ss, 2); ss += __shfl_xor(ss, 4);
            const float rstd = __builtin_amdgcn_rsqf(ss * (1.f / 128.f) + EPS);
            const float rq = rstd * A2_INV; v4u o0;
            { f32x4 t0 = {y[0] * gg[0], y[1] * gg[1], y[2] * gg[2], y[3] * gg[3]}, t1 = {y[4] * gg[4], y[5] * gg[5], y[6] * gg[6], y[7] * gg[7]};
              f32x4 t2 = {y[8] * gg[8], y[9] * gg[9], y[10] * gg[10], y[11] * gg[11]}, t3 = {y[12] * gg[12], y[13] * gg[13], y[14] * gg[14], y[15] * gg[15]};
              o0.x = q4(t0, rq); o0.y = q4(t1, rq); o0.z = q4(t2, rq); o0.w = q4(t3, rq); }
            *(v4u*)(AP_A28 + m * D + DA + 16 * lane) = o0;
#pragma unroll
            for (int i = 0; i < 16; ++i) { zp[i] = zc[i]; zc[i] = zn[i]; }
        }
    }
}

__device__ __forceinline__ unsigned f2key(float f) { const unsigned u = __builtin_bit_cast(unsigned, f); return (u & 0x80000000u) ? ~u : (u | 0x80000000u); }
__device__ __forceinline__ float key2f(unsigned k) { const unsigned u = (k & 0x80000000u) ? (k & 0x7fffffffu) : ~k; return __builtin_bit_cast(float, u); }
__device__ __forceinline__ void ce_desc(unsigned& a, unsigned& b) { const unsigned hi = max(a, b), lo = min(a, b); a = hi; b = lo; }
template <int BASE> __device__ __forceinline__ void sort16_desc(unsigned (&v)[64]) {
#pragma unroll
    for (int k = 2; k <= 16; k <<= 1)
#pragma unroll
        for (int j = k >> 1; j >= 1; j >>= 1)
#pragma unroll
            for (int i = 0; i < 16; ++i) { const int l = i ^ j; if (l > i) { if ((i & k) == 0) ce_desc(v[BASE + i], v[BASE + l]); else ce_desc(v[BASE + l], v[BASE + i]); } }
}
template <int A_, int B_> __device__ __forceinline__ void merge_top16(unsigned (&v)[64]) {
#pragma unroll
    for (int i = 0; i < 16; ++i) v[A_ + i] = max(v[A_ + i], v[B_ + 15 - i]);
#pragma unroll
    for (int j = 8; j >= 1; j >>= 1)
#pragma unroll
        for (int i = 0; i < 16; ++i) { const int l = i ^ j; if (l > i) ce_desc(v[A_ + i], v[A_ + l]); }
}
__device__ __forceinline__ void top16_of_64(unsigned (&v)[64]) {
    sort16_desc<0>(v); sort16_desc<16>(v); sort16_desc<32>(v); sort16_desc<48>(v);
    merge_top16<0, 16>(v); merge_top16<32, 48>(v); merge_top16<0, 32>(v);
}
__device__ __forceinline__ void peer_select_phase(const Frame& F, const Args& A) {
    const int lane = lane_id(), tid = F.wave * 64 + lane; (void)tid;
    const int gw = F.vcu * NWAVES + F.wave, NGW = F.G * NWAVES, tk = lane & 31, hh = lane >> 5;
    LAS unsigned char* qimg = F.lds + F.wave * 16384;
    LAS unsigned char* kimg = qimg + 8192;
    LAS int* ixs = (LAS int*)qimg;
    const int l4 = lane >> 4, c16 = lane & 15;
    unsigned nh4 = (unsigned)(1 - hh) << 2; asm volatile("" : "+v"(nh4));
    for (int task = gw; task < (M / 32) * PH; task += NGW) {
        const int h = task & 7, tb = task >> 3; const int token = tb * 32 + tk;
        unsigned best[2][16];
#pragma unroll
        for (int p = 0; p < 2; ++p) {
            const unsigned char* qsrc = (const unsigned char*)(AP_QP + (size_t)(tb * 32) * D + h * 256 + p * 128);
            const unsigned char* ksrc = (const unsigned char*)(AP_SK + (size_t)((h * 2 + p) * NKEYS) * 128);
            unsigned bq = (unsigned)(l4 * (D * 2) + 16 * (c16 ^ l4)), bk = (unsigned)(l4 * 256 + 16 * (c16 ^ l4));
            asm volatile("s_waitcnt vmcnt(0) lgkmcnt(0)" : "+v"(bq), "+v"(bk) : : "memory");
#pragma unroll
            for (int i = 0; i < 8; ++i) __builtin_amdgcn_global_load_lds((const unsigned*)(qsrc + ((bq ^ (unsigned)(64 * (i & 3))) + (unsigned)(i * 4 * D * 2))), (LAS unsigned*)(qimg + i * 1024), 16, 0, 0);
#define PS_KDMA(KB_) do { _Pragma("unroll") for (int i_ = 0; i_ < 8; ++i_) \
                __builtin_amdgcn_global_load_lds((const unsigned*)(ksrc + ((bk ^ (unsigned)(64 * (i_ & 3))) + (unsigned)((KB_) * 8192 + i_ * 1024))), (LAS unsigned*)(kimg + i_ * 1024), 16, 0, 0); } while (0)
            PS_KDMA(0);
            asm volatile("s_waitcnt vmcnt(8)" ::: "memory");
            bf16x8 qf[8];
#pragma unroll
            for (int s = 0; s < 8; ++s) qf[s] = *(const LAS bf16x8*)(qimg + tk * 256 + 16 * ((8 * (s >> 2) + 4 * hh + (s & 3)) ^ (tk & 15)));
            unsigned ky[64];
#pragma unroll
            for (int kb = 0; kb < 4; ++kb) {
                asm volatile("s_waitcnt vmcnt(0)" ::: "memory");
                bf16x8 kf[8];
#pragma unroll
                for (int s = 0; s < 8; ++s) kf[s] = *(const LAS bf16x8*)(kimg + tk * 256 + 16 * ((8 * (s >> 2) + 4 * hh + (s & 3)) ^ (tk & 15)));
                asm volatile("s_waitcnt lgkmcnt(0)" ::: "memory");
                if (kb < 3) PS_KDMA(kb + 1);
                f32x16 sa;
#pragma unroll
                for (int i = 0; i < 16; ++i) sa[i] = 0.f;
#pragma unroll
                for (int s = 0; s < 8; ++s) sa = __builtin_amdgcn_mfma_f32_32x32x16_bf16(kf[s], qf[s], sa, 0, 0, 0);
#pragma unroll
                for (int i = 0; i < 16; ++i) { const unsigned ck = (unsigned)(127 - (kb * 32 + (i & 3) + 8 * (i >> 2))) & ~4u;
                    ky[kb * 16 + i] = ((f2key(sa[i]) & ~127u) | nh4) | ck; }
                asm volatile("" ::: "memory");
            }
#undef PS_KDMA
            top16_of_64(ky);
#pragma unroll
            for (int i = 0; i < 16; ++i) ky[16 + i] = (unsigned)__shfl_xor((int)ky[i], 32);
            merge_top16<0, 16>(ky);
#pragma unroll
            for (int i = 0; i < 16; ++i) best[p][i] = ky[i];
        }
        float s1[16], s2[16];
#pragma unroll
        for (int i = 0; i < 16; ++i) { s1[i] = key2f(best[0][i] & ~127u); s2[i] = key2f(best[1][i] & ~127u);
            ixs[i * 64 + lane] = 127 - (int)(best[0][i] & 127u); ixs[(16 + i) * 64 + lane] = 127 - (int)(best[1][i] & 127u); }
        unsigned cd[64]; { int n = 0;
#pragma unroll
            for (int i = 0; i < 16; ++i)
#pragma unroll
                for (int j = 0; j < 16; ++j) if ((i + 1) * (j + 1) <= 16) { cd[n] = (f2key(s1[i] + s2[j]) & ~255u) | (unsigned)(255 - (16 * i + j)); ++n; }
#pragma unroll
            for (int i = 50; i < 64; ++i) cd[i] = 0u; }
        top16_of_64(cd);
        unsigned win[16];
#pragma unroll
        for (int i = 0; i < 16; ++i) win[i] = cd[i];
        LDS_WAIT();
        const float vmax = key2f(win[0] & ~255u);
        float ev[16], es = 0.f;
#pragma unroll
        for (int rnd = 0; rnd < 16; ++rnd) { ev[rnd] = __expf(key2f(win[rnd] & ~255u) - vmax); es += ev[rnd]; }
        const float ies = 1.f / es;
        if (hh == 0) {
            int* ip = AP_SELI + (size_t)token * 128 + h * 16; float* gp = AP_SELG + (size_t)token * 128 + h * 16;
#pragma unroll
            for (int rnd = 0; rnd < 16; ++rnd) { const int pos = 255 - (int)(win[rnd] & 255u); const int i1 = ixs[(pos >> 4) * 64 + lane], i2 = ixs[(16 + (pos & 15)) * 64 + lane];
                ip[rnd] = i1 * NKEYS + i2; gp[rnd] = ev[rnd] * ies; }
        }
        LDS_WAIT();
    }
}

typedef int v4i __attribute__((ext_vector_type(4)));
__device__ __forceinline__ float gelu_as(const float v) {
    const float av = fabsf(v), t = __builtin_amdgcn_rcpf(av * 0.2316418882f + 1.0f);
    float q = t * 0.5307027145f + (-0.7265760135f); q = q * t + 0.7107068705f; q = q * t + (-0.142248368f); q = q * t + 0.127414796f; q = q * t;
    const float e = __builtin_amdgcn_exp2f((v * v) * (-0.72134752044f));
    const float m = v * (q * e);
    return v < 0.f ? m : v - m;
}
constexpr int PL_WAVE = 16384, PL_EL = 8192, PL_PACC = 10240, PL_AQ = 14336, PL_SA = 15360;
__device__ __forceinline__ float wave_maxf(float v) {
#pragma unroll
    for (int o = 1; o < 64; o <<= 1) v = fmaxf(v, __shfl_xor(v, o));
    return v;
}
__device__ __forceinline__ void peer_u_phase(const Frame& F, const Args& A, float (&sa)[8]) {
    const int lane = lane_id(), p8 = lane >> 3, c = lane & 7;
    LAS unsigned short* elist = (LAS unsigned short*)(F.lds + F.wave * PL_WAVE + PL_EL);
    LAS int* pacc = (LAS int*)(F.lds + F.wave * PL_WAVE + PL_PACC);
    LAS signed char* aq = (LAS signed char*)(F.lds + F.wave * PL_WAVE + PL_AQ);
    const int tok0 = F.vcu * 64 + F.wave * 8;
    for (int it = 0; it < 16; ++it) { elist[it * 64 + lane] = (unsigned short)AP_SELI[(size_t)tok0 * 128 + it * 64 + lane]; pacc[it * 64 + lane] = 0; }
    LDS_WAIT();
    v4u G0[4], G1[4], G2[4], G3[4], hreg;
    const unsigned char* ub = AP_U8 + 16 * c;
    LAS unsigned char* hst = F.lds + F.wave * PL_WAVE;
#define PU_LOAD(G_, K_) do { const int kg_ = (K_), tp_ = kg_ & 31; const LAS unsigned short* el_ = elist + (2 * tp_) * 16 + p8; \
            const unsigned e0_ = el_[0], e1_ = el_[8], e2_ = el_[16], e3_ = el_[24]; const unsigned char* us_ = ub + 128 * (kg_ >> 5); \
            G_[0] = *(const v4u*)(us_ + (size_t)e0_ * D); G_[1] = *(const v4u*)(us_ + (size_t)e1_ * D); G_[2] = *(const v4u*)(us_ + (size_t)e2_ * D); G_[3] = *(const v4u*)(us_ + (size_t)e3_ * D); } while (0)
#define PU_DOT4(A0_) ([&]() { int d0_ = __builtin_amdgcn_sdot4((int)(A0_).x, (int)hreg.x, 0, false), d1_ = __builtin_amdgcn_sdot4((int)(A0_).y, (int)hreg.y, 0, false); \
            d0_ = __builtin_amdgcn_sdot4((int)(A0_).z, (int)hreg.z, d0_, false); d1_ = __builtin_amdgcn_sdot4((int)(A0_).w, (int)hreg.w, d1_, false); \
            int v_ = d0_ + d1_; \
            v_ += __builtin_amdgcn_update_dpp(0, v_, 0xB1, 0xf, 0xf, true); v_ += __builtin_amdgcn_update_dpp(0, v_, 0x4E, 0xf, 0xf, true); v_ += __builtin_amdgcn_update_dpp(0, v_, 0x141, 0xf, 0xf, true); return v_; }())
#define PU_COMPUTE(G_, TP_) do { const int v0_ = PU_DOT4(G_[0]), v1_ = PU_DOT4(G_[1]), v2_ = PU_DOT4(G_[2]), v3_ = PU_DOT4(G_[3]); \
            if (c == 0) { LAS int* pa_ = pacc + (2 * (TP_)) * 16 + p8; \
                (void)__hip_atomic_fetch_add(pa_, v0_, __ATOMIC_RELAXED, __HIP_MEMORY_SCOPE_WORKGROUP); (void)__hip_atomic_fetch_add(pa_ + 8, v1_, __ATOMIC_RELAXED, __HIP_MEMORY_SCOPE_WORKGROUP); \
                (void)__hip_atomic_fetch_add(pa_ + 16, v2_, __ATOMIC_RELAXED, __HIP_MEMORY_SCOPE_WORKGROUP); (void)__hip_atomic_fetch_add(pa_ + 24, v3_, __ATOMIC_RELAXED, __HIP_MEMORY_SCOPE_WORKGROUP); } } while (0)
    PU_LOAD(G0, 0); PU_LOAD(G1, 1); PU_LOAD(G2, 2); PU_LOAD(G3, 3);
    for (int slice = 0; slice < 16; ++slice) {
        { const int tk_ = lane >> 3, pc_ = lane & 7;
          *(LAS v4u*)(hst + tk_ * 128 + 16 * pc_) = *(const v4u*)(AP_H2Q + (size_t)(tok0 + tk_) * D + 128 * slice + 16 * pc_); }
        for (int tk = 0; tk < 8; ++tk) {
            hreg = *(const LAS v4u*)(hst + tk * 128 + 16 * c);
            { const int tp = tk * 4, k = slice * 32 + tp;
                PU_COMPUTE(G0, tp);     PU_LOAD(G0, (k + 4) & 511);
                PU_COMPUTE(G1, tp + 1); PU_LOAD(G1, (k + 5) & 511);
                PU_COMPUTE(G2, tp + 2); PU_LOAD(G2, (k + 6) & 511);
                PU_COMPUTE(G3, tp + 3); PU_LOAD(G3, (k + 7) & 511);
            }
        }
        if ((slice & 3) == 3) __builtin_amdgcn_s_barrier();
    }
#undef PU_LOAD
#undef PU_COMPUTE
#undef PU_DOT4
    LDS_WAIT();
#pragma unroll
    for (int t = 0; t < 8; ++t) { const int token = tok0 + t; const float hs = AP_H2S[token]; float av[2];
#pragma unroll
        for (int hf = 0; hf < 2; ++hf) { const int p = t * 128 + hf * 64 + lane; const unsigned e = elist[p];
            av[hf] = gelu_as((float)pacc[p] * AP_SU[e] * hs) * AP_SELG[(size_t)tok0 * 128 + p] * AP_SV[e]; }
        const float mx = fmaxf(wave_maxf(fmaxf(fabsf(av[0]), fabsf(av[1]))), 1e-30f), inv = 127.f / mx;
        aq[t * 128 + lane] = (signed char)(int)__builtin_rintf(av[0] * inv); aq[t * 128 + 64 + lane] = (signed char)(int)__builtin_rintf(av[1] * inv);
        sa[t] = mx * (1.f / 127.f); if (lane == 0) *(LAS float*)(F.lds + F.wave * PL_WAVE + PL_SA + 4 * t) = mx * (1.f / 127.f); }
    LDS_WAIT();
}
__device__ __forceinline__ void peer_v_phase(const Frame& F, const Args& A, const float (&sa)[8]) {
    const int lane = lane_id(), n = lane & 15, kq = lane >> 4, rr = n >> 2, cc = n & 3;
    LAS unsigned char* buf = F.lds + F.wave * PL_WAVE;
    const LAS unsigned short* elist = (const LAS unsigned short*)(F.lds + F.wave * PL_WAVE + PL_EL);
    const LAS signed char* aq = (const LAS signed char*)(F.lds + F.wave * PL_WAVE + PL_AQ);
    const int tok0 = F.vcu * 64 + F.wave * 8;
    const int fsw = (rr >> 1) | ((kq & 1) << 1);
    const unsigned trbase = (unsigned)(size_t)buf + (unsigned)((8 * kq + rr) * 128 + 8 * cc);
    const int r0 = lane >> 3, c8 = lane & 7;
    v4u G0[4], G1[4], G2[4], G3[4];
    v4i accE[4], accO[4];
#pragma unroll
    for (int q = 0; q < 4; ++q) { accE[q] = (v4i){0, 0, 0, 0}; accO[q] = (v4i){0, 0, 0, 0}; }
#define PV_EREAD(K_) do { const int ke_ = (K_); _Pragma("unroll") for (int i_ = 0; i_ < 4; ++i_) en[i_] = elist[(ke_ & 31) * 32 + 8 * i_ + r0]; } while (0)
#define PV_LOAD(G_, K_) do { const int kg_ = (K_); _Pragma("unroll") for (int i_ = 0; i_ < 4; ++i_) { const unsigned e_ = en[i_]; \
            const int f_ = ((r0 >> 1) & 1) | ((i_ & 1) << 1); \
            G_[i_] = *(const v4u*)(AP_V8 + (size_t)e_ * D + 128 * (kg_ >> 5) + 32 * ((c8 >> 1) ^ f_) + 16 * (c8 & 1)); } } while (0)
#define PV_STORE(G_, B_) do { _Pragma("unroll") for (int i_ = 0; i_ < 4; ++i_) *(LAS v4u*)(buf + (B_) * 4096 + i_ * 1024 + lane * 16) = G_[i_]; } while (0)
#define PV_TR(B_) do { const unsigned tb_ = trbase + (unsigned)((B_) * 4096); \
            const unsigned t0_ = tb_ + 32u * (unsigned)(0 ^ fsw), t1_ = tb_ + 32u * (unsigned)(1 ^ fsw), t2_ = tb_ + 32u * (unsigned)(2 ^ fsw), t3_ = tb_ + 32u * (unsigned)(3 ^ fsw); \
            asm volatile("s_waitcnt lgkmcnt(0)\n\t" \
                         "ds_read_b64_tr_b16 %0, %8\n\tds_read_b64_tr_b16 %1, %8 offset:512\n\tds_read_b64_tr_b16 %2, %9\n\tds_read_b64_tr_b16 %3, %9 offset:512\n\t" \
                         "ds_read_b64_tr_b16 %4, %10\n\tds_read_b64_tr_b16 %5, %10 offset:512\n\tds_read_b64_tr_b16 %6, %11\n\tds_read_b64_tr_b16 %7, %11 offset:512" \
                         : "=&v"(RR[0][0]), "=&v"(RR[0][1]), "=&v"(RR[1][0]), "=&v"(RR[1][1]), "=&v"(RR[2][0]), "=&v"(RR[2][1]), "=&v"(RR[3][0]), "=&v"(RR[3][1]) : "v"(t0_), "v"(t1_), "v"(t2_), "v"(t3_) : "memory"); } while (0)
#define PV_MMA(K_) do { const int kc_ = (K_), b_ = kc_ & 31; \
            v2u a8_ = *(const LAS v2u*)(aq + b_ * 32 + 8 * kq);                        \
            if (n != (b_ >> 2)) a8_ = (v2u){0u, 0u};                                  \
            v4i AE_, AO_; \
            AE_.x = (int)__builtin_amdgcn_perm(0u, a8_.x, 0x0c010c00u); AE_.y = (int)__builtin_amdgcn_perm(0u, a8_.x, 0x0c030c02u); AE_.z = (int)__builtin_amdgcn_perm(0u, a8_.y, 0x0c010c00u); AE_.w = (int)__builtin_amdgcn_perm(0u, a8_.y, 0x0c030c02u); \
            AO_.x = (int)__builtin_amdgcn_perm(0u, a8_.x, 0x010c000cu); AO_.y = (int)__builtin_amdgcn_perm(0u, a8_.x, 0x030c020cu); AO_.z = (int)__builtin_amdgcn_perm(0u, a8_.y, 0x010c000cu); AO_.w = (int)__builtin_amdgcn_perm(0u, a8_.y, 0x030c020cu); \
            asm volatile("s_waitcnt lgkmcnt(0)" : "+v"(RR[0][0]), "+v"(RR[0][1]), "+v"(RR[1][0]), "+v"(RR[1][1]), "+v"(RR[2][0]), "+v"(RR[2][1]), "+v"(RR[3][0]), "+v"(RR[3][1]) : : "memory"); \
            _Pragma("unroll") for (int q_ = 0; q_ < 4; ++q_) { const v4i Bq_ = {(int)RR[q_][0].x, (int)RR[q_][0].y, (int)RR[q_][1].x, (int)RR[q_][1].y}; \
                accE[q_] = __builtin_amdgcn_mfma_i32_16x16x64_i8(AE_, Bq_, accE[q_], 0, 0, 0); \
                accO[q_] = __builtin_amdgcn_mfma_i32_16x16x64_i8(AO_, Bq_, accO[q_], 0, 0, 0); } } while (0)
    v2u RR[4][2]; unsigned en[4];
    PV_EREAD(0); PV_LOAD(G0, 0); PV_EREAD(1); PV_LOAD(G1, 1); PV_EREAD(2); PV_LOAD(G2, 2); PV_EREAD(3); PV_LOAD(G3, 3); PV_EREAD(4); PV_STORE(G0, 0);
    for (int slice = 0; slice < 16; ++slice) {
        for (int k = slice * 32; k < slice * 32 + 32; k += 4) {
            PV_TR(0); PV_STORE(G1, 1); PV_LOAD(G0, (k + 4) & 511); PV_EREAD((k + 5) & 511); PV_MMA(k);
            PV_TR(1); PV_STORE(G2, 0); PV_LOAD(G1, (k + 5) & 511); PV_EREAD((k + 6) & 511); PV_MMA(k + 1);
            PV_TR(0); PV_STORE(G3, 1); PV_LOAD(G2, (k + 6) & 511); PV_EREAD((k + 7) & 511); PV_MMA(k + 2);
            PV_TR(1); PV_STORE(G0, 0); PV_LOAD(G3, (k + 7) & 511); PV_EREAD((k + 8) & 511); PV_MMA(k + 3);
        }
        if (kq < 2) {
#pragma unroll
            for (int i = 0; i < 4; ++i) { const int token = tok0 + 4 * kq + i; const float sat = kq ? sa[4 + i] : sa[i];
                const float* gtp = AP_MOD + (size_t)(token >> 11) * 6 * D + 5 * D + 128 * slice + 2 * n; float* op = AP_out + (size_t)token * D + 128 * slice + 2 * n;
                const bf16* xp = AP_X1B + (size_t)token * D + 128 * slice + 2 * n;
#pragma unroll
                for (int q = 0; q < 4; ++q) { typedef float f32x2t __attribute__((ext_vector_type(2)));
                    const unsigned xw = *(const unsigned*)(xp + 32 * q); const f32x2t g0 = *(const f32x2t*)(gtp + 32 * q);
                    f32x2t rv; rv.x = bflo(xw) + g0.x * (sat * (float)accE[q][i]); rv.y = bfhi(xw) + g0.y * (sat * (float)accO[q][i]);
                    *(f32x2t*)(op + 32 * q) = rv; } }
        }
#pragma unroll
        for (int q = 0; q < 4; ++q) { accE[q] = (v4i){0, 0, 0, 0}; accO[q] = (v4i){0, 0, 0, 0}; }
        if ((slice & 3) == 3) __builtin_amdgcn_s_barrier();
    }
#undef PV_TR
#undef PV_MMA
#undef PV_LOAD
#undef PV_EREAD
#undef PV_STORE

}

__device__ __forceinline__ void peer_v_phase_valu(const Frame& F, const Args& A) {
    typedef float f32x2v __attribute__((ext_vector_type(2)));
    const int lane = lane_id(), r = lane >> 3, c = lane & 7, jq = lane >> 4, hb = (lane >> 3) & 1;
    const LAS unsigned char* wb = F.lds + F.wave * PL_WAVE;
    const LAS unsigned short* elist = (const LAS unsigned short*)(wb + PL_EL) + 4 * r;
    const LAS unsigned char* aq = wb + PL_AQ + 4 * r;
    const LAS float* sal = (const LAS float*)(wb + PL_SA);
    const int tok0 = F.vcu * 64 + F.wave * 8;
    const unsigned char* vb = AP_V8 + 16 * c;
    v4u G0[4], G1[4], G2[4], G3[4];
    v2u EN[4]; unsigned AC[4], AN[4];
    int acc[16];
#define PW_META(T_) do { const int tm_ = (T_) & 7; _Pragma("unroll") for (int s_ = 0; s_ < 4; ++s_) { EN[s_] = *(const LAS v2u*)(elist + tm_ * 128 + s_ * 32); AN[s_] = *(const LAS unsigned*)(aq + tm_ * 128 + s_ * 32); } } while (0)
#define PW_LOAD(G_, S_, SL_) do { const unsigned char* vs_ = vb + 128 * ((SL_) & 15); const v2u en_ = EN[S_]; \
        G_[0] = *(const v4u*)(vs_ + (size_t)(en_.x & 0xffffu) * D); G_[1] = *(const v4u*)(vs_ + (size_t)(en_.x >> 16) * D); \
        G_[2] = *(const v4u*)(vs_ + (size_t)(en_.y & 0xffffu) * D); G_[3] = *(const v4u*)(vs_ + (size_t)(en_.y >> 16) * D); } while (0)
#define PW_COL(W0_, W1_, W2_, W3_, J_, AP_) do { \
        const unsigned tl0_ = __builtin_amdgcn_perm(W1_, W0_, 0x05010400u), th0_ = __builtin_amdgcn_perm(W1_, W0_, 0x07030602u); \
        const unsigned tl1_ = __builtin_amdgcn_perm(W3_, W2_, 0x05010400u), th1_ = __builtin_amdgcn_perm(W3_, W2_, 0x07030602u); \
        acc[4 * (J_) + 0] = __builtin_amdgcn_sdot4((int)__builtin_amdgcn_perm(tl1_, tl0_, 0x05040100u), (int)(AP_), acc[4 * (J_) + 0], false); \
        acc[4 * (J_) + 1] = __builtin_amdgcn_sdot4((int)__builtin_amdgcn_perm(tl1_, tl0_, 0x07060302u), (int)(AP_), acc[4 * (J_) + 1], false); \
        acc[4 * (J_) + 2] = __builtin_amdgcn_sdot4((int)__builtin_amdgcn_perm(th1_, th0_, 0x05040100u), (int)(AP_), acc[4 * (J_) + 2], false); \
        acc[4 * (J_) + 3] = __builtin_amdgcn_sdot4((int)__builtin_amdgcn_perm(th1_, th0_, 0x07060302u), (int)(AP_), acc[4 * (J_) + 3], false); } while (0)
#define PW_COMPUTE(G_, AP_) do { PW_COL(G_[0].x, G_[1].x, G_[2].x, G_[3].x, 0, AP_); PW_COL(G_[0].y, G_[1].y, G_[2].y, G_[3].y, 1, AP_); \
        PW_COL(G_[0].z, G_[1].z, G_[2].z, G_[3].z, 2, AP_); PW_COL(G_[0].w, G_[1].w, G_[2].w, G_[3].w, 3, AP_); } while (0)
    PW_META(0);
    LDS_WAIT();
    PW_LOAD(G0, 0, 0); PW_LOAD(G1, 1, 0); PW_LOAD(G2, 2, 0); PW_LOAD(G3, 3, 0);
#pragma unroll
    for (int s = 0; s < 4; ++s) AC[s] = AN[s];
    for (int slice = 0; slice < 16; ++slice) {
        for (int t = 0; t < 8; ++t) {
            const int token = tok0 + t, d0 = 128 * slice + 16 * c + 4 * jq + 2 * hb;
            const unsigned xw = __builtin_nontemporal_load((const unsigned*)(AP_X1B + (size_t)token * D + d0));
            const f32x2v g2 = *(const f32x2v*)(AP_MOD + (size_t)(token >> 11) * 6 * D + 5 * D + d0);
            const float sat = sal[t];
            PW_META(t + 1);
            const int sn = slice + ((t + 1) >> 3);
#pragma unroll
            for (int q = 0; q < 16; ++q) acc[q] = 0;
            __builtin_amdgcn_sched_barrier(0);
            PW_COMPUTE(G0, AC[0]); __builtin_amdgcn_sched_barrier(0); PW_LOAD(G0, 0, sn); __builtin_amdgcn_sched_barrier(0);
            PW_COMPUTE(G1, AC[1]); __builtin_amdgcn_sched_barrier(0); PW_LOAD(G1, 1, sn); __builtin_amdgcn_sched_barrier(0);
            PW_COMPUTE(G2, AC[2]); __builtin_amdgcn_sched_barrier(0); PW_LOAD(G2, 2, sn); __builtin_amdgcn_sched_barrier(0);
            PW_COMPUTE(G3, AC[3]); __builtin_amdgcn_sched_barrier(0); PW_LOAD(G3, 3, sn); __builtin_amdgcn_sched_barrier(0);
#pragma unroll
            for (int s = 0; s < 4; ++s) AC[s] = AN[s];
            int s1[8], s2[4];
#pragma unroll
            for (int q = 0; q < 8; ++q) { const auto rr = __builtin_amdgcn_permlane32_swap((unsigned)acc[q], (unsigned)acc[8 + q], false, false); s1[q] = (int)rr[0] + (int)rr[1]; }
#pragma unroll
            for (int q = 0; q < 4; ++q) { const auto rr = __builtin_amdgcn_permlane16_swap((unsigned)s1[q], (unsigned)s1[4 + q], false, false); s2[q] = (int)rr[0] + (int)rr[1]; }
#pragma unroll
            for (int q = 0; q < 4; ++q) s2[q] += __builtin_amdgcn_update_dpp(0, s2[q], 0x128, 0xf, 0xf, true);
            f32x2v o;
            o.x = bflo(xw) + g2.x * (sat * (float)(hb ? s2[2] : s2[0])); o.y = bfhi(xw) + g2.y * (sat * (float)(hb ? s2[3] : s2[1]));
            __builtin_nontemporal_store(o, (f32x2v*)(AP_out + (size_t)token * D + d0));
        }
        __builtin_amdgcn_s_barrier();
    }
#undef PW_META
#undef PW_LOAD
#undef PW_COL
#undef PW_COMPUTE
}
__device__ __forceinline__ void peer_eval_phase(const Frame& F, const Args& A) { float sa[8]; peer_u_phase(F, A, sa); peer_v_phase_valu(F, A); }

template <bool FUSED, int ONLY>
__global__ void __launch_bounds__(NWAVES * 64, 2) mk_fwd(Args args) {
    extern __shared__ __attribute__((aligned(16))) unsigned char lds[];
    Frame F;
    F.lds = (LAS unsigned char*)lds;
    F.wave = __builtin_amdgcn_readfirstlane((int)threadIdx.x >> 6);
    F.G = gridDim.x; { const int bx = blockIdx.x; F.vcu = (F.G % 8 == 0) ? (bx % 8) * (F.G / 8) + bx / 8 : bx; }
    const Args& A = args;
    const int lo = (ONLY >= 0) ? ONLY : args.ph_lo, hi = (ONLY >= 0) ? ONLY + 1 : args.ph_hi;
#define IN(k) ((ONLY < 0 || ONLY == (k)) && lo <= (k) && (k) < hi)
    XcdBarrier bar; bar.bar = (unsigned*)(args.ws + WS_CTL); bar.x = 0; bar.st = (volatile LAS unsigned*)(F.lds + MISC_OFF);
    if constexpr (FUSED) {
        if (MK_CG_SYNC) cg::this_grid().sync();
        bar.x = xb_xcc_id();
        if (F.wave == 0 && lane_id() == 0) { bar.st[0] = 0u; bar.st[1] = 0u; (void)xb_add(&bar.bar[XB_XCNT(bar.x)], 1u); }
        __syncthreads();
    }
#define SEAM(k) do { if (FUSED && IN(k) && IN((k) + 1)) { xcd_barrier(bar, F.wave, (unsigned)F.G); } } while (0)

    if (IN(0)) { p0_prologue(F, A); } SEAM(0);
    if (IN(1)) { p1_norm1(F, A); } SEAM(1);
    if (IN(2)) {
        { pg8::Gemm g{(const bf16*)AP_H8, (const bf16*)AP_WIN8, M, NPROJ, D / 2}; pg8::StaticOrder S; S.init(M, NPROJ, F.G, (int)blockIdx.x);
          EpiProj E{AP_Q, AP_K, AP_VTR, AP_BG, AP_CG, AP_U, AP_qn, AP_kn, (LAS float*)(F.lds + XCH_OFF), 0, 11, 0.08838834764831845f * LOG2E, AP_HS, AP_WINS};
          pg8::gemm_phase<EpiProj, pg8::StaticOrder, true, true, true>(F.lds, g, S, E, F.wave); }
        { pg8::Gemm g{(const bf16*)AP_HC8, (const bf16*)(AP_WIN8 + (size_t)DA * D), MC, 2 * DA, D / 2}; pg8::StaticOrder S; S.init(MC, 2 * DA, F.G, (int)blockIdx.x);
          EpiProj E{nullptr, AP_KC, AP_VCT, nullptr, nullptr, nullptr, AP_qn, AP_kn, (LAS float*)(F.lds + XCH_OFF), 1, 8, 1.f, AP_HCS, AP_WINS + DA};
          pg8::gemm_phase<EpiProj, pg8::StaticOrder, true, true, true>(F.lds, g, S, E, F.wave); }
    } SEAM(2);
    if (IN(3)) { attn_phase(F, A); conv_phase(F, A); } SEAM(3);
    if (IN(4)) { pg8::Gemm g{(const bf16*)AP_A28, (const bf16*)AP_WOUT8, M, D, D / 2}; pg8::StaticOrder S; S.init(M, D, F.G, (int)blockIdx.x);
        EpiRes E{AP_x, AP_X1B, AP_MOD, 2 * D, AP_WOUTS, A2_SCALE};
        pg8::gemm_phase<EpiRes, pg8::StaticOrder, true, true, true>(F.lds, g, S, E, F.wave); } SEAM(4);
    if (IN(5)) { p5_norm2(F, A); } SEAM(5);
    if (IN(6)) { pg8::Gemm g{(const bf16*)AP_H2Q, (const bf16*)AP_WPQ8, M, D, D / 2}; pg8::StaticOrder S; S.init(M, D, F.G, (int)blockIdx.x);
        EpiBf16 E{AP_QP, D, AP_H2S, AP_WPQS};
        pg8::gemm_phase<EpiBf16, pg8::StaticOrder, true, true, true>(F.lds, g, S, E, F.wave); } SEAM(6);
    if (IN(7)) { peer_select_phase(F, A); } SEAM(7);
    if (IN(8)) { peer_eval_phase(F, A); }
#undef IN
#undef SEAM
}

template <int PHS> static bool set_lds() { return hipFuncSetAttribute((const void*)mk_fwd<false, PHS>, hipFuncAttributeMaxDynamicSharedMemorySize, LDS_BYTES) == hipSuccess; }
template <int PHS> static void launch_one(int grid, hipStream_t stream, const Args& a) {
    hipLaunchKernelGGL((mk_fwd<false, PHS>), dim3(grid), dim3(NWAVES * 64), LDS_BYTES, stream, a);
    const hipError_t le = hipPeekAtLastError();
    if (le != hipSuccess) fprintf(stderr, "kernel_launch: launch %d failed: %s\n", PHS, hipGetErrorName(le));
}
extern "C" void kernel_launch(void* const* d_in, const int* in_sizes, int n_in, void* d_out, int out_size, void* d_ws, size_t ws_size, hipStream_t stream) {
    constexpr bool FUSED = (MK_N_LAUNCHES == 1);
    static int grid = 0;
    if (grid == 0) {
        if (n_in != 20 || in_sizes[0] != M * D || out_size != M * D || ws_size < WS_END) { fprintf(stderr, "kernel_launch: unexpected shapes (n_in %d, in0 %d, out %d, ws %zu < %zu); nothing launched\n", n_in, n_in > 0 ? in_sizes[0] : -1, out_size, ws_size, (size_t)WS_END); grid = -1; return; }
        int dev = 0, cus = 0, per_cu = 0;
        if (hipGetDevice(&dev) != hipSuccess || hipDeviceGetAttribute(&cus, hipDeviceAttributeMultiprocessorCount, dev) != hipSuccess) { grid = -1; return; }
        bool okattr = true;
        if constexpr (FUSED) okattr = hipFuncSetAttribute((const void*)mk_fwd<true, -1>, hipFuncAttributeMaxDynamicSharedMemorySize, LDS_BYTES) == hipSuccess;
        else { okattr &= set_lds<0>(); okattr &= set_lds<1>(); okattr &= set_lds<2>(); okattr &= set_lds<3>(); okattr &= set_lds<4>(); okattr &= set_lds<5>(); okattr &= set_lds<6>(); okattr &= set_lds<7>(); okattr &= set_lds<8>(); }
        if (!okattr) { fprintf(stderr, "kernel_launch: hipFuncSetAttribute failed\n"); grid = -1; return; }
        if (hipOccupancyMaxActiveBlocksPerMultiprocessor(&per_cu, (const void*)mk_fwd<FUSED, (FUSED ? -1 : 2)>, NWAVES * 64, LDS_BYTES) != hipSuccess || per_cu < 1) { fprintf(stderr, "kernel_launch: occupancy query says %d blocks per CU; nothing launched\n", per_cu); grid = -1; return; }
        (void)hipGetLastError();
        grid = cus;
        if (grid != 256) fprintf(stderr, "kernel_launch: note: %d CUs (built for 256)\n", grid);
    }
    if (grid < 0) return;
    Args a{};
    for (int i = 0; i < 20; ++i) a.in[i] = (const float*)d_in[i];
    a.out = (float*)d_out; a.ws = (unsigned char*)d_ws;
    if constexpr (FUSED) {
        a.ph_lo = 0; a.ph_hi = NPHASE;
        if (hipMemsetAsync((char*)d_ws + WS_CTL, 0, 128 * 1024, stream) != hipSuccess) { fprintf(stderr, "kernel_launch: memset of the barrier words failed\n"); return; }
        void* kargs[] = {&a};
        hipError_t e;
        if (MK_CG_SYNC) e = hipLaunchCooperativeKernel((const void*)mk_fwd<true, -1>, dim3(grid), dim3(NWAVES * 64), kargs, LDS_BYTES, stream);
        else { hipLaunchKernelGGL((mk_fwd<true, -1>), dim3(grid), dim3(NWAVES * 64), LDS_BYTES, stream, a); e = hipPeekAtLastError(); }
        if (e != hipSuccess) fprintf(stderr, "kernel_launch: launch failed: %s (grid %d)\n", hipGetErrorString(e), grid);
    } else {
        a.ph_lo = 0; a.ph_hi = NPHASE;
        launch_one<0>(grid, stream, a); launch_one<1>(grid, stream, a); launch_one<2>(grid, stream, a); launch_one<3>(grid, stream, a); launch_one<4>(grid, stream, a);
        launch_one<5>(grid, stream, a); launch_one<6>(grid, stream, a); launch_one<7>(grid, stream, a); launch_one<8>(grid, stream, a);
    }
}
```

```cpp
#include <hip/hip_runtime.h>
#include <hip/hip_cooperative_groups.h>
#include <cstdio>
#include <cstdint>
namespace cg = cooperative_groups;
#define MK_N_LAUNCHES 1
namespace pg8 {
#define PG8_LAS __attribute__((address_space(3)))
typedef unsigned short bf16_t;
typedef short bf16x8 __attribute__((ext_vector_type(8)));
typedef float f32x4 __attribute__((ext_vector_type(4)));
typedef unsigned u32x4 __attribute__((ext_vector_type(4)));
constexpr int BM = 256, BK = 64, HALF = 128, HTB = HALF * BK * 2  , STAGE_BYTES = 8 * HTB, NXCD = 8, WGM = 4;

__host__ __device__ __forceinline__ int lds_byte(int r, int c) { const int st = (r >> 4) * 2 + (c >> 5), rr = r & 15, cc = c & 31, ob = rr * 64 + cc * 2; return st * 1024 + (ob ^ (((ob >> 9) & 1) << 5)); }
__host__ __device__ __forceinline__ void stage_rc(int b, int& R, int& C) { const int st = b / 1024, sb = b % 1024, swz = sb ^ (((sb >> 9) & 1) << 5); R = (st >> 1) * 16 + swz / 64; C = (st & 1) * 32 + (swz % 64) / 2; }
__host__ __device__ __forceinline__ int perm32(int rho) { const int n = rho >> 4, i = rho & 15; return 8 * (i >> 2) + 4 * n + (i & 3); }

struct Unit { int pm, pn; };
struct Gemm { const bf16_t* A; const bf16_t* Bt; int M, N, K; };

struct StaticOrder {
    int nM, nN, nwg, G, c;
    __host__ __device__ void init(int M, int N, int G_, int c_) { nM = M / BM; nN = N / BM; nwg = nM * nN; G = G_; c = c_; }
    __host__ __device__ bool next(int i, Unit& u) const {
        const long L = (long)i * G + c; if (L >= nwg) return false;
        int wgid = (int)L; { const int q = nwg / NXCD, r = nwg % NXCD, xcd = wgid % NXCD, off = wgid / NXCD; wgid = (xcd < r ? xcd * (q + 1) : r * (q + 1) + (xcd - r) * q) + off; }
        const int nig = WGM * nN, gid = wgid / nig, fm = gid * WGM, gsz = (nM - fm) < WGM ? (nM - fm) : WGM;
        u.pm = fm + ((wgid % nig) % gsz); u.pn = (wgid % nig) / gsz; return true;
    }
    __device__ __forceinline__ void a_ready(const Unit&) const {}
    __device__ __forceinline__ void done(const Unit&) const {}
};

__device__ __forceinline__ unsigned cvt_pk_bf16(float lo, float hi) { unsigned r; asm volatile("v_cvt_pk_bf16_f32 %0, %1, %2" : "=v"(r) : "v"(lo), "v"(hi)); return r; }
typedef float f32x2 __attribute__((ext_vector_type(2)));
template <class Epi, class Sched, bool ALIGN_EPI = false, bool SP2 = false, bool I8 = false>
__device__ __forceinline__ void gemm_phase(PG8_LAS unsigned char* lds, const Gemm g, const Sched& S, const Epi& E, const int wid) {
    int lane; asm volatile("v_mbcnt_lo_u32_b32 %0, -1, 0\n\tv_mbcnt_hi_u32_b32 %0, -1, %0" : "=v"(lane)); const int tid = wid * 64 + lane, wr = wid >> 2, wc = wid & 3, fr = lane & 15, fq = lane >> 4;
    const int K = g.K, nt = K / BK;
    unsigned voffA[2], voffB[2];
#pragma unroll
    for (int i = 0; i < 2; ++i) { int R, C; stage_rc(tid * 16 + i * 8192, R, C); const int Rb = Epi::PERM ? ((R & ~31) + perm32(R & 31)) : R;
        voffA[i] = (unsigned)(R * K + C) * 2u; voffB[i] = (unsigned)(Rb * K + C) * 2u; }
    const size_t kstep = (size_t)(BK * 2);
    const size_t hstep = (size_t)HALF * K * 2;
    const size_t tstep = 2 * hstep;
    const unsigned ldsw = (unsigned)wid * 1024u;
    const int aoff = lds_byte(wr * 64 + fr, fq * 8), boff = lds_byte(wc * 32 + fr, fq * 8);
#define PG8_SA(b, h) (((b) * 2 + (h)) * HTB)
#define PG8_SB(b, h) ((4 + (b) * 2 + (h)) * HTB)
#define PG8_STAGE(bufoff, gbase, voff) do { _Pragma("unroll") for (int _i = 0; _i < 2; ++_i) \
        __builtin_amdgcn_global_load_lds((const unsigned*)((const char*)(gbase) + (voff)[_i]), (PG8_LAS unsigned*)(lds + (bufoff) + ldsw + _i * 8192), 16, 0, 0); } while (0)
#define PG8_LDA(dst, b, h) do { _Pragma("unroll") for (int m = 0; m < 4; ++m) _Pragma("unroll") for (int k = 0; k < 2; ++k) dst[m][k] = *(const PG8_LAS bf16x8*)(lds + PG8_SA(b, h) + aoff + m * 2048 + k * 1024); } while (0)
#define PG8_LDB(dst, b, h) do { _Pragma("unroll") for (int n = 0; n < 2; ++n) _Pragma("unroll") for (int k = 0; k < 2; ++k) dst[n][k] = *(const PG8_LAS bf16x8*)(lds + PG8_SB(b, h) + boff + n * 2048 + k * 1024); } while (0)
#define PG8_MMA(ai, bj, At, Bt) do { __builtin_amdgcn_s_setprio(1); _Pragma("unroll") for (int m = 0; m < 4; ++m) _Pragma("unroll") for (int n = 0; n < 2; ++n) _Pragma("unroll") for (int k = 0; k < 2; ++k) \
        { if constexpr (I8) { typedef int v4i_ __attribute__((ext_vector_type(4))); acc[ai][bj][m][n] = __builtin_bit_cast(f32x4, __builtin_amdgcn_mfma_i32_16x16x64_i8(__builtin_bit_cast(v4i_, Bt[n][k]), __builtin_bit_cast(v4i_, At[m][k]), __builtin_bit_cast(v4i_, acc[ai][bj][m][n]), 0, 0, 0)); } \
          else acc[ai][bj][m][n] = __builtin_amdgcn_mfma_f32_16x16x32_bf16(Bt[n][k], At[m][k], acc[ai][bj][m][n], 0, 0, 0); } __builtin_amdgcn_s_setprio(0); } while (0)
#define PG8_WAIT_V(n) asm volatile("s_waitcnt vmcnt(" #n ")" ::: "memory")
#define PG8_WAIT_L(n) asm volatile("s_waitcnt lgkmcnt(" #n ")" ::: "memory")
#define PG8_BAR __builtin_amdgcn_s_barrier()
#define PG8_SCHED __builtin_amdgcn_sched_barrier(0)
    Unit cur, nxt; int ui = 0;
    if (!S.next(0, cur)) return;
    f32x4 acc[2][2][4][2];
#pragma unroll
    for (int a = 0; a < 2; ++a)
#pragma unroll
        for (int b = 0; b < 2; ++b)
#pragma unroll
            for (int m = 0; m < 4; ++m)
#pragma unroll
                for (int n = 0; n < 2; ++n) acc[a][b][m][n] = (f32x4){0.f, 0.f, 0.f, 0.f};
    bf16x8 At[4][2], B0[2][2], B1[2][2];
    const char* cA = (const char*)g.A + (size_t)cur.pm * tstep; const char* cB = (const char*)g.Bt + (size_t)cur.pn * tstep;
    S.a_ready(cur);
    if constexpr (SP2) {
        PG8_STAGE(PG8_SB(0, 0), cB, voffB); PG8_STAGE(PG8_SB(0, 1), cB + hstep, voffB); PG8_STAGE(PG8_SA(0, 0), cA, voffA); PG8_STAGE(PG8_SA(0, 1), cA + hstep, voffA);
        if (wr == 1) PG8_BAR;
        PG8_WAIT_V(2); PG8_BAR;
        PG8_STAGE(PG8_SB(1, 0), cB + kstep, voffB); PG8_STAGE(PG8_SA(1, 0), cA + kstep, voffA); PG8_STAGE(PG8_SB(1, 1), cB + hstep + kstep, voffB);
        PG8_WAIT_V(6); PG8_BAR;
    } else {
        PG8_STAGE(PG8_SB(0, 0), cB, voffB); PG8_STAGE(PG8_SA(0, 0), cA, voffA); PG8_STAGE(PG8_SB(0, 1), cB + hstep, voffB); PG8_STAGE(PG8_SA(0, 1), cA + hstep, voffA);
        if (wr == 1) PG8_BAR;
        PG8_WAIT_V(4); PG8_BAR;
        PG8_STAGE(PG8_SB(1, 0), cB + kstep, voffB); PG8_STAGE(PG8_SA(1, 0), cA + kstep, voffA); PG8_STAGE(PG8_SB(1, 1), cB + hstep + kstep, voffB);
        PG8_WAIT_V(6); PG8_BAR;
    }
    for (;;) {
        const bool has_next = S.next(ui + 1, nxt);
        const char* nA = has_next ? (const char*)g.A + (size_t)nxt.pm * tstep : cA; const char* nB = has_next ? (const char*)g.Bt + (size_t)nxt.pn * tstep : cB;
        for (int t = 0; t < nt; t += 2) {
            const bool last = (t == nt - 2);
            const char* a1 = cA + (size_t)(t + 1) * kstep;
            const char* a2 = last ? nA : cA + (size_t)(t + 2) * kstep; const char* b2 = last ? nB : cB + (size_t)(t + 2) * kstep;
            const char* a3 = a2 + kstep; const char* b3 = b2 + kstep;
            if (last && has_next) S.a_ready(nxt);
            if constexpr (SP2) {
            PG8_LDB(B0, 0, 0); PG8_LDB(B1, 0, 1); PG8_SCHED; PG8_LDA(At, 0, 0); PG8_STAGE(PG8_SA(1, 1), a1 + hstep, voffA);
            PG8_WAIT_V(8); PG8_WAIT_L(0); PG8_BAR; PG8_MMA(0, 0, At, B0); PG8_MMA(0, 1, At, B1); PG8_BAR; PG8_SCHED;
            PG8_LDA(At, 0, 1); PG8_STAGE(PG8_SB(0, 0), b2, voffB); PG8_STAGE(PG8_SB(0, 1), b2 + hstep, voffB); PG8_STAGE(PG8_SA(0, 0), a2, voffA);
            PG8_WAIT_V(8); PG8_WAIT_L(0); PG8_BAR; PG8_MMA(1, 0, At, B0); PG8_MMA(1, 1, At, B1); PG8_BAR; PG8_SCHED;
            PG8_LDB(B0, 1, 0); PG8_LDB(B1, 1, 1); PG8_SCHED; PG8_LDA(At, 1, 0); PG8_STAGE(PG8_SA(0, 1), a2 + hstep, voffA);
            PG8_WAIT_V(8); PG8_WAIT_L(0); PG8_BAR; PG8_MMA(0, 0, At, B0); PG8_MMA(0, 1, At, B1); PG8_BAR; PG8_SCHED;
            PG8_LDA(At, 1, 1); PG8_STAGE(PG8_SB(1, 0), b3, voffB); PG8_STAGE(PG8_SB(1, 1), b3 + hstep, voffB); PG8_STAGE(PG8_SA(1, 0), a3, voffA);
            PG8_WAIT_V(8); PG8_WAIT_L(0); PG8_BAR; PG8_MMA(1, 0, At, B0); PG8_MMA(1, 1, At, B1); PG8_BAR; PG8_SCHED;
            } else {
            PG8_LDB(B0, 0, 0); PG8_SCHED; PG8_LDA(At, 0, 0); PG8_STAGE(PG8_SA(1, 1), a1 + hstep, voffA);
            PG8_WAIT_L(8); PG8_BAR; PG8_WAIT_L(0); PG8_MMA(0, 0, At, B0); PG8_BAR; PG8_SCHED;
            PG8_LDB(B1, 0, 1); PG8_STAGE(PG8_SB(0, 0), b2, voffB);
            PG8_BAR; PG8_WAIT_L(0); PG8_MMA(0, 1, At, B1); PG8_BAR;
            PG8_LDA(At, 0, 1); PG8_STAGE(PG8_SA(0, 0), a2, voffA);
            PG8_BAR; PG8_WAIT_L(0); PG8_MMA(1, 0, At, B0); PG8_BAR; PG8_SCHED;
            PG8_STAGE(PG8_SB(0, 1), b2 + hstep, voffB);
            PG8_WAIT_V(6); PG8_BAR; PG8_MMA(1, 1, At, B1); PG8_BAR;
            PG8_LDB(B0, 1, 0); PG8_SCHED; PG8_LDA(At, 1, 0); PG8_STAGE(PG8_SA(0, 1), a2 + hstep, voffA);
            PG8_WAIT_L(8); PG8_BAR; PG8_WAIT_L(0); PG8_MMA(0, 0, At, B0); PG8_BAR; PG8_SCHED;
            PG8_LDB(B1, 1, 1); PG8_STAGE(PG8_SB(1, 0), b3, voffB);
            PG8_BAR; PG8_WAIT_L(0); PG8_MMA(0, 1, At, B1); PG8_BAR;
            PG8_LDA(At, 1, 1); PG8_STAGE(PG8_SA(1, 0), a3, voffA);
            PG8_BAR; PG8_WAIT_L(0); PG8_MMA(1, 0, At, B0); PG8_BAR; PG8_SCHED;
            PG8_STAGE(PG8_SB(1, 1), b3 + hstep, voffB);
            PG8_WAIT_V(6); PG8_BAR; PG8_MMA(1, 1, At, B1); PG8_BAR;
            }
        }
        if constexpr (ALIGN_EPI) { if (wr == 0) PG8_BAR; }
        if constexpr (!Epi::AFTER_DRAIN) { E(acc, cur, wr, wc, fr, fq); S.done(cur); }
        if (!has_next) break;
#pragma unroll
        for (int a = 0; a < 2; ++a)
#pragma unroll
            for (int b = 0; b < 2; ++b)
#pragma unroll
                for (int m = 0; m < 4; ++m)
#pragma unroll
                    for (int n = 0; n < 2; ++n) acc[a][b][m][n] = (f32x4){0.f, 0.f, 0.f, 0.f};
        cur = nxt; cA = nA; cB = nB; ++ui;
        if constexpr (ALIGN_EPI) { if (wr == 1) PG8_BAR; }
    }
    PG8_WAIT_V(0);
    if constexpr (!ALIGN_EPI) { if (wr == 0) PG8_BAR; }
    PG8_BAR;
    if constexpr (Epi::AFTER_DRAIN) { E.fused(acc, cur, wr, wc, fr, fq, lds, wid, lane); S.done(cur); }
#undef PG8_SA
#undef PG8_SB
#undef PG8_STAGE
#undef PG8_LDA
#undef PG8_LDB
#undef PG8_MMA
#undef PG8_WAIT_V
#undef PG8_WAIT_L
#undef PG8_BAR
#undef PG8_SCHED
}
}

#ifndef MK_N_LAUNCHES
#define MK_N_LAUNCHES 1
#endif
constexpr int NPHASE = 9;

constexpr int D = 2048, NB = 8, SEQ = 2048, M = NB * SEQ, CTXL = 256, MC = NB * CTXL;
constexpr int NH = 8, HD = 128, DA = 1024, NPROJ = 6144, GW = 64;
constexpr int NEXP = 16384, PH = 8, PK = 16, NKEYS = 128;
constexpr float EPS = 1e-6f, LOG2E = 1.4426950408889634f;
constexpr int NWAVES = 8;
constexpr float A2_SCALE = 10.0f / 127.0f, A2_INV = 127.0f / 10.0f;

constexpr size_t MiB = 1u << 20;
constexpr size_t WS_CTL = 0, WS_MOD = 1 * MiB, WS_SK = 2 * MiB, WS_WIN = 4 * MiB, WS_WOUT = 28 * MiB, WS_WPQ = 36 * MiB;
constexpr size_t WS_UT = 44 * MiB, WS_VT = 108 * MiB, WS_ACT = 172 * MiB, WS_HC = 236 * MiB;
constexpr size_t WS_Q = 244 * MiB, WS_K = 276 * MiB, WS_VTR = 308 * MiB, WS_BG = 340 * MiB, WS_CG = 372 * MiB, WS_U = 404 * MiB;
constexpr size_t WS_KC = 436 * MiB, WS_VCT = 440 * MiB, WS_QP = 244 * MiB  ;
constexpr size_t WS_SELI = 444 * MiB, WS_SELG = 452 * MiB, WS_AVW = 460 * MiB, WS_END = 468 * MiB;
constexpr size_t WS_U8 = WS_UT, WS_V8 = WS_UT + 32 * MiB, WS_SU = WS_VT, WS_SV = WS_VT + 64 * 1024, WS_H2S = WS_VT + 128 * 1024, WS_H2Q = WS_VT + 1 * MiB;

constexpr int LDS_BYTES = 147456;
constexpr int XCH_OFF = 131072;
constexpr int MISC_OFF = 131072 + 8192;
#ifndef MK_CG_SYNC
#define MK_CG_SYNC 0
#endif
#define MK_COOP_LAUNCH 1

#define GAS __attribute__((address_space(1)))
#define LAS __attribute__((address_space(3)))
typedef unsigned short bf16;
typedef unsigned v4u __attribute__((ext_vector_type(4)));
typedef unsigned v2u __attribute__((ext_vector_type(2)));
typedef float f32x4 __attribute__((ext_vector_type(4)));
typedef float f32x16 __attribute__((ext_vector_type(16)));
typedef short bf16x8 __attribute__((ext_vector_type(8)));
typedef __bf16 bf16x2 __attribute__((ext_vector_type(2)));
#define LDS_WAIT() asm volatile("s_waitcnt lgkmcnt(0)" ::: "memory")

__device__ __forceinline__ unsigned f2bf(float f) { unsigned u = __builtin_bit_cast(unsigned, f); return (u + 0x7fffu + ((u >> 16) & 1u)) >> 16; }
__device__ __forceinline__ unsigned pk2(float lo, float hi) { return pg8::cvt_pk_bf16(lo, hi); }
__device__ __forceinline__ float bflo(unsigned w) { return __builtin_bit_cast(float, w << 16); }
__device__ __forceinline__ float bfhi(unsigned w) { return __builtin_bit_cast(float, w & 0xffff0000u); }
__device__ __forceinline__ float dot2_bf16(unsigned w, unsigned x, float acc) { return __builtin_amdgcn_fdot2_f32_bf16(__builtin_bit_cast(bf16x2, w), __builtin_bit_cast(bf16x2, x), acc, false); }
__device__ __forceinline__ float wave_sum(float v) {
#pragma unroll
    for (int o = 1; o < 64; o <<= 1) v += __shfl_xor(v, o);
    return v;
}

struct Args { const float* in[20]; float* out; unsigned char* ws; int ph_lo, ph_hi; };
struct Frame {
    LAS unsigned char* lds;
    int wave, vcu, G;
};
__device__ __forceinline__ int lane_id() { int l; asm volatile("v_mbcnt_lo_u32_b32 %0, -1, 0\n\tv_mbcnt_hi_u32_b32 %0, -1, %0" : "=v"(l)); return l; }
#define F_LANE lane_id()
#define F_TID (F.wave * 64 + lane_id())
#define AP_x (A.in[0])
#define AP_c (A.in[1])
#define AP_ctx (A.in[2])
#define AP_c_ctx (A.in[3])
#define AP_w_ada (A.in[4])
#define AP_b_ada (A.in[5])
#define AP_g1 (A.in[6])
#define AP_w_in (A.in[7])
#define AP_qn (A.in[8])
#define AP_kn (A.in[9])
#define AP_rpb (A.in[10])
#define AP_w_conv (A.in[11])
#define AP_gao (A.in[12])
#define AP_gco (A.in[13])
#define AP_w_out (A.in[14])
#define AP_g2 (A.in[15])
#define AP_w_pq (A.in[16])
#define AP_subk (A.in[17])
#define AP_uex (A.in[18])
#define AP_vex (A.in[19])
#define AP_SK ((bf16*)(A.ws + WS_SK))
#define AP_WIN ((bf16*)(A.ws + WS_WIN))
#define AP_WOUT ((bf16*)(A.ws + WS_WOUT))
#define AP_WPQ ((bf16*)(A.ws + WS_WPQ))
#define AP_UT ((bf16*)(A.ws + WS_UT))
#define AP_VT ((bf16*)(A.ws + WS_VT))
#define AP_ACT ((bf16*)(A.ws + WS_ACT))
#define AP_HC ((bf16*)(A.ws + WS_HC))
#define AP_Q ((bf16*)(A.ws + WS_Q))
#define AP_K ((bf16*)(A.ws + WS_K))
#define AP_VTR ((bf16*)(A.ws + WS_VTR))
#define AP_BG ((bf16*)(A.ws + WS_BG))
#define AP_CG ((bf16*)(A.ws + WS_CG))
#define AP_U ((bf16*)(A.ws + WS_U))
#define AP_KC ((bf16*)(A.ws + WS_KC))
#define AP_VCT ((bf16*)(A.ws + WS_VCT))
#define AP_QP ((bf16*)(A.ws + WS_QP))
#define AP_MOD ((float*)(A.ws + WS_MOD))
#define AP_SELI ((int*)(A.ws + WS_SELI))
#define AP_SELG ((float*)(A.ws + WS_SELG))
#define AP_AVW ((float*)(A.ws + WS_AVW))
#define AP_WIN8 ((unsigned char*)(A.ws + WS_WIN))
#define AP_WINS ((float*)(A.ws + WS_WIN + 16 * MiB))
#define AP_WOUT8 ((unsigned char*)(A.ws + WS_WOUT))
#define AP_WOUTS ((float*)(A.ws + WS_WOUT + 5 * MiB))
#define AP_CPARTO ((float*)(A.ws + WS_WOUT + 6 * MiB))
#define AP_A28 ((unsigned char*)(A.ws + WS_ACT))
#define AP_WPQ8 ((unsigned char*)(A.ws + WS_WPQ))
#define AP_WPQS ((float*)(A.ws + WS_WPQ + 5 * MiB))
#define AP_CPARTQ ((float*)(A.ws + WS_WPQ + 6 * MiB))
#define AP_CPART ((float*)(A.ws + WS_WIN + 17 * MiB))
#define AP_H8 ((unsigned char*)(A.ws + WS_ACT))
#define AP_HC8 ((unsigned char*)(A.ws + WS_HC))
#define AP_HS ((float*)(A.ws + WS_HC + 4 * MiB))
#define AP_HCS ((float*)(A.ws + WS_HC + 4 * MiB + 65536))
#define AP_X1B ((bf16*)(A.ws + WS_BG))
#define AP_out (A.out)
#define AP_U8 ((const unsigned char*)(A.ws + WS_U8))
#define AP_V8 ((const unsigned char*)(A.ws + WS_V8))
#define AP_SU ((float*)(A.ws + WS_SU))
#define AP_SV ((float*)(A.ws + WS_SV))
#define AP_H2S ((float*)(A.ws + WS_H2S))
#define AP_H2Q ((unsigned char*)(A.ws + WS_H2Q))


#define XB_TMO      128
#define XB_XCNT(j)  (256  + 64 * (j))
#define XB_XSUB(j)  (1280 + 64 * (j))
#define XB_XGEN(j)  (2304 + 64 * (j))
#define XB_TOP      3328
#define XB_TOPGEN   3392
#define XCD_BAR_WORDS 3456
#define XB_SPIN_CAP (1u << 22)
__device__ __forceinline__ unsigned xb_ld(unsigned* p)              { return __hip_atomic_load(p, __ATOMIC_RELAXED, __HIP_MEMORY_SCOPE_AGENT); }
__device__ __forceinline__ unsigned xb_add(unsigned* p, unsigned v) { return __hip_atomic_fetch_add(p, v, __ATOMIC_RELAXED, __HIP_MEMORY_SCOPE_AGENT); }
__device__ __forceinline__ unsigned xb_xcc_id() { return (unsigned)__builtin_amdgcn_s_getreg((3 << 11) | 20) & 0xFu; }
#define XB_SPIN(cond, bar) do { unsigned _sp = 0; while (cond) { __builtin_amdgcn_s_sleep(1); \
    if ((++_sp & 255u) == 0u) { if (xb_ld(&(bar)[XB_TMO])) break; if (_sp > XB_SPIN_CAP) { atomicAdd(&(bar)[XB_TMO], 1u); break; } } } } while (0)
struct XcdBarrier { unsigned* bar; unsigned x; volatile LAS unsigned* st; };
__device__ __forceinline__ void xcd_barrier_complete(unsigned* bar, unsigned x, unsigned G, unsigned& nloc, unsigned& nx) {
    unsigned sum, cnt, mine, sp = 0u;
    for (;;) {
        sum = 0u; cnt = 0u; mine = 0u;
#pragma unroll
        for (unsigned j = 0; j < 16; ++j) { const unsigned c = xb_ld(&bar[XB_XCNT(j)]); sum += c; cnt += (c > 0u) ? 1u : 0u; mine = (j == x) ? c : mine; }
        if (sum == G) break;
        __builtin_amdgcn_s_sleep(1);
        if ((++sp & 255u) == 0u) { if (xb_ld(&bar[XB_TMO])) break; if (sp > XB_SPIN_CAP) { atomicAdd(&bar[XB_TMO], 1u); break; } }
    }
    nloc = mine > 0u ? mine : 1u; nx = cnt > 0u ? cnt : 1u;
}
__device__ __forceinline__ void xcd_barrier(const XcdBarrier& b, const int wave, const unsigned G) {
    asm volatile("s_waitcnt vmcnt(0)" ::: "memory");
    __syncthreads();
    if (wave == 0 && lane_id() == 0) {
        unsigned* bar = b.bar;
        __builtin_amdgcn_s_waitcnt(0);
        unsigned nloc = b.st[0], nx = b.st[1];
        if (nloc == 0u) { xcd_barrier_complete(bar, b.x, G, nloc, nx); b.st[0] = nloc; b.st[1] = nx; }
        const unsigned old = xb_add(&bar[XB_XSUB(b.x)], 1u);
        const unsigned gen = old / nloc;
        if (old + 1u == (gen + 1u) * nloc) {
            __builtin_amdgcn_fence(__ATOMIC_RELEASE, "agent");
            asm volatile("s_waitcnt vmcnt(0)" ::: "memory");
            const unsigned og = xb_add(&bar[XB_TOP], 1u);
            const unsigned tg = og / nx;
            if (og + 1u == (tg + 1u) * nx) xb_add(&bar[XB_TOPGEN], 1u);
            else XB_SPIN(xb_ld(&bar[XB_TOPGEN]) == tg, bar);
            __builtin_amdgcn_fence(__ATOMIC_ACQUIRE, "agent");
            asm volatile("s_waitcnt vmcnt(0)" ::: "memory");
        } else {
            XB_SPIN(xb_ld(&bar[XB_TOPGEN]) == gen, bar);
            __builtin_amdgcn_fence(__ATOMIC_ACQUIRE, "agent");
            asm volatile("s_waitcnt vmcnt(0)" ::: "memory");
        }
    }
    __syncthreads();
}

__device__ __forceinline__ void p0_mod(const Frame& F, const Args& A) {
    const int lane = lane_id(), tid = F.wave * 64 + lane; (void)tid;
    LAS float* sc = (LAS float*)F.lds;
    LAS float* red = (LAS float*)(F.lds + 9 * 2048 * 4);
    for (int i = tid; i < 9 * D; i += NWAVES * 64) { const int r = i >> 11, k = i & (D - 1); const float cv = (r < 8) ? AP_c[r * D + k] : AP_c_ctx[k]; sc[i] = cv / (1.f + __expf(-cv)); }
    __syncthreads();
    const int sr = lane >> 4, cq = lane & 15;
    for (int item = F.vcu; item < (6 * D) / 64; item += F.G) {
        const int n0 = item * 64;
        float acc[9][4];
#pragma unroll
        for (int r = 0; r < 9; ++r)
#pragma unroll
            for (int j = 0; j < 4; ++j) acc[r][j] = 0.f;
        const float* wp = AP_w_ada + (size_t)(F.wave * 4 + sr) * (6 * D) + n0 + 4 * cq;
#pragma unroll 8
        for (int step = 0; step < 64; ++step) {
            const int k = step * 32 + F.wave * 4 + sr;
            const f32x4 w = *(const f32x4*)(wp + (size_t)step * 32 * (6 * D));
#pragma unroll
            for (int r = 0; r < 9; ++r) { const float s = sc[r * D + k]; acc[r][0] += s * w.x; acc[r][1] += s * w.y; acc[r][2] += s * w.z; acc[r][3] += s * w.w; }
        }
#pragma unroll
        for (int r = 0; r < 9; ++r)
#pragma unroll
            for (int j = 0; j < 4; ++j) { float v = acc[r][j]; v += __shfl_xor(v, 16); v += __shfl_xor(v, 32); if (sr == 0) red[(F.wave * 9 + r) * 64 + 4 * cq + j] = v; }
        __syncthreads();
        for (int i = tid; i < 9 * 64; i += NWAVES * 64) { const int r = i >> 6, cc = i & 63; float s = 0.f;
#pragma unroll
            for (int w = 0; w < 8; ++w) s += red[(w * 9 + r) * 64 + cc];
            AP_MOD[r * (6 * D) + n0 + cc] = s + AP_b_ada[n0 + cc]; }
        __syncthreads();
    }
    __syncthreads();
}
__device__ __forceinline__ void cvt_f32_bf16(const float* src, bf16* dst, size_t n, size_t gtid, size_t gthreads) {
    for (size_t i = gtid * 8; i < n; i += gthreads * 8) { const f32x4 a = *(const f32x4*)(src + i), b = *(const f32x4*)(src + i + 4);
        v4u o; o.x = pk2(a.x, a.y); o.y = pk2(a.z, a.w); o.z = pk2(b.x, b.y); o.w = pk2(b.z, b.w); *(v4u*)(dst + i) = o; }
}
__device__ __forceinline__ float wave_max(float v) {
#pragma unroll
    for (int o = 1; o < 64; o <<= 1) v = fmaxf(v, __shfl_xor(v, o));
    return v;
}
__device__ __forceinline__ unsigned q4(const f32x4 v, const float inv, const int off = 0) {
    const int a = (int)fminf(fmaxf(__builtin_rintf(v.x * inv), -127.f), 127.f) + off, b = (int)fminf(fmaxf(__builtin_rintf(v.y * inv), -127.f), 127.f) + off, c = (int)fminf(fmaxf(__builtin_rintf(v.z * inv), -127.f), 127.f) + off, d = (int)fminf(fmaxf(__builtin_rintf(v.w * inv), -127.f), 127.f) + off;
    return (unsigned)(a & 255) | ((unsigned)(b & 255) << 8) | ((unsigned)(c & 255) << 16) | ((unsigned)(d & 255) << 24);
}
__device__ __forceinline__ void quant_row(const float* src, unsigned char* dst, float* scale, int lane, const int off) {
    const f32x4* xr = (const f32x4*)src + lane; f32x4 v[8]; float mx = 0.f;
#pragma unroll
    for (int j = 0; j < 8; ++j) { v[j] = xr[64 * j]; mx = fmaxf(mx, fmaxf(fmaxf(fabsf(v[j].x), fabsf(v[j].y)), fmaxf(fabsf(v[j].z), fabsf(v[j].w)))); }
    mx = fmaxf(wave_max(mx), 1e-30f);
    const float inv = 127.f / mx;
    unsigned* o = (unsigned*)dst + lane;
#pragma unroll
    for (int j = 0; j < 8; ++j) o[64 * j] = q4(v[j], inv, off);
    if (lane == 0) *scale = mx * (1.f / 127.f);
}
struct TrItem { const float* W; const float* cpart; unsigned char* WT; float* wscale; int N, li; };
struct TrRegs { f32x4 wv[8]; float cp[16]; };
__device__ __forceinline__ TrItem tr_item(const Args& A, int it) {
    TrItem t;
    if (it < 6144) { t.W = AP_w_in; t.cpart = AP_CPART; t.WT = AP_WIN8; t.wscale = AP_WINS; t.N = NPROJ; t.li = it; }
    else if (it < 8192) { t.W = AP_w_out; t.cpart = AP_CPARTO; t.WT = AP_WOUT8; t.wscale = AP_WOUTS; t.N = D; t.li = it - 6144; }
    else { t.W = AP_w_pq; t.cpart = AP_CPARTQ; t.WT = AP_WPQ8; t.wscale = AP_WPQS; t.N = D; t.li = it - 8192; }
    return t;
}
__device__ __forceinline__ void tr_load(const TrItem& t, TrRegs& R, int lane) {
    const int nblk = t.N / 32, kb = t.li / nblk, nb = t.li % nblk, k0 = 64 * kb, n0 = 32 * nb;
#pragma unroll
    for (int p = 0; p < 16; ++p) R.cp[p] = t.cpart[(size_t)(16 * (lane >> 5) + p) * t.N + n0 + (lane & 31)];
#pragma unroll
    for (int i = 0; i < 8; ++i) R.wv[i] = *(const f32x4*)(t.W + (size_t)(k0 + 8 * i + (lane >> 3)) * t.N + n0 + 4 * (lane & 7));
}
__device__ __forceinline__ void tr_process(const TrItem& t, const TrRegs& R, LAS float* scr, int lane) {
    constexpr int K = D;
    const int nblk = t.N / 32, kb = t.li / nblk, nb = t.li % nblk, k0 = 64 * kb, n0 = 32 * nb;
    { float cm = 0.f;
#pragma unroll
      for (int p = 0; p < 16; ++p) cm = fmaxf(cm, R.cp[p]);
      cm = fmaxf(cm, __shfl_xor(cm, 32));
      scr[64 * 33 + (lane & 31)] = cm; }
#pragma unroll
    for (int i = 0; i < 8; ++i) { LAS float* d = scr + (8 * i + (lane >> 3)) * 33 + 4 * (lane & 7); d[0] = R.wv[i].x; d[1] = R.wv[i].y; d[2] = R.wv[i].z; d[3] = R.wv[i].w; }
    LDS_WAIT(); asm volatile("" ::: "memory");
    const int c = lane & 7;
#pragma unroll
    for (int j = 0; j < 4; ++j) { const int n = (lane >> 3) + 8 * j; const LAS float* sp = scr + (8 * c) * 33 + n;
        const float mx = fmaxf(scr[64 * 33 + n], 1e-30f), inv = 127.f / mx;
        f32x4 a = {sp[0 * 33], sp[1 * 33], sp[2 * 33], sp[3 * 33]}, b = {sp[4 * 33], sp[5 * 33], sp[6 * 33], sp[7 * 33]};
        v2u o; o.x = q4(a, inv); o.y = q4(b, inv);
        int nd = n0 + n; if (t.N == NPROJ && nd >= 4 * DA) { const int ch = (nd - 4 * DA) & (DA - 1), isu = (nd - 4 * DA) >> 10; nd = 4 * DA + 256 * (ch >> 7) + 128 * isu + (ch & 127); }
        *(v2u*)(t.WT + (size_t)nd * K + k0 + 8 * c) = o;
        if (kb == 0 && c == 0) t.wscale[nd] = mx * (1.f / 127.f); }
    LDS_WAIT(); asm volatile("" ::: "memory");
}
__device__ __forceinline__ void table_row(const Args& A, int e, int lane) {
    const f32x4* ur = (const f32x4*)(AP_uex + (size_t)e * D) + lane; const f32x4* vr = (const f32x4*)(AP_vex + (size_t)e * D) + lane;
    f32x4 uv[8], vv[8]; float mu = 0.f, mv = 0.f;
#pragma unroll
    for (int j = 0; j < 8; ++j) { uv[j] = __builtin_nontemporal_load(ur + 64 * j); vv[j] = __builtin_nontemporal_load(vr + 64 * j); }
#pragma unroll
    for (int j = 0; j < 8; ++j) { mu = fmaxf(mu, fmaxf(fmaxf(fabsf(uv[j].x), fabsf(uv[j].y)), fmaxf(fabsf(uv[j].z), fabsf(uv[j].w)))); mv = fmaxf(mv, fmaxf(fmaxf(fabsf(vv[j].x), fabsf(vv[j].y)), fmaxf(fabsf(vv[j].z), fabsf(vv[j].w)))); }
    mu = fmaxf(wave_max(mu), 1e-30f); mv = fmaxf(wave_max(mv), 1e-30f);
    const float iu = 127.f / mu, iv = 127.f / mv;
    unsigned* ou = (unsigned*)(A.ws + WS_U8 + (size_t)e * D) + lane; unsigned* ov = (unsigned*)(A.ws + WS_V8 + (size_t)e * D) + lane;
#pragma unroll
    for (int j = 0; j < 8; ++j) { ou[64 * j] = q4(uv[j], iu); ov[64 * j] = q4(vv[j], iv); }
    if (lane == 0) { AP_SU[e] = mu * (1.f / 127.f); AP_SV[e] = mv * (1.f / 127.f); }
}
constexpr int TAIL_ROWS = 9216, CTX_WGS = (MC / 256) * (2 * DA / 256);
__device__ __forceinline__ int tail_rows(int G) { return G > CTX_WGS ? TAIL_ROWS : 0; }
constexpr int STAG_ROWS = 4096;
__device__ __forceinline__ int stag_rows(int G) { return (G > CTX_WGS && (G & 1) == 0) ? STAG_ROWS : 0; }
__device__ __forceinline__ void tables_stagger(const Frame& F, const Args& A) {
    const int ns = stag_rows(F.G), bx = (int)blockIdx.x; if (ns == 0 || !(bx & 1)) return;
    const int lane = lane_id(), w = (bx >> 1) * NWAVES + F.wave, nw = (F.G >> 1) * NWAVES, hi = NEXP - tail_rows(F.G);
    for (int e = hi - ns + w; e < hi; e += nw) table_row(A, e, lane);
}
__device__ __forceinline__ void tables_tail(const Frame& F, const Args& A) {
    const int nt = tail_rows(F.G), bx = (int)blockIdx.x; if (nt == 0 || bx < CTX_WGS) return;
    const int lane = lane_id();
    if (F.G == 256) {
        const int p = (bx - CTX_WGS) >> 1, s0 = (p * NWAVES + F.wave) * 3, ns = ((F.G - CTX_WGS) >> 1) * NWAVES * 3;
        if (bx & 1) { for (int e = NEXP - nt + s0 + 2; e < NEXP; e += ns) table_row(A, e, lane); }
        else { for (int e = NEXP - nt + s0; e < NEXP; e += ns) { table_row(A, e, lane); table_row(A, e + 1, lane); } }
    } else {
        const int w = (bx - CTX_WGS) * NWAVES + F.wave, nw = (F.G - CTX_WGS) * NWAVES;
        for (int e = NEXP - nt + w; e < NEXP; e += nw) table_row(A, e, lane);
    }
}
__device__ __forceinline__ void p0_prologue(const Frame& F, const Args& A) {
    const int lane = lane_id(), tid = F.wave * 64 + lane; (void)tid;
    LAS float* scr = (LAS float*)(F.lds + F.wave * 16384);
    const int gw = F.vcu * NWAVES + F.wave, NGW = F.G * NWAVES;
    constexpr int I_SQ = (D / 64) * (D / 32);
    (void)I_SQ; (void)scr;
    const size_t gtid = (size_t)F.vcu * (NWAVES * 64) + tid, gth = (size_t)F.G * NWAVES * 64;
    cvt_f32_bf16(AP_subk, AP_SK, (size_t)PH * 2 * NKEYS * 128, gtid, gth);
    { const int nrow0 = NEXP - tail_rows(F.G) - stag_rows(F.G), nmod = F.G < (6 * D) / 64 ? F.G : (6 * D) / 64, nfree = F.G - nmod;
      if (nfree > 0) { if (F.vcu >= nmod) for (int e = (F.vcu - nmod) * NWAVES + F.wave; e < nrow0; e += nfree * NWAVES) table_row(A, e, lane); }
      else for (int e = gw; e < nrow0; e += NGW) table_row(A, e, lane); }
    p0_mod(F, A);
    for (int it = gw; it < 5120; it += NGW) {
        const float* W; float* CP; int N, li;
        if (it < 3072) { W = AP_w_in; CP = AP_CPART; N = NPROJ; li = it; } else if (it < 4096) { W = AP_w_out; CP = AP_CPARTO; N = D; li = it - 3072; } else { W = AP_w_pq; CP = AP_CPARTQ; N = D; li = it - 4096; }
        const int ncb = N / 64, cb = li % ncb, kb = li / ncb, sr = lane >> 4, cq = lane & 15;
        const f32x4* wp = (const f32x4*)(W + (size_t)(kb * 64 + sr) * N + cb * 64) + cq; f32x4 mx = {0.f, 0.f, 0.f, 0.f};
#pragma unroll
        for (int k = 0; k < 16; ++k) { const f32x4 w = wp[(size_t)k * N]; mx.x = fmaxf(mx.x, fabsf(w.x)); mx.y = fmaxf(mx.y, fabsf(w.y)); mx.z = fmaxf(mx.z, fabsf(w.z)); mx.w = fmaxf(mx.w, fabsf(w.w)); }
        mx.x = fmaxf(mx.x, __shfl_xor(mx.x, 16)); mx.y = fmaxf(mx.y, __shfl_xor(mx.y, 16)); mx.z = fmaxf(mx.z, __shfl_xor(mx.z, 16)); mx.w = fmaxf(mx.w, __shfl_xor(mx.w, 16));
        mx.x = fmaxf(mx.x, __shfl_xor(mx.x, 32)); mx.y = fmaxf(mx.y, __shfl_xor(mx.y, 32)); mx.z = fmaxf(mx.z, __shfl_xor(mx.z, 32)); mx.w = fmaxf(mx.w, __shfl_xor(mx.w, 32));
        if (sr == 0) *((f32x4*)(CP + (size_t)kb * N + cb * 64) + cq) = mx;
    }
}

__device__ __forceinline__ void norm_rows(const float* X, size_t row0, int nrows, const float* g, const float* sh, const float* sc, bf16* out, int lane, unsigned char* q8 = nullptr, float* qs = nullptr) {
    f32x4 gs[8], shv[8];
#pragma unroll
    for (int j = 0; j < 8; ++j) { const int cI = j * 64 + lane; const f32x4 gg = ((const f32x4*)g)[cI], s1 = ((const f32x4*)sc)[cI]; gs[j] = gg * (1.f + s1); shv[j] = ((const f32x4*)sh)[cI]; }
    f32x4 vn[8];
    { const f32x4* xr = (const f32x4*)(X + row0 * D) + lane;
#pragma unroll
      for (int j = 0; j < 8; ++j) vn[j] = xr[64 * j]; }
    for (int r = 0; r < nrows; ++r) {
        f32x4 v[8]; float ss = 0.f;
#pragma unroll
        for (int j = 0; j < 8; ++j) { v[j] = vn[j]; ss += (v[j].x * v[j].x + v[j].y * v[j].y) + (v[j].z * v[j].z + v[j].w * v[j].w); }
        { const f32x4* xr = (const f32x4*)(X + (row0 + ((r + 1 < nrows) ? r + 1 : r)) * D) + lane;
#pragma unroll
          for (int j = 0; j < 8; ++j) vn[j] = xr[64 * j]; }
        const float rstd = __builtin_amdgcn_rsqf(wave_sum(ss) * (1.f / D) + EPS);
        v2u* o8 = (v2u*)(out + (row0 + r) * D) + lane; float mx = 0.f;
#pragma unroll
        for (int j = 0; j < 8; ++j) { const f32x4 y = v[j] * rstd * gs[j] + shv[j]; v[j] = y; if (out) { v2u w; w.x = pk2(y.x, y.y); w.y = pk2(y.z, y.w); o8[64 * j] = w; }
            mx = fmaxf(mx, fmaxf(fmaxf(fabsf(y.x), fabsf(y.y)), fmaxf(fabsf(y.z), fabsf(y.w)))); }
        if (q8) { mx = fmaxf(wave_max(mx), 1e-30f); const float inv = 127.f / mx; unsigned* oq = (unsigned*)(q8 + (row0 + r) * D) + lane;
#pragma unroll
            for (int j = 0; j < 8; ++j) oq[64 * j] = q4(v[j], inv);
            if (lane == 0) qs[row0 + r] = mx * (1.f / 127.f); }
    }
}
__device__ __forceinline__ void norm_rows_b(const bf16* X, size_t row0, int nrows, const float* g, const float* sh, const float* sc, bf16* out, int lane, unsigned char* q8, float* qs) {
    f32x4 gs[8], shv[8];
#pragma unroll
    for (int j = 0; j < 8; ++j) { const int cI = j * 64 + lane; const f32x4 gg = ((const f32x4*)g)[cI], s1 = ((const f32x4*)sc)[cI]; gs[j] = gg * (1.f + s1); shv[j] = ((const f32x4*)sh)[cI]; }
    for (int r = 0; r < nrows; ++r) {
        const v2u* xr = (const v2u*)(X + (row0 + r) * D) + lane;
        f32x4 v[8]; float ss = 0.f;
#pragma unroll
        for (int j = 0; j < 8; ++j) { const v2u w = xr[64 * j]; v[j].x = bflo(w.x); v[j].y = bfhi(w.x); v[j].z = bflo(w.y); v[j].w = bfhi(w.y); ss += (v[j].x * v[j].x + v[j].y * v[j].y) + (v[j].z * v[j].z + v[j].w * v[j].w); }
        const float rstd = __builtin_amdgcn_rsqf(wave_sum(ss) * (1.f / D) + EPS);
        v2u* o8 = (v2u*)(out + (row0 + r) * D) + lane; float mx = 0.f;
#pragma unroll
        for (int j = 0; j < 8; ++j) { const f32x4 y = v[j] * rstd * gs[j] + shv[j]; v[j] = y; if (out) { v2u w; w.x = pk2(y.x, y.y); w.y = pk2(y.z, y.w); o8[64 * j] = w; }
            mx = fmaxf(mx, fmaxf(fmaxf(fabsf(y.x), fabsf(y.y)), fmaxf(fabsf(y.z), fabsf(y.w)))); }
        mx = fmaxf(wave_max(mx), 1e-30f); const float inv = 127.f / mx; unsigned* oq = (unsigned*)(q8 + (row0 + r) * D) + lane;
#pragma unroll
        for (int j = 0; j < 8; ++j) oq[64 * j] = q4(v[j], inv);
        if (lane == 0) qs[row0 + r] = mx * (1.f / 127.f);
    }
}
__device__ __forceinline__ void transposes(const Frame& F, const Args& A, int it, const int stride, const int end, const int lane) {
    LAS float* scr = (LAS float*)(F.lds + F.wave * 16384);
    TrRegs R0, R1;
    if (it < end) { TrItem t0 = tr_item(A, it); tr_load(t0, R0, lane);
        for (;;) {
            const int itn = it + stride; const bool more = itn < end; TrItem t1 = t0;
            if (more) { t1 = tr_item(A, itn); tr_load(t1, R1, lane); }
            tr_process(t0, R0, scr, lane);
            if (!more) break;
            t0 = t1; R0 = R1; it = itn;
        } }
}
__device__ __forceinline__ bool tr_split(int G) { return G == 256; }
__device__ __forceinline__ void p2_pre(const Frame& F, const Args& A) {
    const int bx = (int)blockIdx.x; if (!tr_split(F.G) || bx < CTX_WGS || !(bx & 1)) return;
    const int w = ((bx - CTX_WGS) >> 1) * NWAVES + F.wave, nw = ((F.G - CTX_WGS) >> 1) * NWAVES;
    transposes(F, A, 6144 + w, nw, 10240, lane_id());
    __syncthreads();
}
__device__ __forceinline__ void p1_norm1(const Frame& F, const Args& A) {
    const int lane = lane_id(), tid = F.wave * 64 + lane; (void)tid;
    const int gw = F.vcu * NWAVES + F.wave, NGW = F.G * NWAVES;
    const int tr_end = tr_split(F.G) ? 6144 : 10240;
    if ((F.wave & 1) == 0) transposes(F, A, gw, NGW, tr_end, lane);
    for (int it = gw; it < M / 8; it += NGW) { const size_t row0 = (size_t)it * 8; const int b = (int)(row0 >> 11);
        norm_rows(AP_x, row0, 8, AP_g1, AP_MOD + b * 6 * D + 0 * D, AP_MOD + b * 6 * D + 1 * D, nullptr, lane, AP_H8, AP_HS); }
    for (int it = gw; it < MC; it += NGW) norm_rows(AP_ctx, (size_t)it, 1, AP_g1, AP_MOD + 8 * 6 * D + 0 * D, AP_MOD + 8 * 6 * D + 1 * D, nullptr, lane, AP_HC8, AP_HCS);
    if ((F.wave & 1) != 0) transposes(F, A, gw, NGW, tr_end, lane);
}
__device__ __forceinline__ void p5_norm2(const Frame& F, const Args& A) {
    const int lane = lane_id(), tid = F.wave * 64 + lane; (void)tid;
    const int gw = F.vcu * NWAVES + F.wave, NGW = F.G * NWAVES;
    for (int it = gw; it < M / 8; it += NGW) { const size_t row0 = (size_t)it * 8; const int b = (int)(row0 >> 11);
        norm_rows_b(AP_X1B, row0, 8, AP_g2, AP_MOD + b * 6 * D + 3 * D, AP_MOD + b * 6 * D + 4 * D, nullptr, lane, AP_H2Q, AP_H2S); }
}

__device__ __forceinline__ f32x4 dq4(const f32x4 a, const f32x4 cs, const float rs) {
    typedef int v4i_ __attribute__((ext_vector_type(4))); const v4i_ iv = __builtin_bit_cast(v4i_, a);
    f32x4 r; r.x = (float)iv.x; r.y = (float)iv.y; r.z = (float)iv.z; r.w = (float)iv.w; return r * cs * rs;
}
struct EpiProj {
    static constexpr bool PERM = true, AFTER_DRAIN = false;
    bf16 *Q, *Kp, *VTp, *BG, *CG, *U; const float *qn, *kn; LAS float* xch; int region0, tshift; float qscale; const float *rs, *csb;
    __device__ __forceinline__ void operator()(const f32x4 (&acc)[2][2][4][2], const pg8::Unit& u, int wr, int wc, int fr, int fq) const {
        const int region = (u.pn >> 2) + region0, pnl = u.pn & 3;
        const int rowt = wr * 64 + fr;
        f32x4 cs_[2][2]; float rsc_[2][4];
#pragma unroll
        for (int bj = 0; bj < 2; ++bj)
#pragma unroll
            for (int n = 0; n < 2; ++n) cs_[bj][n] = *(const f32x4*)(csb + u.pn * 256 + bj * 128 + 32 * wc + 8 * fq + 4 * n);
#pragma unroll
        for (int ai = 0; ai < 2; ++ai)
#pragma unroll
            for (int m = 0; m < 4; ++m) rsc_[ai][m] = rs[u.pm * 256 + ai * 128 + rowt + m * 16];
#define DQ(ai_, bj_, m_, n_) dq4(acc[ai_][bj_][m_][n_], cs_[bj_][n_], rsc_[ai_][m_])
        if (region <= 1) {
#pragma unroll
            for (int ai = 0; ai < 2; ++ai)
#pragma unroll
                for (int m = 0; m < 4; ++m)
#pragma unroll
                    for (int bj = 0; bj < 2; ++bj) { const f32x4 a = DQ(ai, bj, m, 0), b = DQ(ai, bj, m, 1);
                        float s = (a.x * a.x + a.y * a.y) + (a.z * a.z + a.w * a.w) + (b.x * b.x + b.y * b.y) + (b.z * b.z + b.w * b.w);
                        s += __shfl_xor(s, 16); s += __shfl_xor(s, 32);
                        if (fq == 0) xch[((ai * 128 + rowt + m * 16) * 2 + bj) * 4 + wc] = s; }
            asm volatile("s_waitcnt lgkmcnt(0)" ::: "memory"); __builtin_amdgcn_s_barrier(); asm volatile("" ::: "memory");
            const float* gain = (region == 0) ? qn : kn; const float mul = (region == 0) ? qscale : 1.f; bf16* O = (region == 0) ? Q : Kp;
            const f32x4 g0 = *(const f32x4*)(gain + 32 * wc + 8 * fq), g1 = *(const f32x4*)(gain + 32 * wc + 8 * fq + 4);
#pragma unroll
            for (int ai = 0; ai < 2; ++ai)
#pragma unroll
                for (int m = 0; m < 4; ++m) { const int rt = ai * 128 + rowt + m * 16; bf16* rowp = O + (size_t)(u.pm * 256 + rt) * DA + (2 * pnl) * HD + 32 * wc + 8 * fq;
#pragma unroll
                    for (int bj = 0; bj < 2; ++bj) { const f32x4 p = *(const LAS f32x4*)(xch + (rt * 2 + bj) * 4);
                        const float rstd = __builtin_amdgcn_rsqf(((p.x + p.y) + (p.z + p.w)) * (1.f / HD) + EPS) * mul;
                        const f32x4 v0 = DQ(ai, bj, m, 0) * rstd * g0, v1 = DQ(ai, bj, m, 1) * rstd * g1;
                        v4u w; w.x = pk2(v0.x, v0.y); w.y = pk2(v0.z, v0.w); w.z = pk2(v1.x, v1.y); w.w = pk2(v1.z, v1.w);
                        *(v4u*)(rowp + bj * HD) = w; } }
        } else if (region == 2) {
            const int tmask = (1 << tshift) - 1;
#pragma unroll
            for (int ai = 0; ai < 2; ++ai)
#pragma unroll
                for (int m = 0; m < 4; ++m) { const int row = u.pm * 256 + ai * 128 + rowt + m * 16; const int b = row >> tshift, t = row & tmask;
#pragma unroll
                    for (int bj = 0; bj < 2; ++bj) { const int head = 2 * pnl + bj; bf16* base = VTp + (((size_t)(b * NH + head) * HD + 32 * wc + 8 * fq) << tshift) + t;
#pragma unroll
                        for (int n = 0; n < 2; ++n) { const f32x4 a = DQ(ai, bj, m, n); const unsigned w0 = pk2(a.x, a.y), w1 = pk2(a.z, a.w);
                            base[(size_t)(4 * n + 0) << tshift] = (bf16)(w0 & 0xffffu); base[(size_t)(4 * n + 1) << tshift] = (bf16)(w0 >> 16);
                            base[(size_t)(4 * n + 2) << tshift] = (bf16)(w1 & 0xffffu); base[(size_t)(4 * n + 3) << tshift] = (bf16)(w1 >> 16); } } }
        } else if (region >= 4) {
#pragma unroll
            for (int ai = 0; ai < 2; ++ai)
#pragma unroll
                for (int m = 0; m < 4; ++m) { bf16* rowp = CG + (size_t)(u.pm * 256 + ai * 128 + rowt + m * 16) * DA + (u.pn - 16) * 128 + 32 * wc + 8 * fq;
                    const f32x4 v0 = DQ(ai, 0, m, 0) * DQ(ai, 1, m, 0), v1 = DQ(ai, 0, m, 1) * DQ(ai, 1, m, 1);
                    v4u w; w.x = pk2(v0.x, v0.y); w.y = pk2(v0.z, v0.w); w.z = pk2(v1.x, v1.y); w.w = pk2(v1.z, v1.w);
                    *(v4u*)rowp = w; }
        } else {
            bf16* O = BG;
#pragma unroll
            for (int ai = 0; ai < 2; ++ai)
#pragma unroll
                for (int m = 0; m < 4; ++m) { bf16* rowp = O + (size_t)(u.pm * 256 + ai * 128 + rowt + m * 16) * DA + pnl * 256 + 32 * wc + 8 * fq;
#pragma unroll
                    for (int bj = 0; bj < 2; ++bj) { const f32x4 v0 = DQ(ai, bj, m, 0), v1 = DQ(ai, bj, m, 1);
                        v4u w; w.x = pk2(v0.x, v0.y); w.y = pk2(v0.z, v0.w); w.z = pk2(v1.x, v1.y); w.w = pk2(v1.z, v1.w);
                        *(v4u*)(rowp + bj * HD) = w; } }
        }
#undef DQ
    }
};
struct EpiBf16 {
    static constexpr bool PERM = true, AFTER_DRAIN = false;
    bf16* O; int ldc; const float *rs, *csb;
    __device__ __forceinline__ void operator()(const f32x4 (&acc)[2][2][4][2], const pg8::Unit& u, int wr, int wc, int fr, int fq) const {
        const int row0 = u.pm * 256 + wr * 64 + fr, col0 = u.pn * 256 + wc * 32 + 8 * fq;
#pragma unroll
        for (int ai = 0; ai < 2; ++ai)
#pragma unroll
            for (int m = 0; m < 4; ++m) { bf16* rowp = O + (size_t)(row0 + ai * 128 + m * 16) * ldc + col0;
#pragma unroll
                for (int bj = 0; bj < 2; ++bj) { const float rsv = rs[row0 + ai * 128 + m * 16]; const f32x4 v0 = dq4(acc[ai][bj][m][0], *(const f32x4*)(csb + col0 + bj * 128), rsv), v1 = dq4(acc[ai][bj][m][1], *(const f32x4*)(csb + col0 + bj * 128 + 4), rsv);
                    v4u w; w.x = pk2(v0.x, v0.y); w.y = pk2(v0.z, v0.w); w.z = pk2(v1.x, v1.y); w.w = pk2(v1.z, v1.w);
                    *(v4u*)(rowp + bj * 128) = w; } }
    }
};
struct EpiRes {
    static constexpr bool PERM = true, AFTER_DRAIN = false;
    const float* base; bf16* out; const float* mod; int gofs; const float* csb; float sa;
    __device__ __forceinline__ void operator()(const f32x4 (&acc)[2][2][4][2], const pg8::Unit& u, int wr, int wc, int fr, int fq) const {
        const int row0 = u.pm * 256 + wr * 64 + fr, col0 = u.pn * 256 + wc * 32 + 8 * fq;
        const float* gp = mod + (size_t)(u.pm >> 3) * 6 * D + gofs + col0;
        f32x4 gv[2][2];
#pragma unroll
        for (int bj = 0; bj < 2; ++bj)
#pragma unroll
            for (int n = 0; n < 2; ++n) gv[bj][n] = *(const f32x4*)(gp + bj * 128 + 4 * n);
        f32x4 cs_[2][2];
#pragma unroll
        for (int bj = 0; bj < 2; ++bj)
#pragma unroll
            for (int n = 0; n < 2; ++n) cs_[bj][n] = *(const f32x4*)(csb + col0 + bj * 128 + 4 * n);
        f32x4 xb[3][2][2];
#define ER_LOAD(I_) do { const size_t o_ = (size_t)(row0 + ((I_) >> 2) * 128 + ((I_) & 3) * 16) * D + col0; _Pragma("unroll") for (int bj_ = 0; bj_ < 2; ++bj_) { \
            xb[(I_) % 3][bj_][0] = *(const f32x4*)(base + o_ + bj_ * 128); xb[(I_) % 3][bj_][1] = *(const f32x4*)(base + o_ + bj_ * 128 + 4); } } while (0)
        ER_LOAD(0); ER_LOAD(1);
#pragma unroll
        for (int idx = 0; idx < 8; ++idx) { const int ai = idx >> 2, m = idx & 3; const size_t off = (size_t)(row0 + ai * 128 + m * 16) * D + col0;
            if (idx + 2 < 8) ER_LOAD(idx + 2);
#pragma unroll
            for (int bj = 0; bj < 2; ++bj) {
                const f32x4 v0 = xb[idx % 3][bj][0] + gv[bj][0] * dq4(acc[ai][bj][m][0], cs_[bj][0], sa), v1 = xb[idx % 3][bj][1] + gv[bj][1] * dq4(acc[ai][bj][m][1], cs_[bj][1], sa);
                v4u w; w.x = pk2(v0.x, v0.y); w.y = pk2(v0.z, v0.w); w.z = pk2(v1.x, v1.y); w.w = pk2(v1.z, v1.w);
                *(v4u*)(out + off + bj * 128) = w; }
            asm volatile("" ::: "memory"); }
#undef ER_LOAD
    }
};

__device__ __forceinline__ void attn_phase(const Frame& F, const Args& A) {
    const int lane = lane_id(), tid = F.wave * 64 + lane; (void)tid;
    LAS float* bias = (LAS float*)(F.lds + XCH_OFF);
    LAS unsigned char* kl = F.lds + F.wave * 16384;
    LAS unsigned char* vl = kl + 8192;
    const int q = lane & 31, hh = lane >> 5;
    const int l4 = lane >> 4, c16 = lane & 15, l2 = lane >> 2, g4 = lane & 3;
    for (int pass = 0; pass < 2; ++pass) {
        const int jx = F.vcu & 31, bh = (F.vcu >> 5) * 8 + 4 * pass + (jx >> 3), b = bh >> 3, h = bh & 7;
        const int tidq = (jx & 7) * 8 + F.wave, r = tidq >> 1, qh = tidq & 1;
        __syncthreads();
        for (int i = tid; i < 15 * 31; i += NWAVES * 64) bias[i] = AP_rpb[h * 465 + i] * LOG2E;
        __syncthreads();
        const int rs = min(max(r - 4, 0), 24);
        const unsigned char* Kb = (const unsigned char*)(AP_K + (size_t)b * SEQ * DA + h * HD);
        const unsigned char* VTb = (const unsigned char*)(AP_VTR + (size_t)(b * NH + h) * HD * SEQ);
        const unsigned char* KCb = (const unsigned char*)(AP_KC + (size_t)b * CTXL * DA + h * HD);
        const unsigned char* VCb = (const unsigned char*)(AP_VCT + (size_t)(b * NH + h) * HD * CTXL);
        const int c0 = qh ? 24 : 0, qcol = qh * 32 + q, cs = min(max(qcol - 8, 0), 48);
        const bf16* qp = AP_Q + (size_t)(b * SEQ + r * GW + qcol) * DA + h * HD + 32 * hh;
        bf16x8 qf[8];
#pragma unroll
        for (int s = 0; s < 8; ++s) qf[s] = *(const bf16x8*)(qp + 64 * (s >> 2) + 8 * (s & 3));
        f32x16 o[4];
#pragma unroll
        for (int db = 0; db < 4; ++db)
#pragma unroll
            for (int i = 0; i < 16; ++i) o[db][i] = 0.f;
        float mrun = -1e30f, lrun = 0.f;
        const int gsw = g4 ^ ((l2 >> 2) & 3);
#define ATT_KDMA(KB_) do { const int kb_ = (KB_); \
            if (kb_ < 10) { \
                _Pragma("unroll") for (int i_ = 0; i_ < 8; ++i_) { const int rho_ = 4 * i_ + l4; const int kk_ = kb_ * 32 + (4 * ((i_ >> 1) & 1) + 8 * (i_ & 1) + 16 * (i_ >> 2)) + l4, krow_ = (kk_ * 205) >> 13, kc_ = c0 + kk_ - krow_ * 40; \
                    __builtin_amdgcn_global_load_lds((const unsigned*)(Kb + (unsigned)(((rs + krow_) * GW + kc_) * (DA * 2) + 16 * (c16 ^ (rho_ & 15)))), (LAS unsigned*)(kl + i_ * 1024), 16, 0, 0); } \
            } else { \
                _Pragma("unroll") for (int i_ = 0; i_ < 8; ++i_) { const int rho_ = 4 * i_ + l4; const int l_ = (kb_ - 10) * 32 + (4 * ((i_ >> 1) & 1) + 8 * (i_ & 1) + 16 * (i_ >> 2)) + l4; \
                    __builtin_amdgcn_global_load_lds((const unsigned*)(KCb + (unsigned)(l_ * (DA * 2) + 16 * (c16 ^ (rho_ & 15)))), (LAS unsigned*)(kl + i_ * 1024), 16, 0, 0); } \
            } } while (0)
#define ATT_VDMA(KB_) do { const int kb_ = (KB_); \
            if (kb_ < 10) { \
                const int k0_ = kb_ * 32 + 8 * gsw, vr_ = (k0_ * 205) >> 13, vc_ = c0 + k0_ - vr_ * 40; const unsigned vo_ = (unsigned)((l2 * SEQ + (rs + vr_) * GW + vc_) * 2); \
                _Pragma("unroll") for (int i_ = 0; i_ < 8; ++i_) __builtin_amdgcn_global_load_lds((const unsigned*)(VTb + vo_ + (unsigned)(i_ * 16 * SEQ * 2)), (LAS unsigned*)(vl + i_ * 1024), 16, 0, 0); \
            } else { \
                const unsigned vo_ = (unsigned)((l2 * CTXL + (kb_ - 10) * 32 + 8 * gsw) * 2); \
                _Pragma("unroll") for (int i_ = 0; i_ < 8; ++i_) __builtin_amdgcn_global_load_lds((const unsigned*)(VCb + vo_ + (unsigned)(i_ * 16 * CTXL * 2)), (LAS unsigned*)(vl + i_ * 1024), 16, 0, 0); \
            } } while (0)
        asm volatile("s_waitcnt vmcnt(0) lgkmcnt(0)" ::: "memory");
        ATT_KDMA(0); ATT_VDMA(0);
        for (int kb = 0; kb < 18; ++kb) {
            const bool win = kb < 10;
            asm volatile("s_waitcnt vmcnt(8)" ::: "memory");
            bf16x8 kf[8];
#pragma unroll
            for (int s = 0; s < 8; ++s) kf[s] = *(const LAS bf16x8*)(kl + q * 256 + 16 * ((8 * (s >> 2) + 4 * hh + (s & 3)) ^ (q & 15)));
            asm volatile("s_waitcnt lgkmcnt(0)" ::: "memory");
            if (kb + 1 < 18) ATT_KDMA(kb + 1);
            f32x16 sa;
#pragma unroll
            for (int i = 0; i < 16; ++i) sa[i] = 0.f;
#pragma unroll
            for (int s = 0; s < 8; ++s) sa = __builtin_amdgcn_mfma_f32_32x32x16_bf16(kf[s], qf[s], sa, 0, 0, 0);
            if (win) {
                float bv[16];
#pragma unroll
                for (int i = 0; i < 16; ++i) {
                    const int g = kb * 4 + 2 * (i >> 3) + hh, w = (i & 3) + 4 * ((i >> 2) & 1);
                    const int krow = (g * 205) >> 10, kcol = c0 + 8 * (g - 5 * krow) + w;
                    const int dr = rs + krow - r + 7;
                    const int dc = min(max(kcol - qcol, -15), 15) + 15;
                    bv[i] = bias[dr * 31 + dc];
                }
#pragma unroll
                for (int i = 0; i < 16; ++i) {
                    const int g = kb * 4 + 2 * (i >> 3) + hh, w = (i & 3) + 4 * ((i >> 2) & 1);
                    const int krow = (g * 205) >> 10, kcol = c0 + 8 * (g - 5 * krow) + w;
                    const bool inw = (unsigned)(kcol - cs) < 16u;
                    const float t = sa[i] + bv[i];
                    sa[i] = inw ? t : -1e30f;
                }
            }
            float bm = sa[0];
#pragma unroll
            for (int i = 1; i < 16; ++i) bm = fmaxf(bm, sa[i]);
            bm = fmaxf(bm, __shfl_xor(bm, 32));
            if (!__all(bm - mrun <= 6.0f)) {
                const float mnew = fmaxf(mrun, bm), alpha = __builtin_amdgcn_exp2f(mrun - mnew);
                mrun = mnew; lrun *= alpha;
#pragma unroll
                for (int db = 0; db < 4; ++db)
#pragma unroll
                    for (int i = 0; i < 16; ++i) o[db][i] *= alpha;
            }
            float ps = 0.f;
#pragma unroll
            for (int i = 0; i < 16; ++i) { sa[i] = __builtin_amdgcn_exp2f(sa[i] - mrun); ps += sa[i]; }
            lrun += ps;
            bf16x8 pf[2];
#pragma unroll
            for (int s2 = 0; s2 < 2; ++s2) { v4u w; w.x = pk2(sa[8 * s2 + 0], sa[8 * s2 + 1]); w.y = pk2(sa[8 * s2 + 2], sa[8 * s2 + 3]); w.z = pk2(sa[8 * s2 + 4], sa[8 * s2 + 5]); w.w = pk2(sa[8 * s2 + 6], sa[8 * s2 + 7]); pf[s2] = __builtin_bit_cast(bf16x8, w); }
            if (kb + 1 < 18) asm volatile("s_waitcnt vmcnt(8)" ::: "memory"); else asm volatile("s_waitcnt vmcnt(0)" ::: "memory");
            bf16x8 vf[4][2];
#pragma unroll
            for (int db = 0; db < 4; ++db) { const int dd = db * 32 + q;
                vf[db][0] = *(const LAS bf16x8*)(vl + dd * 64 + 16 * ((0 + hh) ^ ((dd >> 2) & 3))); vf[db][1] = *(const LAS bf16x8*)(vl + dd * 64 + 16 * ((2 + hh) ^ ((dd >> 2) & 3))); }
            asm volatile("s_waitcnt lgkmcnt(0)" ::: "memory");
            if (kb + 1 < 18) ATT_VDMA(kb + 1);
#pragma unroll
            for (int db = 0; db < 4; ++db) { o[db] = __builtin_amdgcn_mfma_f32_32x32x16_bf16(vf[db][0], pf[0], o[db], 0, 0, 0); o[db] = __builtin_amdgcn_mfma_f32_32x32x16_bf16(vf[db][1], pf[1], o[db], 0, 0, 0); }
        }
#undef ATT_KDMA
#undef ATT_VDMA
        const float ltot = lrun + __shfl_xor(lrun, 32), inv = 1.f / ltot;
        float ss = 0.f;
#pragma unroll
        for (int db = 0; db < 4; ++db)
#pragma unroll
            for (int i = 0; i < 16; ++i) { o[db][i] *= inv; ss += o[db][i] * o[db][i]; }
        ss += __shfl_xor(ss, 32);
        const float rstd = __builtin_amdgcn_rsqf(ss * (1.f / HD) + EPS);
        unsigned char* op = AP_A28 + (size_t)(b * SEQ + r * GW + qcol) * D + h * HD + 4 * hh;
        const float* gp = AP_gao + h * HD + 4 * hh; const float rq = rstd * A2_INV;
#pragma unroll
        for (int db = 0; db < 4; ++db)
#pragma unroll
            for (int i4 = 0; i4 < 4; ++i4) { const f32x4 g = *(const f32x4*)(gp + db * 32 + 8 * i4);
                f32x4 y; y.x = o[db][4 * i4 + 0] * g.x; y.y = o[db][4 * i4 + 1] * g.y; y.z = o[db][4 * i4 + 2] * g.z; y.w = o[db][4 * i4 + 3] * g.w;
                *(unsigned*)(op + db * 32 + 8 * i4) = q4(y, rq); }
    }
    __syncthreads();
}

__device__ __forceinline__ void unpack16(const v4u a, const v4u b, float (&f)[16]) {
    f[0] = bflo(a.x); f[1] = bfhi(a.x); f[2] = bflo(a.y); f[3] = bfhi(a.y); f[4] = bflo(a.z); f[5] = bfhi(a.z); f[6] = bflo(a.w); f[7] = bfhi(a.w);
    f[8] = bflo(b.x); f[9] = bfhi(b.x); f[10] = bflo(b.y); f[11] = bfhi(b.y); f[12] = bflo(b.z); f[13] = bfhi(b.z); f[14] = bflo(b.w); f[15] = bfhi(b.w);
}
__device__ __forceinline__ void load_z(const bf16* Zp, const bf16*, size_t m, int lane, float (&z)[16]) {
    const v4u* cp = (const v4u*)(Zp + m * DA + 16 * lane);
    const v4u c0 = __builtin_nontemporal_load(cp), c1 = __builtin_nontemporal_load(cp + 1);
    unpack16(c0, c1, z);
}
__device__ __forceinline__ void conv_phase(const Frame& F, const Args& A) {
    const int lane = lane_id(), tid = F.wave * 64 + lane; (void)tid;
    const int gw = F.vcu * NWAVES + F.wave, NGW = F.G * NWAVES;
    float w0[16], w1[16], w2[16], gg[16];
#pragma unroll
    for (int i = 0; i < 16; ++i) { w0[i] = AP_w_conv[0 * DA + 16 * lane + i]; w1[i] = AP_w_conv[1 * DA + 16 * lane + i]; w2[i] = AP_w_conv[2 * DA + 16 * lane + i]; gg[i] = AP_gco[16 * lane + i]; }
    for (int it = gw; it < M / 8; it += NGW) {
        const size_t m0 = (size_t)it * 8;
        float zp[16], zc[16], zn[16];
        if ((m0 & (SEQ - 1)) == 0) {
#pragma unroll
            for (int i = 0; i < 16; ++i) zp[i] = 0.f;
        } else load_z(AP_CG, AP_U, m0 - 1, lane, zp);
        load_z(AP_CG, AP_U, m0, lane, zc);
        for (int j = 0; j < 8; ++j) {
            const size_t m = m0 + j;
            if ((m & (SEQ - 1)) == SEQ - 1) {
#pragma unroll
                for (int i = 0; i < 16; ++i) zn[i] = 0.f;
            } else load_z(AP_CG, AP_U, m + 1, lane, zn);
            const v4u* bp = (const v4u*)(AP_BG + m * DA + 16 * lane); const v4u b0 = __builtin_nontemporal_load(bp), b1 = __builtin_nontemporal_load(bp + 1);
            float bf[16]; unpack16(b0, b1, bf);
            float y[16], ss = 0.f;
#pragma unroll
            for (int i = 0; i < 16; ++i) { y[i] = bf[i] * (w0[i] * zp[i] + w1[i] * zc[i] + w2[i] * zn[i]); ss += y[i] * y[i]; }
            ss += __shfl_xor(ss, 1); ss += __shfl_xor(ss, 2); ss += __shfl_xor(ss, 4);
            const float rstd = __builtin_amdgcn_rsqf(ss * (1.f / 128.f) + EPS);
            const float rq = rstd * A2_INV; v4u o0;
            { f32x4 t0 = {y[0] * gg[0], y[1] * gg[1], y[2] * gg[2], y[3] * gg[3]}, t1 = {y[4] * gg[4], y[5] * gg[5], y[6] * gg[6], y[7] * gg[7]};
              f32x4 t2 = {y[8] * gg[8], y[9] * gg[9], y[10] * gg[10], y[11] * gg[11]}, t3 = {y[12] * gg[12], y[13] * gg[13], y[14] * gg[14], y[15] * gg[15]};
              o0.x = q4(t0, rq); o0.y = q4(t1, rq); o0.z = q4(t2, rq); o0.w = q4(t3, rq); }
            __builtin_nontemporal_store(o0, (v4u*)(AP_A28 + m * D + DA + 16 * lane));
#pragma unroll
            for (int i = 0; i < 16; ++i) { zp[i] = zc[i]; zc[i] = zn[i]; }
        }
    }
}

__device__ __forceinline__ unsigned f2key(float f) { const unsigned u = __builtin_bit_cast(unsigned, f); return (u & 0x80000000u) ? ~u : (u | 0x80000000u); }
__device__ __forceinline__ float key2f(unsigned k) { const unsigned u = (k & 0x80000000u) ? (k & 0x7fffffffu) : ~k; return __builtin_bit_cast(float, u); }
__device__ __forceinline__ void ce_desc(unsigned& a, unsigned& b) { const unsigned hi = max(a, b), lo = min(a, b); a = hi; b = lo; }
template <int BASE> __device__ __forceinline__ void sort16_desc(unsigned (&v)[64]) {
#pragma unroll
    for (int k = 2; k <= 16; k <<= 1)
#pragma unroll
        for (int j = k >> 1; j >= 1; j >>= 1)
#pragma unroll
            for (int i = 0; i < 16; ++i) { const int l = i ^ j; if (l > i) { if ((i & k) == 0) ce_desc(v[BASE + i], v[BASE + l]); else ce_desc(v[BASE + l], v[BASE + i]); } }
}
template <int A_, int B_> __device__ __forceinline__ void merge_top16(unsigned (&v)[64]) {
#pragma unroll
    for (int i = 0; i < 16; ++i) v[A_ + i] = max(v[A_ + i], v[B_ + 15 - i]);
#pragma unroll
    for (int j = 8; j >= 1; j >>= 1)
#pragma unroll
        for (int i = 0; i < 16; ++i) { const int l = i ^ j; if (l > i) ce_desc(v[A_ + i], v[A_ + l]); }
}
__device__ __forceinline__ void top16_of_64(unsigned (&v)[64]) {
    sort16_desc<0>(v); sort16_desc<16>(v); sort16_desc<32>(v); sort16_desc<48>(v);
    merge_top16<0, 16>(v); merge_top16<32, 48>(v); merge_top16<0, 32>(v);
}
__device__ __forceinline__ void peer_select_phase(const Frame& F, const Args& A) {
    const int lane = lane_id(), tid = F.wave * 64 + lane; (void)tid;
    const int gw = F.vcu * NWAVES + F.wave, NGW = F.G * NWAVES, tk = lane & 31, hh = lane >> 5;
    LAS unsigned char* qimg = F.lds + F.wave * 16384;
    LAS unsigned char* kimg = qimg + 8192;
    LAS int* ixs = (LAS int*)qimg;
    const int l4 = lane >> 4, c16 = lane & 15;
    unsigned nh4 = (unsigned)(1 - hh) << 2; asm volatile("" : "+v"(nh4));
    for (int task = gw; task < (M / 32) * PH; task += NGW) {
        const int h = task & 7, tb = task >> 3; const int token = tb * 32 + tk;
        unsigned best[2][16];
#pragma unroll
        for (int p = 0; p < 2; ++p) {
            const unsigned char* qsrc = (const unsigned char*)(AP_QP + (size_t)(tb * 32) * D + h * 256 + p * 128);
            const unsigned char* ksrc = (const unsigned char*)(AP_SK + (size_t)((h * 2 + p) * NKEYS) * 128);
            unsigned bq = (unsigned)(l4 * (D * 2) + 16 * (c16 ^ l4)), bk = (unsigned)(l4 * 256 + 16 * (c16 ^ l4));
            asm volatile("s_waitcnt vmcnt(0) lgkmcnt(0)" : "+v"(bq), "+v"(bk) : : "memory");
#pragma unroll
            for (int i = 0; i < 8; ++i) __builtin_amdgcn_global_load_lds((const unsigned*)(qsrc + ((bq ^ (unsigned)(64 * (i & 3))) + (unsigned)(i * 4 * D * 2))), (LAS unsigned*)(qimg + i * 1024), 16, 0, 2);
#define PS_KDMA(KB_) do { _Pragma("unroll") for (int i_ = 0; i_ < 8; ++i_) \
                __builtin_amdgcn_global_load_lds((const unsigned*)(ksrc + ((bk ^ (unsigned)(64 * (i_ & 3))) + (unsigned)((KB_) * 8192 + i_ * 1024))), (LAS unsigned*)(kimg + i_ * 1024), 16, 0, 0); } while (0)
            PS_KDMA(0);
            asm volatile("s_waitcnt vmcnt(8)" ::: "memory");
            bf16x8 qf[8];
#pragma unroll
            for (int s = 0; s < 8; ++s) qf[s] = *(const LAS bf16x8*)(qimg + tk * 256 + 16 * ((8 * (s >> 2) + 4 * hh + (s & 3)) ^ (tk & 15)));
            unsigned ky[64];
#pragma unroll
            for (int kb = 0; kb < 4; ++kb) {
                asm volatile("s_waitcnt vmcnt(0)" ::: "memory");
                bf16x8 kf[8];
#pragma unroll
                for (int s = 0; s < 8; ++s) kf[s] = *(const LAS bf16x8*)(kimg + tk * 256 + 16 * ((8 * (s >> 2) + 4 * hh + (s & 3)) ^ (tk & 15)));
                asm volatile("s_waitcnt lgkmcnt(0)" ::: "memory");
                if (kb < 3) PS_KDMA(kb + 1);
                f32x16 sa;
#pragma unroll
                for (int i = 0; i < 16; ++i) sa[i] = 0.f;
#pragma unroll
                for (int s = 0; s < 8; ++s) sa = __builtin_amdgcn_mfma_f32_32x32x16_bf16(kf[s], qf[s], sa, 0, 0, 0);
#pragma unroll
                for (int i = 0; i < 16; ++i) { const unsigned ck = (unsigned)(127 - (kb * 32 + (i & 3) + 8 * (i >> 2))) & ~4u;
                    ky[kb * 16 + i] = ((f2key(sa[i]) & ~127u) | nh4) | ck; }
                asm volatile("" ::: "memory");
            }
#undef PS_KDMA
            top16_of_64(ky);
#pragma unroll
            for (int i = 0; i < 16; ++i) ky[16 + i] = (unsigned)__shfl_xor((int)ky[i], 32);
            merge_top16<0, 16>(ky);
#pragma unroll
            for (int i = 0; i < 16; ++i) best[p][i] = ky[i];
        }
        float s1[16], s2[16];
#pragma unroll
        for (int i = 0; i < 16; ++i) { s1[i] = key2f(best[0][i] & ~127u); s2[i] = key2f(best[1][i] & ~127u);
            ixs[i * 64 + lane] = 127 - (int)(best[0][i] & 127u); ixs[(16 + i) * 64 + lane] = 127 - (int)(best[1][i] & 127u); }
        unsigned cd[64]; { int n = 0;
#pragma unroll
            for (int i = 0; i < 16; ++i)
#pragma unroll
                for (int j = 0; j < 16; ++j) if ((i + 1) * (j + 1) <= 16) { cd[n] = (f2key(s1[i] + s2[j]) & ~255u) | (unsigned)(255 - (16 * i + j)); ++n; }
#pragma unroll
            for (int i = 50; i < 64; ++i) cd[i] = 0u; }
        top16_of_64(cd);
        unsigned win[16];
#pragma unroll
        for (int i = 0; i < 16; ++i) win[i] = cd[i];
        LDS_WAIT();
        const float vmax = key2f(win[0] & ~255u);
        float ev[16], es = 0.f;
#pragma unroll
        for (int rnd = 0; rnd < 16; ++rnd) { ev[rnd] = __expf(key2f(win[rnd] & ~255u) - vmax); es += ev[rnd]; }
        const float ies = 1.f / es;
        if (hh == 0) {
            int* ip = AP_SELI + (size_t)token * 128 + h * 16; float* gp = AP_SELG + (size_t)token * 128 + h * 16;
#pragma unroll
            for (int rnd = 0; rnd < 16; ++rnd) { const int pos = 255 - (int)(win[rnd] & 255u); const int i1 = ixs[(pos >> 4) * 64 + lane], i2 = ixs[(16 + (pos & 15)) * 64 + lane];
                ip[rnd] = i1 * NKEYS + i2; gp[rnd] = ev[rnd] * ies; }
        }
        LDS_WAIT();
    }
}

typedef int v4i __attribute__((ext_vector_type(4)));
__device__ __forceinline__ float gelu_as(const float v) {
    const float av = fabsf(v), t = __builtin_amdgcn_rcpf(av * 0.2316418882f + 1.0f);
    float q = t * 0.5307027145f + (-0.7265760135f); q = q * t + 0.7107068705f; q = q * t + (-0.142248368f); q = q * t + 0.127414796f; q = q * t;
    const float e = __builtin_amdgcn_exp2f((v * v) * (-0.72134752044f));
    const float m = v * (q * e);
    return v < 0.f ? m : v - m;
}
constexpr int PL_WAVE = 16384, PL_EL = 8192, PL_PACC = 10240, PL_AQ = 14336, PL_SA = 15360;
__device__ __forceinline__ float wave_maxf(float v) {
#pragma unroll
    for (int o = 1; o < 64; o <<= 1) v = fmaxf(v, __shfl_xor(v, o));
    return v;
}
__device__ __forceinline__ void peer_u_phase(const Frame& F, const Args& A, float (&sa)[8]) {
    const int lane = lane_id(), p8 = lane >> 3, c = lane & 7;
    LAS unsigned short* elist = (LAS unsigned short*)(F.lds + F.wave * PL_WAVE + PL_EL);
    LAS int* pacc = (LAS int*)(F.lds + F.wave * PL_WAVE + PL_PACC);
    LAS signed char* aq = (LAS signed char*)(F.lds + F.wave * PL_WAVE + PL_AQ);
    const int tok0 = F.vcu * 64 + F.wave * 8;
    for (int it = 0; it < 16; ++it) { elist[it * 64 + lane] = (unsigned short)AP_SELI[(size_t)tok0 * 128 + it * 64 + lane]; pacc[it * 64 + lane] = 0; }
    LDS_WAIT();
    v4u G0[4], G1[4], G2[4], G3[4], hreg;
    const unsigned char* ub = AP_U8 + 16 * c;
    LAS unsigned char* hst = F.lds + F.wave * PL_WAVE;
#define PU_LOAD(G_, K_) do { const int kg_ = (K_), tp_ = kg_ & 31; const LAS unsigned short* el_ = elist + (2 * tp_) * 16 + p8; \
            const unsigned e0_ = el_[0], e1_ = el_[8], e2_ = el_[16], e3_ = el_[24]; const unsigned char* us_ = ub + 128 * (kg_ >> 5); \
            G_[0] = *(const v4u*)(us_ + (size_t)e0_ * D); G_[1] = *(const v4u*)(us_ + (size_t)e1_ * D); G_[2] = *(const v4u*)(us_ + (size_t)e2_ * D); G_[3] = *(const v4u*)(us_ + (size_t)e3_ * D); } while (0)
#define PU_DOT4(A0_) ([&]() { int d0_ = __builtin_amdgcn_sdot4((int)(A0_).x, (int)hreg.x, 0, false), d1_ = __builtin_amdgcn_sdot4((int)(A0_).y, (int)hreg.y, 0, false); \
            d0_ = __builtin_amdgcn_sdot4((int)(A0_).z, (int)hreg.z, d0_, false); d1_ = __builtin_amdgcn_sdot4((int)(A0_).w, (int)hreg.w, d1_, false); \
            int v_ = d0_ + d1_; \
            v_ += __builtin_amdgcn_update_dpp(0, v_, 0xB1, 0xf, 0xf, true); v_ += __builtin_amdgcn_update_dpp(0, v_, 0x4E, 0xf, 0xf, true); v_ += __builtin_amdgcn_update_dpp(0, v_, 0x141, 0xf, 0xf, true); return v_; }())
#define PU_COMPUTE(G_, TP_) do { const int v0_ = PU_DOT4(G_[0]), v1_ = PU_DOT4(G_[1]), v2_ = PU_DOT4(G_[2]), v3_ = PU_DOT4(G_[3]); \
            if (c == 0) { LAS int* pa_ = pacc + (2 * (TP_)) * 16 + p8; \
                (void)__hip_atomic_fetch_add(pa_, v0_, __ATOMIC_RELAXED, __HIP_MEMORY_SCOPE_WORKGROUP); (void)__hip_atomic_fetch_add(pa_ + 8, v1_, __ATOMIC_RELAXED, __HIP_MEMORY_SCOPE_WORKGROUP); \
                (void)__hip_atomic_fetch_add(pa_ + 16, v2_, __ATOMIC_RELAXED, __HIP_MEMORY_SCOPE_WORKGROUP); (void)__hip_atomic_fetch_add(pa_ + 24, v3_, __ATOMIC_RELAXED, __HIP_MEMORY_SCOPE_WORKGROUP); } } while (0)
    PU_LOAD(G0, 0); PU_LOAD(G1, 1); PU_LOAD(G2, 2); PU_LOAD(G3, 3);
    for (int slice = 0; slice < 16; ++slice) {
        { const int tk_ = lane >> 3, pc_ = lane & 7;
          *(LAS v4u*)(hst + tk_ * 128 + 16 * pc_) = *(const v4u*)(AP_H2Q + (size_t)(tok0 + tk_) * D + 128 * slice + 16 * pc_); }
        for (int tk = 0; tk < 8; ++tk) {
            hreg = *(const LAS v4u*)(hst + tk * 128 + 16 * c);
            { const int tp = tk * 4, k = slice * 32 + tp;
                PU_COMPUTE(G0, tp);     PU_LOAD(G0, (k + 4) & 511);
                PU_COMPUTE(G1, tp + 1); PU_LOAD(G1, (k + 5) & 511);
                PU_COMPUTE(G2, tp + 2); PU_LOAD(G2, (k + 6) & 511);
                PU_COMPUTE(G3, tp + 3); PU_LOAD(G3, (k + 7) & 511);
            }
        }
        if ((slice & 3) == 3) __builtin_amdgcn_s_barrier();
    }
#undef PU_LOAD
#undef PU_COMPUTE
#undef PU_DOT4
    LDS_WAIT();
#pragma unroll
    for (int t = 0; t < 8; ++t) { const int token = tok0 + t; const float hs = AP_H2S[token]; float av[2];
#pragma unroll
        for (int hf = 0; hf < 2; ++hf) { const int p = t * 128 + hf * 64 + lane; const unsigned e = elist[p];
            av[hf] = gelu_as((float)pacc[p] * AP_SU[e] * hs) * AP_SELG[(size_t)tok0 * 128 + p] * AP_SV[e]; }
        const float mx = fmaxf(wave_maxf(fmaxf(fabsf(av[0]), fabsf(av[1]))), 1e-30f), inv = 127.f / mx;
        aq[t * 128 + lane] = (signed char)(int)__builtin_rintf(av[0] * inv); aq[t * 128 + 64 + lane] = (signed char)(int)__builtin_rintf(av[1] * inv);
        sa[t] = mx * (1.f / 127.f); if (lane == 0) *(LAS float*)(F.lds + F.wave * PL_WAVE + PL_SA + 4 * t) = mx * (1.f / 127.f); }
    LDS_WAIT();
}
__device__ __forceinline__ void peer_v_phase_valu(const Frame& F, const Args& A) {
    typedef float f32x2v __attribute__((ext_vector_type(2)));
    const int lane = lane_id(), r = lane >> 3, c = lane & 7, jq = lane >> 4, hb = (lane >> 3) & 1;
    const LAS unsigned char* wb = F.lds + F.wave * PL_WAVE;
    const LAS unsigned short* elist = (const LAS unsigned short*)(wb + PL_EL) + 4 * r;
    const LAS unsigned char* aq = wb + PL_AQ + 4 * r;
    const LAS float* sal = (const LAS float*)(wb + PL_SA);
    const int tok0 = F.vcu * 64 + F.wave * 8;
    const unsigned char* vb = AP_V8 + 16 * c;
    v4u G0[4], G1[4], G2[4], G3[4];
    v2u EN[4]; unsigned AC[4], AN[4];
    int acc[16];
#define PW_META(T_) do { const int tm_ = (T_) & 7; _Pragma("unroll") for (int s_ = 0; s_ < 4; ++s_) { EN[s_] = *(const LAS v2u*)(elist + tm_ * 128 + s_ * 32); AN[s_] = *(const LAS unsigned*)(aq + tm_ * 128 + s_ * 32); } } while (0)
#define PW_LOAD(G_, S_, SL_) do { const unsigned char* vs_ = vb + 128 * ((SL_) & 15); const v2u en_ = EN[S_]; \
        G_[0] = *(const v4u*)(vs_ + (size_t)(en_.x & 0xffffu) * D); G_[1] = *(const v4u*)(vs_ + (size_t)(en_.x >> 16) * D); \
        G_[2] = *(const v4u*)(vs_ + (size_t)(en_.y & 0xffffu) * D); G_[3] = *(const v4u*)(vs_ + (size_t)(en_.y >> 16) * D); } while (0)
#define PW_COL(W0_, W1_, W2_, W3_, J_, AP_) do { \
        const unsigned tl0_ = __builtin_amdgcn_perm(W1_, W0_, 0x05010400u), th0_ = __builtin_amdgcn_perm(W1_, W0_, 0x07030602u); \
        const unsigned tl1_ = __builtin_amdgcn_perm(W3_, W2_, 0x05010400u), th1_ = __builtin_amdgcn_perm(W3_, W2_, 0x07030602u); \
        acc[4 * (J_) + 0] = __builtin_amdgcn_sdot4((int)__builtin_amdgcn_perm(tl1_, tl0_, 0x05040100u), (int)(AP_), acc[4 * (J_) + 0], false); \
        acc[4 * (J_) + 1] = __builtin_amdgcn_sdot4((int)__builtin_amdgcn_perm(tl1_, tl0_, 0x07060302u), (int)(AP_), acc[4 * (J_) + 1], false); \
        acc[4 * (J_) + 2] = __builtin_amdgcn_sdot4((int)__builtin_amdgcn_perm(th1_, th0_, 0x05040100u), (int)(AP_), acc[4 * (J_) + 2], false); \
        acc[4 * (J_) + 3] = __builtin_amdgcn_sdot4((int)__builtin_amdgcn_perm(th1_, th0_, 0x07060302u), (int)(AP_), acc[4 * (J_) + 3], false); } while (0)
#define PW_COMPUTE(G_, AP_) do { PW_COL(G_[0].x, G_[1].x, G_[2].x, G_[3].x, 0, AP_); PW_COL(G_[0].y, G_[1].y, G_[2].y, G_[3].y, 1, AP_); \
        PW_COL(G_[0].z, G_[1].z, G_[2].z, G_[3].z, 2, AP_); PW_COL(G_[0].w, G_[1].w, G_[2].w, G_[3].w, 3, AP_); } while (0)
    PW_META(0);
    LDS_WAIT();
    PW_LOAD(G0, 0, 0); PW_LOAD(G1, 1, 0); PW_LOAD(G2, 2, 0); PW_LOAD(G3, 3, 0);
#pragma unroll
    for (int s = 0; s < 4; ++s) AC[s] = AN[s];
    for (int slice = 0; slice < 16; ++slice) {
        const int d0 = 128 * slice + 16 * c + 4 * jq + 2 * hb;
        const f32x2v g2 = *(const f32x2v*)(AP_MOD + (size_t)(tok0 >> 11) * 6 * D + 5 * D + d0);
        for (int t = 0; t < 8; ++t) {
            const int token = tok0 + t;
            const unsigned xw = __builtin_nontemporal_load((const unsigned*)(AP_X1B + (size_t)token * D + d0));
            const float sat = sal[t];
            PW_META(t + 1);
            const int sn = slice + ((t + 1) >> 3);
#pragma unroll
            for (int q = 0; q < 16; ++q) acc[q] = 0;
            __builtin_amdgcn_sched_barrier(0);
            PW_COMPUTE(G0, AC[0]); __builtin_amdgcn_sched_barrier(0); PW_LOAD(G0, 0, sn); __builtin_amdgcn_sched_barrier(0);
            PW_COMPUTE(G1, AC[1]); __builtin_amdgcn_sched_barrier(0); PW_LOAD(G1, 1, sn); __builtin_amdgcn_sched_barrier(0);
            PW_COMPUTE(G2, AC[2]); __builtin_amdgcn_sched_barrier(0); PW_LOAD(G2, 2, sn); __builtin_amdgcn_sched_barrier(0);
            PW_COMPUTE(G3, AC[3]); __builtin_amdgcn_sched_barrier(0); PW_LOAD(G3, 3, sn); __builtin_amdgcn_sched_barrier(0);
#pragma unroll
            for (int s = 0; s < 4; ++s) AC[s] = AN[s];
            int s1[8], s2[4];
#pragma unroll
            for (int q = 0; q < 8; ++q) { const auto rr = __builtin_amdgcn_permlane32_swap((unsigned)acc[q], (unsigned)acc[8 + q], false, false); s1[q] = (int)rr[0] + (int)rr[1]; }
#pragma unroll
            for (int q = 0; q < 4; ++q) { const auto rr = __builtin_amdgcn_permlane16_swap((unsigned)s1[q], (unsigned)s1[4 + q], false, false); s2[q] = (int)rr[0] + (int)rr[1]; }
#pragma unroll
            for (int q = 0; q < 4; ++q) s2[q] += __builtin_amdgcn_update_dpp(0, s2[q], 0x128, 0xf, 0xf, true);
            f32x2v o;
            o.x = bflo(xw) + g2.x * (sat * (float)(hb ? s2[2] : s2[0])); o.y = bfhi(xw) + g2.y * (sat * (float)(hb ? s2[3] : s2[1]));
            __builtin_nontemporal_store(o, (f32x2v*)(AP_out + (size_t)token * D + d0));
        }
        __builtin_amdgcn_s_barrier();
    }
#undef PW_META
#undef PW_LOAD
#undef PW_COL
#undef PW_COMPUTE
}
__device__ __forceinline__ void peer_eval_phase(const Frame& F, const Args& A) { float sa[8]; peer_u_phase(F, A, sa); peer_v_phase_valu(F, A); }

template <bool FUSED, int ONLY>
__global__ void __launch_bounds__(NWAVES * 64, 2) mk_fwd(Args args) {
    extern __shared__ __attribute__((aligned(16))) unsigned char lds[];
    Frame F;
    F.lds = (LAS unsigned char*)lds;
    F.wave = __builtin_amdgcn_readfirstlane((int)threadIdx.x >> 6);
    F.G = gridDim.x; { const int bx = blockIdx.x; F.vcu = (F.G % 8 == 0) ? (bx % 8) * (F.G / 8) + bx / 8 : bx; }
    const Args& A = args;
    const int lo = (ONLY >= 0) ? ONLY : args.ph_lo, hi = (ONLY >= 0) ? ONLY + 1 : args.ph_hi;
#define IN(k) ((ONLY < 0 || ONLY == (k)) && lo <= (k) && (k) < hi)
    XcdBarrier bar; bar.bar = (unsigned*)(args.ws + WS_CTL); bar.x = 0; bar.st = (volatile LAS unsigned*)(F.lds + MISC_OFF);
    if constexpr (FUSED) {
        if (MK_CG_SYNC) cg::this_grid().sync();
        bar.x = xb_xcc_id();
        if (F.wave == 0 && lane_id() == 0) { bar.st[0] = 0u; bar.st[1] = 0u; (void)xb_add(&bar.bar[XB_XCNT(bar.x)], 1u); }
        __syncthreads();
    }
#define SEAM(k) do { if (FUSED && IN(k) && IN((k) + 1)) { xcd_barrier(bar, F.wave, (unsigned)F.G); } } while (0)

    if (IN(0)) { p0_prologue(F, A); } SEAM(0);
    if (IN(1)) { p1_norm1(F, A); } SEAM(1);
    if (IN(2)) {
        p2_pre(F, A);
        { pg8::Gemm g{(const bf16*)AP_H8, (const bf16*)AP_WIN8, M, NPROJ, D / 2}; pg8::StaticOrder S; S.init(M, NPROJ, F.G, (int)blockIdx.x);
          EpiProj E{AP_Q, AP_K, AP_VTR, AP_BG, AP_CG, AP_U, AP_qn, AP_kn, (LAS float*)(F.lds + XCH_OFF), 0, 11, 0.08838834764831845f * LOG2E, AP_HS, AP_WINS};
          pg8::gemm_phase<EpiProj, pg8::StaticOrder, true, true, true>(F.lds, g, S, E, F.wave); }
        { pg8::Gemm g{(const bf16*)AP_HC8, (const bf16*)(AP_WIN8 + (size_t)DA * D), MC, 2 * DA, D / 2}; pg8::StaticOrder S; S.init(MC, 2 * DA, F.G, (int)blockIdx.x);
          EpiProj E{nullptr, AP_KC, AP_VCT, nullptr, nullptr, nullptr, AP_qn, AP_kn, (LAS float*)(F.lds + XCH_OFF), 1, 8, 1.f, AP_HCS, AP_WINS + DA};
          pg8::gemm_phase<EpiProj, pg8::StaticOrder, true, true, true>(F.lds, g, S, E, F.wave); }
        tables_tail(F, A);
    } SEAM(2);
    if (IN(3)) { if (blockIdx.x & 1) { conv_phase(F, A); attn_phase(F, A); } else { attn_phase(F, A); conv_phase(F, A); } } SEAM(3);
    if (IN(4)) { tables_stagger(F, A); pg8::Gemm g{(const bf16*)AP_A28, (const bf16*)AP_WOUT8, M, D, D / 2}; pg8::StaticOrder S; S.init(M, D, F.G, (int)blockIdx.x);
        EpiRes E{AP_x, AP_X1B, AP_MOD, 2 * D, AP_WOUTS, A2_SCALE};
        pg8::gemm_phase<EpiRes, pg8::StaticOrder, true, true, true>(F.lds, g, S, E, F.wave); } SEAM(4);
    if (IN(5)) { p5_norm2(F, A); } SEAM(5);
    if (IN(6)) { pg8::Gemm g{(const bf16*)AP_H2Q, (const bf16*)AP_WPQ8, M, D, D / 2}; pg8::StaticOrder S; S.init(M, D, F.G, (int)blockIdx.x);
        EpiBf16 E{AP_QP, D, AP_H2S, AP_WPQS};
        pg8::gemm_phase<EpiBf16, pg8::StaticOrder, true, true, true>(F.lds, g, S, E, F.wave); } SEAM(6);
    if (IN(7)) { peer_select_phase(F, A); } SEAM(7);
    if (IN(8)) { peer_eval_phase(F, A); }
#undef IN
#undef SEAM
}

template <int PHS> static bool set_lds() { return hipFuncSetAttribute((const void*)mk_fwd<false, PHS>, hipFuncAttributeMaxDynamicSharedMemorySize, LDS_BYTES) == hipSuccess; }
template <int PHS> static void launch_one(int grid, hipStream_t stream, const Args& a) {
    hipLaunchKernelGGL((mk_fwd<false, PHS>), dim3(grid), dim3(NWAVES * 64), LDS_BYTES, stream, a);
    const hipError_t le = hipPeekAtLastError();
    if (le != hipSuccess) fprintf(stderr, "kernel_launch: launch %d failed: %s\n", PHS, hipGetErrorName(le));
}
extern "C" void kernel_launch(void* const* d_in, const int* in_sizes, int n_in, void* d_out, int out_size, void* d_ws, size_t ws_size, hipStream_t stream) {
    constexpr bool FUSED = (MK_N_LAUNCHES == 1);
    static int grid = 0;
    if (grid == 0) {
        if (n_in != 20 || in_sizes[0] != M * D || out_size != M * D || ws_size < WS_END) { fprintf(stderr, "kernel_launch: unexpected shapes (n_in %d, in0 %d, out %d, ws %zu < %zu); nothing launched\n", n_in, n_in > 0 ? in_sizes[0] : -1, out_size, ws_size, (size_t)WS_END); grid = -1; return; }
        int dev = 0, cus = 0, per_cu = 0;
        if (hipGetDevice(&dev) != hipSuccess || hipDeviceGetAttribute(&cus, hipDeviceAttributeMultiprocessorCount, dev) != hipSuccess) { grid = -1; return; }
        bool okattr = true;
        if constexpr (FUSED) okattr = hipFuncSetAttribute((const void*)mk_fwd<true, -1>, hipFuncAttributeMaxDynamicSharedMemorySize, LDS_BYTES) == hipSuccess;
        else { okattr &= set_lds<0>(); okattr &= set_lds<1>(); okattr &= set_lds<2>(); okattr &= set_lds<3>(); okattr &= set_lds<4>(); okattr &= set_lds<5>(); okattr &= set_lds<6>(); okattr &= set_lds<7>(); okattr &= set_lds<8>(); }
        if (!okattr) { fprintf(stderr, "kernel_launch: hipFuncSetAttribute failed\n"); grid = -1; return; }
        if (hipOccupancyMaxActiveBlocksPerMultiprocessor(&per_cu, (const void*)mk_fwd<FUSED, (FUSED ? -1 : 2)>, NWAVES * 64, LDS_BYTES) != hipSuccess || per_cu < 1) { fprintf(stderr, "kernel_launch: occupancy query says %d blocks per CU; nothing launched\n", per_cu); grid = -1; return; }
        (void)hipGetLastError();
        grid = cus;
        if (grid != 256) fprintf(stderr, "kernel_launch: note: %d CUs (built for 256)\n", grid);
    }
    if (grid < 0) return;
    Args a{};
    for (int i = 0; i < 20; ++i) a.in[i] = (const float*)d_in[i];
    a.out = (float*)d_out; a.ws = (unsigned char*)d_ws;
    if constexpr (FUSED) {
        a.ph_lo = 0; a.ph_hi = NPHASE;
        if (hipMemsetAsync((char*)d_ws + WS_CTL, 0, 128 * 1024, stream) != hipSuccess) { fprintf(stderr, "kernel_launch: memset of the barrier words failed\n"); return; }
        void* kargs[] = {&a};
        hipError_t e;
        if (MK_COOP_LAUNCH) e = hipLaunchCooperativeKernel((const void*)mk_fwd<true, -1>, dim3(grid), dim3(NWAVES * 64), kargs, LDS_BYTES, stream);
        else { hipLaunchKernelGGL((mk_fwd<true, -1>), dim3(grid), dim3(NWAVES * 64), LDS_BYTES, stream, a); e = hipPeekAtLastError(); }
        if (e != hipSuccess) fprintf(stderr, "kernel_launch: launch failed: %s (grid %d)\n", hipGetErrorString(e), grid);
    } else {
        a.ph_lo = 0; a.ph_hi = NPHASE;
        launch_one<0>(grid, stream, a); launch_one<1>(grid, stream, a); launch_one<2>(grid, stream, a); launch_one<3>(grid, stream, a); launch_one<4>(grid, stream, a);
        launch_one<5>(grid, stream, a); launch_one<6>(grid, stream, a); launch_one<7>(grid, stream, a); launch_one<8>(grid, stream, a);
    }
}
```
